# Optimizing an MI355X kernel written in HIP

```python
import math
import jax, jax.numpy as jnp
from jax import lax
import numpy as np

D_MODEL = 2048
BATCH = 8
SEQ = 2048
DEPTH = 2

N_MIXERS = 2
NSA_HEADS = 16
NSA_KV_GROUPS = 4
NSA_HEAD_DIM = D_MODEL // NSA_HEADS
CMP_BLOCK = 32
CMP_STRIDE = 16
SEL_BLOCK = 64
SEL_TOP_N = 8
WINDOW = 512
Q_BLOCK = 128
SEL_Q_BLOCK = 32
FORCE_SCORE = 1.0e4
HGRN_HEADS = 16
HGRN_KDIM = D_MODEL // HGRN_HEADS
HGRN_VDIM = D_MODEL // HGRN_HEADS
HGRN_CHUNK = 64
D_FF = 4 * D_MODEL
REL_BUCKETS = 32
REL_MAX_DIST = 128
RMS_EPS = 1e-6
NEG_INF = -1.0e30

kernel_name = "nsa_hgrn2_interleaved_trunk"


def rmsnorm(x, g):
    x32 = x.astype(jnp.float32)
    y = x32 * lax.rsqrt(jnp.mean(x32 * x32, axis=-1, keepdims=True) + RMS_EPS)
    return (y * g.astype(jnp.float32)).astype(x.dtype)


def rel_bucket(dist):
    n = jnp.maximum(dist, 0)
    max_exact = REL_BUCKETS // 2
    nf = jnp.maximum(n, 1).astype(jnp.float32)
    large = max_exact + (jnp.log(nf / max_exact) / math.log(REL_MAX_DIST / max_exact)
                         * (REL_BUCKETS - max_exact)).astype(jnp.int32)
    large = jnp.minimum(large, REL_BUCKETS - 1)
    return jnp.where(n < max_exact, n, large)


def compress_blocks(kraw, pe, w1, w2):
    B, S, G, Dh = kraw.shape
    ratio = CMP_BLOCK // CMP_STRIDE
    nh = S // CMP_STRIDE
    nc = nh - ratio + 1
    half = kraw.reshape(B, nh, CMP_STRIDE, G, Dh)
    blocks = jnp.concatenate([half[:, j:j + nc] for j in range(ratio)], axis=2)
    blocks = blocks + pe[:, None, :]
    flat = blocks.transpose(0, 1, 3, 2, 4).reshape(B, nc, G, CMP_BLOCK * Dh)
    return jax.nn.gelu(flat @ w1) @ w2


def nsa_mixer(h, w_in, cmp_pe, cmp_w1, cmp_w2, w_out, rel_table):
    B, S, _ = h.shape
    H, G, Dh = NSA_HEADS, NSA_KV_GROUPS, NSA_HEAD_DIM
    R = H // G
    dt = h.dtype
    proj = h @ w_in
    sizes = [H * Dh] + [G * Dh] * 6 + [3 * H]
    q, kc, vc, ks, vs, kw, vw, gl = jnp.split(proj, [int(v) for v in np.cumsum(sizes)[:-1]], axis=-1)
    q = q.reshape(B, S, G, R, Dh) * jnp.asarray(Dh ** -0.5, dt)
    kc, vc, ks, vs, kw, vw = [a.reshape(B, S, G, Dh) for a in (kc, vc, ks, vs, kw, vw)]
    gates = jax.nn.sigmoid(gl.astype(jnp.float32)).astype(dt).reshape(B, S, 3, G, R)
    pos = jnp.arange(S, dtype=jnp.int32)

    k_cmp = compress_blocks(kc, cmp_pe[0], cmp_w1[0], cmp_w2[0])
    v_cmp = compress_blocks(vc, cmp_pe[1], cmp_w1[1], cmp_w2[1])
    nc = k_cmp.shape[1]
    c_start = jnp.arange(nc, dtype=jnp.int32) * CMP_STRIDE
    c_end = c_start + CMP_BLOCK - 1
    dist_c = pos[:, None] - c_end[None, :]
    valid_c = dist_c >= 0
    bias_c = rel_table[rel_bucket(dist_c)].reshape(S, nc, G, R).transpose(2, 3, 0, 1)
    logit_c = jnp.einsum('bsgrd,bcgd->bgrsc', q, k_cmp).astype(jnp.float32) + bias_c
    logit_c = jnp.where(valid_c, logit_c, NEG_INF)
    any_c = jnp.any(valid_c, axis=-1).astype(jnp.float32)[:, None]
    p_c = jax.nn.softmax(logit_c, axis=-1) * any_c
    o_c = jnp.einsum('bgrsc,bcgd->bsgrd', p_c.astype(dt), v_cmp)

    nb = S // SEL_BLOCK
    jb = jnp.arange(nb, dtype=jnp.int32)
    b_start = jb * SEL_BLOCK
    overlap = ((c_start[:, None] <= b_start[None, :] + SEL_BLOCK - 1)
               & (c_end[:, None] >= b_start[None, :])).astype(jnp.float32)
    imp = jnp.einsum('bgrsc,cn->bgsn', p_c, overlap)
    q_blk = pos // SEL_BLOCK
    forced = (jb[None, :] == 0) | (jb[None, :] == q_blk[:, None]) | (jb[None, :] == q_blk[:, None] - 1)
    future = jb[None, :] > q_blk[:, None]
    imp = jnp.where(forced, FORCE_SCORE, jnp.where(future, -1.0, imp))
    n_sel = min(SEL_TOP_N, nb)
    _, sel_idx = lax.top_k(imp, n_sel)

    k_blk = ks.reshape(B, nb, SEL_BLOCK, G, Dh).transpose(0, 3, 1, 2, 4)
    v_blk = vs.reshape(B, nb, SEL_BLOCK, G, Dh).transpose(0, 3, 1, 2, 4)
    nqc = S // SEL_Q_BLOCK
    q_ch = q.reshape(B, nqc, SEL_Q_BLOCK, G, R, Dh).transpose(1, 0, 2, 3, 4, 5)
    idx_ch = sel_idx.reshape(B, G, nqc, SEL_Q_BLOCK, n_sel).transpose(2, 0, 1, 3, 4)
    t_ch = pos.reshape(nqc, SEL_Q_BLOCK)
    table_g = rel_table.reshape(REL_BUCKETS, G, R).transpose(1, 0, 2)
    bi = jnp.arange(B)[:, None, None, None]
    gi = jnp.arange(G)[None, :, None, None]
    gi5 = jnp.arange(G)[None, :, None, None, None]
    offs = jnp.arange(SEL_BLOCK, dtype=jnp.int32)

    def sel_step(args):
        qc, ic, tc = args
        kb = k_blk[bi, gi, ic]
        vb = v_blk[bi, gi, ic]
        kpos = ic[..., None] * SEL_BLOCK + offs
        dist = tc[None, None, :, None, None] - kpos
        bias = table_g[gi5, rel_bucket(dist)].transpose(0, 1, 5, 2, 3, 4)
        logit = jnp.einsum('btgrd,bgtnld->bgrtnl', qc, kb).astype(jnp.float32) + bias
        logit = jnp.where((dist >= 0)[:, :, None], logit, NEG_INF)
        sh = logit.shape
        p = jax.nn.softmax(logit.reshape(sh[:4] + (-1,)), axis=-1).reshape(sh)
        return jnp.einsum('bgrtnl,bgtnld->btgrd', p.astype(dt), vb)

    o_s = lax.map(sel_step, (q_ch, idx_ch, t_ch))
    o_s = o_s.transpose(1, 0, 2, 3, 4, 5).reshape(B, S, G, R, Dh)

    nqb = S // Q_BLOCK
    span = WINDOW + Q_BLOCK
    kw_p = jnp.pad(kw, ((0, 0), (WINDOW, 0), (0, 0), (0, 0)))
    vw_p = jnp.pad(vw, ((0, 0), (WINDOW, 0), (0, 0), (0, 0)))
    q_wb = q.reshape(B, nqb, Q_BLOCK, G, R, Dh).transpose(1, 0, 2, 3, 4, 5)

    def win_step(args):
        qb, c = args
        start = c * Q_BLOCK
        kb = lax.dynamic_slice_in_dim(kw_p, start, span, axis=1)
        vb = lax.dynamic_slice_in_dim(vw_p, start, span, axis=1)
        tq = start + jnp.arange(Q_BLOCK, dtype=jnp.int32)
        kp = start - WINDOW + jnp.arange(span, dtype=jnp.int32)
        dist = tq[:, None] - kp[None, :]
        valid = (dist >= 0) & (dist < WINDOW) & (kp[None, :] >= 0)
        bias = rel_table[rel_bucket(dist)].reshape(Q_BLOCK, span, G, R).transpose(2, 3, 0, 1)
        logit = jnp.einsum('btgrd,bsgd->bgrts', qb, kb).astype(jnp.float32) + bias
        logit = jnp.where(valid, logit, NEG_INF)
        p = jax.nn.softmax(logit, axis=-1)
        return jnp.einsum('bgrts,bsgd->btgrd', p.astype(dt), vb)

    o_w = lax.map(win_step, (q_wb, jnp.arange(nqb, dtype=jnp.int32)))
    o_w = o_w.transpose(1, 0, 2, 3, 4, 5).reshape(B, S, G, R, Dh)

    o = (gates[:, :, 0, :, :, None] * o_c + gates[:, :, 1, :, :, None] * o_s
         + gates[:, :, 2, :, :, None] * o_w)
    return o.reshape(B, S, H * Dh) @ w_out


def hgrn2_mixer(h, w_in, lb, onorm_g, w_out):
    B, S, D = h.shape
    H, dk, dv, C = HGRN_HEADS, HGRN_KDIM, HGRN_VDIM, HGRN_CHUNK
    dt = h.dtype
    proj = h @ w_in
    q, f, i, g = jnp.split(proj, 4, axis=-1)
    q = jax.nn.silu(q.astype(jnp.float32))
    f32 = f.astype(jnp.float32)
    lb = lb.astype(jnp.float32)
    log_f = jnp.logaddexp(jnp.log(lb), jnp.log1p(-lb) + jax.nn.log_sigmoid(f32))
    k = (1.0 - lb) * jax.nn.sigmoid(-f32)
    v = i.astype(jnp.float32)
    nch = S // C

    def to_chunks(a, d):
        return a.reshape(B, nch, C, H, d).transpose(1, 0, 3, 2, 4)

    qc_all, kc_all, vc_all = to_chunks(q, dk), to_chunks(k, dk), to_chunks(v, dv)
    b_all = jnp.cumsum(to_chunks(log_f, dk), axis=3)
    causal = jnp.tril(jnp.ones((C, C), dtype=bool))

    def step(state, args):
        qc, kc, vc, bc = args
        bl = bc[:, :, -1:, :]
        inter = jnp.einsum('bhtk,bhkv->bhtv', qc * jnp.exp(bc), state)
        decay = jnp.exp(jnp.where(causal[:, :, None],
                                  bc[:, :, :, None, :] - bc[:, :, None, :, :], -jnp.inf))
        a = jnp.einsum('bhtk,bhtsk,bhsk->bhts', qc, decay, kc)
        o = inter + jnp.einsum('bhts,bhsv->bhtv', a, vc)
        new_state = (jnp.exp(bl[:, :, 0, :, None]) * state
                     + jnp.einsum('bhsk,bhsv->bhkv', kc * jnp.exp(bl - bc), vc))
        return new_state, o

    s0 = jnp.zeros((B, H, dk, dv), jnp.float32)
    _, o = lax.scan(step, s0, (qc_all, kc_all, vc_all, b_all))
    o = o.transpose(1, 0, 3, 2, 4).reshape(B, S, H, dv)
    o = o * lax.rsqrt(jnp.mean(o * o, axis=-1, keepdims=True) + RMS_EPS)
    o = o.reshape(B, S, D) * onorm_g.astype(jnp.float32)
    o = o * jax.nn.silu(g.astype(jnp.float32))
    return o.astype(dt) @ w_out


def setup_inputs(seed: int = 0) -> dict:
    key = jax.random.key(seed)
    ks = jax.random.split(key, 16)
    n_a = (DEPTH + 1) // 2
    n_b = DEPTH // 2
    H, G, Dh = NSA_HEADS, NSA_KV_GROUPS, NSA_HEAD_DIM
    nsa_in = H * Dh + 6 * G * Dh + 3 * H
    nrm = lambda k, shape, fan: jax.random.normal(k, shape, jnp.float32) * (fan ** -0.5)
    return {
        "x": jax.random.normal(ks[0], (BATCH, SEQ, D_MODEL), jnp.float32),
        "norm_g": 1.0 + 0.02 * jax.random.normal(ks[1], (DEPTH, 4, D_MODEL), jnp.float32),
        "rel_table": 0.5 * jax.random.normal(ks[2], (REL_BUCKETS, NSA_HEADS), jnp.float32),
        "nsa_w_in": nrm(ks[3], (n_a, D_MODEL, nsa_in), D_MODEL),
        "nsa_cmp_pe": 0.1 * jax.random.normal(ks[4], (n_a, 2, CMP_BLOCK, Dh), jnp.float32),
        "nsa_cmp_w1": nrm(ks[5], (n_a, 2, CMP_BLOCK * Dh, Dh), CMP_BLOCK * Dh),
        "nsa_cmp_w2": nrm(ks[6], (n_a, 2, Dh, Dh), Dh),
        "nsa_w_out": nrm(ks[7], (n_a, H * Dh, D_MODEL), H * Dh),
        "hgrn_w_in": nrm(ks[8], (n_b, D_MODEL, 4 * D_MODEL), D_MODEL),
        "hgrn_lb": 0.1 * jax.random.normal(ks[9], (DEPTH, D_MODEL), jnp.float32),
        "hgrn_onorm": 1.0 + 0.02 * jax.random.normal(ks[10], (n_b, D_MODEL), jnp.float32),
        "hgrn_w_out": nrm(ks[11], (n_b, D_MODEL, D_MODEL), D_MODEL),
        "mlp_w_up": nrm(ks[12], (DEPTH, D_MODEL, D_FF), D_MODEL),
        "mlp_w_down": nrm(ks[13], (DEPTH, D_FF, D_MODEL), D_FF),
    }


def reference(x, norm_g, rel_table, nsa_w_in, nsa_cmp_pe, nsa_cmp_w1, nsa_cmp_w2, nsa_w_out,
              hgrn_w_in, hgrn_lb, hgrn_onorm, hgrn_w_out, mlp_w_up, mlp_w_down):
    lbs = jnp.cumsum(jax.nn.softmax(hgrn_lb.astype(jnp.float32), axis=0), axis=0)
    lbs = lbs - lbs[0:1]
    for layer in range(DEPTH):
        j = layer // N_MIXERS
        hn = rmsnorm(x, norm_g[layer, 0])
        if layer % N_MIXERS == 0:
            y = nsa_mixer(hn, nsa_w_in[j], nsa_cmp_pe[j], nsa_cmp_w1[j], nsa_cmp_w2[j],
                          nsa_w_out[j], rel_table)
        else:
            y = hgrn2_mixer(hn, hgrn_w_in[j], lbs[layer], hgrn_onorm[j], hgrn_w_out[j])
        x = x + rmsnorm(y, norm_g[layer, 1])
        hn = rmsnorm(x, norm_g[layer, 2])
        y = jnp.square(jax.nn.relu(hn @ mlp_w_up[layer])) @ mlp_w_down[layer]
        x = x + rmsnorm(y, norm_g[layer, 3])
    return x
```

```cpp
#include <hip/hip_runtime.h>
#include <cstdio>
#include <cstdint>
namespace pg8 {
#define PG8_LAS __attribute__((address_space(3)))
typedef unsigned short bf16_t;
typedef short bf16x8 __attribute__((ext_vector_type(8)));
typedef float f32x4 __attribute__((ext_vector_type(4)));
typedef unsigned u32x4 __attribute__((ext_vector_type(4)));
constexpr int BM = 256, BK = 64, HALF = 128, HTB = HALF * BK * 2  , STAGE_BYTES = 8 * HTB, NXCD = 8, WGM = 4;

__host__ __device__ __forceinline__ int lds_byte(int r, int c) { const int st = (r >> 4) * 2 + (c >> 5), rr = r & 15, cc = c & 31, ob = rr * 64 + cc * 2; return st * 1024 + (ob ^ (((ob >> 9) & 1) << 5)); }
__host__ __device__ __forceinline__ void stage_rc(int b, int& R, int& C) { const int st = b / 1024, sb = b % 1024, swz = sb ^ (((sb >> 9) & 1) << 5); R = (st >> 1) * 16 + swz / 64; C = (st & 1) * 32 + (swz % 64) / 2; }
__host__ __device__ __forceinline__ int perm32(int rho) { const int n = rho >> 4, i = rho & 15; return 8 * (i >> 2) + 4 * n + (i & 3); }

typedef int i32x4 __attribute__((ext_vector_type(4)));
typedef int i32x8 __attribute__((ext_vector_type(8)));
struct Unit { int pm, pn; };
struct Gemm { const bf16_t* A; const bf16_t* Bt; int M, N, K; };

struct StaticOrder {
    int nM, nN, nwg, G, c;
    __host__ __device__ void init(int M, int N, int G_, int c_) { nM = M / BM; nN = N / BM; nwg = nM * nN; G = G_; c = c_; }
    __host__ __device__ bool next(int i, Unit& u) const {
        const long L = (long)i * G + c; if (L >= nwg) return false;
        int wgid = (int)L; { const int q = nwg / NXCD, r = nwg % NXCD, xcd = wgid % NXCD, off = wgid / NXCD; wgid = (xcd < r ? xcd * (q + 1) : r * (q + 1) + (xcd - r) * q) + off; }
        const int nig = WGM * nN, gid = wgid / nig, fm = gid * WGM, gsz = (nM - fm) < WGM ? (nM - fm) : WGM;
        u.pm = fm + ((wgid % nig) % gsz); u.pn = (wgid % nig) / gsz; return true;
    }
    __device__ __forceinline__ void a_ready(const Unit&) const {}
    __device__ __forceinline__ void done(const Unit&) const {}
};

__device__ __forceinline__ unsigned cvt_pk_bf16(float lo, float hi) { unsigned r; asm volatile("v_cvt_pk_bf16_f32 %0, %1, %2" : "=v"(r) : "v"(lo), "v"(hi)); return r; }
typedef float f32x2 __attribute__((ext_vector_type(2)));
__device__ __forceinline__ f32x2 gelu_pk(f32x2 v) {
    const f32x2 av = __builtin_elementwise_abs(v), d = av * 0.2316418882f + 1.0f;
    f32x2 t; t.x = __builtin_amdgcn_rcpf(d.x); t.y = __builtin_amdgcn_rcpf(d.y);
    f32x2 q = t * 0.5307027145f + (-0.7265760135f); q = q * t + 0.7107068705f; q = q * t + (-0.142248368f); q = q * t + 0.127414796f; q = q * t;
    const f32x2 s = (v * v) * (-0.72134752044f);
    f32x2 e; e.x = __builtin_amdgcn_exp2f(s.x); e.y = __builtin_amdgcn_exp2f(s.y);
    const f32x2 m = v * (q * e), r = v - m;
    f32x2 o; o.x = v.x < 0.f ? m.x : r.x; o.y = v.y < 0.f ? m.y : r.y; return o;
}

template <int ACT  > struct EpiBf16 {
    static constexpr bool PERM = true, AFTER_DRAIN = false; static_assert(ACT == 0 || ACT == 1, "EpiBf16: ACT is 0 (none) or 1 (gelu_pk)");
    bf16_t* O; int ldc; const float* bias; int split_cols; size_t split_stride; float scale0;
    __device__ __forceinline__ void operator()(const f32x4 (&acc)[2][2][4][2], const Unit& u, int wr, int wc, int fr, int fq) const {
        const int row0 = u.pm * BM + wr * 64 + fr; int colt = u.pn * BM; bf16_t* base = O;
        float sc = 1.f; if (split_cols) { const int t = colt / split_cols; base += (size_t)t * split_stride; colt -= t * split_cols; if (t == 0) sc = scale0; }
        const int col0 = colt + wc * 32 + 8 * fq, bcol0 = u.pn * BM + wc * 32 + 8 * fq;
        f32x4 bv[2][2];
#pragma unroll
        for (int bj = 0; bj < 2; ++bj)
#pragma unroll
            for (int n = 0; n < 2; ++n) bv[bj][n] = bias ? *(const f32x4*)(bias + bcol0 + bj * HALF + 4 * n) : (f32x4){0.f, 0.f, 0.f, 0.f};
#pragma unroll
        for (int ai = 0; ai < 2; ++ai)
#pragma unroll
            for (int m = 0; m < 4; ++m) { bf16_t* rowp = base + (size_t)(row0 + ai * HALF + m * 16) * ldc + col0;
#pragma unroll
                for (int bj = 0; bj < 2; ++bj) { f32x4 v0 = acc[ai][bj][m][0] + bv[bj][0], v1 = acc[ai][bj][m][1] + bv[bj][1];
                    if (ACT == 1) { f32x2 a = gelu_pk((f32x2){v0[0], v0[1]}), b = gelu_pk((f32x2){v0[2], v0[3]}), c = gelu_pk((f32x2){v1[0], v1[1]}), d = gelu_pk((f32x2){v1[2], v1[3]});
                        v0 = (f32x4){a.x, a.y, b.x, b.y}; v1 = (f32x4){c.x, c.y, d.x, d.y}; }
                    v0 = v0 * sc; v1 = v1 * sc; u32x4 w; w.x = cvt_pk_bf16(v0[0], v0[1]); w.y = cvt_pk_bf16(v0[2], v0[3]); w.z = cvt_pk_bf16(v1[0], v1[1]); w.w = cvt_pk_bf16(v1[2], v1[3]);
                    *(u32x4*)(rowp + bj * HALF) = w; } }
    }
};
__device__ __forceinline__ void mfma_f8(f32x4& c, const i32x8 a, const i32x8 b) { asm volatile("s_nop 1\n\tv_mfma_f32_16x16x128_f8f6f4 %0, %1, %2, %0" : "+v"(c) : "v"(a), "v"(b)); }
template <class Epi, class Sched, bool ALIGN_EPI = false, bool SP2 = false, bool F8 = false>
__device__ __forceinline__ void gemm_phase(PG8_LAS unsigned char* lds, const Gemm g, const Sched& S, const Epi& E, const int tid) {
    const int wid = __builtin_amdgcn_readfirstlane(tid >> 6), lane = tid & 63, wr = wid >> 2, wc = wid & 3, fr = lane & 15, fq = lane >> 4;
    const int K = g.K, nt = K / BK;
    unsigned voffA[2], voffB[2];
#pragma unroll
    for (int i = 0; i < 2; ++i) { int R, C; stage_rc(tid * 16 + i * 8192, R, C); const int Rb = Epi::PERM ? ((R & ~31) + perm32(R & 31)) : R;
        voffA[i] = (unsigned)(R * K + C) * 2u; voffB[i] = (unsigned)(Rb * K + C) * 2u; }
    const size_t kstep = (size_t)(BK * 2);
    const size_t hstep = (size_t)HALF * K * 2;
    const size_t tstep = 2 * hstep;
    const unsigned ldsw = (unsigned)wid * 1024u;
    const int aoff = lds_byte(wr * 64 + fr, fq * 8), boff = lds_byte(wc * 32 + fr, fq * 8);
#define PG8_SA(b, h) (((b) * 2 + (h)) * HTB)
#define PG8_SB(b, h) ((4 + (b) * 2 + (h)) * HTB)
#define PG8_STAGE(bufoff, gbase, voff) do { _Pragma("unroll") for (int _i = 0; _i < 2; ++_i) \
        __builtin_amdgcn_global_load_lds((const unsigned*)((const char*)(gbase) + (voff)[_i]), (PG8_LAS unsigned*)(lds + (bufoff) + ldsw + _i * 8192), 16, 0, 0); } while (0)
#define PG8_LDA(dst, b, h) do { _Pragma("unroll") for (int m = 0; m < 4; ++m) _Pragma("unroll") for (int k = 0; k < 2; ++k) dst[m][k] = *(const PG8_LAS bf16x8*)(lds + PG8_SA(b, h) + aoff + m * 2048 + k * 1024); } while (0)
#define PG8_LDB(dst, b, h) do { _Pragma("unroll") for (int n = 0; n < 2; ++n) _Pragma("unroll") for (int k = 0; k < 2; ++k) dst[n][k] = *(const PG8_LAS bf16x8*)(lds + PG8_SB(b, h) + boff + n * 2048 + k * 1024); } while (0)
#define PG8_CAT8(x) __builtin_shufflevector(__builtin_bit_cast(i32x4, (x)[0]), __builtin_bit_cast(i32x4, (x)[1]), 0, 1, 2, 3, 4, 5, 6, 7)
#define PG8_MMA(ai, bj, At, Bt) do { __builtin_amdgcn_s_setprio(1); _Pragma("unroll") for (int m = 0; m < 4; ++m) _Pragma("unroll") for (int n = 0; n < 2; ++n) { \
        if constexpr (F8) mfma_f8(acc[ai][bj][m][n], PG8_CAT8(Bt[n]), PG8_CAT8(At[m])); \
        else { _Pragma("unroll") for (int k = 0; k < 2; ++k) acc[ai][bj][m][n] = __builtin_amdgcn_mfma_f32_16x16x32_bf16(Bt[n][k], At[m][k], acc[ai][bj][m][n], 0, 0, 0); } } __builtin_amdgcn_s_setprio(0); } while (0)
#define PG8_WAIT_V(n) asm volatile("s_waitcnt vmcnt(" #n ")" ::: "memory")
#define PG8_WAIT_L(n) asm volatile("s_waitcnt lgkmcnt(" #n ")" ::: "memory")
#define PG8_BAR __builtin_amdgcn_s_barrier()
#define PG8_SCHED __builtin_amdgcn_sched_barrier(0)
    Unit cur, nxt; int ui = 0;
    if (!S.next(0, cur)) return;
    float epre[8]; E.prefetch(cur, wr, fr, epre);
    f32x4 acc[2][2][4][2];
#pragma unroll
    for (int a = 0; a < 2; ++a)
#pragma unroll
        for (int b = 0; b < 2; ++b)
#pragma unroll
            for (int m = 0; m < 4; ++m)
#pragma unroll
                for (int n = 0; n < 2; ++n) acc[a][b][m][n] = (f32x4){0.f, 0.f, 0.f, 0.f};
    bf16x8 At[4][2], B0[2][2], B1[2][2];
    const char* cA = (const char*)g.A + (size_t)cur.pm * tstep; const char* cB = (const char*)g.Bt + (size_t)cur.pn * tstep;
    S.a_ready(cur);
    if constexpr (SP2) {
        PG8_STAGE(PG8_SB(0, 0), cB, voffB); PG8_STAGE(PG8_SB(0, 1), cB + hstep, voffB); PG8_STAGE(PG8_SA(0, 0), cA, voffA); PG8_STAGE(PG8_SA(0, 1), cA + hstep, voffA);
        if (wr == 1) PG8_BAR;
        PG8_WAIT_V(2); PG8_BAR;
        PG8_STAGE(PG8_SB(1, 0), cB + kstep, voffB); PG8_STAGE(PG8_SB(1, 1), cB + hstep + kstep, voffB);
        PG8_WAIT_V(4); PG8_BAR;
    } else {
        PG8_STAGE(PG8_SB(0, 0), cB, voffB); PG8_STAGE(PG8_SA(0, 0), cA, voffA); PG8_STAGE(PG8_SB(0, 1), cB + hstep, voffB); PG8_STAGE(PG8_SA(0, 1), cA + hstep, voffA);
        if (wr == 1) PG8_BAR;
        PG8_WAIT_V(4); PG8_BAR;
        PG8_STAGE(PG8_SB(1, 0), cB + kstep, voffB); PG8_STAGE(PG8_SA(1, 0), cA + kstep, voffA); PG8_STAGE(PG8_SB(1, 1), cB + hstep + kstep, voffB);
        PG8_WAIT_V(6); PG8_BAR;
    }
    for (;;) {
        const bool has_next = S.next(ui + 1, nxt);
        const char* nA = has_next ? (const char*)g.A + (size_t)nxt.pm * tstep : cA; const char* nB = has_next ? (const char*)g.Bt + (size_t)nxt.pn * tstep : cB;
        for (int t = 0; t < nt; t += 2) {
            const bool last = (t == nt - 2);
            const char* a1 = cA + (size_t)(t + 1) * kstep;
            const char* a2 = last ? nA : cA + (size_t)(t + 2) * kstep; const char* b2 = last ? nB : cB + (size_t)(t + 2) * kstep;
            const char* a3 = a2 + kstep; const char* b3 = b2 + kstep;
            if (last && has_next) S.a_ready(nxt);
            if constexpr (SP2) {
            PG8_LDB(B0, 0, 0); PG8_LDB(B1, 0, 1); PG8_SCHED; PG8_LDA(At, 0, 0); PG8_STAGE(PG8_SA(1, 0), a1, voffA); PG8_STAGE(PG8_SA(1, 1), a1 + hstep, voffA);
            PG8_WAIT_V(8); PG8_WAIT_L(0); PG8_BAR; PG8_MMA(0, 0, At, B0); PG8_MMA(0, 1, At, B1); PG8_BAR; PG8_SCHED;
            PG8_LDA(At, 0, 1); PG8_STAGE(PG8_SB(0, 0), b2, voffB); PG8_STAGE(PG8_SB(0, 1), b2 + hstep, voffB);
            PG8_WAIT_V(6); PG8_WAIT_L(0); PG8_BAR; PG8_MMA(1, 0, At, B0); PG8_MMA(1, 1, At, B1); PG8_BAR; PG8_SCHED;
            PG8_LDB(B0, 1, 0); PG8_LDB(B1, 1, 1); PG8_SCHED; PG8_LDA(At, 1, 0); PG8_STAGE(PG8_SA(0, 0), a2, voffA); PG8_STAGE(PG8_SA(0, 1), a2 + hstep, voffA);
            PG8_WAIT_V(8); PG8_WAIT_L(0); PG8_BAR; PG8_MMA(0, 0, At, B0); PG8_MMA(0, 1, At, B1); PG8_BAR; PG8_SCHED;
            PG8_LDA(At, 1, 1); PG8_STAGE(PG8_SB(1, 0), b3, voffB); PG8_STAGE(PG8_SB(1, 1), b3 + hstep, voffB);
            PG8_WAIT_V(6); PG8_WAIT_L(0); PG8_BAR; PG8_MMA(1, 0, At, B0); PG8_MMA(1, 1, At, B1); PG8_BAR; PG8_SCHED;
            } else {
            PG8_LDB(B0, 0, 0); PG8_SCHED; PG8_LDA(At, 0, 0); PG8_STAGE(PG8_SA(1, 1), a1 + hstep, voffA);
            PG8_WAIT_L(8); PG8_BAR; PG8_WAIT_L(0); PG8_MMA(0, 0, At, B0); PG8_BAR; PG8_SCHED;
            PG8_LDB(B1, 0, 1); PG8_STAGE(PG8_SB(0, 0), b2, voffB);
            PG8_BAR; PG8_WAIT_L(0); PG8_MMA(0, 1, At, B1); PG8_BAR;
            PG8_LDA(At, 0, 1); PG8_STAGE(PG8_SA(0, 0), a2, voffA);
            PG8_BAR; PG8_WAIT_L(0); PG8_MMA(1, 0, At, B0); PG8_BAR; PG8_SCHED;
            PG8_STAGE(PG8_SB(0, 1), b2 + hstep, voffB);
            PG8_WAIT_V(6); PG8_BAR; PG8_MMA(1, 1, At, B1); PG8_BAR;
            PG8_LDB(B0, 1, 0); PG8_SCHED; PG8_LDA(At, 1, 0); PG8_STAGE(PG8_SA(0, 1), a2 + hstep, voffA);
            PG8_WAIT_L(8); PG8_BAR; PG8_WAIT_L(0); PG8_MMA(0, 0, At, B0); PG8_BAR; PG8_SCHED;
            PG8_LDB(B1, 1, 1); PG8_STAGE(PG8_SB(1, 0), b3, voffB);
            PG8_BAR; PG8_WAIT_L(0); PG8_MMA(0, 1, At, B1); PG8_BAR;
            PG8_LDA(At, 1, 1); PG8_STAGE(PG8_SA(1, 0), a3, voffA);
            PG8_BAR; PG8_WAIT_L(0); PG8_MMA(1, 0, At, B0); PG8_BAR; PG8_SCHED;
            PG8_STAGE(PG8_SB(1, 1), b3 + hstep, voffB);
            PG8_WAIT_V(6); PG8_BAR; PG8_MMA(1, 1, At, B1); PG8_BAR;
            }
        }
        if constexpr (F8) { asm volatile("s_nop 15"); PG8_SCHED; }
        if constexpr (ALIGN_EPI) { if (wr == 0) PG8_BAR; }
        if constexpr (!Epi::AFTER_DRAIN) { E(acc, cur, wr, wc, fr, fq, epre); S.done(cur); }
        if (!has_next) break;
#pragma unroll
        for (int a = 0; a < 2; ++a)
#pragma unroll
            for (int b = 0; b < 2; ++b)
#pragma unroll
                for (int m = 0; m < 4; ++m)
#pragma unroll
                    for (int n = 0; n < 2; ++n) acc[a][b][m][n] = (f32x4){0.f, 0.f, 0.f, 0.f};
        cur = nxt; cA = nA; cB = nB; ++ui;
        E.prefetch(cur, wr, fr, epre);
        if constexpr (ALIGN_EPI) { if (wr == 1) PG8_BAR; }
    }
    PG8_WAIT_V(0);
    if constexpr (!ALIGN_EPI) { if (wr == 0) PG8_BAR; }
    PG8_BAR;
    if constexpr (Epi::AFTER_DRAIN) { E.fused(acc, cur, wr, wc, fr, fq, lds, wid, lane); S.done(cur); }
#undef PG8_SA
#undef PG8_SB
#undef PG8_STAGE
#undef PG8_LDA
#undef PG8_LDB
#undef PG8_MMA
#undef PG8_CAT8
#undef PG8_WAIT_V
#undef PG8_WAIT_L
#undef PG8_BAR
#undef PG8_SCHED
}
}

constexpr int NWAVES = 8, NTHREADS = 512;
constexpr int BATCH = 8, SEQ = 2048, DM = 2048, M = BATCH * SEQ, NH = 16, NG = 4, NR = 4, HD = 128, FF = 8192;
constexpr int NQKV = 5120, NSA_IN = 5168, NC = 127, NCP = 128, NBLK = 32, NGATE = 48;
constexpr float RMS_EPS = 1e-6f;
constexpr int COL_KC = 2048, COL_VC = 2560, COL_KS = 3072, COL_VS = 3584, COL_KW = 4096, COL_VW = 4608;
constexpr float QSCALE = 0.12751743082459868f;

constexpr size_t MiB = 1u << 20;
constexpr size_t WS_CTL = 0, CTL_ZERO_BYTES = 256 * 1024;
constexpr size_t WS_LUT = 1 * MiB, WS_BIAS1 = WS_LUT + 16 * 1024  , WS_LB = WS_BIAS1 + 8192;
constexpr size_t WS_GATES = 2 * MiB;
constexpr size_t WS_KCMP = 5 * MiB, WS_VCMP = 6 * MiB;
constexpr size_t WS_W = 8 * MiB;
constexpr size_t W0_QKV = WS_W, W0_G = WS_W + 20 * MiB, W0_W1 = WS_W + 21 * MiB, W0_W2 = WS_W + 23 * MiB, W0_O = WS_W + 24 * MiB, W0_UP = WS_W + 32 * MiB, W0_DN = WS_W + 64 * MiB;
constexpr size_t W1_IN = WS_W, W1_O = WS_W + 32 * MiB, W1_UP = WS_W + 40 * MiB, W1_DN = WS_W + 72 * MiB;
constexpr size_t WS_A = 120 * MiB;
constexpr size_t WS_BIG = 184 * MiB;
constexpr size_t WS_SCR = 440 * MiB;
constexpr size_t WS_X8 = WS_BIG + 128 * MiB;
constexpr float W8SCALE = 64.f, H8SCALE = 4.f;
constexpr size_t WS_X16 = 440 * MiB;
constexpr size_t WS_RINV = 1 * MiB + 64 * 1024;
constexpr size_t WS_SLOTS = 504 * MiB;
constexpr size_t WS_END = 508 * MiB;
constexpr int CW_XTMO = 64, CW_CONVQ = 128, CW_PANEL = 8192;

constexpr int LDS_BYTES = 147456;

#define GAS __attribute__((address_space(1)))
#define LAS __attribute__((address_space(3)))
typedef unsigned short bf16;
typedef unsigned v4u __attribute__((ext_vector_type(4)));
typedef unsigned v2u __attribute__((ext_vector_type(2)));
typedef float f32x4 __attribute__((ext_vector_type(4)));
#define LDS_WAIT() asm volatile("s_waitcnt lgkmcnt(0)" ::: "memory")
#define VM_WAIT() asm volatile("s_waitcnt vmcnt(0)" ::: "memory")
__device__ __forceinline__ unsigned f2bf(float f) { unsigned u = __builtin_bit_cast(unsigned, f); return (u + 0x7fffu + ((u >> 16) & 1u)) >> 16; }
__device__ __forceinline__ unsigned pk2(float lo, float hi) { return f2bf(lo) | (f2bf(hi) << 16); }
__device__ __forceinline__ float bf2f(unsigned b) { return __builtin_bit_cast(float, b << 16); }
__device__ __forceinline__ float bflo(unsigned w) { return __builtin_bit_cast(float, w << 16); }
__device__ __forceinline__ float bfhi(unsigned w) { return __builtin_bit_cast(float, w & 0xffff0000u); }
__device__ __forceinline__ float wave_sum(float v) {
#pragma unroll
    for (int o = 1; o < 64; o <<= 1) v += __shfl_xor(v, o);
    return v;
}
__device__ __forceinline__ float wave_max(float v) {
#pragma unroll
    for (int o = 1; o < 64; o <<= 1) v = fmaxf(v, __shfl_xor(v, o));
    return v;
}
__device__ __forceinline__ int lane_id() { int l; asm volatile("v_mbcnt_lo_u32_b32 %0, -1, 0\n\tv_mbcnt_hi_u32_b32 %0, -1, %0" : "=v"(l)); return l; }
__device__ __forceinline__ float sigmoidf_(float x) { return 1.f / (1.f + __expf(-x)); }

typedef GAS unsigned gu32;
#define RLX_AGENT __ATOMIC_RELAXED, __HIP_MEMORY_SCOPE_AGENT
#define XB_TMO      128
#define XB_XCNT(j)  (256  + 64 * (j))
#define XB_XSUB(j)  (1280 + 64 * (j))
#define XB_XGEN(j)  (2304 + 64 * (j))
#define XB_TOP      3328
#define XB_TOPGEN   3392
#define XCD_BAR_WORDS 3456
#define XB_SPIN_CAP (1u << 24)

__device__ __forceinline__ unsigned xb_ld(unsigned* p)              { return __hip_atomic_load(p, __ATOMIC_RELAXED, __HIP_MEMORY_SCOPE_AGENT); }
__device__ __forceinline__ unsigned xb_add(unsigned* p, unsigned v) { return __hip_atomic_fetch_add(p, v, __ATOMIC_RELAXED, __HIP_MEMORY_SCOPE_AGENT); }
__device__ __forceinline__ unsigned xb_xcc_id() { return (unsigned)__builtin_amdgcn_s_getreg((3 << 11) | 20) & 0xFu; }
#define XB_SPIN(cond, bar) do { unsigned _sp = 0; while (cond) { __builtin_amdgcn_s_sleep(1); \
    if ((++_sp & 255u) == 0u) { if (xb_ld(&(bar)[XB_TMO])) break; if (_sp > XB_SPIN_CAP) { atomicAdd(&(bar)[XB_TMO], 1u); break; } } } } while (0)

struct XcdBarrier {
    int wave;
    unsigned* bar; unsigned x;
    volatile LAS unsigned* st;
};

__device__ __forceinline__ XcdBarrier xcd_barrier_post(unsigned* bar, volatile LAS unsigned* st, int wave) {
    XcdBarrier b; b.wave = wave; b.bar = bar; b.x = xb_xcc_id(); b.st = st;
    if (wave == 0 && lane_id() == 0) (void)xb_add(&bar[XB_XCNT(b.x)], 1u);
    return b;
}
__device__ __forceinline__ void xcd_barrier_complete(unsigned* bar, unsigned x, unsigned& nloc, unsigned& nx) {
    const unsigned G = gridDim.x * gridDim.y * gridDim.z;
    unsigned sum, cnt, mine, sp = 0u;
    for (;;) {
        sum = 0u; cnt = 0u; mine = 0u;
#pragma unroll
        for (unsigned j = 0; j < 16; ++j) { const unsigned c = xb_ld(&bar[XB_XCNT(j)]); sum += c; cnt += (c > 0u) ? 1u : 0u; mine = (j == x) ? c : mine; }
        if (sum == G) break;
        __builtin_amdgcn_s_sleep(1);
        if ((++sp & 255u) == 0u) { if (xb_ld(&bar[XB_TMO])) break; if (sp > XB_SPIN_CAP) { atomicAdd(&bar[XB_TMO], 1u); break; } }
    }
    nloc = mine > 0u ? mine : 1u; nx = cnt > 0u ? cnt : 1u;
}

__device__ __forceinline__ void xcd_barrier(const XcdBarrier& b) {
    asm volatile("s_waitcnt vmcnt(0)" ::: "memory");
    __syncthreads();
    if (b.wave == 0 && lane_id() == 0) {
        unsigned* bar = b.bar;
        __builtin_amdgcn_s_waitcnt(0);
        unsigned nloc = b.st[0], nx = b.st[1];
        if (nloc == 0u) { xcd_barrier_complete(bar, b.x, nloc, nx); b.st[0] = nloc; b.st[1] = nx; }
        const unsigned old = xb_add(&bar[XB_XSUB(b.x)], 1u);
        const unsigned gen = old / nloc;
        if (old + 1u == (gen + 1u) * nloc) {
            __builtin_amdgcn_fence(__ATOMIC_RELEASE, "agent");
            asm volatile("s_waitcnt vmcnt(0)" ::: "memory");
            const unsigned og = xb_add(&bar[XB_TOP], 1u);
            const unsigned tg = og / nx;
            if (og + 1u == (tg + 1u) * nx) xb_add(&bar[XB_TOPGEN], 1u);
            else XB_SPIN(xb_ld(&bar[XB_TOPGEN]) == tg, bar);
            __builtin_amdgcn_fence(__ATOMIC_ACQUIRE, "agent");
            xb_add(&bar[XB_XGEN(b.x)], 1u);
            asm volatile("s_waitcnt vmcnt(0)" ::: "memory");
        } else {
            XB_SPIN(xb_ld(&bar[XB_XGEN(b.x)]) == gen, bar);
            __builtin_amdgcn_fence(__ATOMIC_ACQUIRE, "agent");
            asm volatile("s_waitcnt vmcnt(0)" ::: "memory");
        }
    }
    __syncthreads();
}

struct Frame {
    LAS unsigned char* lds;
    int tid, lane, wave, G, gw, NGW;
    const float *x, *norm_g, *rel, *w_in, *pe, *cw1, *cw2, *w_out, *h_in, *h_lb, *h_on, *h_out, *up, *dn;
    float* out;
    unsigned char* ws;
};

template <int ACT  > struct EpiAct {
    static constexpr bool PERM = true, AFTER_DRAIN = false;
    bf16* O; int ldc; int scale_tiles; float scale; const float* lb; const float* rs; float rsmul;
    __device__ __forceinline__ void prefetch(const pg8::Unit& u, int wr, int fr, float (&pre)[8]) const {
        const int row0 = u.pm * 256 + wr * 64 + fr;
#pragma unroll
        for (int j = 0; j < 8; ++j) pre[j] = rs ? rs[row0 + (j >> 2) * 128 + (j & 3) * 16] * rsmul : 1.f;
    }
    __device__ __forceinline__ void operator()(const pg8::f32x4 (&acc)[2][2][4][2], const pg8::Unit& u, int wr, int wc, int fr, int fq, const float (&pre)[8]) const {
        const int row0 = u.pm * 256 + wr * 64 + fr, col0 = u.pn * 256 + wc * 32 + 8 * fq;
        const float sc = (u.pn < scale_tiles) ? scale : 1.f;
        const int kind = (ACT == 2) ? ((u.pn < 8 || u.pn >= 24) ? 1 : (u.pn < 16 ? 2 : 0)) : 0;
        pg8::f32x4 lbv[2][2];
        if (ACT == 2) {
#pragma unroll
            for (int bj = 0; bj < 2; ++bj)
#pragma unroll
                for (int n = 0; n < 2; ++n) lbv[bj][n] = (kind == 2) ? *(const pg8::f32x4*)(lb + (col0 - 2048) + bj * 128 + 4 * n) : (pg8::f32x4){0.f, 0.f, 0.f, 0.f};
        }
#pragma unroll
        for (int ai = 0; ai < 2; ++ai)
#pragma unroll
            for (int m = 0; m < 4; ++m) { bf16* rowp = O + (size_t)(row0 + ai * 128 + m * 16) * ldc + col0; const float rsc = pre[ai * 4 + m];
#pragma unroll
                for (int bj = 0; bj < 2; ++bj) { pg8::f32x4 v0 = acc[ai][bj][m][0] * rsc, v1 = acc[ai][bj][m][1] * rsc;
                    if (ACT == 2) {
                        if (kind == 1) {
#pragma unroll
                            for (int j = 0; j < 4; ++j) { v0[j] = v0[j] * __builtin_amdgcn_rcpf(1.f + __expf(-v0[j])); v1[j] = v1[j] * __builtin_amdgcn_rcpf(1.f + __expf(-v1[j])); }
                        } else if (kind == 2) {
#pragma unroll
                            for (int j = 0; j < 4; ++j) { const float l0 = lbv[bj][0][j], l1 = lbv[bj][1][j];
                                v0[j] = __logf(l0 + (1.f - l0) * __builtin_amdgcn_rcpf(1.f + __expf(-v0[j]))); v1[j] = __logf(l1 + (1.f - l1) * __builtin_amdgcn_rcpf(1.f + __expf(-v1[j]))); }
                        }
                    } else { v0 = v0 * sc; v1 = v1 * sc; }
                    pg8::u32x4 w; w.x = pg8::cvt_pk_bf16(v0[0], v0[1]); w.y = pg8::cvt_pk_bf16(v0[2], v0[3]); w.z = pg8::cvt_pk_bf16(v1[0], v1[1]); w.w = pg8::cvt_pk_bf16(v1[2], v1[3]);
                    if (ACT == 2) __builtin_nontemporal_store(w, (pg8::u32x4*)(rowp + bj * 128));
                    else *(pg8::u32x4*)(rowp + bj * 128) = w; } }
    }
};

__device__ __forceinline__ unsigned pk8(float a, float b, float c, float d) { int w = 0; w = __builtin_amdgcn_cvt_pk_fp8_f32(a, b, w, false); w = __builtin_amdgcn_cvt_pk_fp8_f32(c, d, w, true); return (unsigned)w; }
struct EpiUp8 {
    static constexpr bool PERM = true, AFTER_DRAIN = false;
    unsigned char* O; int ldc; const float* rs;
    __device__ __forceinline__ void prefetch(const pg8::Unit& u, int wr, int fr, float (&pre)[8]) const {
        const int row0 = u.pm * 256 + wr * 64 + fr;
#pragma unroll
        for (int j = 0; j < 8; ++j) pre[j] = rs[row0 + (j >> 2) * 128 + (j & 3) * 16] * (2.f / W8SCALE);
    }
    __device__ __forceinline__ void operator()(const pg8::f32x4 (&acc)[2][2][4][2], const pg8::Unit& u, int wr, int wc, int fr, int fq, const float (&pre)[8]) const {
        static_assert(H8SCALE == 4.f, "EpiUp8 folds sqrt(H8SCALE) = 2 into the row scale");
        const int row0 = u.pm * 256 + wr * 64 + fr, col0 = u.pn * 256 + wc * 32 + 8 * fq;
#pragma unroll
        for (int ai = 0; ai < 2; ++ai)
#pragma unroll
            for (int m = 0; m < 4; ++m) { unsigned char* rowp = O + (size_t)(row0 + ai * 128 + m * 16) * ldc + col0; const float rsc = pre[ai * 4 + m];
#pragma unroll
                for (int bj = 0; bj < 2; ++bj) { pg8::f32x4 v0 = acc[ai][bj][m][0] * rsc, v1 = acc[ai][bj][m][1] * rsc;
#pragma unroll
                    for (int j = 0; j < 4; ++j) { v0[j] = __builtin_amdgcn_fmed3f(v0[j], 0.f, 21.166010488f); v1[j] = __builtin_amdgcn_fmed3f(v1[j], 0.f, 21.166010488f); }
                    v0 = v0 * v0; v1 = v1 * v1;
                    v2u w; w.x = pk8(v0[0], v0[1], v0[2], v0[3]); w.y = pk8(v1[0], v1[1], v1[2], v1[3]);
                    *(v2u*)(rowp + bj * 128) = w; } }
    }
};

struct PanelSq {
    float* slots;
    unsigned* cnt;
    unsigned* tmo;
    template <class Fn> __device__ __forceinline__ void run(const float (&ssl)[8], const pg8::Unit& u, int wr, int wc, int fr, int fq, LAS unsigned char* lds, int wid, int lane, Fn&& between) const {
        LAS float* P = (LAS float*)lds; LAS float* S = (LAS float*)(lds + 8192);
#pragma unroll
        for (int j = 0; j < 8; ++j) { float t = ssl[j]; t += __shfl_xor(t, 16); t += __shfl_xor(t, 32);
            if (fq == 0) P[((j >> 2) * 128 + wr * 64 + (j & 3) * 16 + fr) * 4 + wc] = t; }
        asm volatile("s_waitcnt lgkmcnt(0)" ::: "memory"); __builtin_amdgcn_s_barrier(); asm volatile("" ::: "memory");
        const int row = wid * 32 + (lane & 31);
        if (lane < 32) { const f32x4 p4 = *(const LAS f32x4*)(P + row * 4); const float t = (p4.x + p4.y) + (p4.z + p4.w);
            __hip_atomic_store((unsigned*)(slots + (size_t)(u.pm * 256 + row) * 8 + u.pn), __builtin_bit_cast(unsigned, t), __ATOMIC_RELAXED, __HIP_MEMORY_SCOPE_AGENT); }
        asm volatile("s_waitcnt vmcnt(0)" ::: "memory");
        if (lane == 0) __hip_atomic_fetch_add(cnt + 64 * u.pm, 1u, __ATOMIC_RELAXED, __HIP_MEMORY_SCOPE_AGENT);
        between();
        if (wid == 0) {
            unsigned sp = 0;
            while ((unsigned)__builtin_amdgcn_readfirstlane(__hip_atomic_load(cnt + 64 * u.pm, __ATOMIC_RELAXED, __HIP_MEMORY_SCOPE_AGENT)) < 64u) {
                __builtin_amdgcn_s_sleep(1);
                if ((++sp & 255u) == 0u) { if (__hip_atomic_load(tmo, __ATOMIC_RELAXED, __HIP_MEMORY_SCOPE_AGENT)) break; if (sp > (1u << 24)) { if (lane == 0) __hip_atomic_store(tmo, 1u, __ATOMIC_RELAXED, __HIP_MEMORY_SCOPE_AGENT); break; } } }
            __builtin_amdgcn_fence(__ATOMIC_ACQUIRE, "agent");
        }
        asm volatile("s_waitcnt vmcnt(0) lgkmcnt(0)" ::: "memory"); __builtin_amdgcn_s_barrier(); asm volatile("" ::: "memory");
        if (lane < 32) { const unsigned* sl = (const unsigned*)(slots + (size_t)(u.pm * 256 + row) * 8); float t = 0.f;
#pragma unroll
            for (int o = 0; o < 8; ++o) t += __builtin_bit_cast(float, __hip_atomic_load(sl + o, __ATOMIC_RELAXED, __HIP_MEMORY_SCOPE_AGENT));
            S[row] = t; }
        asm volatile("s_waitcnt vmcnt(0) lgkmcnt(0)" ::: "memory"); __builtin_amdgcn_s_barrier(); asm volatile("" ::: "memory");
    }
};
struct PanelSqLast {
    float* slots; unsigned* cnt; float* rinv;
    __device__ __forceinline__ void run(const float (&ssl)[8], const pg8::Unit& u, int wr, int wc, int fr, int fq, LAS unsigned char* lds, int wid, int lane) const {
        LAS float* P = (LAS float*)lds;
#pragma unroll
        for (int j = 0; j < 8; ++j) { float t = ssl[j]; t += __shfl_xor(t, 16); t += __shfl_xor(t, 32);
            if (fq == 0) P[((j >> 2) * 128 + wr * 64 + (j & 3) * 16 + fr) * 4 + wc] = t; }
        asm volatile("s_waitcnt lgkmcnt(0)" ::: "memory"); __builtin_amdgcn_s_barrier(); asm volatile("" ::: "memory");
        const int row = wid * 32 + (lane & 31);
        if (lane < 32) { const f32x4 p4 = *(const LAS f32x4*)(P + row * 4); const float t = (p4.x + p4.y) + (p4.z + p4.w);
            __hip_atomic_store((unsigned*)(slots + (size_t)(u.pm * 256 + row) * 8 + u.pn), __builtin_bit_cast(unsigned, t), __ATOMIC_RELAXED, __HIP_MEMORY_SCOPE_AGENT); }
        asm volatile("s_waitcnt vmcnt(0)" ::: "memory");
        unsigned old = 0u;
        if (lane == 0) old = __hip_atomic_fetch_add(cnt + 64 * u.pm, 1u, __ATOMIC_RELAXED, __HIP_MEMORY_SCOPE_AGENT);
        old = (unsigned)__builtin_amdgcn_readfirstlane((int)old);
        if (old == 63u) {
            __builtin_amdgcn_fence(__ATOMIC_ACQUIRE, "agent"); asm volatile("s_waitcnt vmcnt(0)" ::: "memory");
#pragma unroll
            for (int q = 0; q < 4; ++q) { const int r = q * 64 + lane; const unsigned* sl = (const unsigned*)(slots + (size_t)(u.pm * 256 + r) * 8); float t = 0.f;
#pragma unroll
                for (int o = 0; o < 8; ++o) t += __builtin_bit_cast(float, __hip_atomic_load(sl + o, __ATOMIC_RELAXED, __HIP_MEMORY_SCOPE_AGENT));
                rinv[u.pm * 256 + r] = 1.f / sqrtf(t * (1.f / DM) + RMS_EPS); } }
    }
};
template <bool XF32  , bool FINAL  , bool W8  > struct EpiRmsRes {
    static constexpr bool PERM = true, AFTER_DRAIN = true;
    const void* xold; bf16* xnew; float* outf; const float* g; unsigned char* x8; float osc  ; PanelSq st1; PanelSqLast st2;
    __device__ __forceinline__ void prefetch(const pg8::Unit&, int, int, float (&)[8]) const {}
    __device__ __forceinline__ void fused(pg8::f32x4 (&acc)[2][2][4][2], const pg8::Unit& u, int, int, int, int, LAS unsigned char* lds, int wid, int) const {
        const int lane = lane_id(), fr = lane & 15, fq = lane >> 4, wr = wid >> 2, wc = wid & 3;
        const LAS float* S = (const LAS float*)(lds + 8192);
        const int col0 = u.pn * 256 + wc * 32 + 8 * fq;
        float ssl[8];
#pragma unroll
        for (int ai = 0; ai < 2; ++ai)
#pragma unroll
            for (int m = 0; m < 4; ++m) { float t = 0.f;
#pragma unroll
                for (int bj = 0; bj < 2; ++bj)
#pragma unroll
                    for (int n = 0; n < 2; ++n) { const pg8::f32x4 v = acc[ai][bj][m][n]; t += (v[0] * v[0] + v[1] * v[1]) + (v[2] * v[2] + v[3] * v[3]); }
                ssl[ai * 4 + m] = t; }
        constexpr int NPRE = XF32 ? 4 : 8;
        v4u xpre[NPRE][2];
        pg8::f32x4 gv[2][2];
        st1.run(ssl, u, wr, wc, fr, fq, lds, wid, lane, [&]() {
            if (!XF32) { const char* xb = (const char*)xold + (size_t)u.pm * 256 * DM * 2; asm volatile("" : "+s"(xb));
                const unsigned o0 = (unsigned)(((wr * 64 + fr) * DM + col0) * 2);
#pragma unroll
                for (int j = 0; j < 8; ++j)
#pragma unroll
                    for (int bj = 0; bj < 2; ++bj) xpre[j][bj] = *(const GAS v4u*)(xb + (o0 + (unsigned)((((j >> 2) * 128 + (j & 3) * 16) * DM + bj * 128) * 2)));
            }
#pragma unroll
            for (int bj = 0; bj < 2; ++bj)
#pragma unroll
                for (int n = 0; n < 2; ++n) gv[bj][n] = *(const pg8::f32x4*)(g + col0 + bj * 128 + 4 * n);
        });
#pragma unroll
        for (int ai = 0; ai < 2; ++ai)
#pragma unroll
            for (int m = 0; m < 4; ++m) { const int rl = ai * 128 + wr * 64 + m * 16 + fr; const float ry = osc / sqrtf(S[rl] * (osc * osc * (1.f / DM)) + RMS_EPS);
                const size_t off = (size_t)(u.pm * 256 + rl) * DM + col0; float t = 0.f;
#pragma unroll
                for (int bj = 0; bj < 2; ++bj) { pg8::f32x4 x0, x1;
                    if (XF32) { x0 = *(const pg8::f32x4*)((const float*)xold + off + bj * 128); x1 = *(const pg8::f32x4*)((const float*)xold + off + bj * 128 + 4); }
                    else { const v4u w = xpre[ai * 4 + m][bj]; x0 = (pg8::f32x4){bflo(w.x), bfhi(w.x), bflo(w.y), bfhi(w.y)}; x1 = (pg8::f32x4){bflo(w.z), bfhi(w.z), bflo(w.w), bfhi(w.w)}; }
                    const pg8::f32x4 a0 = x0 + acc[ai][bj][m][0] * ry * gv[bj][0], a1 = x1 + acc[ai][bj][m][1] * ry * gv[bj][1];
                    t += ((a0[0] * a0[0] + a0[1] * a0[1]) + (a0[2] * a0[2] + a0[3] * a0[3])) + ((a1[0] * a1[0] + a1[1] * a1[1]) + (a1[2] * a1[2] + a1[3] * a1[3]));
                    if (FINAL) { *(pg8::f32x4*)(outf + off + bj * 128) = a0; *(pg8::f32x4*)(outf + off + bj * 128 + 4) = a1; }
                    else { pg8::u32x4 w; w.x = pg8::cvt_pk_bf16(a0[0], a0[1]); w.y = pg8::cvt_pk_bf16(a0[2], a0[3]); w.z = pg8::cvt_pk_bf16(a1[0], a1[1]); w.w = pg8::cvt_pk_bf16(a1[2], a1[3]);
                        *(pg8::u32x4*)(xnew + off + bj * 128) = w;
                        if (W8) { v2u w8; w8.x = pk8(__builtin_amdgcn_fmed3f(a0[0], -448.f, 448.f), __builtin_amdgcn_fmed3f(a0[1], -448.f, 448.f), __builtin_amdgcn_fmed3f(a0[2], -448.f, 448.f), __builtin_amdgcn_fmed3f(a0[3], -448.f, 448.f));
                            w8.y = pk8(__builtin_amdgcn_fmed3f(a1[0], -448.f, 448.f), __builtin_amdgcn_fmed3f(a1[1], -448.f, 448.f), __builtin_amdgcn_fmed3f(a1[2], -448.f, 448.f), __builtin_amdgcn_fmed3f(a1[3], -448.f, 448.f));
                            *(v2u*)(x8 + off + bj * 128) = w8; } } }
                ssl[ai * 4 + m] = t;
                if (XF32 && (m & 1)) asm volatile("" ::: "memory"); }
        if (FINAL) return;
        st2.run(ssl, u, wr, wc, fr, fq, lds, wid, lane);
    }
};

__device__ __forceinline__ void tr_item(const float* W, int ldw, int K, int ncols, bf16* WT, LAS float* scr, int item, int lane, const float* gk = nullptr) {
    const int nblk = (ncols + 31) / 32, kb = item / nblk, nb = item % nblk, k0 = 64 * kb, n0 = 32 * nb;
    const int nn = n0 + (lane & 31);
    float wv[32];
#pragma unroll
    for (int i = 0; i < 32; ++i) { const int kk = 2 * i + (lane >> 5); wv[i] = (nn < ncols) ? W[(size_t)(k0 + kk) * ldw + nn] : 0.f; }
#pragma unroll
    for (int i = 0; i < 32; ++i) { const int kk = 2 * i + (lane >> 5); scr[kk * 33 + (lane & 31)] = wv[i] * (gk ? gk[k0 + kk] : 1.f); }
    LDS_WAIT(); asm volatile("" ::: "memory");
    const int c = lane & 7;
#pragma unroll
    for (int j = 0; j < 4; ++j) { const int n = (lane >> 3) + 8 * j; const LAS float* s = scr + (8 * c) * 33 + n;
        v4u o; o.x = pk2(s[0 * 33], s[1 * 33]); o.y = pk2(s[2 * 33], s[3 * 33]); o.z = pk2(s[4 * 33], s[5 * 33]); o.w = pk2(s[6 * 33], s[7 * 33]);
        *(GAS v4u*)(WT + (size_t)(n0 + n) * K + k0 + 8 * c) = o; }
    LDS_WAIT(); asm volatile("" ::: "memory");
}
__device__ __forceinline__ void tr_item8(const float* W, int ldw, int K, int ncols, unsigned char* WT, LAS float* scr, int item, int lane, const float* gk = nullptr) {
    const int nblk = ncols / 32, kb = item / nblk, nb = item % nblk, k0 = 64 * kb, n0 = 32 * nb;
    const int nn = n0 + (lane & 31);
    float wv[32];
#pragma unroll
    for (int i = 0; i < 32; ++i) { const int kk = 2 * i + (lane >> 5); wv[i] = W[(size_t)(k0 + kk) * ldw + nn]; }
#pragma unroll
    for (int i = 0; i < 32; ++i) { const int kk = 2 * i + (lane >> 5); scr[kk * 33 + (lane & 31)] = wv[i] * (gk ? gk[k0 + kk] * W8SCALE : W8SCALE); }
    LDS_WAIT(); asm volatile("" ::: "memory");
    const int c = lane & 7;
#pragma unroll
    for (int j = 0; j < 4; ++j) { const int n = (lane >> 3) + 8 * j; const LAS float* s = scr + (8 * c) * 33 + n;
        v2u o; o.x = pk8(__builtin_amdgcn_fmed3f(s[0 * 33], -448.f, 448.f), __builtin_amdgcn_fmed3f(s[1 * 33], -448.f, 448.f), __builtin_amdgcn_fmed3f(s[2 * 33], -448.f, 448.f), __builtin_amdgcn_fmed3f(s[3 * 33], -448.f, 448.f));
        o.y = pk8(__builtin_amdgcn_fmed3f(s[4 * 33], -448.f, 448.f), __builtin_amdgcn_fmed3f(s[5 * 33], -448.f, 448.f), __builtin_amdgcn_fmed3f(s[6 * 33], -448.f, 448.f), __builtin_amdgcn_fmed3f(s[7 * 33], -448.f, 448.f));
        *(GAS v2u*)(WT + (size_t)(n0 + n) * K + k0 + 8 * c) = o; }
    LDS_WAIT(); asm volatile("" ::: "memory");
}
#define TR_JOB8G(Wp, ldw, K, ncols, WTp, gk) { const int ni_ = ((K) / 64) * ((ncols) / 32); if (r < ni_) { tr_item8((Wp), (ldw), (K), (ncols), (WTp), scr, r, F.lane, (gk)); continue; } r -= ni_; }
#define TR_JOBG(Wp, ldw, K, ncols, WTp, gk) { const int ni_ = ((K) / 64) * (((ncols) + 31) / 32); if (r < ni_) { tr_item((Wp), (ldw), (K), (ncols), (WTp), scr, r, F.lane, (gk)); continue; } r -= ni_; }
#define TR_JOB(Wp, ldw, K, ncols, WTp) TR_JOBG(Wp, ldw, K, ncols, WTp, nullptr)

__device__ __forceinline__ int rel_bucket(int n) {
    if (n < 16) return n;
    const float v = logf((float)n / 16.f) / 2.0794415416798357f * 16.f;
    const int l = 16 + (int)v; return l < 31 ? l : 31;
}

__device__ __forceinline__ void p0_prologue(Frame& F) {
    LAS float* scr = (LAS float*)(F.lds + F.wave * 16384);
    unsigned char* ws = F.ws;
    constexpr int NITEMS = (DM / 64) * (NQKV / 32) + (DM / 64) * 2 + 2 * (4096 / 64) * 4 + 2 * 2 * 4 + (DM / 64) * (DM / 32) + (DM / 64) * (FF / 32) + (FF / 64) * (DM / 32);
    for (int it = F.gw; it < NITEMS; it += F.NGW) {
        int r = it;
        TR_JOBG(F.w_in, NSA_IN, DM, NQKV, (bf16*)(ws + W0_QKV), F.norm_g)
        TR_JOBG(F.w_in + NQKV, NSA_IN, DM, NGATE, (bf16*)(ws + W0_G), F.norm_g)
        TR_JOB(F.cw1, HD, 4096, HD, (bf16*)(ws + W0_W1))
        TR_JOB(F.cw1 + 4096 * HD, HD, 4096, HD, (bf16*)(ws + W0_W1) + HD * 4096)
        TR_JOB(F.cw2, HD, HD, HD, (bf16*)(ws + W0_W2))
        TR_JOB(F.cw2 + HD * HD, HD, HD, HD, (bf16*)(ws + W0_W2) + HD * HD)
        TR_JOB(F.w_out, DM, DM, DM, (bf16*)(ws + W0_O))
        TR_JOB8G(F.up, FF, DM, FF, ws + W0_UP, F.norm_g + 2 * DM)
        TR_JOB8G(F.dn, DM, FF, DM, ws + W0_DN, nullptr)
    }
    if (blockIdx.x == 0) {
        float* lut = (float*)(ws + WS_LUT);
        for (int i = F.tid; i < NH * 128; i += NTHREADS) { const int h = i >> 7, d = i & 127; lut[i] = F.rel[rel_bucket(d) * NH + h] * 1.4426950408889634f; }
    }
    if (blockIdx.x == 1) {
        float* lb = (float*)(ws + WS_LB);
        for (int i = F.tid; i < DM; i += NTHREADS) lb[i] = 1.f / (1.f + expf(F.h_lb[i] - F.h_lb[DM + i]));
    }
    for (int it = F.gw; it < 2 * HD * 8; it += F.NGW) {
        const int k8 = it & 7, n = (it >> 3) & 127, kv = it >> 10; const float* pe = F.pe + kv * 4096 + 512 * k8; const float* w1 = F.cw1 + ((size_t)kv * 4096 + 512 * k8) * HD + n;
        float wv[8]; float s = 0.f;
#pragma unroll
        for (int j = 0; j < 8; ++j) wv[j] = w1[(size_t)(64 * j + F.lane) * HD];
#pragma unroll
        for (int j = 0; j < 8; ++j) s += pe[64 * j + F.lane] * wv[j];
        s = wave_sum(s);
        if (F.lane == 0) ((float*)(ws + WS_BIAS1))[k8 * 256 + kv * HD + n] = s;
    }
    { const int lane = F.lane; f32x4 xv[8]; int m = F.gw; float* rinv = (float*)(ws + WS_RINV);
      if (m < M) { const GAS f32x4* xr = (const GAS f32x4*)(F.x + (size_t)m * DM) + lane;
#pragma unroll
          for (int j = 0; j < 8; ++j) xv[j] = xr[64 * j]; }
      for (; m < M; m += F.NGW) { f32x4 xn[8]; const int m2 = m + F.NGW;
          if (m2 < M) { const GAS f32x4* xr = (const GAS f32x4*)(F.x + (size_t)m2 * DM) + lane;
#pragma unroll
              for (int j = 0; j < 8; ++j) xn[j] = xr[64 * j]; }
          float s = 0.f;
#pragma unroll
          for (int j = 0; j < 8; ++j) s += (xv[j].x * xv[j].x + xv[j].y * xv[j].y) + (xv[j].z * xv[j].z + xv[j].w * xv[j].w);
          const float r = 1.f / sqrtf(wave_sum(s) * (1.f / DM) + RMS_EPS);
          if (lane == 0) rinv[m] = r;
          GAS v2u* o8 = (GAS v2u*)((bf16*)(ws + WS_A) + (size_t)m * DM) + lane;
#pragma unroll
          for (int j = 0; j < 8; ++j) { v2u w; w.x = pk2(xv[j].x, xv[j].y); w.y = pk2(xv[j].z, xv[j].w); o8[64 * j] = w; }
#pragma unroll
          for (int j = 0; j < 8; ++j) xv[j] = xn[j]; } }
}
__device__ __forceinline__ void p_convert_l1a(Frame& F) {
    LAS float* scr = (LAS float*)(F.lds + F.wave * 16384);
    unsigned char* ws = F.ws;
    constexpr int NITEMS = (DM / 64) * (FF / 32);
    for (int it = F.gw; it < NITEMS; it += F.NGW) {
        int r = it;
        TR_JOB8G(F.h_in, FF, DM, FF, ws + W1_IN, F.norm_g + 4 * DM)
    }
}
__device__ __forceinline__ void p_convert_l1b(Frame& F, int first  , int nstatic  ) {
    LAS float* scr = (LAS float*)(F.lds + F.wave * 16384);
    unsigned char* ws = F.ws; unsigned* q = (unsigned*)(ws + WS_CTL) + CW_CONVQ;
    constexpr int NITEMS = (DM / 64) * (DM / 32) + (DM / 64) * (FF / 32) + (FF / 64) * (DM / 32);
    int chunk = first;
    for (;;) {
        if (chunk < 0) { unsigned t = 0u; if (F.lane == 0) t = __hip_atomic_fetch_add(q, 1u, __ATOMIC_RELAXED, __HIP_MEMORY_SCOPE_AGENT);
            chunk = nstatic + __builtin_amdgcn_readfirstlane((int)t); }
        const int base = 8 * chunk; chunk = -1;
        if (base >= NITEMS) break;
        const int end = base + 8 < NITEMS ? base + 8 : NITEMS;
        for (int it = base; it < end; ++it) {
            int r = it;
            TR_JOB(F.h_out, DM, DM, DM, (bf16*)(ws + W1_O))
            TR_JOB8G(F.up + (size_t)DM * FF, FF, DM, FF, ws + W1_UP, F.norm_g + 6 * DM)
            TR_JOB8G(F.dn + (size_t)FF * DM, DM, FF, DM, ws + W1_DN, nullptr)
        }
    }
}


namespace cg {
typedef short bf16x8 __attribute__((ext_vector_type(8)));
typedef float f32x16 __attribute__((ext_vector_type(16)));
constexpr int L_RED = 0, L_H = 16384, HRS = 272;
__device__ __forceinline__ float gelu_tanh_f(float x) { const float u = 0.7978845608028654f * (x + 0.044715f * x * x * x); const float e = __expf(2.f * u); return x * (1.f - 1.f / (e + 1.f)); }

__device__ __forceinline__ void cmp_gate_phase(LAS unsigned char* lds, unsigned char* wsb, int G, const int tid) {
    const int wid = __builtin_amdgcn_readfirstlane(tid >> 6), lane = tid & 63, r32 = lane & 31, hh = lane >> 5;
    const bf16* proj = (const bf16*)(wsb + WS_BIG); const bf16* w1t = (const bf16*)(wsb + W0_W1); const bf16* w2t = (const bf16*)(wsb + W0_W2); const float* bias1 = (const float*)(wsb + WS_BIAS1);
    const bf16* hn = (const bf16*)(wsb + WS_A); const bf16* wg = (const bf16*)(wsb + W0_G); float* gates = (float*)(wsb + WS_GATES); const float* rinv = (const float*)(wsb + WS_RINV);
    LAS float* red = (LAS float*)(lds + L_RED);
    const int ct = wid & 3, kh = wid >> 2;
    for (int u = blockIdx.x; u < 256; u += G) {
        const int kv = u >> 7, R0 = (u & 127) * 32, R = R0 + r32, b = R >> 9, g = (R >> 7) & 3, c = R & 127, cl = c < NC ? c : NC - 1;
        const bf16* arow = proj + ((size_t)b * SEQ + 16 * cl) * NQKV + (kv ? COL_VC : COL_KC) + g * HD;
        const bf16* brow = w1t + (size_t)kv * HD * 4096 + (size_t)(32 * ct + r32) * 4096;
        f32x16 acc = f32x16{};
        for (int l2 = 0; l2 < 8; ++l2) {
            bf16x8 av[16], bv[16];
            const bf16* ap = arow + (size_t)(kh * 16 + 2 * l2) * NQKV + 8 * hh; const bf16* bp = brow + kh * 2048 + 256 * l2 + 8 * hh;
#pragma unroll
            for (int j = 0; j < 16; ++j) { av[j] = *(const GAS bf16x8*)(ap + (size_t)(j >> 3) * NQKV + 16 * (j & 7)); bv[j] = *(const GAS bf16x8*)(bp + 16 * j); }
            __builtin_amdgcn_sched_barrier(0);
#pragma unroll
            for (int j = 0; j < 16; ++j) acc = __builtin_amdgcn_mfma_f32_32x32x16_bf16(av[j], bv[j], acc, 0, 0, 0); }
        if (kh == 1) {
#pragma unroll
            for (int r = 0; r < 16; ++r) red[(ct * 16 + r) * 64 + lane] = acc[r]; }
        LDS_WAIT();
        __syncthreads();
        if (kh == 0) { float bs = 0.f;
#pragma unroll
            for (int k8 = 0; k8 < 8; ++k8) bs += bias1[k8 * 256 + kv * HD + 32 * ct + r32];
#pragma unroll
            for (int r = 0; r < 16; ++r) { const float hv = gelu_tanh_f(acc[r] + red[(ct * 16 + r) * 64 + lane] + bs); const int row = (r & 3) + 8 * (r >> 2) + 4 * hh;
                *(LAS unsigned short*)(lds + L_H + row * HRS + (32 * ct + r32) * 2) = (unsigned short)f2bf(hv); } }
        LDS_WAIT();
        __syncthreads();
        if (kh == 0) { f32x16 o2 = f32x16{}; const bf16* b2 = w2t + (size_t)kv * HD * HD + (size_t)(32 * ct + r32) * HD;
#pragma unroll
            for (int ks = 0; ks < 8; ++ks) { const bf16x8 a = *(const LAS bf16x8*)(lds + L_H + r32 * HRS + (16 * ks + 8 * hh) * 2); const bf16x8 bb = *(const GAS bf16x8*)(b2 + 16 * ks + 8 * hh);
                o2 = __builtin_amdgcn_mfma_f32_32x32x16_bf16(a, bb, o2, 0, 0, 0); }
            bf16* outp = (bf16*)(wsb + (kv ? WS_VCMP : WS_KCMP)) + (size_t)R0 * HD + 32 * ct + r32;
#pragma unroll
            for (int r = 0; r < 16; ++r) { const int row = (r & 3) + 8 * (r >> 2) + 4 * hh; const bool pad = ((R0 + row) & 127) == NC;
                outp[(size_t)row * HD] = pad ? (bf16)0 : (bf16)f2bf(o2[r]); } }
        __syncthreads();
    }
    for (int u = blockIdx.x; u < M / 64; u += G) {
        const int rt = wid & 1, c2 = (wid >> 1) & 1; const int m0 = 64 * u + 32 * rt;
        const bf16* arow = hn + (size_t)(m0 + r32) * DM; const bf16* brow = wg + (size_t)(32 * c2 + r32) * DM;
        f32x16 acc = f32x16{};
        for (int l2 = 0; l2 < 4; ++l2) {
            bf16x8 av[16], bv[16];
            const bf16* ap = arow + kh * 1024 + 256 * l2 + 8 * hh; const bf16* bp = brow + kh * 1024 + 256 * l2 + 8 * hh;
#pragma unroll
            for (int j = 0; j < 16; ++j) { av[j] = *(const GAS bf16x8*)(ap + 16 * j); bv[j] = *(const GAS bf16x8*)(bp + 16 * j); }
            __builtin_amdgcn_sched_barrier(0);
#pragma unroll
            for (int j = 0; j < 16; ++j) acc = __builtin_amdgcn_mfma_f32_32x32x16_bf16(av[j], bv[j], acc, 0, 0, 0); }
        if (kh == 1) {
#pragma unroll
            for (int r = 0; r < 16; ++r) red[((wid & 3) * 16 + r) * 64 + lane] = acc[r]; }
        LDS_WAIT();
        __syncthreads();
        if (kh == 0) { const int col = 32 * c2 + r32; float rv[16];
#pragma unroll
            for (int r = 0; r < 16; ++r) rv[r] = rinv[m0 + (r & 3) + 8 * (r >> 2) + 4 * hh];
#pragma unroll
            for (int r = 0; r < 16; ++r) { const int row = (r & 3) + 8 * (r >> 2) + 4 * hh; const float v = acc[r] + red[((wid & 3) * 16 + r) * 64 + lane];
                if (col < NGATE) gates[(size_t)(m0 + row) * NGATE + col] = 1.f / (1.f + __expf(-v * rv[r])); } }
        __syncthreads();
    }
}
}


namespace nsa {
typedef short bf16x8 __attribute__((ext_vector_type(8)));
typedef short s16x4 __attribute__((ext_vector_type(4)));
typedef float f32x16 __attribute__((ext_vector_type(16)));
typedef unsigned u32x4 __attribute__((ext_vector_type(4)));
constexpr int SHM = 16384;
constexpr int NBUF = 3;
constexpr int L_V = 0, L_K = NBUF * SHM, L_WS = 2 * NBUF * SHM, L_LUT = L_WS + 2048, L_IMP = L_LUT + 8192, L_SEL = L_IMP + 4 * 64 * 33 * 4, L_END = L_SEL + 256;
static_assert(L_END <= LDS_BYTES - 256, "nsa LDS map");
constexpr float THR2 = 11.5f;
#define NSA_KSWZ(row, colB) ((row) * 256 + ((colB) ^ (((row) & 7) << 4)))
#define NSA_SBAR() __builtin_amdgcn_sched_barrier(0)
__device__ __forceinline__ int v_st(int k, int c) { const int kk = (k & ~0xC) | ((k & 4) << 1) | ((k & 8) >> 1); return ((kk >> 3) * 4 + (c >> 5)) * 512 + ((kk & 7) * 32 + (c & 31)) * 2; }
__device__ __forceinline__ int v_rd_base(int lane) { return ((lane & 3) << 3) | (((lane >> 2) & 3) << 6) | (((lane >> 4) & 1) << 5) | (((lane >> 5) & 1) << 8); }
constexpr int v_rd_off(int d0, int ks, int half) { return d0 * 512 + ks * 4096 + half * 2048; }
__device__ __forceinline__ int crow(int r, int hi) { return (r & 3) + 8 * (r >> 2) + 4 * hi; }
__device__ __forceinline__ unsigned cvtpk(float lo, float hi) { unsigned r; asm volatile("v_cvt_pk_bf16_f32 %0, %1, %2" : "=v"(r) : "v"(lo), "v"(hi)); return r; }

__device__ __forceinline__ void qkt(f32x16& p0, f32x16& p1, LAS unsigned char* Kb, int r32, int hi, const bf16x8 (&qr)[8]) {
    p0 = f32x16{}; p1 = f32x16{};
    LAS unsigned char* kb[4];
#pragma unroll
    for (int dd = 0; dd < 4; ++dd) kb[dd] = Kb + NSA_KSWZ(r32, (dd * 16 + hi * 8) * 2);
#pragma unroll
    for (int d0 = 0; d0 < 8; ++d0) { LAS unsigned char* a = kb[d0 & 3] + (d0 >> 2) * 128;
        const bf16x8 b0 = *(const LAS bf16x8*)a; const bf16x8 b1 = *(const LAS bf16x8*)(a + 32 * 256);
        p0 = __builtin_amdgcn_mfma_f32_32x32x16_bf16(b0, qr[d0], p0, 0, 0, 0);
        p1 = __builtin_amdgcn_mfma_f32_32x32x16_bf16(b1, qr[d0], p1, 0, 0, 0); }
}
__device__ __forceinline__ void pv_tile(f32x16 (&o)[4], int vb, bf16x8 pa0, bf16x8 pa1, bf16x8 pa2, bf16x8 pa3) {
#define NSA_TRRD(dst, off) asm volatile("ds_read_b64_tr_b16 %0, %1 offset:%2" : "=&v"(dst) : "v"(vb), "i"(off) : "memory")
#define NSA_PV_KS(ks, pa) do { s16x4 l0, l1, l2, l3, h0, h1, h2, h3; \
        NSA_TRRD(l0, v_rd_off(0, ks, 0)); NSA_TRRD(h0, v_rd_off(0, ks, 1)); NSA_TRRD(l1, v_rd_off(1, ks, 0)); NSA_TRRD(h1, v_rd_off(1, ks, 1)); \
        NSA_TRRD(l2, v_rd_off(2, ks, 0)); NSA_TRRD(h2, v_rd_off(2, ks, 1)); NSA_TRRD(l3, v_rd_off(3, ks, 0)); NSA_TRRD(h3, v_rd_off(3, ks, 1)); \
        asm volatile("s_waitcnt lgkmcnt(0)" ::: "memory"); NSA_SBAR(); \
        o[0] = __builtin_amdgcn_mfma_f32_32x32x16_bf16(pa, (bf16x8){l0[0], l0[1], l0[2], l0[3], h0[0], h0[1], h0[2], h0[3]}, o[0], 0, 0, 0); \
        o[1] = __builtin_amdgcn_mfma_f32_32x32x16_bf16(pa, (bf16x8){l1[0], l1[1], l1[2], l1[3], h1[0], h1[1], h1[2], h1[3]}, o[1], 0, 0, 0); \
        o[2] = __builtin_amdgcn_mfma_f32_32x32x16_bf16(pa, (bf16x8){l2[0], l2[1], l2[2], l2[3], h2[0], h2[1], h2[2], h2[3]}, o[2], 0, 0, 0); \
        o[3] = __builtin_amdgcn_mfma_f32_32x32x16_bf16(pa, (bf16x8){l3[0], l3[1], l3[2], l3[3], h3[0], h3[1], h3[2], h3[3]}, o[3], 0, 0, 0); } while (0)
    NSA_PV_KS(0, pa0); NSA_PV_KS(1, pa1); NSA_PV_KS(2, pa2); NSA_PV_KS(3, pa3);
#undef NSA_PV_KS
#undef NSA_TRRD
}
__device__ __forceinline__ void pack_p(const f32x16& p0, const f32x16& p1, bf16x8& pa0, bf16x8& pa1, bf16x8& pa2, bf16x8& pa3) {
#define NSA_PK4(P, B_, OUT) do { unsigned a0 = cvtpk(P[B_ + 0], P[B_ + 1]), a1 = cvtpk(P[B_ + 2], P[B_ + 3]); \
        unsigned b0 = cvtpk(P[B_ + 4], P[B_ + 5]), b1 = cvtpk(P[B_ + 6], P[B_ + 7]); \
        auto r0 = __builtin_amdgcn_permlane32_swap(a0, b0, false, false); auto r1 = __builtin_amdgcn_permlane32_swap(a1, b1, false, false); \
        u32x4 w = {r0[0], r1[0], r0[1], r1[1]}; OUT = *reinterpret_cast<bf16x8*>(&w); } while (0)
    NSA_PK4(p0, 0, pa0); NSA_PK4(p0, 8, pa1); NSA_PK4(p1, 0, pa2); NSA_PK4(p1, 8, pa3);
#undef NSA_PK4
}
__device__ __forceinline__ float swap_max(float v) { auto rr = __builtin_amdgcn_permlane32_swap(__float_as_uint(v), __float_as_uint(v), false, false); return fmaxf(__uint_as_float(rr[0]), __uint_as_float(rr[1])); }
__device__ __forceinline__ float swap_sum(float v) { auto rr = __builtin_amdgcn_permlane32_swap(__float_as_uint(v), __float_as_uint(v), false, false); return __uint_as_float(rr[0]) + __uint_as_float(rr[1]); }

template <class T> __device__ __forceinline__ const T* opaque_s(const T* p) { asm volatile("" : "+s"(p)); return p; }
__device__ __forceinline__ void tile_dma(LAS unsigned char* lds, int buf, const bf16* Kg, const bf16* Vg, int ld, int pk0, int pk1, int pv0, int pv1, int wid) {
    const char* kb = (const char*)Kg; const char* vb = (const char*)Vg;
    LAS unsigned char* kd = lds + L_K + buf * SHM + wid * 2048; LAS unsigned char* vd = lds + L_V + buf * SHM + wid * 2048;
    __builtin_amdgcn_global_load_lds((const unsigned*)(kb + (unsigned)(((pk0 >> 8) * ld + (pk0 & 255)) * 2)), (LAS unsigned*)kd, 16, 0, 0);
    __builtin_amdgcn_global_load_lds((const unsigned*)(kb + (unsigned)(((pk1 >> 8) * ld + (pk1 & 255)) * 2)), (LAS unsigned*)(kd + 1024), 16, 0, 0);
    __builtin_amdgcn_global_load_lds((const unsigned*)(vb + (unsigned)(((pv0 >> 8) * ld + (pv0 & 255)) * 2)), (LAS unsigned*)vd, 16, 0, 0);
    __builtin_amdgcn_global_load_lds((const unsigned*)(vb + (unsigned)(((pv1 >> 8) * ld + (pv1 & 255)) * 2)), (LAS unsigned*)(vd + 1024), 16, 0, 0);
}
__device__ __forceinline__ int k_piece(int P) { const int row = P >> 8, colB = (P & 255) ^ ((row & 7) << 4); return (row << 8) | (colB >> 1); }
__device__ __forceinline__ int v_piece(int P) { const int st = P >> 9, q = (P & 511) >> 1, kk = (st >> 2) * 8 + (q >> 5), c = (st & 3) * 32 + (q & 31);
    const int k = (kk & ~0xC) | ((kk & 4) << 1) | ((kk & 8) >> 1); return (k << 8) | c; }

__device__ __forceinline__ void nsa_phase(LAS unsigned char* lds, unsigned char* wsb, int G, const int tid) {
    const int wid = __builtin_amdgcn_readfirstlane(tid >> 6), lane = tid & 63, r32 = lane & 31, hi = lane >> 5;
    const int hr = wid >> 1, th = wid & 1;
    const bf16* proj = (const bf16*)(wsb + WS_BIG); const float* gates = (const float*)(wsb + WS_GATES);
    const bf16* kcmp = (const bf16*)(wsb + WS_KCMP); const bf16* vcmp = (const bf16*)(wsb + WS_VCMP); bf16* Oout = (bf16*)(wsb + WS_A);
    float* scrl = (float*)(wsb + WS_SCR) + ((size_t)blockIdx.x * NWAVES + wid) * 4096 + lane * 64;
    LAS float* wsl = (LAS float*)(lds + L_WS) + wid * 64; LAS float* li_l = wsl; LAS float* al_l = wsl + 32;
    LAS float* lutL = (LAS float*)(lds + L_LUT); LAS float* impL = (LAS float*)(lds + L_IMP); LAS unsigned* selL = (LAS unsigned*)(lds + L_SEL);
    const int pk0 = k_piece(wid * 2048 + lane * 16), pk1 = k_piece(wid * 2048 + 1024 + lane * 16), pv0 = v_piece(wid * 2048 + lane * 16), pv1 = v_piece(wid * 2048 + 1024 + lane * 16);
    const int vb0 = (int)(unsigned)(uintptr_t)(lds + L_V) + v_rd_base(lane);
    const float NEG = -__builtin_inff();
    { const float* lut = (const float*)(wsb + WS_LUT); for (int i = tid; i < NH * 128; i += NTHREADS) lutL[i] = lut[i]; }
    __syncthreads();
    for (int ui = 0; ui < 4; ++ui) {
        const int c = blockIdx.x, bg = c & 31, j8 = (c >> 5) & 7;
        if (c >= 256 && G > 256) break;
        const unsigned long long qtab = (ui == 0) ? 0xfeebcf633dull : (ui == 1) ? 0x8ea74b49b7ull : (ui == 2) ? 0x719f062568ull : 0x110a009d43ull;
        const int qb = (int)((qtab >> (5 * j8)) & 31ull);
        const int b = bg >> 2, g = bg & 3, h = g * 4 + hr, t0 = 64 * qb, tq = t0 + 32 * th + r32;
        const size_t rowq = (size_t)b * SEQ + tq;
        const LAS float* lutp = lutL + h * 128; const float c31 = lutp[127];
        bf16x8 qr[8];
        { int hq = hi; asm volatile("" : "+v"(hq));
          const bf16* qp = proj + rowq * NQKV + h * HD + hq * 8;
#pragma unroll
          for (int d0 = 0; d0 < 8; ++d0) qr[d0] = *(const GAS bf16x8*)(qp + d0 * 16); }
        const float g_c = gates[rowq * NGATE + h], g_s = gates[rowq * NGATE + 16 + h], g_w = gates[rowq * NGATE + 32 + h];
        f32x16 o[4]; float cmp_carry = 0.f;
        {
            const bf16* kb = kcmp + (size_t)(b * NG + g) * NCP * HD; const bf16* vbp = vcmp + (size_t)(b * NG + g) * NCP * HD;
            const bool two = (t0 + 63 - 31) >= 16 * 64;
            tile_dma(lds, 0, opaque_s(kb), opaque_s(vbp), HD, pk0, pk1, pv0, pv1, wid);
            if (two) tile_dma(lds, 1, opaque_s(kb + 64 * HD), opaque_s(vbp + 64 * HD), HD, pk0, pk1, pv0, pv1, wid);
            VM_WAIT();
            __syncthreads();
            const int dqc = tq - 31 - 64 * hi;
            f32x16 sA0, sA1, sB0 = f32x16{}, sB1 = f32x16{};
            float tm = -1e30f;
            qkt(sA0, sA1, lds + L_K, r32, hi, qr);
#pragma unroll
            for (int r = 0; r < 16; ++r) { const int cc = (r & 3) + 8 * (r >> 2); const int d0 = dqc - 16 * cc, d1 = d0 - 512;
                sA0[r] = d0 >= 0 ? sA0[r] + lutp[d0 < 0 ? 0 : (d0 < 127 ? d0 : 127)] : NEG; sA1[r] = d1 >= 0 ? sA1[r] + lutp[d1 < 0 ? 0 : (d1 < 127 ? d1 : 127)] : NEG;
                tm = fmaxf(tm, fmaxf(sA0[r], sA1[r]));
                if ((r & 3) == 3) asm volatile("" ::: "memory"); }
            if (two) {
                qkt(sB0, sB1, lds + L_K + SHM, r32, hi, qr);
#pragma unroll
                for (int r = 0; r < 16; ++r) { const int cc = (r & 3) + 8 * (r >> 2); const int d0 = dqc - 1024 - 16 * cc, d1 = d0 - 512;
                    sB0[r] = d0 >= 0 ? sB0[r] + lutp[d0 < 0 ? 0 : (d0 < 127 ? d0 : 127)] : NEG; sB1[r] = d1 >= 0 ? sB1[r] + lutp[d1 < 0 ? 0 : (d1 < 127 ? d1 : 127)] : NEG;
                    tm = fmaxf(tm, fmaxf(sB0[r], sB1[r]));
                    if ((r & 3) == 3) asm volatile("" ::: "memory"); }
            }
            const float mx = swap_max(tm);
            float ps = 0.f;
#pragma unroll
            for (int r = 0; r < 16; ++r) { sA0[r] = __builtin_amdgcn_exp2f(sA0[r] - mx); sA1[r] = __builtin_amdgcn_exp2f(sA1[r] - mx); ps += sA0[r] + sA1[r]; }
            if (two) {
#pragma unroll
                for (int r = 0; r < 16; ++r) { sB0[r] = __builtin_amdgcn_exp2f(sB0[r] - mx); sB1[r] = __builtin_amdgcn_exp2f(sB1[r] - mx); ps += sB0[r] + sB1[r]; }
            }
            const float ls = swap_sum(ps);
            const float inv = ls > 0.f ? 1.f / ls : 0.f;
            LAS float* ip = impL + (hr * 64 + 32 * th + r32) * 33;
#pragma unroll
            for (int d = 0; d < 4; ++d) o[d] = f32x16{};
            if (!two) {
#pragma unroll
                for (int q = 0; q < 16; ++q) ip[16 + q] = 0.f;
            }
            auto imp_pv = [&](f32x16& p0, f32x16& p1, const int T) {
                p0 = p0 * inv; p1 = p1 * inv;
                LAS float* ipt = ip + 16 * T;
#pragma unroll
                for (int q = 0; q < 4; ++q) {
                    ipt[0 + 2 * q + hi] = (p0[4 * q] + p0[4 * q + 1]) + (p0[4 * q + 2] + p0[4 * q + 3]);
                    ipt[8 + 2 * q + hi] = (p1[4 * q] + p1[4 * q + 1]) + (p1[4 * q + 2] + p1[4 * q + 3]); }
                LDS_WAIT(); asm volatile("" ::: "memory");
#pragma unroll
                for (int q = 0; q < 4; ++q) {
                    ipt[0 + 2 * q + hi + 1] += p0[4 * q + 3];
                    if (8 + 2 * q + hi + 1 < 16) ipt[8 + 2 * q + hi + 1] += p1[4 * q + 3]; }
                const float carry = p1[15];
                LDS_WAIT(); asm volatile("" ::: "memory");
                bf16x8 pa0, pa1, pa2, pa3;
                pack_p(p0, p1, pa0, pa1, pa2, pa3); pv_tile(o, vb0 + T * SHM, pa0, pa1, pa2, pa3);
                if (T == 0) cmp_carry = carry;
            };
            imp_pv(sA0, sA1, 0);
            if (two) imp_pv(sB0, sB1, 1);
            if (hi == 1) ip[16] += cmp_carry;
            LDS_WAIT(); asm volatile("" ::: "memory");
            if (hi == 0) li_l[r32] = g_c;
            LDS_WAIT(); asm volatile("" ::: "memory");
            { float gg[16];
#pragma unroll
              for (int r = 0; r < 16; ++r) gg[r] = li_l[crow(r, hi)];
#pragma unroll
              for (int d = 0; d < 4; ++d)
#pragma unroll
                  for (int q = 0; q < 4; ++q) *(GAS f32x4*)(scrl + d * 16 + 4 * q) = (f32x4){o[d][4 * q] * gg[4 * q], o[d][4 * q + 1] * gg[4 * q + 1], o[d][4 * q + 2] * gg[4 * q + 2], o[d][4 * q + 3] * gg[4 * q + 3]}; }
            LDS_WAIT();
            __builtin_amdgcn_s_barrier(); asm volatile("" ::: "memory");
        }
        {
#pragma unroll
            for (int i = 0; i < 4; ++i) { const int tl = 8 * wid + 2 * i + hi, n = r32;
                float v = ((impL[(0 * 64 + tl) * 33 + n] + impL[(1 * 64 + tl) * 33 + n]) + impL[(2 * 64 + tl) * 33 + n]) + impL[(3 * 64 + tl) * 33 + n];
                int key = (int)((__float_as_uint(v) & ~31u) | (unsigned)(31 - n));
                if (n == 0 || n == qb || n == qb - 1) key = (int)(0x461C4000u | (unsigned)(31 - n)); else if (n > qb) key = -64 + (31 - n);
                int cnt = 0;
                for (int mm = 0; mm < 32; ++mm) { const int u = __shfl(key, (lane & 32) | mm); cnt += (u > key) ? 1 : 0; }
                const unsigned long long bal = __ballot(cnt < 8);
                if (lane == 0) { selL[8 * wid + 2 * i] = (unsigned)bal; selL[8 * wid + 2 * i + 1] = (unsigned)(bal >> 32); } }
            LDS_WAIT();
            __builtin_amdgcn_s_barrier(); asm volatile("" ::: "memory");
        }
        const unsigned selw = selL[32 * th + r32];
        const int NS = qb + 1, nlo = qb >= 8 ? qb - 8 : 0, NT = NS + (qb - nlo + 1);
        float m_reg = -1e30f, l_reg = 0.f;
#pragma unroll
        for (int d = 0; d < 4; ++d) o[d] = f32x16{};
        const bf16* kS = proj + (size_t)b * SEQ * NQKV + COL_KS + g * HD; const bf16* vS = proj + (size_t)b * SEQ * NQKV + COL_VS + g * HD;
        const bf16* kW = proj + (size_t)b * SEQ * NQKV + COL_KW + g * HD; const bf16* vW = proj + (size_t)b * SEQ * NQKV + COL_VW + g * HD;
#define NSA_TILE_K(t_) (((t_) >= NS ? kW : kS) + (size_t)(64 * ((t_) >= NS ? nlo + ((t_) - NS) : (t_))) * NQKV)
#define NSA_TILE_V(t_) (((t_) >= NS ? vW : vS) + (size_t)(64 * ((t_) >= NS ? nlo + ((t_) - NS) : (t_))) * NQKV)
        tile_dma(lds, 0, opaque_s(kS), opaque_s(vS), NQKV, pk0, pk1, pv0, pv1, wid);
        if (1 < NT) { tile_dma(lds, 1, opaque_s(NSA_TILE_K(1)), opaque_s(NSA_TILE_V(1)), NQKV, pk0, pk1, pv0, pv1, wid); asm volatile("s_waitcnt vmcnt(4)" ::: "memory"); } else VM_WAIT();
        LDS_WAIT(); __builtin_amdgcn_s_barrier(); asm volatile("" ::: "memory");
        int buf = 0;
        for (int i = 0; i < NT; ++i) {
            const bool win = i >= NS; const int n = win ? nlo + (i - NS) : i;
            if (i == NS) {
                if (hi == 0) li_l[r32] = g_s / l_reg;
                LDS_WAIT(); asm volatile("" ::: "memory");
                { float gg[16];
#pragma unroll
                  for (int r = 0; r < 16; ++r) gg[r] = li_l[crow(r, hi)];
#pragma unroll
                  for (int d = 0; d < 4; ++d)
                  {
                    f32x4 a4[4];
#pragma unroll
                    for (int q = 0; q < 4; ++q) a4[q] = *(const GAS f32x4*)(scrl + d * 16 + 4 * q);
#pragma unroll
                    for (int q = 0; q < 4; ++q) { const f32x4 a = a4[q];
                          *(GAS f32x4*)(scrl + d * 16 + 4 * q) = (f32x4){a.x + o[d][4 * q] * gg[4 * q], a.y + o[d][4 * q + 1] * gg[4 * q + 1], a.z + o[d][4 * q + 2] * gg[4 * q + 2], a.w + o[d][4 * q + 3] * gg[4 * q + 3]}; }
                    asm volatile("" ::: "memory"); }
#pragma unroll
                  for (int d = 0; d < 4; ++d) o[d] = f32x16{}; }
                LDS_WAIT(); m_reg = -1e30f; l_reg = 0.f;
            }
            if (i + 2 < NT) { const int b2 = buf + 2 >= NBUF ? buf + 2 - NBUF : buf + 2;
                tile_dma(lds, b2, opaque_s(NSA_TILE_K(i + 2)), opaque_s(NSA_TILE_V(i + 2)), NQKV, pk0, pk1, pv0, pv1, wid); }
            f32x16 p0, p1;
            qkt(p0, p1, lds + L_K + buf * SHM, r32, hi, qr);
            const bool plain = (n + 2 < qb) && !(win && n + 8 == qb);
            float bofs = 0.f;
            { const int dq = tq - 64 * n - 4 * hi; const unsigned W = win ? 512u : 0x80000000u; const bool ok = win || ((selw >> n) & 1u);
              if (plain) bofs = ok ? c31 : NEG;
              else if (n + 2 >= qb) {
#pragma unroll
                  for (int r = 0; r < 16; ++r) { const int cc = (r & 3) + 8 * (r >> 2); const int d0 = dq - cc, d1 = d0 - 32;
                      const float b0 = lutp[d0 < 0 ? 0 : (d0 < 127 ? d0 : 127)], b1 = lutp[d1 < 0 ? 0 : (d1 < 127 ? d1 : 127)];
                      p0[r] = (ok && (unsigned)d0 < W) ? p0[r] + b0 : NEG; p1[r] = (ok && (unsigned)d1 < W) ? p1[r] + b1 : NEG;
                      if ((r & 3) == 3) asm volatile("" ::: "memory"); }
              } else {
#pragma unroll
                  for (int r = 0; r < 16; ++r) { const int cc = (r & 3) + 8 * (r >> 2); const int d0 = dq - cc, d1 = d0 - 32;
                      p0[r] = (ok && (unsigned)d0 < W) ? p0[r] + c31 : NEG; p1[r] = (ok && (unsigned)d1 < W) ? p1[r] + c31 : NEG; }
              } }
            float pmax = p0[0];
#pragma unroll
            for (int r = 1; r < 16; ++r) pmax = fmaxf(pmax, p0[r]);
#pragma unroll
            for (int r = 0; r < 16; ++r) pmax = fmaxf(pmax, p1[r]);
            pmax = swap_max(pmax) + bofs;
            float mn, alpha;
            if (__all((pmax - m_reg) <= THR2)) { mn = m_reg; alpha = 1.f; }
            else { mn = fmaxf(m_reg, pmax); alpha = __builtin_amdgcn_exp2f(m_reg - mn); m_reg = mn; }
            mn -= bofs;
            float ps = 0.f;
#pragma unroll
            for (int r = 0; r < 16; ++r) { p0[r] = __builtin_amdgcn_exp2f(p0[r] - mn); p1[r] = __builtin_amdgcn_exp2f(p1[r] - mn); ps += p0[r] + p1[r]; }
            ps = swap_sum(ps);
            l_reg = l_reg * alpha + ps;
            if (__any(alpha < 1.f)) { if (hi == 0) al_l[r32] = alpha; LDS_WAIT(); asm volatile("" ::: "memory");
#pragma unroll
                for (int r = 0; r < 16; ++r) { const float aa = al_l[crow(r, hi)];
#pragma unroll
                    for (int d = 0; d < 4; ++d) o[d][r] *= aa; }
                LDS_WAIT(); }
            bf16x8 pa0, pa1, pa2, pa3;
            pack_p(p0, p1, pa0, pa1, pa2, pa3);
            pv_tile(o, vb0 + buf * SHM, pa0, pa1, pa2, pa3);
            if (i + 2 < NT) asm volatile("s_waitcnt vmcnt(4)" ::: "memory"); else VM_WAIT();
            LDS_WAIT();
            __builtin_amdgcn_s_barrier(); asm volatile("" ::: "memory");
            buf = buf + 1 >= NBUF ? 0 : buf + 1;
        }
#undef NSA_TILE_K
#undef NSA_TILE_V
        if (hi == 0) li_l[r32] = g_w / l_reg;
        LDS_WAIT(); asm volatile("" ::: "memory");
        {
            LAS unsigned char* ost = lds + wid * 8192;
            LAS unsigned char* owr = ost + (4 * hi) * 256 + r32 * 2;
            float gg[16];
#pragma unroll
            for (int r = 0; r < 16; ++r) gg[r] = li_l[crow(r, hi)];
#pragma unroll
            for (int d = 0; d < 4; ++d) { f32x4 a4[4];
#pragma unroll
                for (int q = 0; q < 4; ++q) a4[q] = *(const GAS f32x4*)(scrl + d * 16 + 4 * q);
#pragma unroll
                for (int q = 0; q < 4; ++q)
#pragma unroll
                    for (int e = 0; e < 4; ++e) { const int r = 4 * q + e; const float v = a4[q][e] + o[d][r] * gg[r];
                        *(LAS unsigned short*)(owr + ((r & 3) + 8 * (r >> 2)) * 256 + d * 64) = (unsigned short)f2bf(v); }
                asm volatile("" ::: "memory"); }
            LDS_WAIT(); asm volatile("" ::: "memory");
            int ln = lane; asm volatile("" : "+v"(ln));
            bf16* Ow = Oout + ((size_t)b * SEQ + t0 + 32 * th + (ln >> 4)) * DM + h * HD + (ln & 15) * 8;
            const LAS unsigned char* ord = ost + (ln >> 4) * 256 + (ln & 15) * 16;
#pragma unroll
            for (int i = 0; i < 8; ++i) *(GAS v4u*)(Ow + (size_t)(4 * i) * DM) = *(const LAS v4u*)(ord + i * 1024);
        }
        LDS_WAIT();
        __builtin_amdgcn_s_barrier(); asm volatile("" ::: "memory");
    }
}
#undef NSA_KSWZ
#undef NSA_SBAR
}


namespace hg {
typedef short bf16x8 __attribute__((ext_vector_type(8)));
typedef short s16x4 __attribute__((ext_vector_type(4)));
typedef float f32x4v __attribute__((ext_vector_type(4)));
typedef float f32x2v __attribute__((ext_vector_type(2)));
constexpr int RS = 288, RSA = 144;
constexpr int BUFB = 3 * 64 * RS;
constexpr int L_Q = 0, L_K = 64 * RS, L_V = 2 * 64 * RS, L_AM = 2 * BUFB, L_O = L_AM + 64 * RSA, L_EBL = L_O + 64 * RS, L_ON = L_EBL + 1024, L_END = L_ON + 512;
static_assert(L_END <= LDS_BYTES - 256, "hg LDS map");
#define HG_TR(dst, addr, off) asm volatile("ds_read_b64_tr_b16 %0, %1 offset:%2" : "=&v"(dst) : "v"(addr), "i"(off) : "memory")
#define HG_BAR() do { asm volatile("s_waitcnt lgkmcnt(0)" ::: "memory"); __builtin_amdgcn_s_barrier(); asm volatile("" ::: "memory"); } while (0)
__device__ __forceinline__ unsigned cvtpk(float lo, float hi) { unsigned r; asm volatile("v_cvt_pk_bf16_f32 %0, %1, %2" : "=v"(r) : "v"(lo), "v"(hi)); return r; }

__device__ __forceinline__ void scan_phase(LAS unsigned char* lds, unsigned char* wsb, const float* h_on, int G, const int tid) {
    const int wid = __builtin_amdgcn_readfirstlane(tid >> 6), lane = tid & 63, li = lane & 15, g = lane >> 4;
    const bool prod = wid >= 4; const int rw = wid & 3, ptid = rw * 64 + lane;
    const bf16* proj = (const bf16*)(wsb + WS_BIG); bf16* Oout = (bf16*)(wsb + WS_A);
    const float L2E = 1.4426950408889634f;
    const int kp = lane & 7, tg = lane >> 3;
    for (int u = blockIdx.x; u < BATCH * NH; u += G) {
        const int b = u >> 4, h = u & 15;
        if (tid < HD) ((LAS float*)(lds + L_ON))[tid] = h_on[h * HD + tid];
#define HG_LOAD(c_, QW, FW, VW) do { const size_t r0_ = (size_t)b * SEQ + 64 * (c_); \
        _Pragma("unroll") for (int c2 = 0; c2 < 2; ++c2) _Pragma("unroll") for (int i = 0; i < 8; ++i) { const size_t r = r0_ + 8 * tg + i; const int ch_ = h * HD + 32 * rw + 16 * c2 + 2 * kp; \
            QW[c2][i] = *(const GAS unsigned*)(proj + r * FF + ch_); FW[c2][i] = *(const GAS unsigned*)(proj + r * FF + 2048 + ch_); } \
        _Pragma("unroll") for (int j = 0; j < 4; ++j) { const int ci = ptid + 256 * j; VW[j] = *(const GAS v4u*)(proj + (r0_ + (ci >> 4)) * FF + 4096 + h * HD + 8 * (ci & 15)); } } while (0)
#define HG_PREP(pb, QW, FW, VW) do { LAS unsigned char* B_ = lds + (pb) * BUFB; \
        _Pragma("unroll") for (int c2 = 0; c2 < 2; ++c2) { const int chl_ = 32 * rw + 16 * c2 + 2 * kp; float bl0[8], bl1[8]; float c0 = 0.f, c1 = 0.f; \
            _Pragma("unroll") for (int i = 0; i < 8; ++i) { c0 += bflo(FW[c2][i]); c1 += bfhi(FW[c2][i]); bl0[i] = c0; bl1[i] = c1; } \
            float i0 = c0, i1 = c1; \
            _Pragma("unroll") for (int d = 8; d < 64; d <<= 1) { const float x0 = __shfl_up(i0, d), x1 = __shfl_up(i1, d); if (lane >= d) { i0 += x0; i1 += x1; } } \
            const float p0 = i0 - c0, p1 = i1 - c1; \
            if (tg == 7) *(LAS f32x2v*)(lds + L_EBL + (pb) * 512 + chl_ * 4) = (f32x2v){__builtin_amdgcn_exp2f(i0 * L2E), __builtin_amdgcn_exp2f(i1 * L2E)}; \
            _Pragma("unroll") for (int i = 0; i < 8; ++i) { const float b0 = (p0 + bl0[i]) * L2E, b1 = (p1 + bl1[i]) * L2E; \
                const float e0 = __builtin_amdgcn_exp2f(b0), e1 = __builtin_amdgcn_exp2f(b1), n0 = __builtin_amdgcn_exp2f(-b0), n1 = __builtin_amdgcn_exp2f(-b1); \
                const float k0 = 1.f - __builtin_amdgcn_exp2f(bflo(FW[c2][i]) * L2E), k1 = 1.f - __builtin_amdgcn_exp2f(bfhi(FW[c2][i]) * L2E); \
                const int t = 8 * tg + i; \
                *(LAS unsigned*)(B_ + L_Q + t * RS + chl_ * 2) = cvtpk(bflo(QW[c2][i]) * e0, bfhi(QW[c2][i]) * e1); \
                *(LAS unsigned*)(B_ + L_K + t * RS + chl_ * 2) = cvtpk(k0 * n0, k1 * n1); } } \
        _Pragma("unroll") for (int j = 0; j < 4; ++j) { const int ci = ptid + 256 * j; *(LAS v4u*)(B_ + L_V + (ci >> 4) * RS + (ci & 15) * 16) = VW[j]; } } while (0)
        if (prod) {
            unsigned qwA[2][8], fwA[2][8], qwB[2][8], fwB[2][8]; v4u vwA[4], vwB[4], gwA[4], gwB[4];
#pragma unroll
            for (int j = 0; j < 4; ++j) { gwA[j] = (v4u){0u, 0u, 0u, 0u}; gwB[j] = (v4u){0u, 0u, 0u, 0u}; }
#define HG_GATES(c_, GW) do { const int t_ = ptid >> 2, vq_ = ptid & 3; const size_t r_ = (size_t)b * SEQ + 64 * (c_) + t_; \
            _Pragma("unroll") for (int j = 0; j < 4; ++j) GW[j] = *(const GAS v4u*)(proj + r_ * FF + 6144 + h * HD + 32 * vq_ + 8 * j); } while (0)
            HG_LOAD(0, qwA, fwA, vwA); HG_PREP(0, qwA, fwA, vwA); HG_LOAD(1, qwB, fwB, vwB); HG_LOAD(2, qwA, fwA, vwA); HG_GATES(0, gwA);
            HG_BAR();
            for (int c = 0; c < SEQ / 64; c += 2) {
                { const size_t row0 = (size_t)b * SEQ + 64 * c;
                if (c > 0) {
                    const int t = ptid >> 2, vq = ptid & 3; const size_t r = row0 - 64 + t;
                    float ov[32]; float ss = 0.f;
#pragma unroll
                    for (int j = 0; j < 4; ++j) { const v4u w = *(const LAS v4u*)(lds + L_O + t * RS + vq * 64 + j * 16);
                        ov[8 * j + 0] = bflo(w.x); ov[8 * j + 1] = bfhi(w.x); ov[8 * j + 2] = bflo(w.y); ov[8 * j + 3] = bfhi(w.y); ov[8 * j + 4] = bflo(w.z); ov[8 * j + 5] = bfhi(w.z); ov[8 * j + 6] = bflo(w.w); ov[8 * j + 7] = bfhi(w.w); }
#pragma unroll
                    for (int j = 0; j < 32; ++j) ss += ov[j] * ov[j];
                    ss += __shfl_xor(ss, 1); ss += __shfl_xor(ss, 2);
                    const float rinv = 1.f / sqrtf(ss * (1.f / 128.f) + RMS_EPS);
                    bf16* op = Oout + r * DM + h * HD + 32 * vq;
#pragma unroll
                    for (int j = 0; j < 4; ++j) { const v4u gq = gwB[j]; const f32x4v on0 = *(const LAS f32x4v*)(lds + L_ON + (32 * vq + 8 * j) * 4), on1 = *(const LAS f32x4v*)(lds + L_ON + (32 * vq + 8 * j + 4) * 4);
                        v4u o4;
                        o4.x = cvtpk(ov[8 * j + 0] * rinv * on0[0] * bflo(gq.x), ov[8 * j + 1] * rinv * on0[1] * bfhi(gq.x));
                        o4.y = cvtpk(ov[8 * j + 2] * rinv * on0[2] * bflo(gq.y), ov[8 * j + 3] * rinv * on0[3] * bfhi(gq.y));
                        o4.z = cvtpk(ov[8 * j + 4] * rinv * on1[0] * bflo(gq.z), ov[8 * j + 5] * rinv * on1[1] * bfhi(gq.z));
                        o4.w = cvtpk(ov[8 * j + 6] * rinv * on1[2] * bflo(gq.w), ov[8 * j + 7] * rinv * on1[3] * bfhi(gq.w));
                        *(GAS v4u*)(op + 8 * j) = o4; }
                }
                  HG_GATES(c + 1, gwB); }
                HG_BAR();
                HG_PREP(1, qwB, fwB, vwB); if (c + 3 < SEQ / 64) HG_LOAD(c + 3, qwB, fwB, vwB);
                HG_BAR();
                { const int c = 0; (void)c; }
                { const size_t row0 = (size_t)b * SEQ + 64 * (c + 1); const int c_ = c + 1;
                if (c_ > 0) {
                    const int t = ptid >> 2, vq = ptid & 3; const size_t r = row0 - 64 + t;
                    float ov[32]; float ss = 0.f;
#pragma unroll
                    for (int j = 0; j < 4; ++j) { const v4u w = *(const LAS v4u*)(lds + L_O + t * RS + vq * 64 + j * 16);
                        ov[8 * j + 0] = bflo(w.x); ov[8 * j + 1] = bfhi(w.x); ov[8 * j + 2] = bflo(w.y); ov[8 * j + 3] = bfhi(w.y); ov[8 * j + 4] = bflo(w.z); ov[8 * j + 5] = bfhi(w.z); ov[8 * j + 6] = bflo(w.w); ov[8 * j + 7] = bfhi(w.w); }
#pragma unroll
                    for (int j = 0; j < 32; ++j) ss += ov[j] * ov[j];
                    ss += __shfl_xor(ss, 1); ss += __shfl_xor(ss, 2);
                    const float rinv = 1.f / sqrtf(ss * (1.f / 128.f) + RMS_EPS);
                    bf16* op = Oout + r * DM + h * HD + 32 * vq;
#pragma unroll
                    for (int j = 0; j < 4; ++j) { const v4u gq = gwA[j]; const f32x4v on0 = *(const LAS f32x4v*)(lds + L_ON + (32 * vq + 8 * j) * 4), on1 = *(const LAS f32x4v*)(lds + L_ON + (32 * vq + 8 * j + 4) * 4);
                        v4u o4;
                        o4.x = cvtpk(ov[8 * j + 0] * rinv * on0[0] * bflo(gq.x), ov[8 * j + 1] * rinv * on0[1] * bfhi(gq.x));
                        o4.y = cvtpk(ov[8 * j + 2] * rinv * on0[2] * bflo(gq.y), ov[8 * j + 3] * rinv * on0[3] * bfhi(gq.y));
                        o4.z = cvtpk(ov[8 * j + 4] * rinv * on1[0] * bflo(gq.z), ov[8 * j + 5] * rinv * on1[1] * bfhi(gq.z));
                        o4.w = cvtpk(ov[8 * j + 6] * rinv * on1[2] * bflo(gq.w), ov[8 * j + 7] * rinv * on1[3] * bfhi(gq.w));
                        *(GAS v4u*)(op + 8 * j) = o4; }
                }
                  if (c + 2 < SEQ / 64) HG_GATES(c + 2, gwA); }
                HG_BAR();
                if (c + 2 < SEQ / 64) { HG_PREP(0, qwA, fwA, vwA); if (c + 4 < SEQ / 64) HG_LOAD(c + 4, qwA, fwA, vwA); }
                HG_BAR();
            }
            {
            const int t = ptid >> 2, vq = ptid & 3; const size_t r = (size_t)b * SEQ + SEQ - 64 + t;
            float ov[32]; float ss = 0.f;
#pragma unroll
            for (int j = 0; j < 4; ++j) { const v4u w = *(const LAS v4u*)(lds + L_O + t * RS + vq * 64 + j * 16);
                ov[8 * j + 0] = bflo(w.x); ov[8 * j + 1] = bfhi(w.x); ov[8 * j + 2] = bflo(w.y); ov[8 * j + 3] = bfhi(w.y); ov[8 * j + 4] = bflo(w.z); ov[8 * j + 5] = bfhi(w.z); ov[8 * j + 6] = bflo(w.w); ov[8 * j + 7] = bfhi(w.w); }
#pragma unroll
            for (int j = 0; j < 32; ++j) ss += ov[j] * ov[j];
            ss += __shfl_xor(ss, 1); ss += __shfl_xor(ss, 2);
            const float rinv = 1.f / sqrtf(ss * (1.f / 128.f) + RMS_EPS);
            bf16* op = Oout + r * DM + h * HD + 32 * vq;
#pragma unroll
            for (int j = 0; j < 4; ++j) { const v4u gq = gwB[j]; const f32x4v on0 = *(const LAS f32x4v*)(lds + L_ON + (32 * vq + 8 * j) * 4), on1 = *(const LAS f32x4v*)(lds + L_ON + (32 * vq + 8 * j + 4) * 4);
                v4u o4;
                o4.x = cvtpk(ov[8 * j + 0] * rinv * on0[0] * bflo(gq.x), ov[8 * j + 1] * rinv * on0[1] * bfhi(gq.x));
                o4.y = cvtpk(ov[8 * j + 2] * rinv * on0[2] * bflo(gq.y), ov[8 * j + 3] * rinv * on0[3] * bfhi(gq.y));
                o4.z = cvtpk(ov[8 * j + 4] * rinv * on1[0] * bflo(gq.z), ov[8 * j + 5] * rinv * on1[1] * bfhi(gq.z));
                o4.w = cvtpk(ov[8 * j + 6] * rinv * on1[2] * bflo(gq.w), ov[8 * j + 7] * rinv * on1[3] * bfhi(gq.w));
                *(GAS v4u*)(op + 8 * j) = o4; }
            }
#undef HG_GATES
        } else {
            f32x4v S[8][2];
#pragma unroll
            for (int m = 0; m < 8; ++m) { S[m][0] = (f32x4v){0.f, 0.f, 0.f, 0.f}; S[m][1] = (f32x4v){0.f, 0.f, 0.f, 0.f}; }
            HG_BAR();
            for (int c = 0; c < SEQ / 64; ++c) {
                const int cb = c & 1;
                LAS unsigned char* CB = lds + cb * BUFB;
                {
                const int mt = rw;
                f32x4v acc[4];
#pragma unroll
                for (int nt = 0; nt < 4; ++nt) acc[nt] = (f32x4v){0.f, 0.f, 0.f, 0.f};
#pragma unroll
                for (int ks = 0; ks < 4; ++ks) { const bf16x8 a = *(const LAS bf16x8*)(CB + L_Q + (16 * mt + li) * RS + (32 * ks + 8 * g) * 2);
#pragma unroll
                    for (int nt = 0; nt < 4; ++nt) { const bf16x8 bb = *(const LAS bf16x8*)(CB + L_K + (16 * nt + li) * RS + (32 * ks + 8 * g) * 2);
                        acc[nt] = __builtin_amdgcn_mfma_f32_16x16x32_bf16(a, bb, acc[nt], 0, 0, 0); } }
#pragma unroll
                for (int nt = 0; nt < 4; ++nt) { const int s = 16 * nt + li;
#pragma unroll
                    for (int r = 0; r < 4; ++r) { const int t = 16 * mt + 4 * g + r; const float v = (s <= t) ? acc[nt][r] : 0.f;
                        *(LAS unsigned short*)(lds + L_AM + t * RSA + s * 2) = (unsigned short)f2bf(v); } }
                }
                HG_BAR();
                {
                f32x4v o[4][2];
#pragma unroll
                for (int m = 0; m < 4; ++m) { o[m][0] = (f32x4v){0.f, 0.f, 0.f, 0.f}; o[m][1] = (f32x4v){0.f, 0.f, 0.f, 0.f}; }
                { v2u qlo[4][4], qhi[4][4];
#pragma unroll
                  for (int ks = 0; ks < 4; ++ks)
#pragma unroll
                      for (int m = 0; m < 4; ++m) { const LAS unsigned char* qa = CB + L_Q + (16 * m + li) * RS + (32 * ks + 4 * g) * 2; qlo[ks][m] = *(const LAS v2u*)qa; qhi[ks][m] = *(const LAS v2u*)(qa + 32); }
                  __builtin_amdgcn_sched_barrier(0);
#pragma unroll
                  for (int ks = 0; ks < 4; ++ks) { bf16x8 bs[2];
#pragma unroll
                      for (int n = 0; n < 2; ++n) { v4u bw; bw.x = cvtpk(S[2 * ks][n][0], S[2 * ks][n][1]); bw.y = cvtpk(S[2 * ks][n][2], S[2 * ks][n][3]); bw.z = cvtpk(S[2 * ks + 1][n][0], S[2 * ks + 1][n][1]); bw.w = cvtpk(S[2 * ks + 1][n][2], S[2 * ks + 1][n][3]);
                          bs[n] = *reinterpret_cast<bf16x8*>(&bw); }
#pragma unroll
                      for (int m = 0; m < 4; ++m) { v4u aw; aw.x = qlo[ks][m].x; aw.y = qlo[ks][m].y; aw.z = qhi[ks][m].x; aw.w = qhi[ks][m].y;
                          const bf16x8 av = *reinterpret_cast<bf16x8*>(&aw);
                          o[m][0] = __builtin_amdgcn_mfma_f32_16x16x32_bf16(av, bs[0], o[m][0], 0, 0, 0);
                          o[m][1] = __builtin_amdgcn_mfma_f32_16x16x32_bf16(av, bs[1], o[m][1], 0, 0, 0); } } }
                bf16x8 bv[2][2];
#pragma unroll
                for (int n = 0; n < 2; ++n) {
                    const int va = (int)(unsigned)(uintptr_t)(CB + L_V) + (8 * g + (li >> 2)) * RS + (16 * (2 * rw + n) + 4 * (li & 3)) * 2;
                    s16x4 a0, a1, a2, a3; HG_TR(a0, va, 0); HG_TR(a1, va, 4 * RS); HG_TR(a2, va, 32 * RS); HG_TR(a3, va, 36 * RS);
                    asm volatile("s_waitcnt lgkmcnt(0)" ::: "memory"); __builtin_amdgcn_sched_barrier(0);
                    bv[n][0] = (bf16x8){a0[0], a0[1], a0[2], a0[3], a1[0], a1[1], a1[2], a1[3]}; bv[n][1] = (bf16x8){a2[0], a2[1], a2[2], a2[3], a3[0], a3[1], a3[2], a3[3]}; }
#pragma unroll
                for (int ks = 0; ks < 2; ++ks)
#pragma unroll
                    for (int m = 0; m < 4; ++m) { const bf16x8 a = *(const LAS bf16x8*)(lds + L_AM + (16 * m + li) * RSA + (32 * ks + 8 * g) * 2);
                        o[m][0] = __builtin_amdgcn_mfma_f32_16x16x32_bf16(a, bv[0][ks], o[m][0], 0, 0, 0);
                        o[m][1] = __builtin_amdgcn_mfma_f32_16x16x32_bf16(a, bv[1][ks], o[m][1], 0, 0, 0); }
                { const int ka = (int)(unsigned)(uintptr_t)(CB + L_K) + (8 * g + (li >> 2)) * RS + (4 * (li & 3)) * 2;
                  const LAS float* ebl = (const LAS float*)(lds + L_EBL + cb * 512);
#pragma unroll
                  for (int m = 0; m < 8; ++m) { s16x4 a0, a1, a2, a3;
#define HG_KT(m_) HG_TR(a0, ka, (m_) * 32); HG_TR(a1, ka, (m_) * 32 + 4 * RS); HG_TR(a2, ka, (m_) * 32 + 32 * RS); HG_TR(a3, ka, (m_) * 32 + 36 * RS)
                      switch (m) { case 0: HG_KT(0); break; case 1: HG_KT(1); break; case 2: HG_KT(2); break; case 3: HG_KT(3); break; case 4: HG_KT(4); break; case 5: HG_KT(5); break; case 6: HG_KT(6); break; default: HG_KT(7); break; }
#undef HG_KT
                      asm volatile("s_waitcnt lgkmcnt(0)" ::: "memory"); __builtin_amdgcn_sched_barrier(0);
                      const bf16x8 kt0 = (bf16x8){a0[0], a0[1], a0[2], a0[3], a1[0], a1[1], a1[2], a1[3]}, kt1 = (bf16x8){a2[0], a2[1], a2[2], a2[3], a3[0], a3[1], a3[2], a3[3]};
                      const f32x4v e = *(const LAS f32x4v*)(ebl + 16 * m + 4 * g);
#pragma unroll
                      for (int n = 0; n < 2; ++n) { S[m][n] = __builtin_amdgcn_mfma_f32_16x16x32_bf16(kt0, bv[n][0], S[m][n], 0, 0, 0);
                          S[m][n] = __builtin_amdgcn_mfma_f32_16x16x32_bf16(kt1, bv[n][1], S[m][n], 0, 0, 0);
                          S[m][n] = S[m][n] * e; } } }
#pragma unroll
                for (int m = 0; m < 4; ++m)
#pragma unroll
                    for (int n = 0; n < 2; ++n)
#pragma unroll
                        for (int r = 0; r < 4; ++r) *(LAS unsigned short*)(lds + L_O + (16 * m + 4 * g + r) * RS + (16 * (2 * rw + n) + li) * 2) = (unsigned short)f2bf(o[m][n][r]);
                }
                HG_BAR();
            }
        }
        LDS_WAIT();
        __syncthreads();
#undef HG_LOAD
#undef HG_PREP
    }
}
#undef HG_TR
#undef HG_BAR
}

struct Args { const float* in[14]; float* out; unsigned char* ws; int ph_lo, ph_hi; };
#ifndef CONV_IN_SCAN
#define CONV_IN_SCAN 1
#endif
#ifndef MK_N_LAUNCHES
#define MK_N_LAUNCHES 1
#endif
constexpr int MISC_OFF = LDS_BYTES - 64;
constexpr int N_PHASES = 10;
__global__ void __launch_bounds__(NTHREADS, 2) mk_fwd(Args args) {
    extern __shared__ __attribute__((aligned(16))) unsigned char lds[];
    Frame F;
    F.lds = (LAS unsigned char*)lds;
    F.wave = __builtin_amdgcn_readfirstlane((int)threadIdx.x >> 6); F.lane = lane_id(); F.tid = F.wave * 64 + F.lane;
    F.G = gridDim.x; F.gw = blockIdx.x * NWAVES + F.wave; F.NGW = F.G * NWAVES;
    F.x = args.in[0]; F.norm_g = args.in[1]; F.rel = args.in[2]; F.w_in = args.in[3]; F.pe = args.in[4]; F.cw1 = args.in[5]; F.cw2 = args.in[6]; F.w_out = args.in[7];
    F.h_in = args.in[8]; F.h_lb = args.in[9]; F.h_on = args.in[10]; F.h_out = args.in[11]; F.up = args.in[12]; F.dn = args.in[13];
    F.out = args.out; F.ws = args.ws;
    unsigned char* ws = args.ws;
    bf16* A = (bf16*)(ws + WS_A); bf16* BIG = (bf16*)(ws + WS_BIG); bf16* X16 = (bf16*)(ws + WS_X16);
    const int lo = args.ph_lo, hi = args.ph_hi;
    if (F.tid < 4) ((LAS unsigned*)(F.lds + MISC_OFF))[F.tid] = 0u;
    __syncthreads();
    XcdBarrier bar; bar.wave = F.wave; bar.bar = (unsigned*)(ws + WS_CTL) + 1024; bar.x = 0; bar.st = nullptr;
    if (hi - lo > 1) bar = xcd_barrier_post((unsigned*)(ws + WS_CTL) + 1024, (volatile LAS unsigned*)(F.lds + MISC_OFF), F.wave);
#define IN(k) (lo <= (k) && (k) < hi)
#define PH_FENCE() do { F.lane = lane_id(); F.tid = F.wave * 64 + F.lane; } while (0)
#define SEAM(k) do { if (IN(k) && IN((k) + 1)) xcd_barrier(bar); } while (0)
#define GEMM_PHASE_M(ACT, Ap, Btp, MR_, N_, K_, Op, ldc_, st_, sc_, rs_) do { pg8::Gemm g{(Ap), (Btp), (MR_), (N_), (K_)}; pg8::StaticOrder S; S.init((MR_), (N_), F.G, (int)blockIdx.x); \
        EpiAct<ACT> E{(Op), (ldc_), (st_), (sc_), (const float*)(ws + WS_LB), (rs_), 1.f}; pg8::gemm_phase<EpiAct<ACT>, pg8::StaticOrder, true, true>(F.lds, g, S, E, F.tid); } while (0)
#define GEMM_PHASE(ACT, Ap, Btp, N_, K_, Op, ldc_, st_, sc_, rs_) GEMM_PHASE_M(ACT, Ap, Btp, M, N_, K_, Op, ldc_, st_, sc_, rs_)
#define PANEL_SQL(e_, ro_) PanelSqLast{(float*)(ws + WS_SLOTS) + ((size_t)(e_) * M + (ro_)) * 8, (unsigned*)(ws + WS_CTL) + CW_PANEL + ((e_) * 64 + (ro_) / 256) * 64, (float*)(ws + WS_RINV) + (ro_)}
#define PANEL_SQ(e_, ro_) PanelSq{(float*)(ws + WS_SLOTS) + ((size_t)(e_) * M + (ro_)) * 8, (unsigned*)(ws + WS_CTL) + CW_PANEL + ((e_) * 64 + (ro_) / 256) * 64, (unsigned*)(ws + WS_CTL) + CW_XTMO}
#define GEMM_FUSED(XF32_, FINAL_, W8_, F8_, Ap, Btp, K_, osc_, ro_, xoldp, gp, e1_, e2_) GEMM_FUSED8(XF32_, FINAL_, W8_, F8_, Ap, Btp, K_, osc_, ro_, xoldp, gp, e1_, e2_, WS_X8)
#define GEMM_FUSED8(XF32_, FINAL_, W8_, F8_, Ap, Btp, K_, osc_, ro_, xoldp, gp, e1_, e2_, X8OFF_) do { pg8::Gemm g{(Ap), (Btp), M / 2, DM, (K_)}; pg8::StaticOrder S; S.init(M / 2, DM, F.G, (int)blockIdx.x); \
        EpiRmsRes<XF32_, FINAL_, W8_> E{(const void*)(xoldp), X16 + (size_t)(ro_) * DM, F.out + (size_t)(ro_) * DM, (gp), ws + (X8OFF_) + (size_t)(ro_) * DM, (osc_), PANEL_SQ(e1_, ro_), PANEL_SQL(e2_, ro_)}; \
        pg8::gemm_phase<EpiRmsRes<XF32_, FINAL_, W8_>, pg8::StaticOrder, false, true, F8_>(F.lds, g, S, E, F.tid); } while (0)
#define MLP_FULL_F(FINAL_, WUP, WDN, gp, e1_, e2_) do { { pg8::Gemm g{(const bf16*)(ws + WS_X8), (const bf16*)(ws + (WUP)), M, FF, DM / 2}; pg8::StaticOrder S; S.init(M, FF, F.G, (int)blockIdx.x); \
        EpiUp8 E{ws + WS_BIG, FF, (const float*)(ws + WS_RINV)}; pg8::gemm_phase<EpiUp8, pg8::StaticOrder, true, true, true>(F.lds, g, S, E, F.tid); } xcd_barrier(bar); PH_FENCE(); \
        GEMM_FUSED8(false, FINAL_, !(FINAL_), true, BIG, (const bf16*)(ws + (WDN)), FF / 2, 1.f / (W8SCALE * H8SCALE), 0, X16, gp, e1_, e2_, WS_A); __syncthreads(); PH_FENCE(); \
        GEMM_FUSED8(false, FINAL_, !(FINAL_), true, (const bf16*)(ws + WS_BIG + (size_t)(M / 2) * FF), (const bf16*)(ws + (WDN)), FF / 2, 1.f / (W8SCALE * H8SCALE), M / 2, X16 + (size_t)(M / 2) * DM, gp, e1_, e2_, WS_A); } while (0)

    if (IN(0)) { PH_FENCE(); p0_prologue(F); } SEAM(0);
    if (IN(1)) { PH_FENCE(); GEMM_PHASE(0, A, (const bf16*)(ws + W0_QKV), NQKV, DM, BIG, NQKV, 8, QSCALE, (const float*)(ws + WS_RINV)); } SEAM(1);
    if (IN(2)) { PH_FENCE(); cg::cmp_gate_phase(F.lds, ws, F.G, F.tid); } SEAM(2);
    if (IN(3)) { PH_FENCE(); nsa::nsa_phase(F.lds, ws, F.G, F.tid); } SEAM(3);
    if (IN(4)) { PH_FENCE(); GEMM_FUSED(true, false, true, false, A, (const bf16*)(ws + W0_O), DM, 1.f, 0, F.x, F.norm_g + 1 * DM, 0, 1); __syncthreads();
                 GEMM_FUSED(true, false, true, false, A + (size_t)(M / 2) * DM, (const bf16*)(ws + W0_O), DM, 1.f, M / 2, F.x + (size_t)(M / 2) * DM, F.norm_g + 1 * DM, 0, 1); } SEAM(4);
    if (IN(5)) { PH_FENCE(); MLP_FULL_F(false, W0_UP, W0_DN, F.norm_g + 3 * DM, 2, 3); __syncthreads(); PH_FENCE(); p_convert_l1a(F); } SEAM(5);
    if (IN(6)) { PH_FENCE(); pg8::Gemm g{(const bf16*)(ws + WS_A), (const bf16*)(ws + W1_IN), M, FF, DM / 2}; pg8::StaticOrder S; S.init(M, FF, F.G, (int)blockIdx.x);
                 EpiAct<2> E{BIG, FF, 0, 1.f, (const float*)(ws + WS_LB), (const float*)(ws + WS_RINV), 1.f / W8SCALE}; pg8::gemm_phase<EpiAct<2>, pg8::StaticOrder, false, true, true>(F.lds, g, S, E, F.tid); } SEAM(6);
    if (IN(7)) { PH_FENCE(); const int nstat = (F.G - BATCH * NH) * NWAVES;
                 if ((int)blockIdx.x >= BATCH * NH) p_convert_l1b(F, ((int)blockIdx.x - BATCH * NH) * NWAVES + F.wave, nstat);
                 else { hg::scan_phase(F.lds, ws, F.h_on, F.G, F.tid); PH_FENCE(); p_convert_l1b(F, -1, nstat); } } SEAM(7);
    if (IN(8)) { PH_FENCE(); GEMM_FUSED(false, false, true, false, A, (const bf16*)(ws + W1_O), DM, 1.f, 0, X16, F.norm_g + 5 * DM, 4, 5); __syncthreads();
                 GEMM_FUSED(false, false, true, false, A + (size_t)(M / 2) * DM, (const bf16*)(ws + W1_O), DM, 1.f, M / 2, X16 + (size_t)(M / 2) * DM, F.norm_g + 5 * DM, 4, 5); } SEAM(8);
    if (IN(9)) { PH_FENCE(); MLP_FULL_F(true, W1_UP, W1_DN, F.norm_g + 7 * DM, 6, 7); }
#undef IN
}

extern "C" void kernel_launch(void* const* d_in, const int* in_sizes, int n_in, void* d_out, int out_size, void* d_ws, size_t ws_size, hipStream_t stream) {
    static int grid = 0;
    if (grid == 0) {
        if (n_in != 14 || in_sizes[0] != M * DM || out_size != M * DM || ws_size < WS_END) { fprintf(stderr, "kernel_launch: unexpected shapes (n_in %d, ws %zu)\n", n_in, ws_size); grid = -1; return; }
        int dev = 0, cus = 0;
        if (hipGetDevice(&dev) != hipSuccess || hipDeviceGetAttribute(&cus, hipDeviceAttributeMultiprocessorCount, dev) != hipSuccess) { grid = -1; return; }
        if (hipFuncSetAttribute((const void*)mk_fwd, hipFuncAttributeMaxDynamicSharedMemorySize, LDS_BYTES) != hipSuccess) { fprintf(stderr, "kernel_launch: hipFuncSetAttribute failed\n"); grid = -1; return; }
        (void)hipGetLastError();
        if (cus < 256) { fprintf(stderr, "kernel_launch: this kernel needs 256 co-resident workgroups (one per CU); the device has %d CUs\n", cus); grid = -1; return; }
        grid = 256;
    }
    if (grid < 0) return;
    Args a{};
    for (int i = 0; i < 14; ++i) a.in[i] = (const float*)d_in[i];
    a.out = (float*)d_out; a.ws = (unsigned char*)d_ws;
    if (hipMemsetAsync((char*)d_ws + WS_CTL, 0, CTL_ZERO_BYTES, stream) != hipSuccess) return;
    if (MK_N_LAUNCHES == 1) { a.ph_lo = 0; a.ph_hi = N_PHASES; hipLaunchKernelGGL(mk_fwd, dim3(grid), dim3(NTHREADS), LDS_BYTES, stream, a); }
    else for (int p = 0; p < N_PHASES; ++p) { a.ph_lo = p; a.ph_hi = p + 1; hipLaunchKernelGGL(mk_fwd, dim3(grid), dim3(NTHREADS), LDS_BYTES, stream, a); }
}
```

```cpp
#include <hip/hip_runtime.h>
#include <cstdio>
#include <cstdint>
namespace pg8 {
#define PG8_LAS __attribute__((address_space(3)))
typedef unsigned short bf16_t;
typedef short bf16x8 __attribute__((ext_vector_type(8)));
typedef float f32x4 __attribute__((ext_vector_type(4)));
typedef unsigned u32x4 __attribute__((ext_vector_type(4)));
constexpr int BM = 256, BK = 64, HALF = 128, HTB = HALF * BK * 2  , STAGE_BYTES = 8 * HTB, NXCD = 8, WGM = 4;

__host__ __device__ __forceinline__ int lds_byte(int r, int c) { const int st = (r >> 4) * 2 + (c >> 5), rr = r & 15, cc = c & 31, ob = rr * 64 + cc * 2; return st * 1024 + (ob ^ (((ob >> 9) & 1) << 5)); }
__host__ __device__ __forceinline__ void stage_rc(int b, int& R, int& C) { const int st = b / 1024, sb = b % 1024, swz = sb ^ (((sb >> 9) & 1) << 5); R = (st >> 1) * 16 + swz / 64; C = (st & 1) * 32 + (swz % 64) / 2; }
__host__ __device__ __forceinline__ int perm32(int rho) { const int n = rho >> 4, i = rho & 15; return 8 * (i >> 2) + 4 * n + (i & 3); }

typedef int i32x4 __attribute__((ext_vector_type(4)));
typedef int i32x8 __attribute__((ext_vector_type(8)));
struct Unit { int pm, pn; };
struct Gemm { const bf16_t* A; const bf16_t* Bt; int M, N, K; };

struct StaticOrder {
    int nM, nN, nwg, G, c;
    __host__ __device__ void init(int M, int N, int G_, int c_) { nM = M / BM; nN = N / BM; nwg = nM * nN; G = G_; c = c_; }
    __host__ __device__ bool next(int i, Unit& u) const {
        const long L = (long)i * G + c; if (L >= nwg) return false;
        int wgid = (int)L; { const int q = nwg / NXCD, r = nwg % NXCD, xcd = wgid % NXCD, off = wgid / NXCD; wgid = (xcd < r ? xcd * (q + 1) : r * (q + 1) + (xcd - r) * q) + off; }
        const int nig = WGM * nN, gid = wgid / nig, fm = gid * WGM, gsz = (nM - fm) < WGM ? (nM - fm) : WGM;
        u.pm = fm + ((wgid % nig) % gsz); u.pn = (wgid % nig) / gsz; return true;
    }
    __device__ __forceinline__ void a_ready(const Unit&) const {}
    __device__ __forceinline__ void done(const Unit&) const {}
};

__device__ __forceinline__ unsigned cvt_pk_bf16(float lo, float hi) { unsigned r; asm volatile("v_cvt_pk_bf16_f32 %0, %1, %2" : "=v"(r) : "v"(lo), "v"(hi)); return r; }
typedef float f32x2 __attribute__((ext_vector_type(2)));
__device__ __forceinline__ f32x2 gelu_pk(f32x2 v) {
    const f32x2 av = __builtin_elementwise_abs(v), d = av * 0.2316418882f + 1.0f;
    f32x2 t; t.x = __builtin_amdgcn_rcpf(d.x); t.y = __builtin_amdgcn_rcpf(d.y);
    f32x2 q = t * 0.5307027145f + (-0.7265760135f); q = q * t + 0.7107068705f; q = q * t + (-0.142248368f); q = q * t + 0.127414796f; q = q * t;
    const f32x2 s = (v * v) * (-0.72134752044f);
    f32x2 e; e.x = __builtin_amdgcn_exp2f(s.x); e.y = __builtin_amdgcn_exp2f(s.y);
    const f32x2 m = v * (q * e), r = v - m;
    f32x2 o; o.x = v.x < 0.f ? m.x : r.x; o.y = v.y < 0.f ? m.y : r.y; return o;
}

template <int ACT  > struct EpiBf16 {
    static constexpr bool PERM = true, AFTER_DRAIN = false; static_assert(ACT == 0 || ACT == 1, "EpiBf16: ACT is 0 (none) or 1 (gelu_pk)");
    bf16_t* O; int ldc; const float* bias; int split_cols; size_t split_stride; float scale0;
    __device__ __forceinline__ void operator()(const f32x4 (&acc)[2][2][4][2], const Unit& u, int wr, int wc, int fr, int fq) const {
        const int row0 = u.pm * BM + wr * 64 + fr; int colt = u.pn * BM; bf16_t* base = O;
        float sc = 1.f; if (split_cols) { const int t = colt / split_cols; base += (size_t)t * split_stride; colt -= t * split_cols; if (t == 0) sc = scale0; }
        const int col0 = colt + wc * 32 + 8 * fq, bcol0 = u.pn * BM + wc * 32 + 8 * fq;
        f32x4 bv[2][2];
#pragma unroll
        for (int bj = 0; bj < 2; ++bj)
#pragma unroll
            for (int n = 0; n < 2; ++n) bv[bj][n] = bias ? *(const f32x4*)(bias + bcol0 + bj * HALF + 4 * n) : (f32x4){0.f, 0.f, 0.f, 0.f};
#pragma unroll
        for (int ai = 0; ai < 2; ++ai)
#pragma unroll
            for (int m = 0; m < 4; ++m) { bf16_t* rowp = base + (size_t)(row0 + ai * HALF + m * 16) * ldc + col0;
#pragma unroll
                for (int bj = 0; bj < 2; ++bj) { f32x4 v0 = acc[ai][bj][m][0] + bv[bj][0], v1 = acc[ai][bj][m][1] + bv[bj][1];
                    if (ACT == 1) { f32x2 a = gelu_pk((f32x2){v0[0], v0[1]}), b = gelu_pk((f32x2){v0[2], v0[3]}), c = gelu_pk((f32x2){v1[0], v1[1]}), d = gelu_pk((f32x2){v1[2], v1[3]});
                        v0 = (f32x4){a.x, a.y, b.x, b.y}; v1 = (f32x4){c.x, c.y, d.x, d.y}; }
                    v0 = v0 * sc; v1 = v1 * sc; u32x4 w; w.x = cvt_pk_bf16(v0[0], v0[1]); w.y = cvt_pk_bf16(v0[2], v0[3]); w.z = cvt_pk_bf16(v1[0], v1[1]); w.w = cvt_pk_bf16(v1[2], v1[3]);
                    *(u32x4*)(rowp + bj * HALF) = w; } }
    }
};
__device__ __forceinline__ void mfma_f8(f32x4& c, const i32x8 a, const i32x8 b) { asm volatile("s_nop 1\n\tv_mfma_f32_16x16x128_f8f6f4 %0, %1, %2, %0" : "+v"(c) : "v"(a), "v"(b)); }
template <class Epi, class Sched, bool ALIGN_EPI = false, bool SP2 = false, bool F8 = false>
__device__ __forceinline__ void gemm_phase(PG8_LAS unsigned char* lds, const Gemm g, const Sched& S, const Epi& E, const int tid) {
    const int wid = __builtin_amdgcn_readfirstlane(tid >> 6), lane = tid & 63, wr = wid >> 2, wc = wid & 3, fr = lane & 15, fq = lane >> 4;
    const int K = g.K, nt = K / BK;
    unsigned voffA[2], voffB[2];
#pragma unroll
    for (int i = 0; i < 2; ++i) { int R, C; stage_rc(tid * 16 + i * 8192, R, C); const int Rb = Epi::PERM ? ((R & ~31) + perm32(R & 31)) : R;
        voffA[i] = (unsigned)(R * K + C) * 2u; voffB[i] = (unsigned)(Rb * K + C) * 2u; }
    const size_t kstep = (size_t)(BK * 2);
    const size_t hstep = (size_t)HALF * K * 2;
    const size_t tstep = 2 * hstep;
    const unsigned ldsw = (unsigned)wid * 1024u;
    const int aoff = lds_byte(wr * 64 + fr, fq * 8), boff = lds_byte(wc * 32 + fr, fq * 8);
#define PG8_SA(b, h) (((b) * 2 + (h)) * HTB)
#define PG8_SB(b, h) ((4 + (b) * 2 + (h)) * HTB)
#define PG8_STAGE(bufoff, gbase, voff) do { _Pragma("unroll") for (int _i = 0; _i < 2; ++_i) \
        __builtin_amdgcn_global_load_lds((const unsigned*)((const char*)(gbase) + (voff)[_i]), (PG8_LAS unsigned*)(lds + (bufoff) + ldsw + _i * 8192), 16, 0, 0); } while (0)
#define PG8_LDA(dst, b, h) do { _Pragma("unroll") for (int m = 0; m < 4; ++m) _Pragma("unroll") for (int k = 0; k < 2; ++k) dst[m][k] = *(const PG8_LAS bf16x8*)(lds + PG8_SA(b, h) + aoff + m * 2048 + k * 1024); } while (0)
#define PG8_LDB(dst, b, h) do { _Pragma("unroll") for (int n = 0; n < 2; ++n) _Pragma("unroll") for (int k = 0; k < 2; ++k) dst[n][k] = *(const PG8_LAS bf16x8*)(lds + PG8_SB(b, h) + boff + n * 2048 + k * 1024); } while (0)
#define PG8_CAT8(x) __builtin_shufflevector(__builtin_bit_cast(i32x4, (x)[0]), __builtin_bit_cast(i32x4, (x)[1]), 0, 1, 2, 3, 4, 5, 6, 7)
#define PG8_MMA(ai, bj, At, Bt) do { __builtin_amdgcn_s_setprio(1); _Pragma("unroll") for (int m = 0; m < 4; ++m) _Pragma("unroll") for (int n = 0; n < 2; ++n) { \
        if constexpr (F8) mfma_f8(acc[ai][bj][m][n], PG8_CAT8(Bt[n]), PG8_CAT8(At[m])); \
        else { _Pragma("unroll") for (int k = 0; k < 2; ++k) acc[ai][bj][m][n] = __builtin_amdgcn_mfma_f32_16x16x32_bf16(Bt[n][k], At[m][k], acc[ai][bj][m][n], 0, 0, 0); } } __builtin_amdgcn_s_setprio(0); } while (0)
#define PG8_WAIT_V(n) asm volatile("s_waitcnt vmcnt(" #n ")" ::: "memory")
#define PG8_WAIT_L(n) asm volatile("s_waitcnt lgkmcnt(" #n ")" ::: "memory")
#define PG8_BAR __builtin_amdgcn_s_barrier()
#define PG8_SCHED __builtin_amdgcn_sched_barrier(0)
    Unit cur, nxt; int ui = 0;
    if (!S.next(0, cur)) return;
    float epre[8]; E.prefetch(cur, wr, fr, epre);
    f32x4 acc[2][2][4][2];
#pragma unroll
    for (int a = 0; a < 2; ++a)
#pragma unroll
        for (int b = 0; b < 2; ++b)
#pragma unroll
            for (int m = 0; m < 4; ++m)
#pragma unroll
                for (int n = 0; n < 2; ++n) acc[a][b][m][n] = (f32x4){0.f, 0.f, 0.f, 0.f};
    bf16x8 At[4][2], B0[2][2], B1[2][2];
    const char* cA = (const char*)g.A + (size_t)cur.pm * tstep; const char* cB = (const char*)g.Bt + (size_t)cur.pn * tstep;
    S.a_ready(cur);
    if constexpr (SP2) {
        PG8_STAGE(PG8_SB(0, 0), cB, voffB); PG8_STAGE(PG8_SB(0, 1), cB + hstep, voffB); PG8_STAGE(PG8_SA(0, 0), cA, voffA); PG8_STAGE(PG8_SA(0, 1), cA + hstep, voffA);
        if (wr == 1) PG8_BAR;
        PG8_WAIT_V(2); PG8_BAR;
        PG8_STAGE(PG8_SB(1, 0), cB + kstep, voffB); PG8_STAGE(PG8_SB(1, 1), cB + hstep + kstep, voffB);
        PG8_WAIT_V(4); PG8_BAR;
    } else {
        PG8_STAGE(PG8_SB(0, 0), cB, voffB); PG8_STAGE(PG8_SA(0, 0), cA, voffA); PG8_STAGE(PG8_SB(0, 1), cB + hstep, voffB); PG8_STAGE(PG8_SA(0, 1), cA + hstep, voffA);
        if (wr == 1) PG8_BAR;
        PG8_WAIT_V(4); PG8_BAR;
        PG8_STAGE(PG8_SB(1, 0), cB + kstep, voffB); PG8_STAGE(PG8_SA(1, 0), cA + kstep, voffA); PG8_STAGE(PG8_SB(1, 1), cB + hstep + kstep, voffB);
        PG8_WAIT_V(6); PG8_BAR;
    }
    for (;;) {
        const bool has_next = S.next(ui + 1, nxt);
        const char* nA = has_next ? (const char*)g.A + (size_t)nxt.pm * tstep : cA; const char* nB = has_next ? (const char*)g.Bt + (size_t)nxt.pn * tstep : cB;
        for (int t = 0; t < nt; t += 2) {
            const bool last = (t == nt - 2);
            const char* a1 = cA + (size_t)(t + 1) * kstep;
            const char* a2 = last ? nA : cA + (size_t)(t + 2) * kstep; const char* b2 = last ? nB : cB + (size_t)(t + 2) * kstep;
            const char* a3 = a2 + kstep; const char* b3 = b2 + kstep;
            if (last && has_next) S.a_ready(nxt);
            if constexpr (SP2) {
            PG8_LDB(B0, 0, 0); PG8_LDB(B1, 0, 1); PG8_SCHED; PG8_LDA(At, 0, 0); PG8_STAGE(PG8_SA(1, 0), a1, voffA); PG8_STAGE(PG8_SA(1, 1), a1 + hstep, voffA);
            PG8_WAIT_V(8); PG8_WAIT_L(0); PG8_BAR; PG8_MMA(0, 0, At, B0); PG8_MMA(0, 1, At, B1); PG8_BAR; PG8_SCHED;
            PG8_LDA(At, 0, 1); PG8_STAGE(PG8_SB(0, 0), b2, voffB); PG8_STAGE(PG8_SB(0, 1), b2 + hstep, voffB);
            PG8_WAIT_V(6); PG8_WAIT_L(0); PG8_BAR; PG8_MMA(1, 0, At, B0); PG8_MMA(1, 1, At, B1); PG8_BAR; PG8_SCHED;
            PG8_LDB(B0, 1, 0); PG8_LDB(B1, 1, 1); PG8_SCHED; PG8_LDA(At, 1, 0); PG8_STAGE(PG8_SA(0, 0), a2, voffA); PG8_STAGE(PG8_SA(0, 1), a2 + hstep, voffA);
            PG8_WAIT_V(8); PG8_WAIT_L(0); PG8_BAR; PG8_MMA(0, 0, At, B0); PG8_MMA(0, 1, At, B1); PG8_BAR; PG8_SCHED;
            PG8_LDA(At, 1, 1); PG8_STAGE(PG8_SB(1, 0), b3, voffB); PG8_STAGE(PG8_SB(1, 1), b3 + hstep, voffB);
            PG8_WAIT_V(6); PG8_WAIT_L(0); PG8_BAR; PG8_MMA(1, 0, At, B0); PG8_MMA(1, 1, At, B1); PG8_BAR; PG8_SCHED;
            } else {
            PG8_LDB(B0, 0, 0); PG8_SCHED; PG8_LDA(At, 0, 0); PG8_STAGE(PG8_SA(1, 1), a1 + hstep, voffA);
            PG8_WAIT_L(8); PG8_BAR; PG8_WAIT_L(0); PG8_MMA(0, 0, At, B0); PG8_BAR; PG8_SCHED;
            PG8_LDB(B1, 0, 1); PG8_STAGE(PG8_SB(0, 0), b2, voffB);
            PG8_BAR; PG8_WAIT_L(0); PG8_MMA(0, 1, At, B1); PG8_BAR;
            PG8_LDA(At, 0, 1); PG8_STAGE(PG8_SA(0, 0), a2, voffA);
            PG8_BAR; PG8_WAIT_L(0); PG8_MMA(1, 0, At, B0); PG8_BAR; PG8_SCHED;
            PG8_STAGE(PG8_SB(0, 1), b2 + hstep, voffB);
            PG8_WAIT_V(6); PG8_BAR; PG8_MMA(1, 1, At, B1); PG8_BAR;
            PG8_LDB(B0, 1, 0); PG8_SCHED; PG8_LDA(At, 1, 0); PG8_STAGE(PG8_SA(0, 1), a2 + hstep, voffA);
            PG8_WAIT_L(8); PG8_BAR; PG8_WAIT_L(0); PG8_MMA(0, 0, At, B0); PG8_BAR; PG8_SCHED;
            PG8_LDB(B1, 1, 1); PG8_STAGE(PG8_SB(1, 0), b3, voffB);
            PG8_BAR; PG8_WAIT_L(0); PG8_MMA(0, 1, At, B1); PG8_BAR;
            PG8_LDA(At, 1, 1); PG8_STAGE(PG8_SA(1, 0), a3, voffA);
            PG8_BAR; PG8_WAIT_L(0); PG8_MMA(1, 0, At, B0); PG8_BAR; PG8_SCHED;
            PG8_STAGE(PG8_SB(1, 1), b3 + hstep, voffB);
            PG8_WAIT_V(6); PG8_BAR; PG8_MMA(1, 1, At, B1); PG8_BAR;
            }
        }
        if constexpr (F8) { asm volatile("s_nop 15"); PG8_SCHED; }
        if constexpr (ALIGN_EPI) { if (wr == 0) PG8_BAR; }
        if constexpr (!Epi::AFTER_DRAIN) { E(acc, cur, wr, wc, fr, fq, epre); S.done(cur); }
        if (!has_next) break;
#pragma unroll
        for (int a = 0; a < 2; ++a)
#pragma unroll
            for (int b = 0; b < 2; ++b)
#pragma unroll
                for (int m = 0; m < 4; ++m)
#pragma unroll
                    for (int n = 0; n < 2; ++n) acc[a][b][m][n] = (f32x4){0.f, 0.f, 0.f, 0.f};
        cur = nxt; cA = nA; cB = nB; ++ui;
        E.prefetch(cur, wr, fr, epre);
        if constexpr (ALIGN_EPI) { if (wr == 1) PG8_BAR; }
    }
    PG8_WAIT_V(0);
    if constexpr (!ALIGN_EPI) { if (wr == 0) PG8_BAR; }
    PG8_BAR;
    if constexpr (Epi::AFTER_DRAIN) { E.fused(acc, cur, wr, wc, fr, fq, lds, wid, lane); S.done(cur); }
#undef PG8_SA
#undef PG8_SB
#undef PG8_STAGE
#undef PG8_LDA
#undef PG8_LDB
#undef PG8_MMA
#undef PG8_CAT8
#undef PG8_WAIT_V
#undef PG8_WAIT_L
#undef PG8_BAR
#undef PG8_SCHED
}
}

constexpr int NWAVES = 8, NTHREADS = 512;
constexpr int BATCH = 8, SEQ = 2048, DM = 2048, M = BATCH * SEQ, NH = 16, NG = 4, NR = 4, HD = 128, FF = 8192;
constexpr int NQKV = 5120, NSA_IN = 5168, NC = 127, NCP = 128, NBLK = 32, NGATE = 48;
constexpr float RMS_EPS = 1e-6f;
constexpr int COL_KC = 2048, COL_VC = 2560, COL_KS = 3072, COL_VS = 3584, COL_KW = 4096, COL_VW = 4608;
constexpr float QSCALE = 0.12751743082459868f;

constexpr size_t MiB = 1u << 20;
constexpr size_t WS_CTL = 0, CTL_ZERO_BYTES = 256 * 1024;
constexpr size_t WS_LUT = 1 * MiB, WS_BIAS1 = WS_LUT + 16 * 1024  , WS_LB = WS_BIAS1 + 8192;
constexpr size_t WS_GATES = 2 * MiB;
constexpr size_t WS_KCMP = 5 * MiB, WS_VCMP = 6 * MiB;
constexpr size_t WS_W = 8 * MiB;
constexpr size_t W0_QKV = WS_W, W0_G = WS_W + 20 * MiB, W0_W1 = WS_W + 21 * MiB, W0_W2 = WS_W + 23 * MiB, W0_O = WS_W + 24 * MiB, W0_UP = WS_W + 32 * MiB, W0_DN = WS_W + 64 * MiB;
constexpr size_t W1_IN = WS_W, W1_O = WS_W + 32 * MiB, W1_UP = WS_W + 40 * MiB, W1_DN = WS_W + 72 * MiB;
constexpr size_t WS_A = 120 * MiB;
constexpr size_t WS_BIG = 184 * MiB;
constexpr size_t WS_SCR = 440 * MiB;
constexpr size_t WS_X8 = WS_BIG + 128 * MiB;
constexpr float W8SCALE = 64.f, H8SCALE = 4.f;
constexpr size_t WS_X16 = 440 * MiB;
constexpr size_t WS_RINV = 1 * MiB + 64 * 1024;
constexpr size_t WS_SLOTS = 504 * MiB;
constexpr size_t WS_END = 508 * MiB;
constexpr int CW_XTMO = 64, CW_CONVQ = 128, CW_PANEL = 8192;

constexpr int LDS_BYTES = 147456;

#define GAS __attribute__((address_space(1)))
#define LAS __attribute__((address_space(3)))
typedef unsigned short bf16;
typedef unsigned v4u __attribute__((ext_vector_type(4)));
typedef unsigned v2u __attribute__((ext_vector_type(2)));
typedef float f32x4 __attribute__((ext_vector_type(4)));
#define LDS_WAIT() asm volatile("s_waitcnt lgkmcnt(0)" ::: "memory")
#define VM_WAIT() asm volatile("s_waitcnt vmcnt(0)" ::: "memory")
__device__ __forceinline__ unsigned f2bf(float f) { unsigned u = __builtin_bit_cast(unsigned, f); return (u + 0x7fffu + ((u >> 16) & 1u)) >> 16; }
__device__ __forceinline__ unsigned pk2(float lo, float hi) { return f2bf(lo) | (f2bf(hi) << 16); }
__device__ __forceinline__ float bf2f(unsigned b) { return __builtin_bit_cast(float, b << 16); }
__device__ __forceinline__ float bflo(unsigned w) { return __builtin_bit_cast(float, w << 16); }
__device__ __forceinline__ float bfhi(unsigned w) { return __builtin_bit_cast(float, w & 0xffff0000u); }
__device__ __forceinline__ float wave_sum(float v) {
#pragma unroll
    for (int o = 1; o < 64; o <<= 1) v += __shfl_xor(v, o);
    return v;
}
__device__ __forceinline__ float wave_max(float v) {
#pragma unroll
    for (int o = 1; o < 64; o <<= 1) v = fmaxf(v, __shfl_xor(v, o));
    return v;
}
__device__ __forceinline__ int lane_id() { int l; asm volatile("v_mbcnt_lo_u32_b32 %0, -1, 0\n\tv_mbcnt_hi_u32_b32 %0, -1, %0" : "=v"(l)); return l; }
__device__ __forceinline__ float sigmoidf_(float x) { return 1.f / (1.f + __expf(-x)); }

typedef GAS unsigned gu32;
#define RLX_AGENT __ATOMIC_RELAXED, __HIP_MEMORY_SCOPE_AGENT
#define XB_TMO      128
#define XB_XCNT(j)  (256  + 64 * (j))
#define XB_XSUB(j)  (1280 + 64 * (j))
#define XB_XGEN(j)  (2304 + 64 * (j))
#define XB_TOP      3328
#define XB_TOPGEN   3392
#define XCD_BAR_WORDS 3456
#define XB_SPIN_CAP (1u << 24)

__device__ __forceinline__ unsigned xb_ld(unsigned* p)              { return __hip_atomic_load(p, __ATOMIC_RELAXED, __HIP_MEMORY_SCOPE_AGENT); }
__device__ __forceinline__ unsigned xb_add(unsigned* p, unsigned v) { return __hip_atomic_fetch_add(p, v, __ATOMIC_RELAXED, __HIP_MEMORY_SCOPE_AGENT); }
__device__ __forceinline__ unsigned xb_xcc_id() { return (unsigned)__builtin_amdgcn_s_getreg((3 << 11) | 20) & 0xFu; }
#define XB_SPIN(cond, bar) do { unsigned _sp = 0; while (cond) { __builtin_amdgcn_s_sleep(1); \
    if ((++_sp & 255u) == 0u) { if (xb_ld(&(bar)[XB_TMO])) break; if (_sp > XB_SPIN_CAP) { atomicAdd(&(bar)[XB_TMO], 1u); break; } } } } while (0)

struct XcdBarrier {
    int wave;
    unsigned* bar; unsigned x;
    volatile LAS unsigned* st;
};

__device__ __forceinline__ XcdBarrier xcd_barrier_post(unsigned* bar, volatile LAS unsigned* st, int wave) {
    XcdBarrier b; b.wave = wave; b.bar = bar; b.x = xb_xcc_id(); b.st = st;
    if (wave == 0 && lane_id() == 0) (void)xb_add(&bar[XB_XCNT(b.x)], 1u);
    return b;
}
__device__ __forceinline__ void xcd_barrier_complete(unsigned* bar, unsigned x, unsigned& nloc, unsigned& nx) {
    const unsigned G = gridDim.x * gridDim.y * gridDim.z;
    unsigned sum, cnt, mine, sp = 0u;
    for (;;) {
        sum = 0u; cnt = 0u; mine = 0u;
#pragma unroll
        for (unsigned j = 0; j < 16; ++j) { const unsigned c = xb_ld(&bar[XB_XCNT(j)]); sum += c; cnt += (c > 0u) ? 1u : 0u; mine = (j == x) ? c : mine; }
        if (sum == G) break;
        __builtin_amdgcn_s_sleep(1);
        if ((++sp & 255u) == 0u) { if (xb_ld(&bar[XB_TMO])) break; if (sp > XB_SPIN_CAP) { atomicAdd(&bar[XB_TMO], 1u); break; } }
    }
    nloc = mine > 0u ? mine : 1u; nx = cnt > 0u ? cnt : 1u;
}

__device__ __forceinline__ void xcd_barrier(const XcdBarrier& b) {
    asm volatile("s_waitcnt vmcnt(0)" ::: "memory");
    __syncthreads();
    if (b.wave == 0 && lane_id() == 0) {
        unsigned* bar = b.bar;
        __builtin_amdgcn_s_waitcnt(0);
        unsigned nloc = b.st[0], nx = b.st[1];
        if (nloc == 0u) { xcd_barrier_complete(bar, b.x, nloc, nx); b.st[0] = nloc; b.st[1] = nx; }
        const unsigned old = xb_add(&bar[XB_XSUB(b.x)], 1u);
        const unsigned gen = old / nloc;
        if (old + 1u == (gen + 1u) * nloc) {
            __builtin_amdgcn_fence(__ATOMIC_RELEASE, "agent");
            asm volatile("s_waitcnt vmcnt(0)" ::: "memory");
            const unsigned og = xb_add(&bar[XB_TOP], 1u);
            const unsigned tg = og / nx;
            if (og + 1u == (tg + 1u) * nx) xb_add(&bar[XB_TOPGEN], 1u);
            else XB_SPIN(xb_ld(&bar[XB_TOPGEN]) == tg, bar);
            __builtin_amdgcn_fence(__ATOMIC_ACQUIRE, "agent");
            xb_add(&bar[XB_XGEN(b.x)], 1u);
            asm volatile("s_waitcnt vmcnt(0)" ::: "memory");
        } else {
            XB_SPIN(xb_ld(&bar[XB_XGEN(b.x)]) == gen, bar);
            __builtin_amdgcn_fence(__ATOMIC_ACQUIRE, "agent");
            asm volatile("s_waitcnt vmcnt(0)" ::: "memory");
        }
    }
    __syncthreads();
}

struct Frame {
    LAS unsigned char* lds;
    int tid, lane, wave, G, gw, NGW;
    const float *x, *norm_g, *rel, *w_in, *pe, *cw1, *cw2, *w_out, *h_in, *h_lb, *h_on, *h_out, *up, *dn;
    float* out;
    unsigned char* ws;
};

template <int ACT  > struct EpiAct {
    static constexpr bool PERM = true, AFTER_DRAIN = false;
    bf16* O; int ldc; int scale_tiles; float scale; const float* lb; const float* rs; float rsmul;
    __device__ __forceinline__ void prefetch(const pg8::Unit& u, int wr, int fr, float (&pre)[8]) const {
        const int row0 = u.pm * 256 + wr * 64 + fr;
#pragma unroll
        for (int j = 0; j < 8; ++j) pre[j] = rs ? rs[row0 + (j >> 2) * 128 + (j & 3) * 16] * rsmul : 1.f;
    }
    __device__ __forceinline__ void operator()(const pg8::f32x4 (&acc)[2][2][4][2], const pg8::Unit& u, int wr, int wc, int fr, int fq, const float (&pre)[8]) const {
        const int row0 = u.pm * 256 + wr * 64 + fr, col0 = u.pn * 256 + wc * 32 + 8 * fq;
        const float sc = (u.pn < scale_tiles) ? scale : 1.f;
        const int kind = (ACT == 2) ? ((u.pn < 8 || u.pn >= 24) ? 1 : (u.pn < 16 ? 2 : 0)) : 0;
        pg8::f32x4 lbv[2][2];
        if (ACT == 2) {
#pragma unroll
            for (int bj = 0; bj < 2; ++bj)
#pragma unroll
                for (int n = 0; n < 2; ++n) lbv[bj][n] = (kind == 2) ? *(const pg8::f32x4*)(lb + (col0 - 2048) + bj * 128 + 4 * n) : (pg8::f32x4){0.f, 0.f, 0.f, 0.f};
        }
#pragma unroll
        for (int ai = 0; ai < 2; ++ai)
#pragma unroll
            for (int m = 0; m < 4; ++m) { bf16* rowp = O + (size_t)(row0 + ai * 128 + m * 16) * ldc + col0; const float rsc = pre[ai * 4 + m];
#pragma unroll
                for (int bj = 0; bj < 2; ++bj) { pg8::f32x4 v0 = acc[ai][bj][m][0] * rsc, v1 = acc[ai][bj][m][1] * rsc;
                    if (ACT == 2) {
                        if (kind == 1) {
#pragma unroll
                            for (int j = 0; j < 4; ++j) { v0[j] = v0[j] * __builtin_amdgcn_rcpf(1.f + __expf(-v0[j])); v1[j] = v1[j] * __builtin_amdgcn_rcpf(1.f + __expf(-v1[j])); }
                        } else if (kind == 2) {
#pragma unroll
                            for (int j = 0; j < 4; ++j) { const float l0 = lbv[bj][0][j], l1 = lbv[bj][1][j];
                                v0[j] = __logf(l0 + (1.f - l0) * __builtin_amdgcn_rcpf(1.f + __expf(-v0[j]))); v1[j] = __logf(l1 + (1.f - l1) * __builtin_amdgcn_rcpf(1.f + __expf(-v1[j]))); }
                        }
                    } else { v0 = v0 * sc; v1 = v1 * sc; }
                    pg8::u32x4 w; w.x = pg8::cvt_pk_bf16(v0[0], v0[1]); w.y = pg8::cvt_pk_bf16(v0[2], v0[3]); w.z = pg8::cvt_pk_bf16(v1[0], v1[1]); w.w = pg8::cvt_pk_bf16(v1[2], v1[3]);
                    if (ACT == 2) __builtin_nontemporal_store(w, (pg8::u32x4*)(rowp + bj * 128));
                    else *(pg8::u32x4*)(rowp + bj * 128) = w; } }
    }
};

__device__ __forceinline__ unsigned pk8(float a, float b, float c, float d) { int w = 0; w = __builtin_amdgcn_cvt_pk_fp8_f32(a, b, w, false); w = __builtin_amdgcn_cvt_pk_fp8_f32(c, d, w, true); return (unsigned)w; }
struct EpiUp8 {
    static constexpr bool PERM = true, AFTER_DRAIN = false;
    unsigned char* O; int ldc; const float* rs;
    __device__ __forceinline__ void prefetch(const pg8::Unit& u, int wr, int fr, float (&pre)[8]) const {
        const int row0 = u.pm * 256 + wr * 64 + fr;
#pragma unroll
        for (int j = 0; j < 8; ++j) pre[j] = rs[row0 + (j >> 2) * 128 + (j & 3) * 16] * (2.f / W8SCALE);
    }
    __device__ __forceinline__ void operator()(const pg8::f32x4 (&acc)[2][2][4][2], const pg8::Unit& u, int wr, int wc, int fr, int fq, const float (&pre)[8]) const {
        static_assert(H8SCALE == 4.f, "EpiUp8 folds sqrt(H8SCALE) = 2 into the row scale");
        const int row0 = u.pm * 256 + wr * 64 + fr, col0 = u.pn * 256 + wc * 32 + 8 * fq;
#pragma unroll
        for (int ai = 0; ai < 2; ++ai)
#pragma unroll
            for (int m = 0; m < 4; ++m) { const float rsc = pre[ai * 4 + m]; v2u w[2];
#pragma unroll
                for (int bj = 0; bj < 2; ++bj) { pg8::f32x4 v0 = acc[ai][bj][m][0] * rsc, v1 = acc[ai][bj][m][1] * rsc;
#pragma unroll
                    for (int j = 0; j < 4; ++j) { v0[j] = __builtin_amdgcn_fmed3f(v0[j], 0.f, 21.166010488f); v1[j] = __builtin_amdgcn_fmed3f(v1[j], 0.f, 21.166010488f); }
                    v0 = v0 * v0; v1 = v1 * v1;
                    w[bj].x = pk8(v0[0], v0[1], v0[2], v0[3]); w[bj].y = pk8(v1[0], v1[1], v1[2], v1[3]); }
                const auto sx = __builtin_amdgcn_permlane16_swap(w[0].x, w[1].x, false, false); const auto sy = __builtin_amdgcn_permlane16_swap(w[0].y, w[1].y, false, false);
                *(v4u*)(O + (size_t)(row0 + ai * 128 + m * 16) * ldc + u.pn * 256 + wc * 32 + 8 * (fq & ~1) + (fq & 1) * 128) = (v4u){sx[0], sy[0], sx[1], sy[1]}; }
    }
};

struct PanelSq {
    float* slots;
    unsigned* cnt;
    unsigned* tmo;
    template <class Fn> __device__ __forceinline__ void run(const float (&ssl)[8], const pg8::Unit& u, int wr, int wc, int fr, int fq, LAS unsigned char* lds, int wid, int lane, Fn&& between) const {
        LAS float* P = (LAS float*)lds; LAS float* S = (LAS float*)(lds + 8192);
#pragma unroll
        for (int j = 0; j < 8; ++j) { float t = ssl[j]; t += __shfl_xor(t, 16); t += __shfl_xor(t, 32);
            if (fq == 0) P[((j >> 2) * 128 + wr * 64 + (j & 3) * 16 + fr) * 4 + wc] = t; }
        asm volatile("s_waitcnt lgkmcnt(0)" ::: "memory"); __builtin_amdgcn_s_barrier(); asm volatile("" ::: "memory");
        const int row = wid * 32 + (lane & 31);
        if (lane < 32) { const f32x4 p4 = *(const LAS f32x4*)(P + row * 4); const float t = (p4.x + p4.y) + (p4.z + p4.w);
            __hip_atomic_store((unsigned*)(slots + (size_t)(u.pm * 256 + row) * 8 + u.pn), __builtin_bit_cast(unsigned, t), __ATOMIC_RELAXED, __HIP_MEMORY_SCOPE_AGENT); }
        asm volatile("s_waitcnt vmcnt(0)" ::: "memory");
        if (lane == 0) __hip_atomic_fetch_add(cnt + 64 * u.pm, 1u, __ATOMIC_RELAXED, __HIP_MEMORY_SCOPE_AGENT);
        between();
        if (wid == 0) {
            unsigned sp = 0;
            while ((unsigned)__builtin_amdgcn_readfirstlane(__hip_atomic_load(cnt + 64 * u.pm, __ATOMIC_RELAXED, __HIP_MEMORY_SCOPE_AGENT)) < 64u) {
                __builtin_amdgcn_s_sleep(1);
                if ((++sp & 255u) == 0u) { if (__hip_atomic_load(tmo, __ATOMIC_RELAXED, __HIP_MEMORY_SCOPE_AGENT)) break; if (sp > (1u << 24)) { if (lane == 0) __hip_atomic_store(tmo, 1u, __ATOMIC_RELAXED, __HIP_MEMORY_SCOPE_AGENT); break; } } }
            __builtin_amdgcn_fence(__ATOMIC_ACQUIRE, "agent");
        }
        asm volatile("s_waitcnt vmcnt(0) lgkmcnt(0)" ::: "memory"); __builtin_amdgcn_s_barrier(); asm volatile("" ::: "memory");
        if (lane < 32) { const unsigned* sl = (const unsigned*)(slots + (size_t)(u.pm * 256 + row) * 8); float t = 0.f;
#pragma unroll
            for (int o = 0; o < 8; ++o) t += __builtin_bit_cast(float, __hip_atomic_load(sl + o, __ATOMIC_RELAXED, __HIP_MEMORY_SCOPE_AGENT));
            S[row] = t; }
        asm volatile("s_waitcnt vmcnt(0) lgkmcnt(0)" ::: "memory"); __builtin_amdgcn_s_barrier(); asm volatile("" ::: "memory");
    }
};
struct PanelSqLast {
    float* slots; unsigned* cnt; float* rinv;
    __device__ __forceinline__ void run(const float (&ssl)[8], const pg8::Unit& u, int wr, int wc, int fr, int fq, LAS unsigned char* lds, int wid, int lane) const {
        LAS float* P = (LAS float*)lds;
#pragma unroll
        for (int j = 0; j < 8; ++j) { float t = ssl[j]; t += __shfl_xor(t, 16); t += __shfl_xor(t, 32);
            if (fq == 0) P[((j >> 2) * 128 + wr * 64 + (j & 3) * 16 + fr) * 4 + wc] = t; }
        asm volatile("s_waitcnt lgkmcnt(0)" ::: "memory"); __builtin_amdgcn_s_barrier(); asm volatile("" ::: "memory");
        const int row = wid * 32 + (lane & 31);
        if (lane < 32) { const f32x4 p4 = *(const LAS f32x4*)(P + row * 4); const float t = (p4.x + p4.y) + (p4.z + p4.w);
            __hip_atomic_store((unsigned*)(slots + (size_t)(u.pm * 256 + row) * 8 + u.pn), __builtin_bit_cast(unsigned, t), __ATOMIC_RELAXED, __HIP_MEMORY_SCOPE_AGENT); }
        asm volatile("s_waitcnt vmcnt(0)" ::: "memory");
        unsigned old = 0u;
        if (lane == 0) old = __hip_atomic_fetch_add(cnt + 64 * u.pm, 1u, __ATOMIC_RELAXED, __HIP_MEMORY_SCOPE_AGENT);
        old = (unsigned)__builtin_amdgcn_readfirstlane((int)old);
        if (old == 63u) {
            __builtin_amdgcn_fence(__ATOMIC_ACQUIRE, "agent"); asm volatile("s_waitcnt vmcnt(0)" ::: "memory");
#pragma unroll
            for (int q = 0; q < 4; ++q) { const int r = q * 64 + lane; const unsigned* sl = (const unsigned*)(slots + (size_t)(u.pm * 256 + r) * 8); float t = 0.f;
#pragma unroll
                for (int o = 0; o < 8; ++o) t += __builtin_bit_cast(float, __hip_atomic_load(sl + o, __ATOMIC_RELAXED, __HIP_MEMORY_SCOPE_AGENT));
                rinv[u.pm * 256 + r] = 1.f / sqrtf(t * (1.f / DM) + RMS_EPS); } }
    }
};
template <bool XF32  , bool FINAL  , bool W8  > struct EpiRmsRes {
    static constexpr bool PERM = true, AFTER_DRAIN = true;
    const void* xold; bf16* xnew; float* outf; const float* g; unsigned char* x8; float osc  ; PanelSq st1; PanelSqLast st2;
    __device__ __forceinline__ void prefetch(const pg8::Unit&, int, int, float (&)[8]) const {}
    __device__ __forceinline__ void fused(pg8::f32x4 (&acc)[2][2][4][2], const pg8::Unit& u, int, int, int, int, LAS unsigned char* lds, int wid, int) const {
        const int lane = lane_id(), fr = lane & 15, fq = lane >> 4, wr = wid >> 2, wc = wid & 3;
        const LAS float* S = (const LAS float*)(lds + 8192);
        const int col0 = u.pn * 256 + wc * 32 + 8 * fq;
        float ssl[8];
#pragma unroll
        for (int ai = 0; ai < 2; ++ai)
#pragma unroll
            for (int m = 0; m < 4; ++m) { float t = 0.f;
#pragma unroll
                for (int bj = 0; bj < 2; ++bj)
#pragma unroll
                    for (int n = 0; n < 2; ++n) { const pg8::f32x4 v = acc[ai][bj][m][n]; t += (v[0] * v[0] + v[1] * v[1]) + (v[2] * v[2] + v[3] * v[3]); }
                ssl[ai * 4 + m] = t; }
        constexpr int NPRE = XF32 ? 4 : 8;
        v4u xpre[NPRE][2];
        pg8::f32x4 gv[2][2];
        st1.run(ssl, u, wr, wc, fr, fq, lds, wid, lane, [&]() {
            if (!XF32) { const char* xb = (const char*)xold + (size_t)u.pm * 256 * DM * 2; asm volatile("" : "+s"(xb));
                const unsigned o0 = (unsigned)(((wr * 64 + fr) * DM + col0) * 2);
#pragma unroll
                for (int j = 0; j < 8; ++j)
#pragma unroll
                    for (int bj = 0; bj < 2; ++bj) xpre[j][bj] = *(const GAS v4u*)(xb + (o0 + (unsigned)((((j >> 2) * 128 + (j & 3) * 16) * DM + bj * 128) * 2)));
            }
#pragma unroll
            for (int bj = 0; bj < 2; ++bj)
#pragma unroll
                for (int n = 0; n < 2; ++n) gv[bj][n] = *(const pg8::f32x4*)(g + col0 + bj * 128 + 4 * n);
        });
#pragma unroll
        for (int ai = 0; ai < 2; ++ai)
#pragma unroll
            for (int m = 0; m < 4; ++m) { const int rl = ai * 128 + wr * 64 + m * 16 + fr; const float ry = osc / sqrtf(S[rl] * (osc * osc * (1.f / DM)) + RMS_EPS);
                const size_t off = (size_t)(u.pm * 256 + rl) * DM + col0; float t = 0.f;
#pragma unroll
                for (int bj = 0; bj < 2; ++bj) { pg8::f32x4 x0, x1;
                    if (XF32) { x0 = *(const pg8::f32x4*)((const float*)xold + off + bj * 128); x1 = *(const pg8::f32x4*)((const float*)xold + off + bj * 128 + 4); }
                    else { const v4u w = xpre[ai * 4 + m][bj]; x0 = (pg8::f32x4){bflo(w.x), bfhi(w.x), bflo(w.y), bfhi(w.y)}; x1 = (pg8::f32x4){bflo(w.z), bfhi(w.z), bflo(w.w), bfhi(w.w)}; }
                    const pg8::f32x4 a0 = x0 + acc[ai][bj][m][0] * ry * gv[bj][0], a1 = x1 + acc[ai][bj][m][1] * ry * gv[bj][1];
                    t += ((a0[0] * a0[0] + a0[1] * a0[1]) + (a0[2] * a0[2] + a0[3] * a0[3])) + ((a1[0] * a1[0] + a1[1] * a1[1]) + (a1[2] * a1[2] + a1[3] * a1[3]));
                    if (FINAL) { *(pg8::f32x4*)(outf + off + bj * 128) = a0; *(pg8::f32x4*)(outf + off + bj * 128 + 4) = a1; }
                    else { pg8::u32x4 w; w.x = pg8::cvt_pk_bf16(a0[0], a0[1]); w.y = pg8::cvt_pk_bf16(a0[2], a0[3]); w.z = pg8::cvt_pk_bf16(a1[0], a1[1]); w.w = pg8::cvt_pk_bf16(a1[2], a1[3]);
                        *(pg8::u32x4*)(xnew + off + bj * 128) = w;
                        if (W8) { v2u w8; w8.x = pk8(__builtin_amdgcn_fmed3f(a0[0], -448.f, 448.f), __builtin_amdgcn_fmed3f(a0[1], -448.f, 448.f), __builtin_amdgcn_fmed3f(a0[2], -448.f, 448.f), __builtin_amdgcn_fmed3f(a0[3], -448.f, 448.f));
                            w8.y = pk8(__builtin_amdgcn_fmed3f(a1[0], -448.f, 448.f), __builtin_amdgcn_fmed3f(a1[1], -448.f, 448.f), __builtin_amdgcn_fmed3f(a1[2], -448.f, 448.f), __builtin_amdgcn_fmed3f(a1[3], -448.f, 448.f));
                            *(v2u*)(x8 + off + bj * 128) = w8; } } }
                ssl[ai * 4 + m] = t;
                if (XF32 && (m & 1)) asm volatile("" ::: "memory"); }
        if (FINAL) return;
        st2.run(ssl, u, wr, wc, fr, fq, lds, wid, lane);
    }
};

__device__ __forceinline__ void tr_item(const float* W, int ldw, int K, int ncols, bf16* WT, LAS float* scr, int item, int lane, const float* gk = nullptr) {
    const int nblk = (ncols + 31) / 32, kb = item / nblk, nb = item % nblk, k0 = 64 * kb, n0 = 32 * nb;
    const int nn = n0 + (lane & 31);
    float wv[32];
#pragma unroll
    for (int i = 0; i < 32; ++i) { const int kk = 2 * i + (lane >> 5); wv[i] = (nn < ncols) ? W[(size_t)(k0 + kk) * ldw + nn] : 0.f; }
#pragma unroll
    for (int i = 0; i < 32; ++i) { const int kk = 2 * i + (lane >> 5); scr[kk * 33 + (lane & 31)] = wv[i] * (gk ? gk[k0 + kk] : 1.f); }
    LDS_WAIT(); asm volatile("" ::: "memory");
    const int c = lane & 7;
#pragma unroll
    for (int j = 0; j < 4; ++j) { const int n = (lane >> 3) + 8 * j; const LAS float* s = scr + (8 * c) * 33 + n;
        v4u o; o.x = pk2(s[0 * 33], s[1 * 33]); o.y = pk2(s[2 * 33], s[3 * 33]); o.z = pk2(s[4 * 33], s[5 * 33]); o.w = pk2(s[6 * 33], s[7 * 33]);
        *(GAS v4u*)(WT + (size_t)(n0 + n) * K + k0 + 8 * c) = o; }
    LDS_WAIT(); asm volatile("" ::: "memory");
}
__device__ __forceinline__ void tr_item8(const float* W, int ldw, int K, int ncols, unsigned char* WT, LAS float* scr, int item, int lane, const float* gk = nullptr) {
    const int nblk = ncols / 32, kb = item / nblk, nb = item % nblk, k0 = 64 * kb, n0 = 32 * nb;
    const int nn = n0 + (lane & 31);
    float wv[32];
#pragma unroll
    for (int i = 0; i < 32; ++i) { const int kk = 2 * i + (lane >> 5); wv[i] = W[(size_t)(k0 + kk) * ldw + nn]; }
#pragma unroll
    for (int i = 0; i < 32; ++i) { const int kk = 2 * i + (lane >> 5); scr[kk * 33 + (lane & 31)] = wv[i] * (gk ? gk[k0 + kk] * W8SCALE : W8SCALE); }
    LDS_WAIT(); asm volatile("" ::: "memory");
    const int c = lane & 7;
#pragma unroll
    for (int j = 0; j < 4; ++j) { const int n = (lane >> 3) + 8 * j; const LAS float* s = scr + (8 * c) * 33 + n;
        v2u o; o.x = pk8(__builtin_amdgcn_fmed3f(s[0 * 33], -448.f, 448.f), __builtin_amdgcn_fmed3f(s[1 * 33], -448.f, 448.f), __builtin_amdgcn_fmed3f(s[2 * 33], -448.f, 448.f), __builtin_amdgcn_fmed3f(s[3 * 33], -448.f, 448.f));
        o.y = pk8(__builtin_amdgcn_fmed3f(s[4 * 33], -448.f, 448.f), __builtin_amdgcn_fmed3f(s[5 * 33], -448.f, 448.f), __builtin_amdgcn_fmed3f(s[6 * 33], -448.f, 448.f), __builtin_amdgcn_fmed3f(s[7 * 33], -448.f, 448.f));
        *(GAS v2u*)(WT + (size_t)(n0 + n) * K + k0 + 8 * c) = o; }
    LDS_WAIT(); asm volatile("" ::: "memory");
}
#define TR_JOB8G(Wp, ldw, K, ncols, WTp, gk) { const int ni_ = ((K) / 64) * ((ncols) / 32); if (r < ni_) { tr_item8((Wp), (ldw), (K), (ncols), (WTp), scr, r, F.lane, (gk)); continue; } r -= ni_; }
#define TR_JOBG(Wp, ldw, K, ncols, WTp, gk) { const int ni_ = ((K) / 64) * (((ncols) + 31) / 32); if (r < ni_) { tr_item((Wp), (ldw), (K), (ncols), (WTp), scr, r, F.lane, (gk)); continue; } r -= ni_; }
#define TR_JOB(Wp, ldw, K, ncols, WTp) TR_JOBG(Wp, ldw, K, ncols, WTp, nullptr)

__device__ __forceinline__ int rel_bucket(int n) {
    if (n < 16) return n;
    const float v = logf((float)n / 16.f) / 2.0794415416798357f * 16.f;
    const int l = 16 + (int)v; return l < 31 ? l : 31;
}

__device__ __forceinline__ void p0_prologue(Frame& F) {
    LAS float* scr = (LAS float*)(F.lds + F.wave * 16384);
    unsigned char* ws = F.ws;
    constexpr int NITEMS = (DM / 64) * (NQKV / 32) + (DM / 64) * 2 + 2 * (4096 / 64) * 4 + 2 * 2 * 4 + (DM / 64) * (DM / 32) + (DM / 64) * (FF / 32) + (FF / 64) * (DM / 32);
    for (int it = F.gw; it < NITEMS; it += F.NGW) {
        int r = it;
        TR_JOBG(F.w_in, NSA_IN, DM, NQKV, (bf16*)(ws + W0_QKV), F.norm_g)
        TR_JOBG(F.w_in + NQKV, NSA_IN, DM, NGATE, (bf16*)(ws + W0_G), F.norm_g)
        TR_JOB(F.cw1, HD, 4096, HD, (bf16*)(ws + W0_W1))
        TR_JOB(F.cw1 + 4096 * HD, HD, 4096, HD, (bf16*)(ws + W0_W1) + HD * 4096)
        TR_JOB(F.cw2, HD, HD, HD, (bf16*)(ws + W0_W2))
        TR_JOB(F.cw2 + HD * HD, HD, HD, HD, (bf16*)(ws + W0_W2) + HD * HD)
        TR_JOB(F.w_out, DM, DM, DM, (bf16*)(ws + W0_O))
        TR_JOB8G(F.up, FF, DM, FF, ws + W0_UP, F.norm_g + 2 * DM)
        TR_JOB8G(F.dn, DM, FF, DM, ws + W0_DN, nullptr)
    }
    if (blockIdx.x == 0) {
        float* lut = (float*)(ws + WS_LUT);
        for (int i = F.tid; i < NH * 128; i += NTHREADS) { const int h = i >> 7, d = i & 127; lut[i] = F.rel[rel_bucket(d) * NH + h] * 1.4426950408889634f; }
    }
    if (blockIdx.x == 1) {
        float* lb = (float*)(ws + WS_LB);
        for (int i = F.tid; i < DM; i += NTHREADS) lb[i] = 1.f / (1.f + expf(F.h_lb[i] - F.h_lb[DM + i]));
    }
    for (int it = F.gw; it < 2 * HD * 8; it += F.NGW) {
        const int k8 = it & 7, n = (it >> 3) & 127, kv = it >> 10; const float* pe = F.pe + kv * 4096 + 512 * k8; const float* w1 = F.cw1 + ((size_t)kv * 4096 + 512 * k8) * HD + n;
        float wv[8]; float s = 0.f;
#pragma unroll
        for (int j = 0; j < 8; ++j) wv[j] = w1[(size_t)(64 * j + F.lane) * HD];
#pragma unroll
        for (int j = 0; j < 8; ++j) s += pe[64 * j + F.lane] * wv[j];
        s = wave_sum(s);
        if (F.lane == 0) ((float*)(ws + WS_BIAS1))[k8 * 256 + kv * HD + n] = s;
    }
    { const int lane = F.lane; f32x4 xv[8]; int m = F.gw; float* rinv = (float*)(ws + WS_RINV);
      if (m < M) { const GAS f32x4* xr = (const GAS f32x4*)(F.x + (size_t)m * DM) + lane;
#pragma unroll
          for (int j = 0; j < 8; ++j) xv[j] = xr[64 * j]; }
      for (; m < M; m += F.NGW) { f32x4 xn[8]; const int m2 = m + F.NGW;
          if (m2 < M) { const GAS f32x4* xr = (const GAS f32x4*)(F.x + (size_t)m2 * DM) + lane;
#pragma unroll
              for (int j = 0; j < 8; ++j) xn[j] = xr[64 * j]; }
          float s = 0.f;
#pragma unroll
          for (int j = 0; j < 8; ++j) s += (xv[j].x * xv[j].x + xv[j].y * xv[j].y) + (xv[j].z * xv[j].z + xv[j].w * xv[j].w);
          const float r = 1.f / sqrtf(wave_sum(s) * (1.f / DM) + RMS_EPS);
          if (lane == 0) rinv[m] = r;
          GAS v2u* o8 = (GAS v2u*)((bf16*)(ws + WS_A) + (size_t)m * DM) + lane;
#pragma unroll
          for (int j = 0; j < 8; ++j) { v2u w; w.x = pk2(xv[j].x, xv[j].y); w.y = pk2(xv[j].z, xv[j].w); o8[64 * j] = w; }
#pragma unroll
          for (int j = 0; j < 8; ++j) xv[j] = xn[j]; } }
}
__device__ __forceinline__ void p_convert_l1a(Frame& F) {
    LAS float* scr = (LAS float*)(F.lds + F.wave * 16384);
    unsigned char* ws = F.ws;
    constexpr int NITEMS = (DM / 64) * (FF / 32);
    for (int it = F.gw; it < NITEMS; it += F.NGW) {
        int r = it;
        TR_JOB8G(F.h_in, FF, DM, FF, ws + W1_IN, F.norm_g + 4 * DM)
    }
}
__device__ __forceinline__ void p_convert_l1b(Frame& F, int first  , int nstatic  ) {
    LAS float* scr = (LAS float*)(F.lds + F.wave * 16384);
    unsigned char* ws = F.ws; unsigned* q = (unsigned*)(ws + WS_CTL) + CW_CONVQ;
    constexpr int NITEMS = (DM / 64) * (DM / 32) + (DM / 64) * (FF / 32) + (FF / 64) * (DM / 32);
    int chunk = first;
    for (;;) {
        if (chunk < 0) { unsigned t = 0u; if (F.lane == 0) t = __hip_atomic_fetch_add(q, 1u, __ATOMIC_RELAXED, __HIP_MEMORY_SCOPE_AGENT);
            chunk = nstatic + __builtin_amdgcn_readfirstlane((int)t); }
        const int base = 8 * chunk; chunk = -1;
        if (base >= NITEMS) break;
        const int end = base + 8 < NITEMS ? base + 8 : NITEMS;
        for (int it = base; it < end; ++it) {
            int r = it;
            TR_JOB(F.h_out, DM, DM, DM, (bf16*)(ws + W1_O))
            TR_JOB8G(F.up + (size_t)DM * FF, FF, DM, FF, ws + W1_UP, F.norm_g + 6 * DM)
            TR_JOB8G(F.dn + (size_t)FF * DM, DM, FF, DM, ws + W1_DN, nullptr)
        }
    }
}


namespace cg {
typedef short bf16x8 __attribute__((ext_vector_type(8)));
typedef float f32x16 __attribute__((ext_vector_type(16)));
constexpr int L_RED = 0, L_H = 16384, HRS = 272;
__device__ __forceinline__ float gelu_tanh_f(float x) { const float u = 0.7978845608028654f * (x + 0.044715f * x * x * x); const float e = __expf(2.f * u); return x * (1.f - 1.f / (e + 1.f)); }

__device__ __forceinline__ void cmp_gate_phase(LAS unsigned char* lds, unsigned char* wsb, int G, const int tid) {
    const int wid = __builtin_amdgcn_readfirstlane(tid >> 6), lane = tid & 63, r32 = lane & 31, hh = lane >> 5;
    const bf16* proj = (const bf16*)(wsb + WS_BIG); const bf16* w1t = (const bf16*)(wsb + W0_W1); const bf16* w2t = (const bf16*)(wsb + W0_W2); const float* bias1 = (const float*)(wsb + WS_BIAS1);
    const bf16* hn = (const bf16*)(wsb + WS_A); const bf16* wg = (const bf16*)(wsb + W0_G); float* gates = (float*)(wsb + WS_GATES); const float* rinv = (const float*)(wsb + WS_RINV);
    LAS float* red = (LAS float*)(lds + L_RED);
    const int ct = wid & 3, kh = wid >> 2;
    for (int u = blockIdx.x; u < 256; u += G) {
        const int kv = u >> 7, R0 = (u & 127) * 32, R = R0 + r32, b = R >> 9, g = (R >> 7) & 3, c = R & 127, cl = c < NC ? c : NC - 1;
        const bf16* arow = proj + ((size_t)b * SEQ + 16 * cl) * NQKV + (kv ? COL_VC : COL_KC) + g * HD;
        const bf16* brow = w1t + (size_t)kv * HD * 4096 + (size_t)(32 * ct + r32) * 4096;
        f32x16 acc = f32x16{};
        for (int l2 = 0; l2 < 8; ++l2) {
            bf16x8 av[16], bv[16];
            const bf16* ap = arow + (size_t)(kh * 16 + 2 * l2) * NQKV + 8 * hh; const bf16* bp = brow + kh * 2048 + 256 * l2 + 8 * hh;
#pragma unroll
            for (int j = 0; j < 16; ++j) { av[j] = *(const GAS bf16x8*)(ap + (size_t)(j >> 3) * NQKV + 16 * (j & 7)); bv[j] = *(const GAS bf16x8*)(bp + 16 * j); }
            __builtin_amdgcn_sched_barrier(0);
#pragma unroll
            for (int j = 0; j < 16; ++j) acc = __builtin_amdgcn_mfma_f32_32x32x16_bf16(av[j], bv[j], acc, 0, 0, 0); }
        if (kh == 1) {
#pragma unroll
            for (int r = 0; r < 16; ++r) red[(ct * 16 + r) * 64 + lane] = acc[r]; }
        LDS_WAIT();
        __syncthreads();
        if (kh == 0) { float bs = 0.f;
#pragma unroll
            for (int k8 = 0; k8 < 8; ++k8) bs += bias1[k8 * 256 + kv * HD + 32 * ct + r32];
#pragma unroll
            for (int r = 0; r < 16; ++r) { const float hv = gelu_tanh_f(acc[r] + red[(ct * 16 + r) * 64 + lane] + bs); const int row = (r & 3) + 8 * (r >> 2) + 4 * hh;
                *(LAS unsigned short*)(lds + L_H + row * HRS + (32 * ct + r32) * 2) = (unsigned short)f2bf(hv); } }
        LDS_WAIT();
        __syncthreads();
        if (kh == 0) { f32x16 o2 = f32x16{}; const bf16* b2 = w2t + (size_t)kv * HD * HD + (size_t)(32 * ct + r32) * HD;
#pragma unroll
            for (int ks = 0; ks < 8; ++ks) { const bf16x8 a = *(const LAS bf16x8*)(lds + L_H + r32 * HRS + (16 * ks + 8 * hh) * 2); const bf16x8 bb = *(const GAS bf16x8*)(b2 + 16 * ks + 8 * hh);
                o2 = __builtin_amdgcn_mfma_f32_32x32x16_bf16(a, bb, o2, 0, 0, 0); }
            bf16* outp = (bf16*)(wsb + (kv ? WS_VCMP : WS_KCMP)) + (size_t)R0 * HD + 32 * ct + r32;
#pragma unroll
            for (int r = 0; r < 16; ++r) { const int row = (r & 3) + 8 * (r >> 2) + 4 * hh; const bool pad = ((R0 + row) & 127) == NC;
                outp[(size_t)row * HD] = pad ? (bf16)0 : (bf16)f2bf(o2[r]); } }
        __syncthreads();
    }
    for (int u = blockIdx.x; u < M / 64; u += G) {
        const int rt = wid & 1, c2 = (wid >> 1) & 1; const int m0 = 64 * u + 32 * rt;
        const bf16* arow = hn + (size_t)(m0 + r32) * DM; const bf16* brow = wg + (size_t)(32 * c2 + r32) * DM;
        f32x16 acc = f32x16{};
        for (int l2 = 0; l2 < 4; ++l2) {
            bf16x8 av[16], bv[16];
            const bf16* ap = arow + kh * 1024 + 256 * l2 + 8 * hh; const bf16* bp = brow + kh * 1024 + 256 * l2 + 8 * hh;
#pragma unroll
            for (int j = 0; j < 16; ++j) { av[j] = *(const GAS bf16x8*)(ap + 16 * j); bv[j] = *(const GAS bf16x8*)(bp + 16 * j); }
            __builtin_amdgcn_sched_barrier(0);
#pragma unroll
            for (int j = 0; j < 16; ++j) acc = __builtin_amdgcn_mfma_f32_32x32x16_bf16(av[j], bv[j], acc, 0, 0, 0); }
        if (kh == 1) {
#pragma unroll
            for (int r = 0; r < 16; ++r) red[((wid & 3) * 16 + r) * 64 + lane] = acc[r]; }
        LDS_WAIT();
        __syncthreads();
        if (kh == 0) { const int col = 32 * c2 + r32; float rv[16];
#pragma unroll
            for (int r = 0; r < 16; ++r) rv[r] = rinv[m0 + (r & 3) + 8 * (r >> 2) + 4 * hh];
#pragma unroll
            for (int r = 0; r < 16; ++r) { const int row = (r & 3) + 8 * (r >> 2) + 4 * hh; const float v = acc[r] + red[((wid & 3) * 16 + r) * 64 + lane];
                if (col < NGATE) gates[(size_t)(m0 + row) * NGATE + col] = 1.f / (1.f + __expf(-v * rv[r])); } }
        __syncthreads();
    }
}
}


namespace nsa {
typedef short bf16x8 __attribute__((ext_vector_type(8)));
typedef short s16x4 __attribute__((ext_vector_type(4)));
typedef float f32x16 __attribute__((ext_vector_type(16)));
typedef unsigned u32x4 __attribute__((ext_vector_type(4)));
constexpr int SHM = 16384;
constexpr int NBUF = 3;
constexpr int L_V = 0, L_K = NBUF * SHM, L_WS = 2 * NBUF * SHM, L_LUT = L_WS + 2048, L_IMP = L_LUT + 8192, L_SEL = L_IMP + 4 * 64 * 33 * 4, L_END = L_SEL + 256;
static_assert(L_END <= LDS_BYTES - 256, "nsa LDS map");
constexpr float THR2 = 11.5f;
#define NSA_KSWZ(row, colB) ((row) * 256 + ((colB) ^ (((row) & 7) << 4)))
#define NSA_SBAR() __builtin_amdgcn_sched_barrier(0)
__device__ __forceinline__ int v_st(int k, int c) { const int kk = (k & ~0xC) | ((k & 4) << 1) | ((k & 8) >> 1); return ((kk >> 3) * 4 + (c >> 5)) * 512 + ((kk & 7) * 32 + (c & 31)) * 2; }
__device__ __forceinline__ int v_rd_base(int lane) { return ((lane & 3) << 3) | (((lane >> 2) & 3) << 6) | (((lane >> 4) & 1) << 5) | (((lane >> 5) & 1) << 8); }
constexpr int v_rd_off(int d0, int ks, int half) { return d0 * 512 + ks * 4096 + half * 2048; }
__device__ __forceinline__ int crow(int r, int hi) { return (r & 3) + 8 * (r >> 2) + 4 * hi; }
__device__ __forceinline__ unsigned cvtpk(float lo, float hi) { unsigned r; asm volatile("v_cvt_pk_bf16_f32 %0, %1, %2" : "=v"(r) : "v"(lo), "v"(hi)); return r; }

__device__ __forceinline__ void qkt(f32x16& p0, f32x16& p1, LAS unsigned char* Kb, int r32, int hi, const bf16x8 (&qr)[8]) {
    p0 = f32x16{}; p1 = f32x16{};
    LAS unsigned char* kb[4];
#pragma unroll
    for (int dd = 0; dd < 4; ++dd) kb[dd] = Kb + NSA_KSWZ(r32, (dd * 16 + hi * 8) * 2);
#pragma unroll
    for (int d0 = 0; d0 < 8; ++d0) { LAS unsigned char* a = kb[d0 & 3] + (d0 >> 2) * 128;
        const bf16x8 b0 = *(const LAS bf16x8*)a; const bf16x8 b1 = *(const LAS bf16x8*)(a + 32 * 256);
        p0 = __builtin_amdgcn_mfma_f32_32x32x16_bf16(b0, qr[d0], p0, 0, 0, 0);
        p1 = __builtin_amdgcn_mfma_f32_32x32x16_bf16(b1, qr[d0], p1, 0, 0, 0); }
}
__device__ __forceinline__ void pv_tile(f32x16 (&o)[4], int vb, bf16x8 pa0, bf16x8 pa1, bf16x8 pa2, bf16x8 pa3) {
#define NSA_TRRD(dst, off) asm volatile("ds_read_b64_tr_b16 %0, %1 offset:%2" : "=&v"(dst) : "v"(vb), "i"(off) : "memory")
#define NSA_PV_KS(ks, pa) do { s16x4 l0, l1, l2, l3, h0, h1, h2, h3; \
        NSA_TRRD(l0, v_rd_off(0, ks, 0)); NSA_TRRD(h0, v_rd_off(0, ks, 1)); NSA_TRRD(l1, v_rd_off(1, ks, 0)); NSA_TRRD(h1, v_rd_off(1, ks, 1)); \
        NSA_TRRD(l2, v_rd_off(2, ks, 0)); NSA_TRRD(h2, v_rd_off(2, ks, 1)); NSA_TRRD(l3, v_rd_off(3, ks, 0)); NSA_TRRD(h3, v_rd_off(3, ks, 1)); \
        asm volatile("s_waitcnt lgkmcnt(0)" ::: "memory"); NSA_SBAR(); \
        o[0] = __builtin_amdgcn_mfma_f32_32x32x16_bf16(pa, (bf16x8){l0[0], l0[1], l0[2], l0[3], h0[0], h0[1], h0[2], h0[3]}, o[0], 0, 0, 0); \
        o[1] = __builtin_amdgcn_mfma_f32_32x32x16_bf16(pa, (bf16x8){l1[0], l1[1], l1[2], l1[3], h1[0], h1[1], h1[2], h1[3]}, o[1], 0, 0, 0); \
        o[2] = __builtin_amdgcn_mfma_f32_32x32x16_bf16(pa, (bf16x8){l2[0], l2[1], l2[2], l2[3], h2[0], h2[1], h2[2], h2[3]}, o[2], 0, 0, 0); \
        o[3] = __builtin_amdgcn_mfma_f32_32x32x16_bf16(pa, (bf16x8){l3[0], l3[1], l3[2], l3[3], h3[0], h3[1], h3[2], h3[3]}, o[3], 0, 0, 0); } while (0)
    NSA_PV_KS(0, pa0); NSA_PV_KS(1, pa1); NSA_PV_KS(2, pa2); NSA_PV_KS(3, pa3);
#undef NSA_PV_KS
#undef NSA_TRRD
}
__device__ __forceinline__ void pack_p(const f32x16& p0, const f32x16& p1, bf16x8& pa0, bf16x8& pa1, bf16x8& pa2, bf16x8& pa3) {
#define NSA_PK4(P, B_, OUT) do { unsigned a0 = cvtpk(P[B_ + 0], P[B_ + 1]), a1 = cvtpk(P[B_ + 2], P[B_ + 3]); \
        unsigned b0 = cvtpk(P[B_ + 4], P[B_ + 5]), b1 = cvtpk(P[B_ + 6], P[B_ + 7]); \
        auto r0 = __builtin_amdgcn_permlane32_swap(a0, b0, false, false); auto r1 = __builtin_amdgcn_permlane32_swap(a1, b1, false, false); \
        u32x4 w = {r0[0], r1[0], r0[1], r1[1]}; OUT = *reinterpret_cast<bf16x8*>(&w); } while (0)
    NSA_PK4(p0, 0, pa0); NSA_PK4(p0, 8, pa1); NSA_PK4(p1, 0, pa2); NSA_PK4(p1, 8, pa3);
#undef NSA_PK4
}
__device__ __forceinline__ float swap_max(float v) { auto rr = __builtin_amdgcn_permlane32_swap(__float_as_uint(v), __float_as_uint(v), false, false); return fmaxf(__uint_as_float(rr[0]), __uint_as_float(rr[1])); }
__device__ __forceinline__ float swap_sum(float v) { auto rr = __builtin_amdgcn_permlane32_swap(__float_as_uint(v), __float_as_uint(v), false, false); return __uint_as_float(rr[0]) + __uint_as_float(rr[1]); }

template <class T> __device__ __forceinline__ const T* opaque_s(const T* p) { asm volatile("" : "+s"(p)); return p; }
__device__ __forceinline__ void tile_dma(LAS unsigned char* lds, int buf, const bf16* Kg, const bf16* Vg, int ld, int pk0, int pk1, int pv0, int pv1, int wid) {
    const char* kb = (const char*)Kg; const char* vb = (const char*)Vg;
    LAS unsigned char* kd = lds + L_K + buf * SHM + wid * 2048; LAS unsigned char* vd = lds + L_V + buf * SHM + wid * 2048;
    __builtin_amdgcn_global_load_lds((const unsigned*)(kb + (unsigned)(((pk0 >> 8) * ld + (pk0 & 255)) * 2)), (LAS unsigned*)kd, 16, 0, 0);
    __builtin_amdgcn_global_load_lds((const unsigned*)(kb + (unsigned)(((pk1 >> 8) * ld + (pk1 & 255)) * 2)), (LAS unsigned*)(kd + 1024), 16, 0, 0);
    __builtin_amdgcn_global_load_lds((const unsigned*)(vb + (unsigned)(((pv0 >> 8) * ld + (pv0 & 255)) * 2)), (LAS unsigned*)vd, 16, 0, 0);
    __builtin_amdgcn_global_load_lds((const unsigned*)(vb + (unsigned)(((pv1 >> 8) * ld + (pv1 & 255)) * 2)), (LAS unsigned*)(vd + 1024), 16, 0, 0);
}
__device__ __forceinline__ int k_piece(int P) { const int row = P >> 8, colB = (P & 255) ^ ((row & 7) << 4); return (row << 8) | (colB >> 1); }
__device__ __forceinline__ int v_piece(int P) { const int st = P >> 9, q = (P & 511) >> 1, kk = (st >> 2) * 8 + (q >> 5), c = (st & 3) * 32 + (q & 31);
    const int k = (kk & ~0xC) | ((kk & 4) << 1) | ((kk & 8) >> 1); return (k << 8) | c; }

__device__ __forceinline__ void nsa_phase(LAS unsigned char* lds, unsigned char* wsb, int G, const int tid) {
    const int wid = __builtin_amdgcn_readfirstlane(tid >> 6), lane = tid & 63, r32 = lane & 31, hi = lane >> 5;
    const int hr = wid >> 1, th = wid & 1;
    const bf16* proj = (const bf16*)(wsb + WS_BIG); const float* gates = (const float*)(wsb + WS_GATES);
    const bf16* kcmp = (const bf16*)(wsb + WS_KCMP); const bf16* vcmp = (const bf16*)(wsb + WS_VCMP); bf16* Oout = (bf16*)(wsb + WS_A);
    float* scrl = (float*)(wsb + WS_SCR) + ((size_t)blockIdx.x * NWAVES + wid) * 4096 + lane * 64;
    LAS float* wsl = (LAS float*)(lds + L_WS) + wid * 64; LAS float* li_l = wsl; LAS float* al_l = wsl + 32;
    LAS float* lutL = (LAS float*)(lds + L_LUT); LAS float* impL = (LAS float*)(lds + L_IMP); LAS unsigned* selL = (LAS unsigned*)(lds + L_SEL);
    const int pk0 = k_piece(wid * 2048 + lane * 16), pk1 = k_piece(wid * 2048 + 1024 + lane * 16), pv0 = v_piece(wid * 2048 + lane * 16), pv1 = v_piece(wid * 2048 + 1024 + lane * 16);
    const int vb0 = (int)(unsigned)(uintptr_t)(lds + L_V) + v_rd_base(lane);
    const float NEG = -__builtin_inff();
    { const float* lut = (const float*)(wsb + WS_LUT); for (int i = tid; i < NH * 128; i += NTHREADS) lutL[i] = lut[i]; }
    __syncthreads();
    for (int ui = 0; ui < 4; ++ui) {
        const int c = blockIdx.x, bg = c & 31, j8 = (c >> 5) & 7;
        if (c >= 256 && G > 256) break;
        const unsigned long long qtab = (ui == 0) ? 0xfeebcf633dull : (ui == 1) ? 0x8ea74b49b7ull : (ui == 2) ? 0x719f062568ull : 0x110a009d43ull;
        const int qb = (int)((qtab >> (5 * j8)) & 31ull);
        const int b = bg >> 2, g = bg & 3, h = g * 4 + hr, t0 = 64 * qb, tq = t0 + 32 * th + r32;
        const size_t rowq = (size_t)b * SEQ + tq;
        const LAS float* lutp = lutL + h * 128; const float c31 = lutp[127];
        bf16x8 qr[8];
        { int hq = hi; asm volatile("" : "+v"(hq));
          const bf16* qp = proj + rowq * NQKV + h * HD + hq * 8;
#pragma unroll
          for (int d0 = 0; d0 < 8; ++d0) qr[d0] = *(const GAS bf16x8*)(qp + d0 * 16); }
        const float g_c = gates[rowq * NGATE + h], g_s = gates[rowq * NGATE + 16 + h], g_w = gates[rowq * NGATE + 32 + h];
        f32x16 o[4]; float cmp_carry = 0.f;
        {
            const bf16* kb = kcmp + (size_t)(b * NG + g) * NCP * HD; const bf16* vbp = vcmp + (size_t)(b * NG + g) * NCP * HD;
            const bool two = (t0 + 63 - 31) >= 16 * 64;
            tile_dma(lds, 0, opaque_s(kb), opaque_s(vbp), HD, pk0, pk1, pv0, pv1, wid);
            if (two) tile_dma(lds, 1, opaque_s(kb + 64 * HD), opaque_s(vbp + 64 * HD), HD, pk0, pk1, pv0, pv1, wid);
            VM_WAIT();
            __syncthreads();
            const int dqc = tq - 31 - 64 * hi;
            f32x16 sA0, sA1, sB0 = f32x16{}, sB1 = f32x16{};
            float tm = -1e30f;
            qkt(sA0, sA1, lds + L_K, r32, hi, qr);
#pragma unroll
            for (int r = 0; r < 16; ++r) { const int cc = (r & 3) + 8 * (r >> 2); const int d0 = dqc - 16 * cc, d1 = d0 - 512;
                sA0[r] = d0 >= 0 ? sA0[r] + lutp[d0 < 0 ? 0 : (d0 < 127 ? d0 : 127)] : NEG; sA1[r] = d1 >= 0 ? sA1[r] + lutp[d1 < 0 ? 0 : (d1 < 127 ? d1 : 127)] : NEG;
                tm = fmaxf(tm, fmaxf(sA0[r], sA1[r]));
                if ((r & 3) == 3) asm volatile("" ::: "memory"); }
            if (two) {
                qkt(sB0, sB1, lds + L_K + SHM, r32, hi, qr);
#pragma unroll
                for (int r = 0; r < 16; ++r) { const int cc = (r & 3) + 8 * (r >> 2); const int d0 = dqc - 1024 - 16 * cc, d1 = d0 - 512;
                    sB0[r] = d0 >= 0 ? sB0[r] + lutp[d0 < 0 ? 0 : (d0 < 127 ? d0 : 127)] : NEG; sB1[r] = d1 >= 0 ? sB1[r] + lutp[d1 < 0 ? 0 : (d1 < 127 ? d1 : 127)] : NEG;
                    tm = fmaxf(tm, fmaxf(sB0[r], sB1[r]));
                    if ((r & 3) == 3) asm volatile("" ::: "memory"); }
            }
            const float mx = swap_max(tm);
            float ps = 0.f;
#pragma unroll
            for (int r = 0; r < 16; ++r) { sA0[r] = __builtin_amdgcn_exp2f(sA0[r] - mx); sA1[r] = __builtin_amdgcn_exp2f(sA1[r] - mx); ps += sA0[r] + sA1[r]; }
            if (two) {
#pragma unroll
                for (int r = 0; r < 16; ++r) { sB0[r] = __builtin_amdgcn_exp2f(sB0[r] - mx); sB1[r] = __builtin_amdgcn_exp2f(sB1[r] - mx); ps += sB0[r] + sB1[r]; }
            }
            const float ls = swap_sum(ps);
            const float inv = ls > 0.f ? 1.f / ls : 0.f;
            LAS float* ip = impL + (hr * 64 + 32 * th + r32) * 33;
#pragma unroll
            for (int d = 0; d < 4; ++d) o[d] = f32x16{};
            if (!two) {
#pragma unroll
                for (int q = 0; q < 16; ++q) ip[16 + q] = 0.f;
            }
            auto imp_pv = [&](f32x16& p0, f32x16& p1, const int T) {
                p0 = p0 * inv; p1 = p1 * inv;
                LAS float* ipt = ip + 16 * T;
#pragma unroll
                for (int q = 0; q < 4; ++q) {
                    ipt[0 + 2 * q + hi] = (p0[4 * q] + p0[4 * q + 1]) + (p0[4 * q + 2] + p0[4 * q + 3]);
                    ipt[8 + 2 * q + hi] = (p1[4 * q] + p1[4 * q + 1]) + (p1[4 * q + 2] + p1[4 * q + 3]); }
                LDS_WAIT(); asm volatile("" ::: "memory");
#pragma unroll
                for (int q = 0; q < 4; ++q) {
                    ipt[0 + 2 * q + hi + 1] += p0[4 * q + 3];
                    if (8 + 2 * q + hi + 1 < 16) ipt[8 + 2 * q + hi + 1] += p1[4 * q + 3]; }
                const float carry = p1[15];
                LDS_WAIT(); asm volatile("" ::: "memory");
                bf16x8 pa0, pa1, pa2, pa3;
                pack_p(p0, p1, pa0, pa1, pa2, pa3); pv_tile(o, vb0 + T * SHM, pa0, pa1, pa2, pa3);
                if (T == 0) cmp_carry = carry;
            };
            imp_pv(sA0, sA1, 0);
            if (two) imp_pv(sB0, sB1, 1);
            if (hi == 1) ip[16] += cmp_carry;
            LDS_WAIT(); asm volatile("" ::: "memory");
            if (hi == 0) li_l[r32] = g_c;
            LDS_WAIT(); asm volatile("" ::: "memory");
            { float gg[16];
#pragma unroll
              for (int r = 0; r < 16; ++r) gg[r] = li_l[crow(r, hi)];
#pragma unroll
              for (int d = 0; d < 4; ++d)
#pragma unroll
                  for (int q = 0; q < 4; ++q) *(GAS f32x4*)(scrl + d * 16 + 4 * q) = (f32x4){o[d][4 * q] * gg[4 * q], o[d][4 * q + 1] * gg[4 * q + 1], o[d][4 * q + 2] * gg[4 * q + 2], o[d][4 * q + 3] * gg[4 * q + 3]}; }
            LDS_WAIT();
            __builtin_amdgcn_s_barrier(); asm volatile("" ::: "memory");
        }
        {
#pragma unroll
            for (int i = 0; i < 4; ++i) { const int tl = 8 * wid + 2 * i + hi, n = r32;
                float v = ((impL[(0 * 64 + tl) * 33 + n] + impL[(1 * 64 + tl) * 33 + n]) + impL[(2 * 64 + tl) * 33 + n]) + impL[(3 * 64 + tl) * 33 + n];
                int key = (int)((__float_as_uint(v) & ~31u) | (unsigned)(31 - n));
                if (n == 0 || n == qb || n == qb - 1) key = (int)(0x461C4000u | (unsigned)(31 - n)); else if (n > qb) key = -64 + (31 - n);
                int cnt = 0;
                for (int mm = 0; mm < 32; ++mm) { const int u = __shfl(key, (lane & 32) | mm); cnt += (u > key) ? 1 : 0; }
                const unsigned long long bal = __ballot(cnt < 8);
                if (lane == 0) { selL[8 * wid + 2 * i] = (unsigned)bal; selL[8 * wid + 2 * i + 1] = (unsigned)(bal >> 32); } }
            LDS_WAIT();
            __builtin_amdgcn_s_barrier(); asm volatile("" ::: "memory");
        }
        const unsigned selw = selL[32 * th + r32];
        const int NS = qb + 1, nlo = qb >= 8 ? qb - 8 : 0, NT = NS + (qb - nlo + 1);
        float m_reg = -1e30f, l_reg = 0.f;
#pragma unroll
        for (int d = 0; d < 4; ++d) o[d] = f32x16{};
        const bf16* kS = proj + (size_t)b * SEQ * NQKV + COL_KS + g * HD; const bf16* vS = proj + (size_t)b * SEQ * NQKV + COL_VS + g * HD;
        const bf16* kW = proj + (size_t)b * SEQ * NQKV + COL_KW + g * HD; const bf16* vW = proj + (size_t)b * SEQ * NQKV + COL_VW + g * HD;
#define NSA_TILE_K(t_) (((t_) >= NS ? kW : kS) + (size_t)(64 * ((t_) >= NS ? nlo + ((t_) - NS) : (t_))) * NQKV)
#define NSA_TILE_V(t_) (((t_) >= NS ? vW : vS) + (size_t)(64 * ((t_) >= NS ? nlo + ((t_) - NS) : (t_))) * NQKV)
        tile_dma(lds, 0, opaque_s(kS), opaque_s(vS), NQKV, pk0, pk1, pv0, pv1, wid);
        if (1 < NT) { tile_dma(lds, 1, opaque_s(NSA_TILE_K(1)), opaque_s(NSA_TILE_V(1)), NQKV, pk0, pk1, pv0, pv1, wid); asm volatile("s_waitcnt vmcnt(4)" ::: "memory"); } else VM_WAIT();
        LDS_WAIT(); __builtin_amdgcn_s_barrier(); asm volatile("" ::: "memory");
        int buf = 0;
        for (int i = 0; i < NT; ++i) {
            const bool win = i >= NS; const int n = win ? nlo + (i - NS) : i;
            if (i == NS) {
                if (hi == 0) li_l[r32] = g_s / l_reg;
                LDS_WAIT(); asm volatile("" ::: "memory");
                { float gg[16];
#pragma unroll
                  for (int r = 0; r < 16; ++r) gg[r] = li_l[crow(r, hi)];
#pragma unroll
                  for (int d = 0; d < 4; ++d)
                  {
                    f32x4 a4[4];
#pragma unroll
                    for (int q = 0; q < 4; ++q) a4[q] = *(const GAS f32x4*)(scrl + d * 16 + 4 * q);
#pragma unroll
                    for (int q = 0; q < 4; ++q) { const f32x4 a = a4[q];
                          *(GAS f32x4*)(scrl + d * 16 + 4 * q) = (f32x4){a.x + o[d][4 * q] * gg[4 * q], a.y + o[d][4 * q + 1] * gg[4 * q + 1], a.z + o[d][4 * q + 2] * gg[4 * q + 2], a.w + o[d][4 * q + 3] * gg[4 * q + 3]}; }
                    asm volatile("" ::: "memory"); }
#pragma unroll
                  for (int d = 0; d < 4; ++d) o[d] = f32x16{}; }
                LDS_WAIT(); m_reg = -1e30f; l_reg = 0.f;
            }
            if (i + 2 < NT) { const int b2 = buf + 2 >= NBUF ? buf + 2 - NBUF : buf + 2;
                tile_dma(lds, b2, opaque_s(NSA_TILE_K(i + 2)), opaque_s(NSA_TILE_V(i + 2)), NQKV, pk0, pk1, pv0, pv1, wid); }
            f32x16 p0, p1;
            qkt(p0, p1, lds + L_K + buf * SHM, r32, hi, qr);
            const bool plain = (n + 2 < qb) && !(win && n + 8 == qb);
            float bofs = 0.f;
            { const int dq = tq - 64 * n - 4 * hi; const unsigned W = win ? 512u : 0x80000000u; const bool ok = win || ((selw >> n) & 1u);
              if (plain) bofs = ok ? c31 : NEG;
              else if (n + 2 >= qb) {
#pragma unroll
                  for (int r = 0; r < 16; ++r) { const int cc = (r & 3) + 8 * (r >> 2); const int d0 = dq - cc, d1 = d0 - 32;
                      const float b0 = lutp[d0 < 0 ? 0 : (d0 < 127 ? d0 : 127)], b1 = lutp[d1 < 0 ? 0 : (d1 < 127 ? d1 : 127)];
                      p0[r] = (ok && (unsigned)d0 < W) ? p0[r] + b0 : NEG; p1[r] = (ok && (unsigned)d1 < W) ? p1[r] + b1 : NEG;
                      if ((r & 3) == 3) asm volatile("" ::: "memory"); }
              } else {
#pragma unroll
                  for (int r = 0; r < 16; ++r) { const int cc = (r & 3) + 8 * (r >> 2); const int d0 = dq - cc, d1 = d0 - 32;
                      p0[r] = (ok && (unsigned)d0 < W) ? p0[r] + c31 : NEG; p1[r] = (ok && (unsigned)d1 < W) ? p1[r] + c31 : NEG; }
              } }
            float pmax = p0[0];
#pragma unroll
            for (int r = 1; r < 16; ++r) pmax = fmaxf(pmax, p0[r]);
#pragma unroll
            for (int r = 0; r < 16; ++r) pmax = fmaxf(pmax, p1[r]);
            pmax = swap_max(pmax) + bofs;
            float mn, alpha;
            if (__all((pmax - m_reg) <= THR2)) { mn = m_reg; alpha = 1.f; }
            else { mn = fmaxf(m_reg, pmax); alpha = __builtin_amdgcn_exp2f(m_reg - mn); m_reg = mn; }
            mn -= bofs;
            float ps = 0.f;
#pragma unroll
            for (int r = 0; r < 16; ++r) { p0[r] = __builtin_amdgcn_exp2f(p0[r] - mn); p1[r] = __builtin_amdgcn_exp2f(p1[r] - mn); ps += p0[r] + p1[r]; }
            ps = swap_sum(ps);
            l_reg = l_reg * alpha + ps;
            if (__any(alpha < 1.f)) { if (hi == 0) al_l[r32] = alpha; LDS_WAIT(); asm volatile("" ::: "memory");
#pragma unroll
                for (int r = 0; r < 16; ++r) { const float aa = al_l[crow(r, hi)];
#pragma unroll
                    for (int d = 0; d < 4; ++d) o[d][r] *= aa; }
                LDS_WAIT(); }
            bf16x8 pa0, pa1, pa2, pa3;
            pack_p(p0, p1, pa0, pa1, pa2, pa3);
            pv_tile(o, vb0 + buf * SHM, pa0, pa1, pa2, pa3);
            if (i + 2 < NT) asm volatile("s_waitcnt vmcnt(4)" ::: "memory"); else VM_WAIT();
            LDS_WAIT();
            __builtin_amdgcn_s_barrier(); asm volatile("" ::: "memory");
            buf = buf + 1 >= NBUF ? 0 : buf + 1;
        }
#undef NSA_TILE_K
#undef NSA_TILE_V
        if (hi == 0) li_l[r32] = g_w / l_reg;
        LDS_WAIT(); asm volatile("" ::: "memory");
        {
            LAS unsigned char* ost = lds + wid * 8192;
            LAS unsigned char* owr = ost + (4 * hi) * 256 + r32 * 2;
            float gg[16];
#pragma unroll
            for (int r = 0; r < 16; ++r) gg[r] = li_l[crow(r, hi)];
#pragma unroll
            for (int d = 0; d < 4; ++d) { f32x4 a4[4];
#pragma unroll
                for (int q = 0; q < 4; ++q) a4[q] = *(const GAS f32x4*)(scrl + d * 16 + 4 * q);
#pragma unroll
                for (int q = 0; q < 4; ++q)
#pragma unroll
                    for (int e = 0; e < 4; ++e) { const int r = 4 * q + e; const float v = a4[q][e] + o[d][r] * gg[r];
                        *(LAS unsigned short*)(owr + ((r & 3) + 8 * (r >> 2)) * 256 + d * 64) = (unsigned short)f2bf(v); }
                asm volatile("" ::: "memory"); }
            LDS_WAIT(); asm volatile("" ::: "memory");
            int ln = lane; asm volatile("" : "+v"(ln));
            bf16* Ow = Oout + ((size_t)b * SEQ + t0 + 32 * th + (ln >> 4)) * DM + h * HD + (ln & 15) * 8;
            const LAS unsigned char* ord = ost + (ln >> 4) * 256 + (ln & 15) * 16;
#pragma unroll
            for (int i = 0; i < 8; ++i) *(GAS v4u*)(Ow + (size_t)(4 * i) * DM) = *(const LAS v4u*)(ord + i * 1024);
        }
        LDS_WAIT();
        __builtin_amdgcn_s_barrier(); asm volatile("" ::: "memory");
    }
}
#undef NSA_KSWZ
#undef NSA_SBAR
}


namespace hg {
typedef short bf16x8 __attribute__((ext_vector_type(8)));
typedef short s16x4 __attribute__((ext_vector_type(4)));
typedef float f32x4v __attribute__((ext_vector_type(4)));
typedef float f32x2v __attribute__((ext_vector_type(2)));
constexpr int RS = 288, RSA = 144;
constexpr int BUFB = 3 * 64 * RS;
constexpr int L_Q = 0, L_K = 64 * RS, L_V = 2 * 64 * RS, L_AM = 2 * BUFB, L_O = L_AM + 64 * RSA, L_EBL = L_O + 64 * RS, L_ON = L_EBL + 1024, L_END = L_ON + 512;
static_assert(L_END <= LDS_BYTES - 256, "hg LDS map");
#define HG_TR(dst, addr, off) asm volatile("ds_read_b64_tr_b16 %0, %1 offset:%2" : "=&v"(dst) : "v"(addr), "i"(off) : "memory")
#define HG_BAR() do { asm volatile("s_waitcnt lgkmcnt(0)" ::: "memory"); __builtin_amdgcn_s_barrier(); asm volatile("" ::: "memory"); } while (0)
__device__ __forceinline__ unsigned cvtpk(float lo, float hi) { unsigned r; asm volatile("v_cvt_pk_bf16_f32 %0, %1, %2" : "=v"(r) : "v"(lo), "v"(hi)); return r; }

__device__ __forceinline__ void scan_phase(LAS unsigned char* lds, unsigned char* wsb, const float* h_on, int G, const int tid) {
    const int wid = __builtin_amdgcn_readfirstlane(tid >> 6), lane = tid & 63, li = lane & 15, g = lane >> 4;
    const bool prod = wid >= 4; const int rw = wid & 3, ptid = rw * 64 + lane;
    const bf16* proj = (const bf16*)(wsb + WS_BIG); bf16* Oout = (bf16*)(wsb + WS_A);
    const float L2E = 1.4426950408889634f;
    const int kp = lane & 7, tg = lane >> 3;
    for (int u = blockIdx.x; u < BATCH * NH; u += G) {
        const int b = u >> 4, h = u & 15;
        if (tid < HD) ((LAS float*)(lds + L_ON))[tid] = h_on[h * HD + tid];
#define HG_LOAD(c_, QW, FW, VW) do { const size_t r0_ = (size_t)b * SEQ + 64 * (c_); \
        _Pragma("unroll") for (int c2 = 0; c2 < 2; ++c2) _Pragma("unroll") for (int i = 0; i < 8; ++i) { const size_t r = r0_ + 8 * tg + i; const int ch_ = h * HD + 32 * rw + 16 * c2 + 2 * kp; \
            QW[c2][i] = *(const GAS unsigned*)(proj + r * FF + ch_); FW[c2][i] = *(const GAS unsigned*)(proj + r * FF + 2048 + ch_); } \
        _Pragma("unroll") for (int j = 0; j < 4; ++j) { const int ci = ptid + 256 * j; VW[j] = *(const GAS v4u*)(proj + (r0_ + (ci >> 4)) * FF + 4096 + h * HD + 8 * (ci & 15)); } } while (0)
#define HG_PREP(pb, QW, FW, VW) do { LAS unsigned char* B_ = lds + (pb) * BUFB; \
        _Pragma("unroll") for (int c2 = 0; c2 < 2; ++c2) { const int chl_ = 32 * rw + 16 * c2 + 2 * kp; float bl0[8], bl1[8]; float c0 = 0.f, c1 = 0.f; \
            _Pragma("unroll") for (int i = 0; i < 8; ++i) { c0 += bflo(FW[c2][i]); c1 += bfhi(FW[c2][i]); bl0[i] = c0; bl1[i] = c1; } \
            float i0 = c0, i1 = c1; \
            _Pragma("unroll") for (int d = 8; d < 64; d <<= 1) { const float x0 = __shfl_up(i0, d), x1 = __shfl_up(i1, d); if (lane >= d) { i0 += x0; i1 += x1; } } \
            const float p0 = i0 - c0, p1 = i1 - c1; \
            if (tg == 7) *(LAS f32x2v*)(lds + L_EBL + (pb) * 512 + chl_ * 4) = (f32x2v){__builtin_amdgcn_exp2f(i0 * L2E), __builtin_amdgcn_exp2f(i1 * L2E)}; \
            _Pragma("unroll") for (int i = 0; i < 8; ++i) { const float b0 = (p0 + bl0[i]) * L2E, b1 = (p1 + bl1[i]) * L2E; \
                const float e0 = __builtin_amdgcn_exp2f(b0), e1 = __builtin_amdgcn_exp2f(b1), n0 = __builtin_amdgcn_exp2f(-b0), n1 = __builtin_amdgcn_exp2f(-b1); \
                const float k0 = 1.f - __builtin_amdgcn_exp2f(bflo(FW[c2][i]) * L2E), k1 = 1.f - __builtin_amdgcn_exp2f(bfhi(FW[c2][i]) * L2E); \
                const int t = 8 * tg + i; \
                *(LAS unsigned*)(B_ + L_Q + t * RS + chl_ * 2) = cvtpk(bflo(QW[c2][i]) * e0, bfhi(QW[c2][i]) * e1); \
                *(LAS unsigned*)(B_ + L_K + t * RS + chl_ * 2) = cvtpk(k0 * n0, k1 * n1); } } \
        _Pragma("unroll") for (int j = 0; j < 4; ++j) { const int ci = ptid + 256 * j; *(LAS v4u*)(B_ + L_V + (ci >> 4) * RS + (ci & 15) * 16) = VW[j]; } } while (0)
        if (prod) {
            unsigned qwA[2][8], fwA[2][8], qwB[2][8], fwB[2][8]; v4u vwA[4], vwB[4], gwA[4], gwB[4];
#pragma unroll
            for (int j = 0; j < 4; ++j) { gwA[j] = (v4u){0u, 0u, 0u, 0u}; gwB[j] = (v4u){0u, 0u, 0u, 0u}; }
#define HG_GATES(c_, GW) do { const int t_ = ptid >> 2, vq_ = ptid & 3; const size_t r_ = (size_t)b * SEQ + 64 * (c_) + t_; \
            _Pragma("unroll") for (int j = 0; j < 4; ++j) GW[j] = *(const GAS v4u*)(proj + r_ * FF + 6144 + h * HD + 32 * vq_ + 8 * j); } while (0)
            HG_LOAD(0, qwA, fwA, vwA); HG_PREP(0, qwA, fwA, vwA); HG_LOAD(1, qwB, fwB, vwB); HG_LOAD(2, qwA, fwA, vwA); HG_GATES(0, gwA);
            HG_BAR();
            for (int c = 0; c < SEQ / 64; c += 2) {
                { const size_t row0 = (size_t)b * SEQ + 64 * c;
                if (c > 0) {
                    const int t = ptid >> 2, vq = ptid & 3; const size_t r = row0 - 64 + t;
                    float ov[32]; float ss = 0.f;
#pragma unroll
                    for (int j = 0; j < 4; ++j) { const v4u w = *(const LAS v4u*)(lds + L_O + t * RS + vq * 64 + j * 16);
                        ov[8 * j + 0] = bflo(w.x); ov[8 * j + 1] = bfhi(w.x); ov[8 * j + 2] = bflo(w.y); ov[8 * j + 3] = bfhi(w.y); ov[8 * j + 4] = bflo(w.z); ov[8 * j + 5] = bfhi(w.z); ov[8 * j + 6] = bflo(w.w); ov[8 * j + 7] = bfhi(w.w); }
#pragma unroll
                    for (int j = 0; j < 32; ++j) ss += ov[j] * ov[j];
                    ss += __shfl_xor(ss, 1); ss += __shfl_xor(ss, 2);
                    const float rinv = 1.f / sqrtf(ss * (1.f / 128.f) + RMS_EPS);
                    bf16* op = Oout + r * DM + h * HD + 32 * vq;
#pragma unroll
                    for (int j = 0; j < 4; ++j) { const v4u gq = gwB[j]; const f32x4v on0 = *(const LAS f32x4v*)(lds + L_ON + (32 * vq + 8 * j) * 4), on1 = *(const LAS f32x4v*)(lds + L_ON + (32 * vq + 8 * j + 4) * 4);
                        v4u o4;
                        o4.x = cvtpk(ov[8 * j + 0] * rinv * on0[0] * bflo(gq.x), ov[8 * j + 1] * rinv * on0[1] * bfhi(gq.x));
                        o4.y = cvtpk(ov[8 * j + 2] * rinv * on0[2] * bflo(gq.y), ov[8 * j + 3] * rinv * on0[3] * bfhi(gq.y));
                        o4.z = cvtpk(ov[8 * j + 4] * rinv * on1[0] * bflo(gq.z), ov[8 * j + 5] * rinv * on1[1] * bfhi(gq.z));
                        o4.w = cvtpk(ov[8 * j + 6] * rinv * on1[2] * bflo(gq.w), ov[8 * j + 7] * rinv * on1[3] * bfhi(gq.w));
                        *(GAS v4u*)(op + 8 * j) = o4; }
                }
                  HG_GATES(c + 1, gwB); }
                HG_BAR();
                HG_PREP(1, qwB, fwB, vwB); if (c + 3 < SEQ / 64) HG_LOAD(c + 3, qwB, fwB, vwB);
                HG_BAR();
                { const int c = 0; (void)c; }
                { const size_t row0 = (size_t)b * SEQ + 64 * (c + 1); const int c_ = c + 1;
                if (c_ > 0) {
                    const int t = ptid >> 2, vq = ptid & 3; const size_t r = row0 - 64 + t;
                    float ov[32]; float ss = 0.f;
#pragma unroll
                    for (int j = 0; j < 4; ++j) { const v4u w = *(const LAS v4u*)(lds + L_O + t * RS + vq * 64 + j * 16);
                        ov[8 * j + 0] = bflo(w.x); ov[8 * j + 1] = bfhi(w.x); ov[8 * j + 2] = bflo(w.y); ov[8 * j + 3] = bfhi(w.y); ov[8 * j + 4] = bflo(w.z); ov[8 * j + 5] = bfhi(w.z); ov[8 * j + 6] = bflo(w.w); ov[8 * j + 7] = bfhi(w.w); }
#pragma unroll
                    for (int j = 0; j < 32; ++j) ss += ov[j] * ov[j];
                    ss += __shfl_xor(ss, 1); ss += __shfl_xor(ss, 2);
                    const float rinv = 1.f / sqrtf(ss * (1.f / 128.f) + RMS_EPS);
                    bf16* op = Oout + r * DM + h * HD + 32 * vq;
#pragma unroll
                    for (int j = 0; j < 4; ++j) { const v4u gq = gwA[j]; const f32x4v on0 = *(const LAS f32x4v*)(lds + L_ON + (32 * vq + 8 * j) * 4), on1 = *(const LAS f32x4v*)(lds + L_ON + (32 * vq + 8 * j + 4) * 4);
                        v4u o4;
                        o4.x = cvtpk(ov[8 * j + 0] * rinv * on0[0] * bflo(gq.x), ov[8 * j + 1] * rinv * on0[1] * bfhi(gq.x));
                        o4.y = cvtpk(ov[8 * j + 2] * rinv * on0[2] * bflo(gq.y), ov[8 * j + 3] * rinv * on0[3] * bfhi(gq.y));
                        o4.z = cvtpk(ov[8 * j + 4] * rinv * on1[0] * bflo(gq.z), ov[8 * j + 5] * rinv * on1[1] * bfhi(gq.z));
                        o4.w = cvtpk(ov[8 * j + 6] * rinv * on1[2] * bflo(gq.w), ov[8 * j + 7] * rinv * on1[3] * bfhi(gq.w));
                        *(GAS v4u*)(op + 8 * j) = o4; }
                }
                  if (c + 2 < SEQ / 64) HG_GATES(c + 2, gwA); }
                HG_BAR();
                if (c + 2 < SEQ / 64) { HG_PREP(0, qwA, fwA, vwA); if (c + 4 < SEQ / 64) HG_LOAD(c + 4, qwA, fwA, vwA); }
                HG_BAR();
            }
            {
            const int t = ptid >> 2, vq = ptid & 3; const size_t r = (size_t)b * SEQ + SEQ - 64 + t;
            float ov[32]; float ss = 0.f;
#pragma unroll
            for (int j = 0; j < 4; ++j) { const v4u w = *(const LAS v4u*)(lds + L_O + t * RS + vq * 64 + j * 16);
                ov[8 * j + 0] = bflo(w.x); ov[8 * j + 1] = bfhi(w.x); ov[8 * j + 2] = bflo(w.y); ov[8 * j + 3] = bfhi(w.y); ov[8 * j + 4] = bflo(w.z); ov[8 * j + 5] = bfhi(w.z); ov[8 * j + 6] = bflo(w.w); ov[8 * j + 7] = bfhi(w.w); }
#pragma unroll
            for (int j = 0; j < 32; ++j) ss += ov[j] * ov[j];
            ss += __shfl_xor(ss, 1); ss += __shfl_xor(ss, 2);
            const float rinv = 1.f / sqrtf(ss * (1.f / 128.f) + RMS_EPS);
            bf16* op = Oout + r * DM + h * HD + 32 * vq;
#pragma unroll
            for (int j = 0; j < 4; ++j) { const v4u gq = gwB[j]; const f32x4v on0 = *(const LAS f32x4v*)(lds + L_ON + (32 * vq + 8 * j) * 4), on1 = *(const LAS f32x4v*)(lds + L_ON + (32 * vq + 8 * j + 4) * 4);
                v4u o4;
                o4.x = cvtpk(ov[8 * j + 0] * rinv * on0[0] * bflo(gq.x), ov[8 * j + 1] * rinv * on0[1] * bfhi(gq.x));
                o4.y = cvtpk(ov[8 * j + 2] * rinv * on0[2] * bflo(gq.y), ov[8 * j + 3] * rinv * on0[3] * bfhi(gq.y));
                o4.z = cvtpk(ov[8 * j + 4] * rinv * on1[0] * bflo(gq.z), ov[8 * j + 5] * rinv * on1[1] * bfhi(gq.z));
                o4.w = cvtpk(ov[8 * j + 6] * rinv * on1[2] * bflo(gq.w), ov[8 * j + 7] * rinv * on1[3] * bfhi(gq.w));
                *(GAS v4u*)(op + 8 * j) = o4; }
            }
#undef HG_GATES
        } else {
            f32x4v S[8][2];
#pragma unroll
            for (int m = 0; m < 8; ++m) { S[m][0] = (f32x4v){0.f, 0.f, 0.f, 0.f}; S[m][1] = (f32x4v){0.f, 0.f, 0.f, 0.f}; }
            HG_BAR();
            for (int c = 0; c < SEQ / 64; ++c) {
                const int cb = c & 1;
                LAS unsigned char* CB = lds + cb * BUFB;
                {
                const int mt = rw;
                f32x4v acc[4];
#pragma unroll
                for (int nt = 0; nt < 4; ++nt) acc[nt] = (f32x4v){0.f, 0.f, 0.f, 0.f};
#pragma unroll
                for (int ks = 0; ks < 4; ++ks) { const bf16x8 a = *(const LAS bf16x8*)(CB + L_Q + (16 * mt + li) * RS + (32 * ks + 8 * g) * 2);
#pragma unroll
                    for (int nt = 0; nt < 4; ++nt) { const bf16x8 bb = *(const LAS bf16x8*)(CB + L_K + (16 * nt + li) * RS + (32 * ks + 8 * g) * 2);
                        acc[nt] = __builtin_amdgcn_mfma_f32_16x16x32_bf16(a, bb, acc[nt], 0, 0, 0); } }
#pragma unroll
                for (int nt = 0; nt < 4; ++nt) { const int s = 16 * nt + li;
#pragma unroll
                    for (int r = 0; r < 4; ++r) { const int t = 16 * mt + 4 * g + r; const float v = (s <= t) ? acc[nt][r] : 0.f;
                        *(LAS unsigned short*)(lds + L_AM + t * RSA + s * 2) = (unsigned short)f2bf(v); } }
                }
                HG_BAR();
                {
                f32x4v o[4][2];
#pragma unroll
                for (int m = 0; m < 4; ++m) { o[m][0] = (f32x4v){0.f, 0.f, 0.f, 0.f}; o[m][1] = (f32x4v){0.f, 0.f, 0.f, 0.f}; }
#pragma unroll
                for (int ks = 0; ks < 4; ++ks) { bf16x8 bs[2];
#pragma unroll
                    for (int n = 0; n < 2; ++n) { v4u bw; bw.x = cvtpk(S[2 * ks][n][0], S[2 * ks][n][1]); bw.y = cvtpk(S[2 * ks][n][2], S[2 * ks][n][3]); bw.z = cvtpk(S[2 * ks + 1][n][0], S[2 * ks + 1][n][1]); bw.w = cvtpk(S[2 * ks + 1][n][2], S[2 * ks + 1][n][3]);
                        bs[n] = *reinterpret_cast<bf16x8*>(&bw); }
#pragma unroll
                    for (int m = 0; m < 4; ++m) { const LAS unsigned char* qa = CB + L_Q + (16 * m + li) * RS + (32 * ks + 4 * g) * 2;
                        const v2u lo = *(const LAS v2u*)qa, hi2 = *(const LAS v2u*)(qa + 32); v4u aw; aw.x = lo.x; aw.y = lo.y; aw.z = hi2.x; aw.w = hi2.y;
                        const bf16x8 av = *reinterpret_cast<bf16x8*>(&aw);
                        o[m][0] = __builtin_amdgcn_mfma_f32_16x16x32_bf16(av, bs[0], o[m][0], 0, 0, 0);
                        o[m][1] = __builtin_amdgcn_mfma_f32_16x16x32_bf16(av, bs[1], o[m][1], 0, 0, 0); } }
                bf16x8 bv[2][2];
#pragma unroll
                for (int n = 0; n < 2; ++n) {
                    const int va = (int)(unsigned)(uintptr_t)(CB + L_V) + (8 * g + (li >> 2)) * RS + (16 * (2 * rw + n) + 4 * (li & 3)) * 2;
                    s16x4 a0, a1, a2, a3; HG_TR(a0, va, 0); HG_TR(a1, va, 4 * RS); HG_TR(a2, va, 32 * RS); HG_TR(a3, va, 36 * RS);
                    asm volatile("s_waitcnt lgkmcnt(0)" ::: "memory"); __builtin_amdgcn_sched_barrier(0);
                    bv[n][0] = (bf16x8){a0[0], a0[1], a0[2], a0[3], a1[0], a1[1], a1[2], a1[3]}; bv[n][1] = (bf16x8){a2[0], a2[1], a2[2], a2[3], a3[0], a3[1], a3[2], a3[3]}; }
#pragma unroll
                for (int ks = 0; ks < 2; ++ks)
#pragma unroll
                    for (int m = 0; m < 4; ++m) { const bf16x8 a = *(const LAS bf16x8*)(lds + L_AM + (16 * m + li) * RSA + (32 * ks + 8 * g) * 2);
                        o[m][0] = __builtin_amdgcn_mfma_f32_16x16x32_bf16(a, bv[0][ks], o[m][0], 0, 0, 0);
                        o[m][1] = __builtin_amdgcn_mfma_f32_16x16x32_bf16(a, bv[1][ks], o[m][1], 0, 0, 0); }
                { const int ka = (int)(unsigned)(uintptr_t)(CB + L_K) + (8 * g + (li >> 2)) * RS + (4 * (li & 3)) * 2;
                  const LAS float* ebl = (const LAS float*)(lds + L_EBL + cb * 512);
#pragma unroll
                  for (int m = 0; m < 8; ++m) { s16x4 a0, a1, a2, a3;
#define HG_KT(m_) HG_TR(a0, ka, (m_) * 32); HG_TR(a1, ka, (m_) * 32 + 4 * RS); HG_TR(a2, ka, (m_) * 32 + 32 * RS); HG_TR(a3, ka, (m_) * 32 + 36 * RS)
                      switch (m) { case 0: HG_KT(0); break; case 1: HG_KT(1); break; case 2: HG_KT(2); break; case 3: HG_KT(3); break; case 4: HG_KT(4); break; case 5: HG_KT(5); break; case 6: HG_KT(6); break; default: HG_KT(7); break; }
#undef HG_KT
                      asm volatile("s_waitcnt lgkmcnt(0)" ::: "memory"); __builtin_amdgcn_sched_barrier(0);
                      const bf16x8 kt0 = (bf16x8){a0[0], a0[1], a0[2], a0[3], a1[0], a1[1], a1[2], a1[3]}, kt1 = (bf16x8){a2[0], a2[1], a2[2], a2[3], a3[0], a3[1], a3[2], a3[3]};
                      const f32x4v e = *(const LAS f32x4v*)(ebl + 16 * m + 4 * g);
#pragma unroll
                      for (int n = 0; n < 2; ++n) { S[m][n] = __builtin_amdgcn_mfma_f32_16x16x32_bf16(kt0, bv[n][0], S[m][n], 0, 0, 0);
                          S[m][n] = __builtin_amdgcn_mfma_f32_16x16x32_bf16(kt1, bv[n][1], S[m][n], 0, 0, 0);
                          S[m][n] = S[m][n] * e; } } }
#pragma unroll
                for (int m = 0; m < 4; ++m)
#pragma unroll
                    for (int n = 0; n < 2; ++n)
#pragma unroll
                        for (int r = 0; r < 4; ++r) *(LAS unsigned short*)(lds + L_O + (16 * m + 4 * g + r) * RS + (16 * (2 * rw + n) + li) * 2) = (unsigned short)f2bf(o[m][n][r]);
                }
                HG_BAR();
            }
        }
        LDS_WAIT();
        __syncthreads();
#undef HG_LOAD
#undef HG_PREP
    }
}
#undef HG_TR
#undef HG_BAR
}

struct Args { const float* in[14]; float* out; unsigned char* ws; int ph_lo, ph_hi; };
#ifndef CONV_IN_SCAN
#define CONV_IN_SCAN 1
#endif
#ifndef MK_N_LAUNCHES
#define MK_N_LAUNCHES 1
#endif
constexpr int MISC_OFF = LDS_BYTES - 64;
constexpr int N_PHASES = 10;
__global__ void __launch_bounds__(NTHREADS, 2) mk_fwd(Args args) {
    extern __shared__ __attribute__((aligned(16))) unsigned char lds[];
    Frame F;
    F.lds = (LAS unsigned char*)lds;
    F.wave = __builtin_amdgcn_readfirstlane((int)threadIdx.x >> 6); F.lane = lane_id(); F.tid = F.wave * 64 + F.lane;
    F.G = gridDim.x; F.gw = blockIdx.x * NWAVES + F.wave; F.NGW = F.G * NWAVES;
    F.x = args.in[0]; F.norm_g = args.in[1]; F.rel = args.in[2]; F.w_in = args.in[3]; F.pe = args.in[4]; F.cw1 = args.in[5]; F.cw2 = args.in[6]; F.w_out = args.in[7];
    F.h_in = args.in[8]; F.h_lb = args.in[9]; F.h_on = args.in[10]; F.h_out = args.in[11]; F.up = args.in[12]; F.dn = args.in[13];
    F.out = args.out; F.ws = args.ws;
    unsigned char* ws = args.ws;
    bf16* A = (bf16*)(ws + WS_A); bf16* BIG = (bf16*)(ws + WS_BIG); bf16* X16 = (bf16*)(ws + WS_X16);
    const int lo = args.ph_lo, hi = args.ph_hi;
    if (F.tid < 4) ((LAS unsigned*)(F.lds + MISC_OFF))[F.tid] = 0u;
    __syncthreads();
    XcdBarrier bar; bar.wave = F.wave; bar.bar = (unsigned*)(ws + WS_CTL) + 1024; bar.x = 0; bar.st = nullptr;
    if (hi - lo > 1) bar = xcd_barrier_post((unsigned*)(ws + WS_CTL) + 1024, (volatile LAS unsigned*)(F.lds + MISC_OFF), F.wave);
#define IN(k) (lo <= (k) && (k) < hi)
#define PH_FENCE() do { F.lane = lane_id(); F.tid = F.wave * 64 + F.lane; } while (0)
#define SEAM(k) do { if (IN(k) && IN((k) + 1)) xcd_barrier(bar); } while (0)
#define GEMM_PHASE_M(ACT, Ap, Btp, MR_, N_, K_, Op, ldc_, st_, sc_, rs_) do { pg8::Gemm g{(Ap), (Btp), (MR_), (N_), (K_)}; pg8::StaticOrder S; S.init((MR_), (N_), F.G, (int)blockIdx.x); \
        EpiAct<ACT> E{(Op), (ldc_), (st_), (sc_), (const float*)(ws + WS_LB), (rs_), 1.f}; pg8::gemm_phase<EpiAct<ACT>, pg8::StaticOrder, true, true>(F.lds, g, S, E, F.tid); } while (0)
#define GEMM_PHASE(ACT, Ap, Btp, N_, K_, Op, ldc_, st_, sc_, rs_) GEMM_PHASE_M(ACT, Ap, Btp, M, N_, K_, Op, ldc_, st_, sc_, rs_)
#define PANEL_SQL(e_, ro_) PanelSqLast{(float*)(ws + WS_SLOTS) + ((size_t)(e_) * M + (ro_)) * 8, (unsigned*)(ws + WS_CTL) + CW_PANEL + ((e_) * 64 + (ro_) / 256) * 64, (float*)(ws + WS_RINV) + (ro_)}
#define PANEL_SQ(e_, ro_) PanelSq{(float*)(ws + WS_SLOTS) + ((size_t)(e_) * M + (ro_)) * 8, (unsigned*)(ws + WS_CTL) + CW_PANEL + ((e_) * 64 + (ro_) / 256) * 64, (unsigned*)(ws + WS_CTL) + CW_XTMO}
#define GEMM_FUSED(XF32_, FINAL_, W8_, F8_, Ap, Btp, K_, osc_, ro_, xoldp, gp, e1_, e2_) GEMM_FUSED8(XF32_, FINAL_, W8_, F8_, Ap, Btp, K_, osc_, ro_, xoldp, gp, e1_, e2_, WS_X8)
#define GEMM_FUSED8(XF32_, FINAL_, W8_, F8_, Ap, Btp, K_, osc_, ro_, xoldp, gp, e1_, e2_, X8OFF_) do { pg8::Gemm g{(Ap), (Btp), M / 2, DM, (K_)}; pg8::StaticOrder S; S.init(M / 2, DM, F.G, (int)blockIdx.x); \
        EpiRmsRes<XF32_, FINAL_, W8_> E{(const void*)(xoldp), X16 + (size_t)(ro_) * DM, F.out + (size_t)(ro_) * DM, (gp), ws + (X8OFF_) + (size_t)(ro_) * DM, (osc_), PANEL_SQ(e1_, ro_), PANEL_SQL(e2_, ro_)}; \
        pg8::gemm_phase<EpiRmsRes<XF32_, FINAL_, W8_>, pg8::StaticOrder, false, true, F8_>(F.lds, g, S, E, F.tid); } while (0)
#define MLP_FULL_F(FINAL_, WUP, WDN, gp, e1_, e2_) do { { pg8::Gemm g{(const bf16*)(ws + WS_X8), (const bf16*)(ws + (WUP)), M, FF, DM / 2}; pg8::StaticOrder S; S.init(M, FF, F.G, (int)blockIdx.x); \
        EpiUp8 E{ws + WS_BIG, FF, (const float*)(ws + WS_RINV)}; pg8::gemm_phase<EpiUp8, pg8::StaticOrder, true, true, true>(F.lds, g, S, E, F.tid); } xcd_barrier(bar); PH_FENCE(); \
        GEMM_FUSED8(false, FINAL_, !(FINAL_), true, BIG, (const bf16*)(ws + (WDN)), FF / 2, 1.f / (W8SCALE * H8SCALE), 0, X16, gp, e1_, e2_, WS_A); __syncthreads(); PH_FENCE(); \
        GEMM_FUSED8(false, FINAL_, !(FINAL_), true, (const bf16*)(ws + WS_BIG + (size_t)(M / 2) * FF), (const bf16*)(ws + (WDN)), FF / 2, 1.f / (W8SCALE * H8SCALE), M / 2, X16 + (size_t)(M / 2) * DM, gp, e1_, e2_, WS_A); } while (0)

    if (IN(0)) { PH_FENCE(); p0_prologue(F); } SEAM(0);
    if (IN(1)) { PH_FENCE(); GEMM_PHASE(0, A, (const bf16*)(ws + W0_QKV), NQKV, DM, BIG, NQKV, 8, QSCALE, (const float*)(ws + WS_RINV)); } SEAM(1);
    if (IN(2)) { PH_FENCE(); cg::cmp_gate_phase(F.lds, ws, F.G, F.tid); } SEAM(2);
    if (IN(3)) { PH_FENCE(); nsa::nsa_phase(F.lds, ws, F.G, F.tid); } SEAM(3);
    if (IN(4)) { PH_FENCE(); GEMM_FUSED(true, false, true, false, A, (const bf16*)(ws + W0_O), DM, 1.f, 0, F.x, F.norm_g + 1 * DM, 0, 1); __syncthreads();
                 GEMM_FUSED(true, false, true, false, A + (size_t)(M / 2) * DM, (const bf16*)(ws + W0_O), DM, 1.f, M / 2, F.x + (size_t)(M / 2) * DM, F.norm_g + 1 * DM, 0, 1); } SEAM(4);
    if (IN(5)) { PH_FENCE(); MLP_FULL_F(false, W0_UP, W0_DN, F.norm_g + 3 * DM, 2, 3); __syncthreads(); PH_FENCE(); p_convert_l1a(F); } SEAM(5);
    if (IN(6)) { PH_FENCE(); pg8::Gemm g{(const bf16*)(ws + WS_A), (const bf16*)(ws + W1_IN), M, FF, DM / 2}; pg8::StaticOrder S; S.init(M, FF, F.G, (int)blockIdx.x);
                 EpiAct<2> E{BIG, FF, 0, 1.f, (const float*)(ws + WS_LB), (const float*)(ws + WS_RINV), 1.f / W8SCALE}; pg8::gemm_phase<EpiAct<2>, pg8::StaticOrder, false, true, true>(F.lds, g, S, E, F.tid); } SEAM(6);
    if (IN(7)) { PH_FENCE(); const int nstat = (F.G - BATCH * NH) * NWAVES;
                 if ((int)blockIdx.x >= BATCH * NH) p_convert_l1b(F, ((int)blockIdx.x - BATCH * NH) * NWAVES + F.wave, nstat);
                 else { hg::scan_phase(F.lds, ws, F.h_on, F.G, F.tid); PH_FENCE(); p_convert_l1b(F, -1, nstat); } } SEAM(7);
    if (IN(8)) { PH_FENCE(); GEMM_FUSED(false, false, true, false, A, (const bf16*)(ws + W1_O), DM, 1.f, 0, X16, F.norm_g + 5 * DM, 4, 5); __syncthreads();
                 GEMM_FUSED(false, false, true, false, A + (size_t)(M / 2) * DM, (const bf16*)(ws + W1_O), DM, 1.f, M / 2, X16 + (size_t)(M / 2) * DM, F.norm_g + 5 * DM, 4, 5); } SEAM(8);
    if (IN(9)) { PH_FENCE(); MLP_FULL_F(true, W1_UP, W1_DN, F.norm_g + 7 * DM, 6, 7); }
#undef IN
}

extern "C" void kernel_launch(void* const* d_in, const int* in_sizes, int n_in, void* d_out, int out_size, void* d_ws, size_t ws_size, hipStream_t stream) {
    static int grid = 0;
    if (grid == 0) {
        if (n_in != 14 || in_sizes[0] != M * DM || out_size != M * DM || ws_size < WS_END) { fprintf(stderr, "kernel_launch: unexpected shapes (n_in %d, ws %zu)\n", n_in, ws_size); grid = -1; return; }
        int dev = 0, cus = 0;
        if (hipGetDevice(&dev) != hipSuccess || hipDeviceGetAttribute(&cus, hipDeviceAttributeMultiprocessorCount, dev) != hipSuccess) { grid = -1; return; }
        if (hipFuncSetAttribute((const void*)mk_fwd, hipFuncAttributeMaxDynamicSharedMemorySize, LDS_BYTES) != hipSuccess) { fprintf(stderr, "kernel_launch: hipFuncSetAttribute failed\n"); grid = -1; return; }
        (void)hipGetLastError();
        if (cus < 256) { fprintf(stderr, "kernel_launch: this kernel needs 256 co-resident workgroups (one per CU); the device has %d CUs\n", cus); grid = -1; return; }
        grid = 256;
    }
    if (grid < 0) return;
    Args a{};
    for (int i = 0; i < 14; ++i) a.in[i] = (const float*)d_in[i];
    a.out = (float*)d_out; a.ws = (unsigned char*)d_ws;
    if (hipMemsetAsync((char*)d_ws + WS_CTL, 0, CTL_ZERO_BYTES, stream) != hipSuccess) return;
    if (MK_N_LAUNCHES == 1) { a.ph_lo = 0; a.ph_hi = N_PHASES; hipLaunchKernelGGL(mk_fwd, dim3(grid), dim3(NTHREADS), LDS_BYTES, stream, a); }
    else for (int p = 0; p < N_PHASES; ++p) { a.ph_lo = p; a.ph_hi = p + 1; hipLaunchKernelGGL(mk_fwd, dim3(grid), dim3(NTHREADS), LDS_BYTES, stream, a); }
}
```

```cpp
#include <hip/hip_runtime.h>
#include <cstdio>
#include <cstdint>
namespace pg8 {
#define PG8_LAS __attribute__((address_space(3)))
typedef unsigned short bf16_t;
typedef short bf16x8 __attribute__((ext_vector_type(8)));
typedef float f32x4 __attribute__((ext_vector_type(4)));
typedef unsigned u32x4 __attribute__((ext_vector_type(4)));
constexpr int BM = 256, BK = 64, HALF = 128, HTB = HALF * BK * 2  , STAGE_BYTES = 8 * HTB, NXCD = 8, WGM = 4;

__host__ __device__ __forceinline__ int lds_byte(int r, int c) { const int st = (r >> 4) * 2 + (c >> 5), rr = r & 15, cc = c & 31, ob = rr * 64 + cc * 2; return st * 1024 + (ob ^ (((ob >> 9) & 1) << 5)); }
__host__ __device__ __forceinline__ void stage_rc(int b, int& R, int& C) { const int st = b / 1024, sb = b % 1024, swz = sb ^ (((sb >> 9) & 1) << 5); R = (st >> 1) * 16 + swz / 64; C = (st & 1) * 32 + (swz % 64) / 2; }
__host__ __device__ __forceinline__ int perm32(int rho) { const int n = rho >> 4, i = rho & 15; return 8 * (i >> 2) + 4 * n + (i & 3); }

typedef int i32x4 __attribute__((ext_vector_type(4)));
typedef int i32x8 __attribute__((ext_vector_type(8)));
struct Unit { int pm, pn; };
struct Gemm { const bf16_t* A; const bf16_t* Bt; int M, N, K; };

struct StaticOrder {
    int nM, nN, nwg, G, c;
    __host__ __device__ void init(int M, int N, int G_, int c_) { nM = M / BM; nN = N / BM; nwg = nM * nN; G = G_; c = c_; }
    __host__ __device__ bool next(int i, Unit& u) const {
        const long L = (long)i * G + c; if (L >= nwg) return false;
        int wgid = (int)L; { const int q = nwg / NXCD, r = nwg % NXCD, xcd = wgid % NXCD, off = wgid / NXCD; wgid = (xcd < r ? xcd * (q + 1) : r * (q + 1) + (xcd - r) * q) + off; }
        const int nig = WGM * nN, gid = wgid / nig, fm = gid * WGM, gsz = (nM - fm) < WGM ? (nM - fm) : WGM;
        u.pm = fm + ((wgid % nig) % gsz); u.pn = (wgid % nig) / gsz; return true;
    }
    __device__ __forceinline__ void a_ready(const Unit&) const {}
    __device__ __forceinline__ void done(const Unit&) const {}
};

__device__ __forceinline__ unsigned cvt_pk_bf16(float lo, float hi) { unsigned r; asm volatile("v_cvt_pk_bf16_f32 %0, %1, %2" : "=v"(r) : "v"(lo), "v"(hi)); return r; }
typedef float f32x2 __attribute__((ext_vector_type(2)));
__device__ __forceinline__ f32x2 gelu_pk(f32x2 v) {
    const f32x2 av = __builtin_elementwise_abs(v), d = av * 0.2316418882f + 1.0f;
    f32x2 t; t.x = __builtin_amdgcn_rcpf(d.x); t.y = __builtin_amdgcn_rcpf(d.y);
    f32x2 q = t * 0.5307027145f + (-0.7265760135f); q = q * t + 0.7107068705f; q = q * t + (-0.142248368f); q = q * t + 0.127414796f; q = q * t;
    const f32x2 s = (v * v) * (-0.72134752044f);
    f32x2 e; e.x = __builtin_amdgcn_exp2f(s.x); e.y = __builtin_amdgcn_exp2f(s.y);
    const f32x2 m = v * (q * e), r = v - m;
    f32x2 o; o.x = v.x < 0.f ? m.x : r.x; o.y = v.y < 0.f ? m.y : r.y; return o;
}

template <int ACT  > struct EpiBf16 {
    static constexpr bool PERM = true, AFTER_DRAIN = false; static_assert(ACT == 0 || ACT == 1, "EpiBf16: ACT is 0 (none) or 1 (gelu_pk)");
    bf16_t* O; int ldc; const float* bias; int split_cols; size_t split_stride; float scale0;
    __device__ __forceinline__ void operator()(const f32x4 (&acc)[2][2][4][2], const Unit& u, int wr, int wc, int fr, int fq) const {
        const int row0 = u.pm * BM + wr * 64 + fr; int colt = u.pn * BM; bf16_t* base = O;
        float sc = 1.f; if (split_cols) { const int t = colt / split_cols; base += (size_t)t * split_stride; colt -= t * split_cols; if (t == 0) sc = scale0; }
        const int col0 = colt + wc * 32 + 8 * fq, bcol0 = u.pn * BM + wc * 32 + 8 * fq;
        f32x4 bv[2][2];
#pragma unroll
        for (int bj = 0; bj < 2; ++bj)
#pragma unroll
            for (int n = 0; n < 2; ++n) bv[bj][n] = bias ? *(const f32x4*)(bias + bcol0 + bj * HALF + 4 * n) : (f32x4){0.f, 0.f, 0.f, 0.f};
#pragma unroll
        for (int ai = 0; ai < 2; ++ai)
#pragma unroll
            for (int m = 0; m < 4; ++m) { bf16_t* rowp = base + (size_t)(row0 + ai * HALF + m * 16) * ldc + col0;
#pragma unroll
                for (int bj = 0; bj < 2; ++bj) { f32x4 v0 = acc[ai][bj][m][0] + bv[bj][0], v1 = acc[ai][bj][m][1] + bv[bj][1];
                    if (ACT == 1) { f32x2 a = gelu_pk((f32x2){v0[0], v0[1]}), b = gelu_pk((f32x2){v0[2], v0[3]}), c = gelu_pk((f32x2){v1[0], v1[1]}), d = gelu_pk((f32x2){v1[2], v1[3]});
                        v0 = (f32x4){a.x, a.y, b.x, b.y}; v1 = (f32x4){c.x, c.y, d.x, d.y}; }
                    v0 = v0 * sc; v1 = v1 * sc; u32x4 w; w.x = cvt_pk_bf16(v0[0], v0[1]); w.y = cvt_pk_bf16(v0[2], v0[3]); w.z = cvt_pk_bf16(v1[0], v1[1]); w.w = cvt_pk_bf16(v1[2], v1[3]);
                    *(u32x4*)(rowp + bj * HALF) = w; } }
    }
};
__device__ __forceinline__ void mfma_f8(f32x4& c, const i32x8 a, const i32x8 b) { asm volatile("s_nop 1\n\tv_mfma_f32_16x16x128_f8f6f4 %0, %1, %2, %0" : "+v"(c) : "v"(a), "v"(b)); }
template <class Epi, class Sched, bool ALIGN_EPI = false, bool SP2 = false, bool F8 = false>
__device__ __forceinline__ void gemm_phase(PG8_LAS unsigned char* lds, const Gemm g, const Sched& S, const Epi& E, const int tid) {
    const int wid = __builtin_amdgcn_readfirstlane(tid >> 6), lane = tid & 63, wr = wid >> 2, wc = wid & 3, fr = lane & 15, fq = lane >> 4;
    const int K = g.K, nt = K / BK;
    unsigned voffA[2], voffB[2];
#pragma unroll
    for (int i = 0; i < 2; ++i) { int R, C; stage_rc(tid * 16 + i * 8192, R, C); const int Rb = Epi::PERM ? ((R & ~31) + perm32(R & 31)) : R;
        voffA[i] = (unsigned)(R * K + C) * 2u; voffB[i] = (unsigned)(Rb * K + C) * 2u; }
    const size_t kstep = (size_t)(BK * 2);
    const size_t hstep = (size_t)HALF * K * 2;
    const size_t tstep = 2 * hstep;
    const unsigned ldsw = (unsigned)wid * 1024u;
    const int aoff = lds_byte(wr * 64 + fr, fq * 8), boff = lds_byte(wc * 32 + fr, fq * 8);
#define PG8_SA(b, h) (((b) * 2 + (h)) * HTB)
#define PG8_SB(b, h) ((4 + (b) * 2 + (h)) * HTB)
#define PG8_STAGE(bufoff, gbase, voff) do { _Pragma("unroll") for (int _i = 0; _i < 2; ++_i) \
        __builtin_amdgcn_global_load_lds((const unsigned*)((const char*)(gbase) + (voff)[_i]), (PG8_LAS unsigned*)(lds + (bufoff) + ldsw + _i * 8192), 16, 0, 0); } while (0)
#define PG8_LDA(dst, b, h) do { _Pragma("unroll") for (int m = 0; m < 4; ++m) _Pragma("unroll") for (int k = 0; k < 2; ++k) dst[m][k] = *(const PG8_LAS bf16x8*)(lds + PG8_SA(b, h) + aoff + m * 2048 + k * 1024); } while (0)
#define PG8_LDB(dst, b, h) do { _Pragma("unroll") for (int n = 0; n < 2; ++n) _Pragma("unroll") for (int k = 0; k < 2; ++k) dst[n][k] = *(const PG8_LAS bf16x8*)(lds + PG8_SB(b, h) + boff + n * 2048 + k * 1024); } while (0)
#define PG8_CAT8(x) __builtin_shufflevector(__builtin_bit_cast(i32x4, (x)[0]), __builtin_bit_cast(i32x4, (x)[1]), 0, 1, 2, 3, 4, 5, 6, 7)
#define PG8_MMA(ai, bj, At, Bt) do { __builtin_amdgcn_s_setprio(1); _Pragma("unroll") for (int m = 0; m < 4; ++m) _Pragma("unroll") for (int n = 0; n < 2; ++n) { \
        if constexpr (F8) mfma_f8(acc[ai][bj][m][n], PG8_CAT8(Bt[n]), PG8_CAT8(At[m])); \
        else { _Pragma("unroll") for (int k = 0; k < 2; ++k) acc[ai][bj][m][n] = __builtin_amdgcn_mfma_f32_16x16x32_bf16(Bt[n][k], At[m][k], acc[ai][bj][m][n], 0, 0, 0); } } __builtin_amdgcn_s_setprio(0); } while (0)
#define PG8_WAIT_V(n) asm volatile("s_waitcnt vmcnt(" #n ")" ::: "memory")
#define PG8_WAIT_L(n) asm volatile("s_waitcnt lgkmcnt(" #n ")" ::: "memory")
#define PG8_BAR __builtin_amdgcn_s_barrier()
#define PG8_SCHED __builtin_amdgcn_sched_barrier(0)
    Unit cur, nxt; int ui = 0;
    if (!S.next(0, cur)) return;
    float epre[8]; E.prefetch(cur, wr, fr, epre);
    f32x4 acc[2][2][4][2];
#pragma unroll
    for (int a = 0; a < 2; ++a)
#pragma unroll
        for (int b = 0; b < 2; ++b)
#pragma unroll
            for (int m = 0; m < 4; ++m)
#pragma unroll
                for (int n = 0; n < 2; ++n) acc[a][b][m][n] = (f32x4){0.f, 0.f, 0.f, 0.f};
    bf16x8 At[4][2], B0[2][2], B1[2][2];
    const char* cA = (const char*)g.A + (size_t)cur.pm * tstep; const char* cB = (const char*)g.Bt + (size_t)cur.pn * tstep;
    S.a_ready(cur);
    if constexpr (SP2) {
        PG8_STAGE(PG8_SB(0, 0), cB, voffB); PG8_STAGE(PG8_SB(0, 1), cB + hstep, voffB); PG8_STAGE(PG8_SA(0, 0), cA, voffA); PG8_STAGE(PG8_SA(0, 1), cA + hstep, voffA);
        if (wr == 1) PG8_BAR;
        PG8_WAIT_V(2); PG8_BAR;
        PG8_STAGE(PG8_SB(1, 0), cB + kstep, voffB); PG8_STAGE(PG8_SB(1, 1), cB + hstep + kstep, voffB);
        PG8_WAIT_V(4); PG8_BAR;
    } else {
        PG8_STAGE(PG8_SB(0, 0), cB, voffB); PG8_STAGE(PG8_SA(0, 0), cA, voffA); PG8_STAGE(PG8_SB(0, 1), cB + hstep, voffB); PG8_STAGE(PG8_SA(0, 1), cA + hstep, voffA);
        if (wr == 1) PG8_BAR;
        PG8_WAIT_V(4); PG8_BAR;
        PG8_STAGE(PG8_SB(1, 0), cB + kstep, voffB); PG8_STAGE(PG8_SA(1, 0), cA + kstep, voffA); PG8_STAGE(PG8_SB(1, 1), cB + hstep + kstep, voffB);
        PG8_WAIT_V(6); PG8_BAR;
    }
    for (;;) {
        const bool has_next = S.next(ui + 1, nxt);
        const char* nA = has_next ? (const char*)g.A + (size_t)nxt.pm * tstep : cA; const char* nB = has_next ? (const char*)g.Bt + (size_t)nxt.pn * tstep : cB;
        for (int t = 0; t < nt; t += 2) {
            const bool last = (t == nt - 2);
            const char* a1 = cA + (size_t)(t + 1) * kstep;
            const char* a2 = last ? nA : cA + (size_t)(t + 2) * kstep; const char* b2 = last ? nB : cB + (size_t)(t + 2) * kstep;
            const char* a3 = a2 + kstep; const char* b3 = b2 + kstep;
            if (last && has_next) S.a_ready(nxt);
            if constexpr (SP2) {
            PG8_LDB(B0, 0, 0); PG8_LDB(B1, 0, 1); PG8_SCHED; PG8_LDA(At, 0, 0); PG8_STAGE(PG8_SA(1, 0), a1, voffA); PG8_STAGE(PG8_SA(1, 1), a1 + hstep, voffA);
            PG8_WAIT_V(8); PG8_WAIT_L(0); PG8_BAR; PG8_MMA(0, 0, At, B0); PG8_MMA(0, 1, At, B1); PG8_BAR; PG8_SCHED;
            PG8_LDA(At, 0, 1); PG8_STAGE(PG8_SB(0, 0), b2, voffB); PG8_STAGE(PG8_SB(0, 1), b2 + hstep, voffB);
            PG8_WAIT_V(6); PG8_WAIT_L(0); PG8_BAR; PG8_MMA(1, 0, At, B0); PG8_MMA(1, 1, At, B1); PG8_BAR; PG8_SCHED;
            PG8_LDB(B0, 1, 0); PG8_LDB(B1, 1, 1); PG8_SCHED; PG8_LDA(At, 1, 0); PG8_STAGE(PG8_SA(0, 0), a2, voffA); PG8_STAGE(PG8_SA(0, 1), a2 + hstep, voffA);
            PG8_WAIT_V(8); PG8_WAIT_L(0); PG8_BAR; PG8_MMA(0, 0, At, B0); PG8_MMA(0, 1, At, B1); PG8_BAR; PG8_SCHED;
            PG8_LDA(At, 1, 1); PG8_STAGE(PG8_SB(1, 0), b3, voffB); PG8_STAGE(PG8_SB(1, 1), b3 + hstep, voffB);
            PG8_WAIT_V(6); PG8_WAIT_L(0); PG8_BAR; PG8_MMA(1, 0, At, B0); PG8_MMA(1, 1, At, B1); PG8_BAR; PG8_SCHED;
            } else {
            PG8_LDB(B0, 0, 0); PG8_SCHED; PG8_LDA(At, 0, 0); PG8_STAGE(PG8_SA(1, 1), a1 + hstep, voffA);
            PG8_WAIT_L(8); PG8_BAR; PG8_WAIT_L(0); PG8_MMA(0, 0, At, B0); PG8_BAR; PG8_SCHED;
            PG8_LDB(B1, 0, 1); PG8_STAGE(PG8_SB(0, 0), b2, voffB);
            PG8_BAR; PG8_WAIT_L(0); PG8_MMA(0, 1, At, B1); PG8_BAR;
            PG8_LDA(At, 0, 1); PG8_STAGE(PG8_SA(0, 0), a2, voffA);
            PG8_BAR; PG8_WAIT_L(0); PG8_MMA(1, 0, At, B0); PG8_BAR; PG8_SCHED;
            PG8_STAGE(PG8_SB(0, 1), b2 + hstep, voffB);
            PG8_WAIT_V(6); PG8_BAR; PG8_MMA(1, 1, At, B1); PG8_BAR;
            PG8_LDB(B0, 1, 0); PG8_SCHED; PG8_LDA(At, 1, 0); PG8_STAGE(PG8_SA(0, 1), a2 + hstep, voffA);
            PG8_WAIT_L(8); PG8_BAR; PG8_WAIT_L(0); PG8_MMA(0, 0, At, B0); PG8_BAR; PG8_SCHED;
            PG8_LDB(B1, 1, 1); PG8_STAGE(PG8_SB(1, 0), b3, voffB);
            PG8_BAR; PG8_WAIT_L(0); PG8_MMA(0, 1, At, B1); PG8_BAR;
            PG8_LDA(At, 1, 1); PG8_STAGE(PG8_SA(1, 0), a3, voffA);
            PG8_BAR; PG8_WAIT_L(0); PG8_MMA(1, 0, At, B0); PG8_BAR; PG8_SCHED;
            PG8_STAGE(PG8_SB(1, 1), b3 + hstep, voffB);
            PG8_WAIT_V(6); PG8_BAR; PG8_MMA(1, 1, At, B1); PG8_BAR;
            }
        }
        if constexpr (F8) { asm volatile("s_nop 15"); PG8_SCHED; }
        if constexpr (ALIGN_EPI) { if (wr == 0) PG8_BAR; }
        if constexpr (!Epi::AFTER_DRAIN) { E(acc, cur, wr, wc, fr, fq, epre); S.done(cur); }
        if (!has_next) break;
#pragma unroll
        for (int a = 0; a < 2; ++a)
#pragma unroll
            for (int b = 0; b < 2; ++b)
#pragma unroll
                for (int m = 0; m < 4; ++m)
#pragma unroll
                    for (int n = 0; n < 2; ++n) acc[a][b][m][n] = (f32x4){0.f, 0.f, 0.f, 0.f};
        cur = nxt; cA = nA; cB = nB; ++ui;
        E.prefetch(cur, wr, fr, epre);
        if constexpr (ALIGN_EPI) { if (wr == 1) PG8_BAR; }
    }
    PG8_WAIT_V(0);
    if constexpr (!ALIGN_EPI) { if (wr == 0) PG8_BAR; }
    PG8_BAR;
    if constexpr (Epi::AFTER_DRAIN) { E.fused(acc, cur, wr, wc, fr, fq, lds, wid, lane); S.done(cur); }
#undef PG8_SA
#undef PG8_SB
#undef PG8_STAGE
#undef PG8_LDA
#undef PG8_LDB
#undef PG8_MMA
#undef PG8_CAT8
#undef PG8_WAIT_V
#undef PG8_WAIT_L
#undef PG8_BAR
#undef PG8_SCHED
}
}

constexpr int NWAVES = 8, NTHREADS = 512;
constexpr int BATCH = 8, SEQ = 2048, DM = 2048, M = BATCH * SEQ, NH = 16, NG = 4, NR = 4, HD = 128, FF = 8192;
constexpr int NQKV = 5120, NSA_IN = 5168, NC = 127, NCP = 128, NBLK = 32, NGATE = 48;
constexpr float RMS_EPS = 1e-6f;
constexpr int COL_KC = 2048, COL_VC = 2560, COL_KS = 3072, COL_VS = 3584, COL_KW = 4096, COL_VW = 4608;
constexpr float QSCALE = 0.12751743082459868f;

constexpr size_t MiB = 1u << 20;
constexpr size_t WS_CTL = 0, CTL_ZERO_BYTES = 256 * 1024;
constexpr size_t WS_LUT = 1 * MiB, WS_BIAS1 = WS_LUT + 16 * 1024  , WS_LB = WS_BIAS1 + 8192;
constexpr size_t WS_GATES = 2 * MiB;
constexpr size_t WS_KCMP = 5 * MiB, WS_VCMP = 6 * MiB;
constexpr size_t WS_W = 8 * MiB;
constexpr size_t W0_QKV = WS_W, W0_G = WS_W + 20 * MiB, W0_W1 = WS_W + 21 * MiB, W0_W2 = WS_W + 23 * MiB, W0_O = WS_W + 24 * MiB, W0_UP = WS_W + 32 * MiB, W0_DN = WS_W + 64 * MiB;
constexpr size_t W1_IN = WS_W, W1_O = WS_W + 32 * MiB, W1_UP = WS_W + 40 * MiB, W1_DN = WS_W + 72 * MiB;
constexpr size_t WS_A = 120 * MiB;
constexpr size_t WS_BIG = 184 * MiB;
constexpr size_t WS_SCR = 440 * MiB;
constexpr size_t WS_X8 = WS_BIG + 128 * MiB;
constexpr float W8SCALE = 64.f, H8SCALE = 4.f;
constexpr size_t WS_X16 = 440 * MiB;
constexpr size_t WS_RINV = 1 * MiB + 64 * 1024;
constexpr size_t WS_SLOTS = 504 * MiB;
constexpr size_t WS_END = 508 * MiB;
constexpr int CW_XTMO = 64, CW_CONVQ = 128, CW_PANEL = 8192;

constexpr int LDS_BYTES = 147456;

#define GAS __attribute__((address_space(1)))
#define LAS __attribute__((address_space(3)))
typedef unsigned short bf16;
typedef unsigned v4u __attribute__((ext_vector_type(4)));
typedef unsigned v2u __attribute__((ext_vector_type(2)));
typedef float f32x4 __attribute__((ext_vector_type(4)));
#define LDS_WAIT() asm volatile("s_waitcnt lgkmcnt(0)" ::: "memory")
#define VM_WAIT() asm volatile("s_waitcnt vmcnt(0)" ::: "memory")
__device__ __forceinline__ unsigned f2bf(float f) { unsigned u = __builtin_bit_cast(unsigned, f); return (u + 0x7fffu + ((u >> 16) & 1u)) >> 16; }
__device__ __forceinline__ unsigned pk2(float lo, float hi) { return f2bf(lo) | (f2bf(hi) << 16); }
__device__ __forceinline__ float bf2f(unsigned b) { return __builtin_bit_cast(float, b << 16); }
__device__ __forceinline__ float bflo(unsigned w) { return __builtin_bit_cast(float, w << 16); }
__device__ __forceinline__ float bfhi(unsigned w) { return __builtin_bit_cast(float, w & 0xffff0000u); }
__device__ __forceinline__ float wave_sum(float v) {
#pragma unroll
    for (int o = 1; o < 64; o <<= 1) v += __shfl_xor(v, o);
    return v;
}
__device__ __forceinline__ float wave_max(float v) {
#pragma unroll
    for (int o = 1; o < 64; o <<= 1) v = fmaxf(v, __shfl_xor(v, o));
    return v;
}
__device__ __forceinline__ int lane_id() { int l; asm volatile("v_mbcnt_lo_u32_b32 %0, -1, 0\n\tv_mbcnt_hi_u32_b32 %0, -1, %0" : "=v"(l)); return l; }
__device__ __forceinline__ float sigmoidf_(float x) { return 1.f / (1.f + __expf(-x)); }

typedef GAS unsigned gu32;
#define RLX_AGENT __ATOMIC_RELAXED, __HIP_MEMORY_SCOPE_AGENT
#define XB_TMO      128
#define XB_XCNT(j)  (256  + 64 * (j))
#define XB_XSUB(j)  (1280 + 64 * (j))
#define XB_XGEN(j)  (2304 + 64 * (j))
#define XB_TOP      3328
#define XB_TOPGEN   3392
#define XCD_BAR_WORDS 3456
#define XB_SPIN_CAP (1u << 24)

__device__ __forceinline__ unsigned xb_ld(unsigned* p)              { return __hip_atomic_load(p, __ATOMIC_RELAXED, __HIP_MEMORY_SCOPE_AGENT); }
__device__ __forceinline__ unsigned xb_add(unsigned* p, unsigned v) { return __hip_atomic_fetch_add(p, v, __ATOMIC_RELAXED, __HIP_MEMORY_SCOPE_AGENT); }
__device__ __forceinline__ unsigned xb_xcc_id() { return (unsigned)__builtin_amdgcn_s_getreg((3 << 11) | 20) & 0xFu; }
#define XB_SPIN(cond, bar) do { unsigned _sp = 0; while (cond) { __builtin_amdgcn_s_sleep(1); \
    if ((++_sp & 255u) == 0u) { if (xb_ld(&(bar)[XB_TMO])) break; if (_sp > XB_SPIN_CAP) { atomicAdd(&(bar)[XB_TMO], 1u); break; } } } } while (0)

struct XcdBarrier {
    int wave;
    unsigned* bar; unsigned x;
    volatile LAS unsigned* st;
};

__device__ __forceinline__ XcdBarrier xcd_barrier_post(unsigned* bar, volatile LAS unsigned* st, int wave) {
    XcdBarrier b; b.wave = wave; b.bar = bar; b.x = xb_xcc_id(); b.st = st;
    if (wave == 0 && lane_id() == 0) (void)xb_add(&bar[XB_XCNT(b.x)], 1u);
    return b;
}
__device__ __forceinline__ void xcd_barrier_complete(unsigned* bar, unsigned x, unsigned& nloc, unsigned& nx) {
    const unsigned G = gridDim.x * gridDim.y * gridDim.z;
    unsigned sum, cnt, mine, sp = 0u;
    for (;;) {
        sum = 0u; cnt = 0u; mine = 0u;
#pragma unroll
        for (unsigned j = 0; j < 16; ++j) { const unsigned c = xb_ld(&bar[XB_XCNT(j)]); sum += c; cnt += (c > 0u) ? 1u : 0u; mine = (j == x) ? c : mine; }
        if (sum == G) break;
        __builtin_amdgcn_s_sleep(1);
        if ((++sp & 255u) == 0u) { if (xb_ld(&bar[XB_TMO])) break; if (sp > XB_SPIN_CAP) { atomicAdd(&bar[XB_TMO], 1u); break; } }
    }
    nloc = mine > 0u ? mine : 1u; nx = cnt > 0u ? cnt : 1u;
}

__device__ __forceinline__ void xcd_barrier(const XcdBarrier& b) {
    asm volatile("s_waitcnt vmcnt(0)" ::: "memory");
    __syncthreads();
    if (b.wave == 0 && lane_id() == 0) {
        unsigned* bar = b.bar;
        __builtin_amdgcn_s_waitcnt(0);
        unsigned nloc = b.st[0], nx = b.st[1];
        if (nloc == 0u) { xcd_barrier_complete(bar, b.x, nloc, nx); b.st[0] = nloc; b.st[1] = nx; }
        const unsigned old = xb_add(&bar[XB_XSUB(b.x)], 1u);
        const unsigned gen = old / nloc;
        if (old + 1u == (gen + 1u) * nloc) {
            __builtin_amdgcn_fence(__ATOMIC_RELEASE, "agent");
            asm volatile("s_waitcnt vmcnt(0)" ::: "memory");
            const unsigned og = xb_add(&bar[XB_TOP], 1u);
            const unsigned tg = og / nx;
            if (og + 1u == (tg + 1u) * nx) xb_add(&bar[XB_TOPGEN], 1u);
            else XB_SPIN(xb_ld(&bar[XB_TOPGEN]) == tg, bar);
            __builtin_amdgcn_fence(__ATOMIC_ACQUIRE, "agent");
            xb_add(&bar[XB_XGEN(b.x)], 1u);
            asm volatile("s_waitcnt vmcnt(0)" ::: "memory");
        } else {
            XB_SPIN(xb_ld(&bar[XB_XGEN(b.x)]) == gen, bar);
            __builtin_amdgcn_fence(__ATOMIC_ACQUIRE, "agent");
            asm volatile("s_waitcnt vmcnt(0)" ::: "memory");
        }
    }
    __syncthreads();
}

struct Frame {
    LAS unsigned char* lds;
    int tid, lane, wave, G, gw, NGW;
    const float *x, *norm_g, *rel, *w_in, *pe, *cw1, *cw2, *w_out, *h_in, *h_lb, *h_on, *h_out, *up, *dn;
    float* out;
    unsigned char* ws;
};

template <int ACT  > struct EpiAct {
    static constexpr bool PERM = true, AFTER_DRAIN = false;
    bf16* O; int ldc; int scale_tiles; float scale; const float* lb; const float* rs; float rsmul;
    __device__ __forceinline__ void prefetch(const pg8::Unit& u, int wr, int fr, float (&pre)[8]) const {
        const int row0 = u.pm * 256 + wr * 64 + fr;
#pragma unroll
        for (int j = 0; j < 8; ++j) pre[j] = rs ? rs[row0 + (j >> 2) * 128 + (j & 3) * 16] * rsmul : 1.f;
    }
    __device__ __forceinline__ void operator()(const pg8::f32x4 (&acc)[2][2][4][2], const pg8::Unit& u, int wr, int wc, int fr, int fq, const float (&pre)[8]) const {
        const int row0 = u.pm * 256 + wr * 64 + fr, col0 = u.pn * 256 + wc * 32 + 8 * fq;
        const float sc = (u.pn < scale_tiles) ? scale : 1.f;
        const int kind = (ACT == 2) ? ((u.pn < 8 || u.pn >= 24) ? 1 : (u.pn < 16 ? 2 : 0)) : 0;
        pg8::f32x4 lbv[2][2];
        if (ACT == 2) {
#pragma unroll
            for (int bj = 0; bj < 2; ++bj)
#pragma unroll
                for (int n = 0; n < 2; ++n) lbv[bj][n] = (kind == 2) ? *(const pg8::f32x4*)(lb + (col0 - 2048) + bj * 128 + 4 * n) : (pg8::f32x4){0.f, 0.f, 0.f, 0.f};
        }
#pragma unroll
        for (int ai = 0; ai < 2; ++ai)
#pragma unroll
            for (int m = 0; m < 4; ++m) { bf16* rowp = O + (size_t)(row0 + ai * 128 + m * 16) * ldc + col0; const float rsc = pre[ai * 4 + m];
#pragma unroll
                for (int bj = 0; bj < 2; ++bj) { pg8::f32x4 v0 = acc[ai][bj][m][0] * rsc, v1 = acc[ai][bj][m][1] * rsc;
                    if (ACT == 2) {
                        if (kind == 1) {
#pragma unroll
                            for (int j = 0; j < 4; ++j) { v0[j] = v0[j] * __builtin_amdgcn_rcpf(1.f + __expf(-v0[j])); v1[j] = v1[j] * __builtin_amdgcn_rcpf(1.f + __expf(-v1[j])); }
                        } else if (kind == 2) {
#pragma unroll
                            for (int j = 0; j < 4; ++j) { const float l0 = lbv[bj][0][j], l1 = lbv[bj][1][j];
                                v0[j] = __logf(l0 + (1.f - l0) * __builtin_amdgcn_rcpf(1.f + __expf(-v0[j]))); v1[j] = __logf(l1 + (1.f - l1) * __builtin_amdgcn_rcpf(1.f + __expf(-v1[j]))); }
                        }
                    } else { v0 = v0 * sc; v1 = v1 * sc; }
                    pg8::u32x4 w; w.x = pg8::cvt_pk_bf16(v0[0], v0[1]); w.y = pg8::cvt_pk_bf16(v0[2], v0[3]); w.z = pg8::cvt_pk_bf16(v1[0], v1[1]); w.w = pg8::cvt_pk_bf16(v1[2], v1[3]);
                    if (ACT == 2) __builtin_nontemporal_store(w, (pg8::u32x4*)(rowp + bj * 128));
                    else *(pg8::u32x4*)(rowp + bj * 128) = w; } }
    }
};

__device__ __forceinline__ unsigned pk8(float a, float b, float c, float d) { int w = 0; w = __builtin_amdgcn_cvt_pk_fp8_f32(a, b, w, false); w = __builtin_amdgcn_cvt_pk_fp8_f32(c, d, w, true); return (unsigned)w; }
struct EpiUp8 {
    static constexpr bool PERM = true, AFTER_DRAIN = false;
    unsigned char* O; int ldc; const float* rs;
    __device__ __forceinline__ void prefetch(const pg8::Unit& u, int wr, int fr, float (&pre)[8]) const {
        const int row0 = u.pm * 256 + wr * 64 + fr;
#pragma unroll
        for (int j = 0; j < 8; ++j) pre[j] = rs[row0 + (j >> 2) * 128 + (j & 3) * 16] * (2.f / W8SCALE);
    }
    __device__ __forceinline__ void operator()(const pg8::f32x4 (&acc)[2][2][4][2], const pg8::Unit& u, int wr, int wc, int fr, int fq, const float (&pre)[8]) const {
        static_assert(H8SCALE == 4.f, "EpiUp8 folds sqrt(H8SCALE) = 2 into the row scale");
        const int row0 = u.pm * 256 + wr * 64 + fr, col0 = u.pn * 256 + wc * 32 + 8 * fq;
#pragma unroll
        for (int ai = 0; ai < 2; ++ai)
#pragma unroll
            for (int m = 0; m < 4; ++m) { const float rsc = pre[ai * 4 + m]; v2u w[2];
#pragma unroll
                for (int bj = 0; bj < 2; ++bj) { pg8::f32x4 v0 = acc[ai][bj][m][0] * rsc, v1 = acc[ai][bj][m][1] * rsc;
#pragma unroll
                    for (int j = 0; j < 4; ++j) { v0[j] = __builtin_amdgcn_fmed3f(v0[j], 0.f, 21.166010488f); v1[j] = __builtin_amdgcn_fmed3f(v1[j], 0.f, 21.166010488f); }
                    v0 = v0 * v0; v1 = v1 * v1;
                    w[bj].x = pk8(v0[0], v0[1], v0[2], v0[3]); w[bj].y = pk8(v1[0], v1[1], v1[2], v1[3]); }
                const auto sx = __builtin_amdgcn_permlane16_swap(w[0].x, w[1].x, false, false); const auto sy = __builtin_amdgcn_permlane16_swap(w[0].y, w[1].y, false, false);
                *(v4u*)(O + (size_t)(row0 + ai * 128 + m * 16) * ldc + u.pn * 256 + wc * 32 + 8 * (fq & ~1) + (fq & 1) * 128) = (v4u){sx[0], sy[0], sx[1], sy[1]}; }
    }
};

struct PanelSq {
    float* slots;
    unsigned* cnt;
    unsigned* tmo;
    template <class Fn> __device__ __forceinline__ void run(const float (&ssl)[8], const pg8::Unit& u, int wr, int wc, int fr, int fq, LAS unsigned char* lds, int wid, int lane, Fn&& between) const {
        LAS float* P = (LAS float*)lds; LAS float* S = (LAS float*)(lds + 8192);
#pragma unroll
        for (int j = 0; j < 8; ++j) { float t = ssl[j]; t += __shfl_xor(t, 16); t += __shfl_xor(t, 32);
            if (fq == 0) P[((j >> 2) * 128 + wr * 64 + (j & 3) * 16 + fr) * 4 + wc] = t; }
        asm volatile("s_waitcnt lgkmcnt(0)" ::: "memory"); __builtin_amdgcn_s_barrier(); asm volatile("" ::: "memory");
        const int row = wid * 32 + (lane & 31);
        if (lane < 32) { const f32x4 p4 = *(const LAS f32x4*)(P + row * 4); const float t = (p4.x + p4.y) + (p4.z + p4.w);
            __hip_atomic_store((unsigned*)(slots + (size_t)(u.pm * 256 + row) * 8 + u.pn), __builtin_bit_cast(unsigned, t), __ATOMIC_RELAXED, __HIP_MEMORY_SCOPE_AGENT); }
        asm volatile("s_waitcnt vmcnt(0)" ::: "memory");
        if (lane == 0) __hip_atomic_fetch_add(cnt + 64 * u.pm, 1u, __ATOMIC_RELAXED, __HIP_MEMORY_SCOPE_AGENT);
        between();
        if (wid == 0) {
            unsigned sp = 0;
            while ((unsigned)__builtin_amdgcn_readfirstlane(__hip_atomic_load(cnt + 64 * u.pm, __ATOMIC_RELAXED, __HIP_MEMORY_SCOPE_AGENT)) < 64u) {
                __builtin_amdgcn_s_sleep(1);
                if ((++sp & 255u) == 0u) { if (__hip_atomic_load(tmo, __ATOMIC_RELAXED, __HIP_MEMORY_SCOPE_AGENT)) break; if (sp > (1u << 24)) { if (lane == 0) __hip_atomic_store(tmo, 1u, __ATOMIC_RELAXED, __HIP_MEMORY_SCOPE_AGENT); break; } } }
            __builtin_amdgcn_fence(__ATOMIC_ACQUIRE, "agent");
        }
        asm volatile("s_waitcnt vmcnt(0) lgkmcnt(0)" ::: "memory"); __builtin_amdgcn_s_barrier(); asm volatile("" ::: "memory");
        if (lane < 32) { const unsigned* sl = (const unsigned*)(slots + (size_t)(u.pm * 256 + row) * 8); float t = 0.f;
#pragma unroll
            for (int o = 0; o < 8; ++o) t += __builtin_bit_cast(float, __hip_atomic_load(sl + o, __ATOMIC_RELAXED, __HIP_MEMORY_SCOPE_AGENT));
            S[row] = t; }
        asm volatile("s_waitcnt vmcnt(0) lgkmcnt(0)" ::: "memory"); __builtin_amdgcn_s_barrier(); asm volatile("" ::: "memory");
    }
};
struct PanelSqLast {
    float* slots; unsigned* cnt; float* rinv;
    __device__ __forceinline__ void run(const float (&ssl)[8], const pg8::Unit& u, int wr, int wc, int fr, int fq, LAS unsigned char* lds, int wid, int lane) const {
        LAS float* P = (LAS float*)lds;
#pragma unroll
        for (int j = 0; j < 8; ++j) { float t = ssl[j]; t += __shfl_xor(t, 16); t += __shfl_xor(t, 32);
            if (fq == 0) P[((j >> 2) * 128 + wr * 64 + (j & 3) * 16 + fr) * 4 + wc] = t; }
        asm volatile("s_waitcnt lgkmcnt(0)" ::: "memory"); __builtin_amdgcn_s_barrier(); asm volatile("" ::: "memory");
        const int row = wid * 32 + (lane & 31);
        if (lane < 32) { const f32x4 p4 = *(const LAS f32x4*)(P + row * 4); const float t = (p4.x + p4.y) + (p4.z + p4.w);
            __hip_atomic_store((unsigned*)(slots + (size_t)(u.pm * 256 + row) * 8 + u.pn), __builtin_bit_cast(unsigned, t), __ATOMIC_RELAXED, __HIP_MEMORY_SCOPE_AGENT); }
        asm volatile("s_waitcnt vmcnt(0)" ::: "memory");
        unsigned old = 0u;
        if (lane == 0) old = __hip_atomic_fetch_add(cnt + 64 * u.pm, 1u, __ATOMIC_RELAXED, __HIP_MEMORY_SCOPE_AGENT);
        old = (unsigned)__builtin_amdgcn_readfirstlane((int)old);
        if (old == 63u) {
            __builtin_amdgcn_fence(__ATOMIC_ACQUIRE, "agent"); asm volatile("s_waitcnt vmcnt(0)" ::: "memory");
#pragma unroll
            for (int q = 0; q < 4; ++q) { const int r = q * 64 + lane; const unsigned* sl = (const unsigned*)(slots + (size_t)(u.pm * 256 + r) * 8); float t = 0.f;
#pragma unroll
                for (int o = 0; o < 8; ++o) t += __builtin_bit_cast(float, __hip_atomic_load(sl + o, __ATOMIC_RELAXED, __HIP_MEMORY_SCOPE_AGENT));
                rinv[u.pm * 256 + r] = 1.f / sqrtf(t * (1.f / DM) + RMS_EPS); } }
    }
};
template <bool XF32  , bool FINAL  , bool W8  > struct EpiRmsRes {
    static constexpr bool PERM = true, AFTER_DRAIN = true;
    const void* xold; bf16* xnew; float* outf; const float* g; unsigned char* x8; float osc  ; PanelSq st1; PanelSqLast st2;
    __device__ __forceinline__ void prefetch(const pg8::Unit&, int, int, float (&)[8]) const {}
    __device__ __forceinline__ void fused(pg8::f32x4 (&acc)[2][2][4][2], const pg8::Unit& u, int, int, int, int, LAS unsigned char* lds, int wid, int) const {
        const int lane = lane_id(), fr = lane & 15, fq = lane >> 4, wr = wid >> 2, wc = wid & 3;
        const LAS float* S = (const LAS float*)(lds + 8192);
        const int col0 = u.pn * 256 + wc * 32 + 8 * fq;
        float ssl[8];
#pragma unroll
        for (int ai = 0; ai < 2; ++ai)
#pragma unroll
            for (int m = 0; m < 4; ++m) { float t = 0.f;
#pragma unroll
                for (int bj = 0; bj < 2; ++bj)
#pragma unroll
                    for (int n = 0; n < 2; ++n) { const pg8::f32x4 v = acc[ai][bj][m][n]; t += (v[0] * v[0] + v[1] * v[1]) + (v[2] * v[2] + v[3] * v[3]); }
                ssl[ai * 4 + m] = t; }
        constexpr int NPRE = XF32 ? 4 : 8;
        v4u xpre[NPRE][2];
        pg8::f32x4 gv[2][2];
        st1.run(ssl, u, wr, wc, fr, fq, lds, wid, lane, [&]() {
            if (!XF32) { const char* xb = (const char*)xold + (size_t)u.pm * 256 * DM * 2; asm volatile("" : "+s"(xb));
                const unsigned o0 = (unsigned)(((wr * 64 + fr) * DM + col0) * 2);
#pragma unroll
                for (int j = 0; j < 8; ++j)
#pragma unroll
                    for (int bj = 0; bj < 2; ++bj) xpre[j][bj] = *(const GAS v4u*)(xb + (o0 + (unsigned)((((j >> 2) * 128 + (j & 3) * 16) * DM + bj * 128) * 2)));
            }
#pragma unroll
            for (int bj = 0; bj < 2; ++bj)
#pragma unroll
                for (int n = 0; n < 2; ++n) gv[bj][n] = *(const pg8::f32x4*)(g + col0 + bj * 128 + 4 * n);
        });
#pragma unroll
        for (int ai = 0; ai < 2; ++ai)
#pragma unroll
            for (int m = 0; m < 4; ++m) { const int rl = ai * 128 + wr * 64 + m * 16 + fr; const float ry = osc / sqrtf(S[rl] * (osc * osc * (1.f / DM)) + RMS_EPS);
                const size_t off = (size_t)(u.pm * 256 + rl) * DM + col0; float t = 0.f; v2u w8p[2] = {(v2u){0u, 0u}, (v2u){0u, 0u}};
#pragma unroll
                for (int bj = 0; bj < 2; ++bj) { pg8::f32x4 x0, x1;
                    if (XF32) { x0 = *(const pg8::f32x4*)((const float*)xold + off + bj * 128); x1 = *(const pg8::f32x4*)((const float*)xold + off + bj * 128 + 4); }
                    else { const v4u w = xpre[ai * 4 + m][bj]; x0 = (pg8::f32x4){bflo(w.x), bfhi(w.x), bflo(w.y), bfhi(w.y)}; x1 = (pg8::f32x4){bflo(w.z), bfhi(w.z), bflo(w.w), bfhi(w.w)}; }
                    const pg8::f32x4 a0 = x0 + acc[ai][bj][m][0] * ry * gv[bj][0], a1 = x1 + acc[ai][bj][m][1] * ry * gv[bj][1];
                    t += ((a0[0] * a0[0] + a0[1] * a0[1]) + (a0[2] * a0[2] + a0[3] * a0[3])) + ((a1[0] * a1[0] + a1[1] * a1[1]) + (a1[2] * a1[2] + a1[3] * a1[3]));
                    if (FINAL) { *(pg8::f32x4*)(outf + off + bj * 128) = a0; *(pg8::f32x4*)(outf + off + bj * 128 + 4) = a1; }
                    else { pg8::u32x4 w; w.x = pg8::cvt_pk_bf16(a0[0], a0[1]); w.y = pg8::cvt_pk_bf16(a0[2], a0[3]); w.z = pg8::cvt_pk_bf16(a1[0], a1[1]); w.w = pg8::cvt_pk_bf16(a1[2], a1[3]);
                        *(pg8::u32x4*)(xnew + off + bj * 128) = w;
                        if (W8) { w8p[bj].x = pk8(__builtin_amdgcn_fmed3f(a0[0], -448.f, 448.f), __builtin_amdgcn_fmed3f(a0[1], -448.f, 448.f), __builtin_amdgcn_fmed3f(a0[2], -448.f, 448.f), __builtin_amdgcn_fmed3f(a0[3], -448.f, 448.f));
                            w8p[bj].y = pk8(__builtin_amdgcn_fmed3f(a1[0], -448.f, 448.f), __builtin_amdgcn_fmed3f(a1[1], -448.f, 448.f), __builtin_amdgcn_fmed3f(a1[2], -448.f, 448.f), __builtin_amdgcn_fmed3f(a1[3], -448.f, 448.f)); } } }
                if (W8 && !FINAL) {
                    const auto sx = __builtin_amdgcn_permlane16_swap(w8p[0].x, w8p[1].x, false, false); const auto sy = __builtin_amdgcn_permlane16_swap(w8p[0].y, w8p[1].y, false, false);
                    *(v4u*)(x8 + (size_t)(u.pm * 256 + rl) * DM + u.pn * 256 + wc * 32 + 8 * (fq & ~1) + (fq & 1) * 128) = (v4u){sx[0], sy[0], sx[1], sy[1]}; }
                ssl[ai * 4 + m] = t;
                if (XF32 && (m & 1)) asm volatile("" ::: "memory"); }
        if (FINAL) return;
        st2.run(ssl, u, wr, wc, fr, fq, lds, wid, lane);
    }
};

__device__ __forceinline__ void tr_item(const float* W, int ldw, int K, int ncols, bf16* WT, LAS float* scr, int item, int lane, const float* gk = nullptr) {
    const int nblk = (ncols + 31) / 32, kb = item / nblk, nb = item % nblk, k0 = 64 * kb, n0 = 32 * nb;
    const int nn = n0 + (lane & 31);
    float wv[32];
#pragma unroll
    for (int i = 0; i < 32; ++i) { const int kk = 2 * i + (lane >> 5); wv[i] = (nn < ncols) ? W[(size_t)(k0 + kk) * ldw + nn] : 0.f; }
#pragma unroll
    for (int i = 0; i < 32; ++i) { const int kk = 2 * i + (lane >> 5); scr[kk * 33 + (lane & 31)] = wv[i] * (gk ? gk[k0 + kk] : 1.f); }
    LDS_WAIT(); asm volatile("" ::: "memory");
    const int c = lane & 7;
#pragma unroll
    for (int j = 0; j < 4; ++j) { const int n = (lane >> 3) + 8 * j; const LAS float* s = scr + (8 * c) * 33 + n;
        v4u o; o.x = pk2(s[0 * 33], s[1 * 33]); o.y = pk2(s[2 * 33], s[3 * 33]); o.z = pk2(s[4 * 33], s[5 * 33]); o.w = pk2(s[6 * 33], s[7 * 33]);
        *(GAS v4u*)(WT + (size_t)(n0 + n) * K + k0 + 8 * c) = o; }
    LDS_WAIT(); asm volatile("" ::: "memory");
}
__device__ __forceinline__ void tr_item8(const float* W, int ldw, int K, int ncols, unsigned char* WT, LAS float* scr, int item, int lane, const float* gk = nullptr) {
    const int nblk = ncols / 32, kb = item / nblk, nb = item % nblk, k0 = 64 * kb, n0 = 32 * nb;
    const int nn = n0 + (lane & 31);
    float wv[32];
#pragma unroll
    for (int i = 0; i < 32; ++i) { const int kk = 2 * i + (lane >> 5); wv[i] = W[(size_t)(k0 + kk) * ldw + nn]; }
#pragma unroll
    for (int i = 0; i < 32; ++i) { const int kk = 2 * i + (lane >> 5); scr[kk * 33 + (lane & 31)] = wv[i] * (gk ? gk[k0 + kk] * W8SCALE : W8SCALE); }
    LDS_WAIT(); asm volatile("" ::: "memory");
    const int c = lane & 7;
#pragma unroll
    for (int j = 0; j < 4; ++j) { const int n = (lane >> 3) + 8 * j; const LAS float* s = scr + (8 * c) * 33 + n;
        v2u o; o.x = pk8(__builtin_amdgcn_fmed3f(s[0 * 33], -448.f, 448.f), __builtin_amdgcn_fmed3f(s[1 * 33], -448.f, 448.f), __builtin_amdgcn_fmed3f(s[2 * 33], -448.f, 448.f), __builtin_amdgcn_fmed3f(s[3 * 33], -448.f, 448.f));
        o.y = pk8(__builtin_amdgcn_fmed3f(s[4 * 33], -448.f, 448.f), __builtin_amdgcn_fmed3f(s[5 * 33], -448.f, 448.f), __builtin_amdgcn_fmed3f(s[6 * 33], -448.f, 448.f), __builtin_amdgcn_fmed3f(s[7 * 33], -448.f, 448.f));
        *(GAS v2u*)(WT + (size_t)(n0 + n) * K + k0 + 8 * c) = o; }
    LDS_WAIT(); asm volatile("" ::: "memory");
}
#define TR_JOB8G(Wp, ldw, K, ncols, WTp, gk) { const int ni_ = ((K) / 64) * ((ncols) / 32); if (r < ni_) { tr_item8((Wp), (ldw), (K), (ncols), (WTp), scr, r, F.lane, (gk)); continue; } r -= ni_; }
#define TR_JOBG(Wp, ldw, K, ncols, WTp, gk) { const int ni_ = ((K) / 64) * (((ncols) + 31) / 32); if (r < ni_) { tr_item((Wp), (ldw), (K), (ncols), (WTp), scr, r, F.lane, (gk)); continue; } r -= ni_; }
#define TR_JOB(Wp, ldw, K, ncols, WTp) TR_JOBG(Wp, ldw, K, ncols, WTp, nullptr)

__device__ __forceinline__ int rel_bucket(int n) {
    if (n < 16) return n;
    const float v = logf((float)n / 16.f) / 2.0794415416798357f * 16.f;
    const int l = 16 + (int)v; return l < 31 ? l : 31;
}

__device__ __forceinline__ void p0_prologue(Frame& F) {
    LAS float* scr = (LAS float*)(F.lds + F.wave * 16384);
    unsigned char* ws = F.ws;
    constexpr int NITEMS = (DM / 64) * (NQKV / 32) + (DM / 64) * 2 + 2 * (4096 / 64) * 4 + 2 * 2 * 4 + (DM / 64) * (DM / 32) + (DM / 64) * (FF / 32) + (FF / 64) * (DM / 32);
    for (int it = F.gw; it < NITEMS; it += F.NGW) {
        int r = it;
        TR_JOBG(F.w_in, NSA_IN, DM, NQKV, (bf16*)(ws + W0_QKV), F.norm_g)
        TR_JOBG(F.w_in + NQKV, NSA_IN, DM, NGATE, (bf16*)(ws + W0_G), F.norm_g)
        TR_JOB(F.cw1, HD, 4096, HD, (bf16*)(ws + W0_W1))
        TR_JOB(F.cw1 + 4096 * HD, HD, 4096, HD, (bf16*)(ws + W0_W1) + HD * 4096)
        TR_JOB(F.cw2, HD, HD, HD, (bf16*)(ws + W0_W2))
        TR_JOB(F.cw2 + HD * HD, HD, HD, HD, (bf16*)(ws + W0_W2) + HD * HD)
        TR_JOB(F.w_out, DM, DM, DM, (bf16*)(ws + W0_O))
        TR_JOB8G(F.up, FF, DM, FF, ws + W0_UP, F.norm_g + 2 * DM)
        TR_JOB8G(F.dn, DM, FF, DM, ws + W0_DN, nullptr)
    }
    if (blockIdx.x == 0) {
        float* lut = (float*)(ws + WS_LUT);
        for (int i = F.tid; i < NH * 128; i += NTHREADS) { const int h = i >> 7, d = i & 127; lut[i] = F.rel[rel_bucket(d) * NH + h] * 1.4426950408889634f; }
    }
    if (blockIdx.x == 1) {
        float* lb = (float*)(ws + WS_LB);
        for (int i = F.tid; i < DM; i += NTHREADS) lb[i] = 1.f / (1.f + expf(F.h_lb[i] - F.h_lb[DM + i]));
    }
    for (int it = F.gw; it < 2 * HD * 8; it += F.NGW) {
        const int k8 = it & 7, n = (it >> 3) & 127, kv = it >> 10; const float* pe = F.pe + kv * 4096 + 512 * k8; const float* w1 = F.cw1 + ((size_t)kv * 4096 + 512 * k8) * HD + n;
        float wv[8]; float s = 0.f;
#pragma unroll
        for (int j = 0; j < 8; ++j) wv[j] = w1[(size_t)(64 * j + F.lane) * HD];
#pragma unroll
        for (int j = 0; j < 8; ++j) s += pe[64 * j + F.lane] * wv[j];
        s = wave_sum(s);
        if (F.lane == 0) ((float*)(ws + WS_BIAS1))[k8 * 256 + kv * HD + n] = s;
    }
    { const int lane = F.lane; f32x4 xv[8]; int m = F.gw; float* rinv = (float*)(ws + WS_RINV);
      if (m < M) { const GAS f32x4* xr = (const GAS f32x4*)(F.x + (size_t)m * DM) + 2 * lane;
#pragma unroll
          for (int j = 0; j < 8; ++j) xv[j] = xr[128 * (j >> 1) + (j & 1)]; }
      for (; m < M; m += F.NGW) { f32x4 xn[8]; const int m2 = m + F.NGW;
          if (m2 < M) { const GAS f32x4* xr = (const GAS f32x4*)(F.x + (size_t)m2 * DM) + 2 * lane;
#pragma unroll
              for (int j = 0; j < 8; ++j) xn[j] = xr[128 * (j >> 1) + (j & 1)]; }
          float s = 0.f;
#pragma unroll
          for (int j = 0; j < 8; ++j) s += (xv[j].x * xv[j].x + xv[j].y * xv[j].y) + (xv[j].z * xv[j].z + xv[j].w * xv[j].w);
          const float r = 1.f / sqrtf(wave_sum(s) * (1.f / DM) + RMS_EPS);
          if (lane == 0) rinv[m] = r;
          GAS v4u* o16 = (GAS v4u*)((bf16*)(ws + WS_A) + (size_t)m * DM) + lane;
#pragma unroll
          for (int jj = 0; jj < 4; ++jj) { v4u w; w.x = pk2(xv[2 * jj].x, xv[2 * jj].y); w.y = pk2(xv[2 * jj].z, xv[2 * jj].w); w.z = pk2(xv[2 * jj + 1].x, xv[2 * jj + 1].y); w.w = pk2(xv[2 * jj + 1].z, xv[2 * jj + 1].w); o16[64 * jj] = w; }
#pragma unroll
          for (int j = 0; j < 8; ++j) xv[j] = xn[j]; } }
}
__device__ __forceinline__ void p_convert_l1a(Frame& F) {
    LAS float* scr = (LAS float*)(F.lds + F.wave * 16384);
    unsigned char* ws = F.ws;
    constexpr int NITEMS = (DM / 64) * (FF / 32);
    for (int it = F.gw; it < NITEMS; it += F.NGW) {
        int r = it;
        TR_JOB8G(F.h_in, FF, DM, FF, ws + W1_IN, F.norm_g + 4 * DM)
    }
}
__device__ __forceinline__ void p_convert_l1b(Frame& F, int first  , int nstatic  ) {
    LAS float* scr = (LAS float*)(F.lds + F.wave * 16384);
    unsigned char* ws = F.ws; unsigned* q = (unsigned*)(ws + WS_CTL) + CW_CONVQ;
    constexpr int NITEMS = (DM / 64) * (DM / 32) + (DM / 64) * (FF / 32) + (FF / 64) * (DM / 32);
    int chunk = first;
    for (;;) {
        if (chunk < 0) { unsigned t = 0u; if (F.lane == 0) t = __hip_atomic_fetch_add(q, 1u, __ATOMIC_RELAXED, __HIP_MEMORY_SCOPE_AGENT);
            chunk = nstatic + __builtin_amdgcn_readfirstlane((int)t); }
        const int base = 8 * chunk; chunk = -1;
        if (base >= NITEMS) break;
        const int end = base + 8 < NITEMS ? base + 8 : NITEMS;
        for (int it = base; it < end; ++it) {
            int r = it;
            TR_JOB(F.h_out, DM, DM, DM, (bf16*)(ws + W1_O))
            TR_JOB8G(F.up + (size_t)DM * FF, FF, DM, FF, ws + W1_UP, F.norm_g + 6 * DM)
            TR_JOB8G(F.dn + (size_t)FF * DM, DM, FF, DM, ws + W1_DN, nullptr)
        }
    }
}


namespace cg {
typedef short bf16x8 __attribute__((ext_vector_type(8)));
typedef float f32x16 __attribute__((ext_vector_type(16)));
constexpr int L_RED = 0, L_H = 16384, HRS = 272;
__device__ __forceinline__ float gelu_tanh_f(float x) { const float u = 0.7978845608028654f * (x + 0.044715f * x * x * x); const float e = __expf(2.f * u); return x * (1.f - 1.f / (e + 1.f)); }

__device__ __forceinline__ void cmp_gate_phase(LAS unsigned char* lds, unsigned char* wsb, int G, const int tid) {
    const int wid = __builtin_amdgcn_readfirstlane(tid >> 6), lane = tid & 63, r32 = lane & 31, hh = lane >> 5;
    const bf16* proj = (const bf16*)(wsb + WS_BIG); const bf16* w1t = (const bf16*)(wsb + W0_W1); const bf16* w2t = (const bf16*)(wsb + W0_W2); const float* bias1 = (const float*)(wsb + WS_BIAS1);
    const bf16* hn = (const bf16*)(wsb + WS_A); const bf16* wg = (const bf16*)(wsb + W0_G); float* gates = (float*)(wsb + WS_GATES); const float* rinv = (const float*)(wsb + WS_RINV);
    LAS float* red = (LAS float*)(lds + L_RED);
    const int ct = wid & 3, kh = wid >> 2;
    for (int u = blockIdx.x; u < 256; u += G) {
        const int kv = u >> 7, R0 = (u & 127) * 32, R = R0 + r32, b = R >> 9, g = (R >> 7) & 3, c = R & 127, cl = c < NC ? c : NC - 1;
        const bf16* arow = proj + ((size_t)b * SEQ + 16 * cl) * NQKV + (kv ? COL_VC : COL_KC) + g * HD;
        const bf16* brow = w1t + (size_t)kv * HD * 4096 + (size_t)(32 * ct + r32) * 4096;
        f32x16 acc = f32x16{};
        for (int l2 = 0; l2 < 8; ++l2) {
            bf16x8 av[16], bv[16];
            const bf16* ap = arow + (size_t)(kh * 16 + 2 * l2) * NQKV + 8 * hh; const bf16* bp = brow + kh * 2048 + 256 * l2 + 8 * hh;
#pragma unroll
            for (int j = 0; j < 16; ++j) { av[j] = *(const GAS bf16x8*)(ap + (size_t)(j >> 3) * NQKV + 16 * (j & 7)); bv[j] = *(const GAS bf16x8*)(bp + 16 * j); }
            __builtin_amdgcn_sched_barrier(0);
#pragma unroll
            for (int j = 0; j < 16; ++j) acc = __builtin_amdgcn_mfma_f32_32x32x16_bf16(av[j], bv[j], acc, 0, 0, 0); }
        if (kh == 1) {
#pragma unroll
            for (int r = 0; r < 16; ++r) red[(ct * 16 + r) * 64 + lane] = acc[r]; }
        LDS_WAIT();
        __syncthreads();
        if (kh == 0) { float bs = 0.f;
#pragma unroll
            for (int k8 = 0; k8 < 8; ++k8) bs += bias1[k8 * 256 + kv * HD + 32 * ct + r32];
#pragma unroll
            for (int r = 0; r < 16; ++r) { const float hv = gelu_tanh_f(acc[r] + red[(ct * 16 + r) * 64 + lane] + bs); const int row = (r & 3) + 8 * (r >> 2) + 4 * hh;
                *(LAS unsigned short*)(lds + L_H + row * HRS + (32 * ct + r32) * 2) = (unsigned short)f2bf(hv); } }
        LDS_WAIT();
        __syncthreads();
        if (kh == 0) { f32x16 o2 = f32x16{}; const bf16* b2 = w2t + (size_t)kv * HD * HD + (size_t)(32 * ct + r32) * HD;
#pragma unroll
            for (int ks = 0; ks < 8; ++ks) { const bf16x8 a = *(const LAS bf16x8*)(lds + L_H + r32 * HRS + (16 * ks + 8 * hh) * 2); const bf16x8 bb = *(const GAS bf16x8*)(b2 + 16 * ks + 8 * hh);
                o2 = __builtin_amdgcn_mfma_f32_32x32x16_bf16(a, bb, o2, 0, 0, 0); }
            bf16* outp = (bf16*)(wsb + (kv ? WS_VCMP : WS_KCMP)) + (size_t)R0 * HD + 32 * ct + r32;
#pragma unroll
            for (int r = 0; r < 16; ++r) { const int row = (r & 3) + 8 * (r >> 2) + 4 * hh; const bool pad = ((R0 + row) & 127) == NC;
                outp[(size_t)row * HD] = pad ? (bf16)0 : (bf16)f2bf(o2[r]); } }
        __syncthreads();
    }
    for (int u = blockIdx.x; u < M / 64; u += G) {
        const int rt = wid & 1, c2 = (wid >> 1) & 1; const int m0 = 64 * u + 32 * rt;
        const bf16* arow = hn + (size_t)(m0 + r32) * DM; const bf16* brow = wg + (size_t)(32 * c2 + r32) * DM;
        f32x16 acc = f32x16{};
        for (int l2 = 0; l2 < 4; ++l2) {
            bf16x8 av[16], bv[16];
            const bf16* ap = arow + kh * 1024 + 256 * l2 + 8 * hh; const bf16* bp = brow + kh * 1024 + 256 * l2 + 8 * hh;
#pragma unroll
            for (int j = 0; j < 16; ++j) { av[j] = *(const GAS bf16x8*)(ap + 16 * j); bv[j] = *(const GAS bf16x8*)(bp + 16 * j); }
            __builtin_amdgcn_sched_barrier(0);
#pragma unroll
            for (int j = 0; j < 16; ++j) acc = __builtin_amdgcn_mfma_f32_32x32x16_bf16(av[j], bv[j], acc, 0, 0, 0); }
        if (kh == 1) {
#pragma unroll
            for (int r = 0; r < 16; ++r) red[((wid & 3) * 16 + r) * 64 + lane] = acc[r]; }
        LDS_WAIT();
        __syncthreads();
        if (kh == 0) { const int col = 32 * c2 + r32; float rv[16];
#pragma unroll
            for (int r = 0; r < 16; ++r) rv[r] = rinv[m0 + (r & 3) + 8 * (r >> 2) + 4 * hh];
#pragma unroll
            for (int r = 0; r < 16; ++r) { const int row = (r & 3) + 8 * (r >> 2) + 4 * hh; const float v = acc[r] + red[((wid & 3) * 16 + r) * 64 + lane];
                if (col < NGATE) gates[(size_t)(m0 + row) * NGATE + col] = 1.f / (1.f + __expf(-v * rv[r])); } }
        __syncthreads();
    }
}
}


namespace nsa {
typedef short bf16x8 __attribute__((ext_vector_type(8)));
typedef short s16x4 __attribute__((ext_vector_type(4)));
typedef float f32x16 __attribute__((ext_vector_type(16)));
typedef unsigned u32x4 __attribute__((ext_vector_type(4)));
constexpr int SHM = 16384;
constexpr int NBUF = 3;
constexpr int L_V = 0, L_K = NBUF * SHM, L_WS = 2 * NBUF * SHM, L_LUT = L_WS + 2048, L_IMP = L_LUT + 8192, L_SEL = L_IMP + 4 * 64 * 33 * 4, L_END = L_SEL + 256;
static_assert(L_END <= LDS_BYTES - 256, "nsa LDS map");
constexpr float THR2 = 11.5f;
#define NSA_KSWZ(row, colB) ((row) * 256 + ((colB) ^ (((row) & 7) << 4)))
#define NSA_SBAR() __builtin_amdgcn_sched_barrier(0)
__device__ __forceinline__ int v_st(int k, int c) { const int kk = (k & ~0xC) | ((k & 4) << 1) | ((k & 8) >> 1); return ((kk >> 3) * 4 + (c >> 5)) * 512 + ((kk & 7) * 32 + (c & 31)) * 2; }
__device__ __forceinline__ int v_rd_base(int lane) { return ((lane & 3) << 3) | (((lane >> 2) & 3) << 6) | (((lane >> 4) & 1) << 5) | (((lane >> 5) & 1) << 8); }
constexpr int v_rd_off(int d0, int ks, int half) { return d0 * 512 + ks * 4096 + half * 2048; }
__device__ __forceinline__ int crow(int r, int hi) { return (r & 3) + 8 * (r >> 2) + 4 * hi; }
__device__ __forceinline__ unsigned cvtpk(float lo, float hi) { unsigned r; asm volatile("v_cvt_pk_bf16_f32 %0, %1, %2" : "=v"(r) : "v"(lo), "v"(hi)); return r; }

__device__ __forceinline__ void qkt(f32x16& p0, f32x16& p1, LAS unsigned char* Kb, int r32, int hi, const bf16x8 (&qr)[8]) {
    p0 = f32x16{}; p1 = f32x16{};
    LAS unsigned char* kb[4];
#pragma unroll
    for (int dd = 0; dd < 4; ++dd) kb[dd] = Kb + NSA_KSWZ(r32, (dd * 16 + hi * 8) * 2);
#pragma unroll
    for (int d0 = 0; d0 < 8; ++d0) { LAS unsigned char* a = kb[d0 & 3] + (d0 >> 2) * 128;
        const bf16x8 b0 = *(const LAS bf16x8*)a; const bf16x8 b1 = *(const LAS bf16x8*)(a + 32 * 256);
        p0 = __builtin_amdgcn_mfma_f32_32x32x16_bf16(b0, qr[d0], p0, 0, 0, 0);
        p1 = __builtin_amdgcn_mfma_f32_32x32x16_bf16(b1, qr[d0], p1, 0, 0, 0); }
}
__device__ __forceinline__ void pv_tile(f32x16 (&o)[4], int vb, bf16x8 pa0, bf16x8 pa1, bf16x8 pa2, bf16x8 pa3) {
#define NSA_TRRD(dst, off) asm volatile("ds_read_b64_tr_b16 %0, %1 offset:%2" : "=&v"(dst) : "v"(vb), "i"(off) : "memory")
#define NSA_PV_KS(ks, pa) do { s16x4 l0, l1, l2, l3, h0, h1, h2, h3; \
        NSA_TRRD(l0, v_rd_off(0, ks, 0)); NSA_TRRD(h0, v_rd_off(0, ks, 1)); NSA_TRRD(l1, v_rd_off(1, ks, 0)); NSA_TRRD(h1, v_rd_off(1, ks, 1)); \
        NSA_TRRD(l2, v_rd_off(2, ks, 0)); NSA_TRRD(h2, v_rd_off(2, ks, 1)); NSA_TRRD(l3, v_rd_off(3, ks, 0)); NSA_TRRD(h3, v_rd_off(3, ks, 1)); \
        asm volatile("s_waitcnt lgkmcnt(0)" ::: "memory"); NSA_SBAR(); \
        o[0] = __builtin_amdgcn_mfma_f32_32x32x16_bf16(pa, (bf16x8){l0[0], l0[1], l0[2], l0[3], h0[0], h0[1], h0[2], h0[3]}, o[0], 0, 0, 0); \
        o[1] = __builtin_amdgcn_mfma_f32_32x32x16_bf16(pa, (bf16x8){l1[0], l1[1], l1[2], l1[3], h1[0], h1[1], h1[2], h1[3]}, o[1], 0, 0, 0); \
        o[2] = __builtin_amdgcn_mfma_f32_32x32x16_bf16(pa, (bf16x8){l2[0], l2[1], l2[2], l2[3], h2[0], h2[1], h2[2], h2[3]}, o[2], 0, 0, 0); \
        o[3] = __builtin_amdgcn_mfma_f32_32x32x16_bf16(pa, (bf16x8){l3[0], l3[1], l3[2], l3[3], h3[0], h3[1], h3[2], h3[3]}, o[3], 0, 0, 0); } while (0)
    NSA_PV_KS(0, pa0); NSA_PV_KS(1, pa1); NSA_PV_KS(2, pa2); NSA_PV_KS(3, pa3);
#undef NSA_PV_KS
#undef NSA_TRRD
}
__device__ __forceinline__ void pack_p(const f32x16& p0, const f32x16& p1, bf16x8& pa0, bf16x8& pa1, bf16x8& pa2, bf16x8& pa3) {
#define NSA_PK4(P, B_, OUT) do { unsigned a0 = cvtpk(P[B_ + 0], P[B_ + 1]), a1 = cvtpk(P[B_ + 2], P[B_ + 3]); \
        unsigned b0 = cvtpk(P[B_ + 4], P[B_ + 5]), b1 = cvtpk(P[B_ + 6], P[B_ + 7]); \
        auto r0 = __builtin_amdgcn_permlane32_swap(a0, b0, false, false); auto r1 = __builtin_amdgcn_permlane32_swap(a1, b1, false, false); \
        u32x4 w = {r0[0], r1[0], r0[1], r1[1]}; OUT = *reinterpret_cast<bf16x8*>(&w); } while (0)
    NSA_PK4(p0, 0, pa0); NSA_PK4(p0, 8, pa1); NSA_PK4(p1, 0, pa2); NSA_PK4(p1, 8, pa3);
#undef NSA_PK4
}
__device__ __forceinline__ float swap_max(float v) { auto rr = __builtin_amdgcn_permlane32_swap(__float_as_uint(v), __float_as_uint(v), false, false); return fmaxf(__uint_as_float(rr[0]), __uint_as_float(rr[1])); }
__device__ __forceinline__ float swap_sum(float v) { auto rr = __builtin_amdgcn_permlane32_swap(__float_as_uint(v), __float_as_uint(v), false, false); return __uint_as_float(rr[0]) + __uint_as_float(rr[1]); }

template <class T> __device__ __forceinline__ const T* opaque_s(const T* p) { asm volatile("" : "+s"(p)); return p; }
__device__ __forceinline__ void tile_dma(LAS unsigned char* lds, int buf, const bf16* Kg, const bf16* Vg, int ld, int pk0, int pk1, int pv0, int pv1, int wid) {
    const char* kb = (const char*)Kg; const char* vb = (const char*)Vg;
    LAS unsigned char* kd = lds + L_K + buf * SHM + wid * 2048; LAS unsigned char* vd = lds + L_V + buf * SHM + wid * 2048;
    __builtin_amdgcn_global_load_lds((const unsigned*)(kb + (unsigned)(((pk0 >> 8) * ld + (pk0 & 255)) * 2)), (LAS unsigned*)kd, 16, 0, 0);
    __builtin_amdgcn_global_load_lds((const unsigned*)(kb + (unsigned)(((pk1 >> 8) * ld + (pk1 & 255)) * 2)), (LAS unsigned*)(kd + 1024), 16, 0, 0);
    __builtin_amdgcn_global_load_lds((const unsigned*)(vb + (unsigned)(((pv0 >> 8) * ld + (pv0 & 255)) * 2)), (LAS unsigned*)vd, 16, 0, 0);
    __builtin_amdgcn_global_load_lds((const unsigned*)(vb + (unsigned)(((pv1 >> 8) * ld + (pv1 & 255)) * 2)), (LAS unsigned*)(vd + 1024), 16, 0, 0);
}
__device__ __forceinline__ int k_piece(int P) { const int row = P >> 8, colB = (P & 255) ^ ((row & 7) << 4); return (row << 8) | (colB >> 1); }
__device__ __forceinline__ int v_piece(int P) { const int st = P >> 9, q = (P & 511) >> 1, kk = (st >> 2) * 8 + (q >> 5), c = (st & 3) * 32 + (q & 31);
    const int k = (kk & ~0xC) | ((kk & 4) << 1) | ((kk & 8) >> 1); return (k << 8) | c; }

__device__ __forceinline__ void nsa_phase(LAS unsigned char* lds, unsigned char* wsb, int G, const int tid) {
    const int wid = __builtin_amdgcn_readfirstlane(tid >> 6), lane = tid & 63, r32 = lane & 31, hi = lane >> 5;
    const int hr = wid >> 1, th = wid & 1;
    const bf16* proj = (const bf16*)(wsb + WS_BIG); const float* gates = (const float*)(wsb + WS_GATES);
    const bf16* kcmp = (const bf16*)(wsb + WS_KCMP); const bf16* vcmp = (const bf16*)(wsb + WS_VCMP); bf16* Oout = (bf16*)(wsb + WS_A);
    float* scrl = (float*)(wsb + WS_SCR) + ((size_t)blockIdx.x * NWAVES + wid) * 4096 + lane * 64;
    LAS float* wsl = (LAS float*)(lds + L_WS) + wid * 64; LAS float* li_l = wsl; LAS float* al_l = wsl + 32;
    LAS float* lutL = (LAS float*)(lds + L_LUT); LAS float* impL = (LAS float*)(lds + L_IMP); LAS unsigned* selL = (LAS unsigned*)(lds + L_SEL);
    const int pk0 = k_piece(wid * 2048 + lane * 16), pk1 = k_piece(wid * 2048 + 1024 + lane * 16), pv0 = v_piece(wid * 2048 + lane * 16), pv1 = v_piece(wid * 2048 + 1024 + lane * 16);
    const int vb0 = (int)(unsigned)(uintptr_t)(lds + L_V) + v_rd_base(lane);
    const float NEG = -__builtin_inff();
    { const float* lut = (const float*)(wsb + WS_LUT); for (int i = tid; i < NH * 128; i += NTHREADS) lutL[i] = lut[i]; }
    __syncthreads();
    for (int ui = 0; ui < 4; ++ui) {
        const int c = blockIdx.x, bg = c & 31, j8 = (c >> 5) & 7;
        if (c >= 256 && G > 256) break;
        const unsigned long long qtab = (ui == 0) ? 0xfeebcf633dull : (ui == 1) ? 0x8ea74b49b7ull : (ui == 2) ? 0x719f062568ull : 0x110a009d43ull;
        const int qb = (int)((qtab >> (5 * j8)) & 31ull);
        const int b = bg >> 2, g = bg & 3, h = g * 4 + hr, t0 = 64 * qb, tq = t0 + 32 * th + r32;
        const size_t rowq = (size_t)b * SEQ + tq;
        const LAS float* lutp = lutL + h * 128; const float c31 = lutp[127];
        bf16x8 qr[8];
        { int hq = hi; asm volatile("" : "+v"(hq));
          const bf16* qp = proj + rowq * NQKV + h * HD + hq * 8;
#pragma unroll
          for (int d0 = 0; d0 < 8; ++d0) qr[d0] = *(const GAS bf16x8*)(qp + d0 * 16); }
        const float g_c = gates[rowq * NGATE + h], g_s = gates[rowq * NGATE + 16 + h], g_w = gates[rowq * NGATE + 32 + h];
        f32x16 o[4]; float cmp_carry = 0.f;
        {
            const bf16* kb = kcmp + (size_t)(b * NG + g) * NCP * HD; const bf16* vbp = vcmp + (size_t)(b * NG + g) * NCP * HD;
            const bool two = (t0 + 63 - 31) >= 16 * 64;
            tile_dma(lds, 0, opaque_s(kb), opaque_s(vbp), HD, pk0, pk1, pv0, pv1, wid);
            if (two) tile_dma(lds, 1, opaque_s(kb + 64 * HD), opaque_s(vbp + 64 * HD), HD, pk0, pk1, pv0, pv1, wid);
            VM_WAIT();
            __syncthreads();
            const int dqc = tq - 31 - 64 * hi;
            f32x16 sA0, sA1, sB0 = f32x16{}, sB1 = f32x16{};
            float tm = -1e30f;
            qkt(sA0, sA1, lds + L_K, r32, hi, qr);
#pragma unroll
            for (int r = 0; r < 16; ++r) { const int cc = (r & 3) + 8 * (r >> 2); const int d0 = dqc - 16 * cc, d1 = d0 - 512;
                sA0[r] = d0 >= 0 ? sA0[r] + lutp[d0 < 0 ? 0 : (d0 < 127 ? d0 : 127)] : NEG; sA1[r] = d1 >= 0 ? sA1[r] + lutp[d1 < 0 ? 0 : (d1 < 127 ? d1 : 127)] : NEG;
                tm = fmaxf(tm, fmaxf(sA0[r], sA1[r]));
                if ((r & 3) == 3) asm volatile("" ::: "memory"); }
            if (two) {
                qkt(sB0, sB1, lds + L_K + SHM, r32, hi, qr);
#pragma unroll
                for (int r = 0; r < 16; ++r) { const int cc = (r & 3) + 8 * (r >> 2); const int d0 = dqc - 1024 - 16 * cc, d1 = d0 - 512;
                    sB0[r] = d0 >= 0 ? sB0[r] + lutp[d0 < 0 ? 0 : (d0 < 127 ? d0 : 127)] : NEG; sB1[r] = d1 >= 0 ? sB1[r] + lutp[d1 < 0 ? 0 : (d1 < 127 ? d1 : 127)] : NEG;
                    tm = fmaxf(tm, fmaxf(sB0[r], sB1[r]));
                    if ((r & 3) == 3) asm volatile("" ::: "memory"); }
            }
            const float mx = swap_max(tm);
            float ps = 0.f;
#pragma unroll
            for (int r = 0; r < 16; ++r) { sA0[r] = __builtin_amdgcn_exp2f(sA0[r] - mx); sA1[r] = __builtin_amdgcn_exp2f(sA1[r] - mx); ps += sA0[r] + sA1[r]; }
            if (two) {
#pragma unroll
                for (int r = 0; r < 16; ++r) { sB0[r] = __builtin_amdgcn_exp2f(sB0[r] - mx); sB1[r] = __builtin_amdgcn_exp2f(sB1[r] - mx); ps += sB0[r] + sB1[r]; }
            }
            const float ls = swap_sum(ps);
            const float inv = ls > 0.f ? 1.f / ls : 0.f;
            LAS float* ip = impL + (hr * 64 + 32 * th + r32) * 33;
#pragma unroll
            for (int d = 0; d < 4; ++d) o[d] = f32x16{};
            if (!two) {
#pragma unroll
                for (int q = 0; q < 16; ++q) ip[16 + q] = 0.f;
            }
            auto imp_pv = [&](f32x16& p0, f32x16& p1, const int T) {
                p0 = p0 * inv; p1 = p1 * inv;
                LAS float* ipt = ip + 16 * T;
#pragma unroll
                for (int q = 0; q < 4; ++q) {
                    ipt[0 + 2 * q + hi] = (p0[4 * q] + p0[4 * q + 1]) + (p0[4 * q + 2] + p0[4 * q + 3]);
                    ipt[8 + 2 * q + hi] = (p1[4 * q] + p1[4 * q + 1]) + (p1[4 * q + 2] + p1[4 * q + 3]); }
                LDS_WAIT(); asm volatile("" ::: "memory");
#pragma unroll
                for (int q = 0; q < 4; ++q) {
                    ipt[0 + 2 * q + hi + 1] += p0[4 * q + 3];
                    if (8 + 2 * q + hi + 1 < 16) ipt[8 + 2 * q + hi + 1] += p1[4 * q + 3]; }
                const float carry = p1[15];
                LDS_WAIT(); asm volatile("" ::: "memory");
                bf16x8 pa0, pa1, pa2, pa3;
                pack_p(p0, p1, pa0, pa1, pa2, pa3); pv_tile(o, vb0 + T * SHM, pa0, pa1, pa2, pa3);
                if (T == 0) cmp_carry = carry;
            };
            imp_pv(sA0, sA1, 0);
            if (two) imp_pv(sB0, sB1, 1);
            if (hi == 1) ip[16] += cmp_carry;
            LDS_WAIT(); asm volatile("" ::: "memory");
            if (hi == 0) li_l[r32] = g_c;
            LDS_WAIT(); asm volatile("" ::: "memory");
            { float gg[16];
#pragma unroll
              for (int r = 0; r < 16; ++r) gg[r] = li_l[crow(r, hi)];
#pragma unroll
              for (int d = 0; d < 4; ++d)
#pragma unroll
                  for (int q = 0; q < 4; ++q) *(GAS f32x4*)(scrl + d * 16 + 4 * q) = (f32x4){o[d][4 * q] * gg[4 * q], o[d][4 * q + 1] * gg[4 * q + 1], o[d][4 * q + 2] * gg[4 * q + 2], o[d][4 * q + 3] * gg[4 * q + 3]}; }
            LDS_WAIT();
            __builtin_amdgcn_s_barrier(); asm volatile("" ::: "memory");
        }
        {
#pragma unroll
            for (int i = 0; i < 4; ++i) { const int tl = 8 * wid + 2 * i + hi, n = r32;
                float v = ((impL[(0 * 64 + tl) * 33 + n] + impL[(1 * 64 + tl) * 33 + n]) + impL[(2 * 64 + tl) * 33 + n]) + impL[(3 * 64 + tl) * 33 + n];
                int key = (int)((__float_as_uint(v) & ~31u) | (unsigned)(31 - n));
                if (n == 0 || n == qb || n == qb - 1) key = (int)(0x461C4000u | (unsigned)(31 - n)); else if (n > qb) key = -64 + (31 - n);
                int cnt = 0;
                for (int mm = 0; mm < 32; ++mm) { const int u = __shfl(key, (lane & 32) | mm); cnt += (u > key) ? 1 : 0; }
                const unsigned long long bal = __ballot(cnt < 8);
                if (lane == 0) { selL[8 * wid + 2 * i] = (unsigned)bal; selL[8 * wid + 2 * i + 1] = (unsigned)(bal >> 32); } }
            LDS_WAIT();
            __builtin_amdgcn_s_barrier(); asm volatile("" ::: "memory");
        }
        const unsigned selw = selL[32 * th + r32];
        const int NS = qb + 1, nlo = qb >= 8 ? qb - 8 : 0, NT = NS + (qb - nlo + 1);
        float m_reg = -1e30f, l_reg = 0.f;
#pragma unroll
        for (int d = 0; d < 4; ++d) o[d] = f32x16{};
        const bf16* kS = proj + (size_t)b * SEQ * NQKV + COL_KS + g * HD; const bf16* vS = proj + (size_t)b * SEQ * NQKV + COL_VS + g * HD;
        const bf16* kW = proj + (size_t)b * SEQ * NQKV + COL_KW + g * HD; const bf16* vW = proj + (size_t)b * SEQ * NQKV + COL_VW + g * HD;
#define NSA_TILE_K(t_) (((t_) >= NS ? kW : kS) + (size_t)(64 * ((t_) >= NS ? nlo + ((t_) - NS) : (t_))) * NQKV)
#define NSA_TILE_V(t_) (((t_) >= NS ? vW : vS) + (size_t)(64 * ((t_) >= NS ? nlo + ((t_) - NS) : (t_))) * NQKV)
        tile_dma(lds, 0, opaque_s(kS), opaque_s(vS), NQKV, pk0, pk1, pv0, pv1, wid);
        if (1 < NT) { tile_dma(lds, 1, opaque_s(NSA_TILE_K(1)), opaque_s(NSA_TILE_V(1)), NQKV, pk0, pk1, pv0, pv1, wid); asm volatile("s_waitcnt vmcnt(4)" ::: "memory"); } else VM_WAIT();
        LDS_WAIT(); __builtin_amdgcn_s_barrier(); asm volatile("" ::: "memory");
        int buf = 0;
        for (int i = 0; i < NT; ++i) {
            const bool win = i >= NS; const int n = win ? nlo + (i - NS) : i;
            if (i == NS) {
                if (hi == 0) li_l[r32] = g_s / l_reg;
                LDS_WAIT(); asm volatile("" ::: "memory");
                { float gg[16];
#pragma unroll
                  for (int r = 0; r < 16; ++r) gg[r] = li_l[crow(r, hi)];
#pragma unroll
                  for (int d = 0; d < 4; ++d)
                  {
                    f32x4 a4[4];
#pragma unroll
                    for (int q = 0; q < 4; ++q) a4[q] = *(const GAS f32x4*)(scrl + d * 16 + 4 * q);
#pragma unroll
                    for (int q = 0; q < 4; ++q) { const f32x4 a = a4[q];
                          *(GAS f32x4*)(scrl + d * 16 + 4 * q) = (f32x4){a.x + o[d][4 * q] * gg[4 * q], a.y + o[d][4 * q + 1] * gg[4 * q + 1], a.z + o[d][4 * q + 2] * gg[4 * q + 2], a.w + o[d][4 * q + 3] * gg[4 * q + 3]}; }
                    asm volatile("" ::: "memory"); }
#pragma unroll
                  for (int d = 0; d < 4; ++d) o[d] = f32x16{}; }
                LDS_WAIT(); m_reg = -1e30f; l_reg = 0.f;
            }
            if (i + 2 < NT) { const int b2 = buf + 2 >= NBUF ? buf + 2 - NBUF : buf + 2;
                tile_dma(lds, b2, opaque_s(NSA_TILE_K(i + 2)), opaque_s(NSA_TILE_V(i + 2)), NQKV, pk0, pk1, pv0, pv1, wid); }
            f32x16 p0, p1;
            qkt(p0, p1, lds + L_K + buf * SHM, r32, hi, qr);
            const bool plain = (n + 2 < qb) && !(win && n + 8 == qb);
            float bofs = 0.f;
            { const int dq = tq - 64 * n - 4 * hi; const unsigned W = win ? 512u : 0x80000000u; const bool ok = win || ((selw >> n) & 1u);
              if (plain) bofs = ok ? c31 : NEG;
              else if (n + 2 >= qb) {
#pragma unroll
                  for (int r = 0; r < 16; ++r) { const int cc = (r & 3) + 8 * (r >> 2); const int d0 = dq - cc, d1 = d0 - 32;
                      const float b0 = lutp[d0 < 0 ? 0 : (d0 < 127 ? d0 : 127)], b1 = lutp[d1 < 0 ? 0 : (d1 < 127 ? d1 : 127)];
                      p0[r] = (ok && (unsigned)d0 < W) ? p0[r] + b0 : NEG; p1[r] = (ok && (unsigned)d1 < W) ? p1[r] + b1 : NEG;
                      if ((r & 3) == 3) asm volatile("" ::: "memory"); }
              } else {
#pragma unroll
                  for (int r = 0; r < 16; ++r) { const int cc = (r & 3) + 8 * (r >> 2); const int d0 = dq - cc, d1 = d0 - 32;
                      p0[r] = (ok && (unsigned)d0 < W) ? p0[r] + c31 : NEG; p1[r] = (ok && (unsigned)d1 < W) ? p1[r] + c31 : NEG; }
              } }
            float pmax = p0[0];
#pragma unroll
            for (int r = 1; r < 16; ++r) pmax = fmaxf(pmax, p0[r]);
#pragma unroll
            for (int r = 0; r < 16; ++r) pmax = fmaxf(pmax, p1[r]);
            pmax = swap_max(pmax) + bofs;
            float mn, alpha;
            if (__all((pmax - m_reg) <= THR2)) { mn = m_reg; alpha = 1.f; }
            else { mn = fmaxf(m_reg, pmax); alpha = __builtin_amdgcn_exp2f(m_reg - mn); m_reg = mn; }
            mn -= bofs;
            float ps = 0.f;
#pragma unroll
            for (int r = 0; r < 16; ++r) { p0[r] = __builtin_amdgcn_exp2f(p0[r] - mn); p1[r] = __builtin_amdgcn_exp2f(p1[r] - mn); ps += p0[r] + p1[r]; }
            ps = swap_sum(ps);
            l_reg = l_reg * alpha + ps;
            if (__any(alpha < 1.f)) { if (hi == 0) al_l[r32] = alpha; LDS_WAIT(); asm volatile("" ::: "memory");
#pragma unroll
                for (int r = 0; r < 16; ++r) { const float aa = al_l[crow(r, hi)];
#pragma unroll
                    for (int d = 0; d < 4; ++d) o[d][r] *= aa; }
                LDS_WAIT(); }
            bf16x8 pa0, pa1, pa2, pa3;
            pack_p(p0, p1, pa0, pa1, pa2, pa3);
            pv_tile(o, vb0 + buf * SHM, pa0, pa1, pa2, pa3);
            if (i + 2 < NT) asm volatile("s_waitcnt vmcnt(4)" ::: "memory"); else VM_WAIT();
            LDS_WAIT();
            __builtin_amdgcn_s_barrier(); asm volatile("" ::: "memory");
            buf = buf + 1 >= NBUF ? 0 : buf + 1;
        }
#undef NSA_TILE_K
#undef NSA_TILE_V
        if (hi == 0) li_l[r32] = g_w / l_reg;
        LDS_WAIT(); asm volatile("" ::: "memory");
        {
            LAS unsigned char* ost = lds + wid * 8192;
            LAS unsigned char* owr = ost + (4 * hi) * 256 + r32 * 2;
            float gg[16];
#pragma unroll
            for (int r = 0; r < 16; ++r) gg[r] = li_l[crow(r, hi)];
#pragma unroll
            for (int d = 0; d < 4; ++d) { f32x4 a4[4];
#pragma unroll
                for (int q = 0; q < 4; ++q) a4[q] = *(const GAS f32x4*)(scrl + d * 16 + 4 * q);
#pragma unroll
                for (int q = 0; q < 4; ++q)
#pragma unroll
                    for (int e = 0; e < 4; ++e) { const int r = 4 * q + e; const float v = a4[q][e] + o[d][r] * gg[r];
                        *(LAS unsigned short*)(owr + ((r & 3) + 8 * (r >> 2)) * 256 + d * 64) = (unsigned short)f2bf(v); }
                asm volatile("" ::: "memory"); }
            LDS_WAIT(); asm volatile("" ::: "memory");
            int ln = lane; asm volatile("" : "+v"(ln));
            bf16* Ow = Oout + ((size_t)b * SEQ + t0 + 32 * th + (ln >> 4)) * DM + h * HD + (ln & 15) * 8;
            const LAS unsigned char* ord = ost + (ln >> 4) * 256 + (ln & 15) * 16;
#pragma unroll
            for (int i = 0; i < 8; ++i) *(GAS v4u*)(Ow + (size_t)(4 * i) * DM) = *(const LAS v4u*)(ord + i * 1024);
        }
        LDS_WAIT();
        __builtin_amdgcn_s_barrier(); asm volatile("" ::: "memory");
    }
}
#undef NSA_KSWZ
#undef NSA_SBAR
}


namespace hg {
typedef short bf16x8 __attribute__((ext_vector_type(8)));
typedef short s16x4 __attribute__((ext_vector_type(4)));
typedef float f32x4v __attribute__((ext_vector_type(4)));
typedef float f32x2v __attribute__((ext_vector_type(2)));
constexpr int RS = 288, RSA = 144;
constexpr int BUFB = 3 * 64 * RS;
constexpr int L_Q = 0, L_K = 64 * RS, L_V = 2 * 64 * RS, L_AM = 2 * BUFB, L_O = L_AM + 64 * RSA, L_EBL = L_O + 64 * RS, L_ON = L_EBL + 1024, L_END = L_ON + 512;
static_assert(L_END <= LDS_BYTES - 256, "hg LDS map");
#define HG_TR(dst, addr, off) asm volatile("ds_read_b64_tr_b16 %0, %1 offset:%2" : "=&v"(dst) : "v"(addr), "i"(off) : "memory")
#define HG_BAR() do { asm volatile("s_waitcnt lgkmcnt(0)" ::: "memory"); __builtin_amdgcn_s_barrier(); asm volatile("" ::: "memory"); } while (0)
__device__ __forceinline__ unsigned cvtpk(float lo, float hi) { unsigned r; asm volatile("v_cvt_pk_bf16_f32 %0, %1, %2" : "=v"(r) : "v"(lo), "v"(hi)); return r; }

__device__ __forceinline__ void scan_phase(LAS unsigned char* lds, unsigned char* wsb, const float* h_on, int G, const int tid) {
    const int wid = __builtin_amdgcn_readfirstlane(tid >> 6), lane = tid & 63, li = lane & 15, g = lane >> 4;
    const bool prod = wid >= 4; const int rw = wid & 3, ptid = rw * 64 + lane;
    const bf16* proj = (const bf16*)(wsb + WS_BIG); bf16* Oout = (bf16*)(wsb + WS_A);
    const float L2E = 1.4426950408889634f;
    const int kp = lane & 7, tg = lane >> 3;
    for (int u = blockIdx.x; u < BATCH * NH; u += G) {
        const int b = u >> 4, h = u & 15;
        if (tid < HD) ((LAS float*)(lds + L_ON))[tid] = h_on[h * HD + tid];
#define HG_LOAD(c_, QW, FW, VW) do { const size_t r0_ = (size_t)b * SEQ + 64 * (c_); \
        _Pragma("unroll") for (int c2 = 0; c2 < 2; ++c2) _Pragma("unroll") for (int i = 0; i < 8; ++i) { const size_t r = r0_ + 8 * tg + i; const int ch_ = h * HD + 32 * rw + 16 * c2 + 2 * kp; \
            QW[c2][i] = *(const GAS unsigned*)(proj + r * FF + ch_); FW[c2][i] = *(const GAS unsigned*)(proj + r * FF + 2048 + ch_); } \
        _Pragma("unroll") for (int j = 0; j < 4; ++j) { const int ci = ptid + 256 * j; VW[j] = *(const GAS v4u*)(proj + (r0_ + (ci >> 4)) * FF + 4096 + h * HD + 8 * (ci & 15)); } } while (0)
#define HG_PREP(pb, QW, FW, VW) do { LAS unsigned char* B_ = lds + (pb) * BUFB; \
        _Pragma("unroll") for (int c2 = 0; c2 < 2; ++c2) { const int chl_ = 32 * rw + 16 * c2 + 2 * kp; float bl0[8], bl1[8]; float c0 = 0.f, c1 = 0.f; \
            _Pragma("unroll") for (int i = 0; i < 8; ++i) { c0 += bflo(FW[c2][i]); c1 += bfhi(FW[c2][i]); bl0[i] = c0; bl1[i] = c1; } \
            float i0 = c0, i1 = c1; \
            _Pragma("unroll") for (int d = 8; d < 64; d <<= 1) { const float x0 = __shfl_up(i0, d), x1 = __shfl_up(i1, d); if (lane >= d) { i0 += x0; i1 += x1; } } \
            const float p0 = i0 - c0, p1 = i1 - c1; \
            if (tg == 7) *(LAS f32x2v*)(lds + L_EBL + (pb) * 512 + chl_ * 4) = (f32x2v){__builtin_amdgcn_exp2f(i0 * L2E), __builtin_amdgcn_exp2f(i1 * L2E)}; \
            _Pragma("unroll") for (int i = 0; i < 8; ++i) { const float b0 = (p0 + bl0[i]) * L2E, b1 = (p1 + bl1[i]) * L2E; \
                const float e0 = __builtin_amdgcn_exp2f(b0), e1 = __builtin_amdgcn_exp2f(b1), n0 = __builtin_amdgcn_exp2f(-b0), n1 = __builtin_amdgcn_exp2f(-b1); \
                const float k0 = 1.f - __builtin_amdgcn_exp2f(bflo(FW[c2][i]) * L2E), k1 = 1.f - __builtin_amdgcn_exp2f(bfhi(FW[c2][i]) * L2E); \
                const int t = 8 * tg + i; \
                *(LAS unsigned*)(B_ + L_Q + t * RS + chl_ * 2) = cvtpk(bflo(QW[c2][i]) * e0, bfhi(QW[c2][i]) * e1); \
                *(LAS unsigned*)(B_ + L_K + t * RS + chl_ * 2) = cvtpk(k0 * n0, k1 * n1); } } \
        _Pragma("unroll") for (int j = 0; j < 4; ++j) { const int ci = ptid + 256 * j; *(LAS v4u*)(B_ + L_V + (ci >> 4) * RS + (ci & 15) * 16) = VW[j]; } } while (0)
        if (prod) {
            unsigned qwA[2][8], fwA[2][8], qwB[2][8], fwB[2][8]; v4u vwA[4], vwB[4], gwA[4], gwB[4];
#pragma unroll
            for (int j = 0; j < 4; ++j) { gwA[j] = (v4u){0u, 0u, 0u, 0u}; gwB[j] = (v4u){0u, 0u, 0u, 0u}; }
#define HG_GATES(c_, GW) do { const int t_ = ptid >> 2, vq_ = ptid & 3; const size_t r_ = (size_t)b * SEQ + 64 * (c_) + t_; \
            _Pragma("unroll") for (int j = 0; j < 4; ++j) GW[j] = *(const GAS v4u*)(proj + r_ * FF + 6144 + h * HD + 32 * vq_ + 8 * j); } while (0)
            HG_LOAD(0, qwA, fwA, vwA); HG_PREP(0, qwA, fwA, vwA); HG_LOAD(1, qwB, fwB, vwB); HG_LOAD(2, qwA, fwA, vwA); HG_GATES(0, gwA);
            HG_BAR();
            for (int c = 0; c < SEQ / 64; c += 2) {
                { const size_t row0 = (size_t)b * SEQ + 64 * c;
                if (c > 0) {
                    const int t = ptid >> 2, vq = ptid & 3; const size_t r = row0 - 64 + t;
                    float ov[32]; float ss = 0.f;
#pragma unroll
                    for (int j = 0; j < 4; ++j) { const v4u w = *(const LAS v4u*)(lds + L_O + t * RS + vq * 64 + j * 16);
                        ov[8 * j + 0] = bflo(w.x); ov[8 * j + 1] = bfhi(w.x); ov[8 * j + 2] = bflo(w.y); ov[8 * j + 3] = bfhi(w.y); ov[8 * j + 4] = bflo(w.z); ov[8 * j + 5] = bfhi(w.z); ov[8 * j + 6] = bflo(w.w); ov[8 * j + 7] = bfhi(w.w); }
#pragma unroll
                    for (int j = 0; j < 32; ++j) ss += ov[j] * ov[j];
                    ss += __shfl_xor(ss, 1); ss += __shfl_xor(ss, 2);
                    const float rinv = 1.f / sqrtf(ss * (1.f / 128.f) + RMS_EPS);
                    bf16* op = Oout + r * DM + h * HD + 32 * vq;
#pragma unroll
                    for (int j = 0; j < 4; ++j) { const v4u gq = gwB[j]; const f32x4v on0 = *(const LAS f32x4v*)(lds + L_ON + (32 * vq + 8 * j) * 4), on1 = *(const LAS f32x4v*)(lds + L_ON + (32 * vq + 8 * j + 4) * 4);
                        v4u o4;
                        o4.x = cvtpk(ov[8 * j + 0] * rinv * on0[0] * bflo(gq.x), ov[8 * j + 1] * rinv * on0[1] * bfhi(gq.x));
                        o4.y = cvtpk(ov[8 * j + 2] * rinv * on0[2] * bflo(gq.y), ov[8 * j + 3] * rinv * on0[3] * bfhi(gq.y));
                        o4.z = cvtpk(ov[8 * j + 4] * rinv * on1[0] * bflo(gq.z), ov[8 * j + 5] * rinv * on1[1] * bfhi(gq.z));
                        o4.w = cvtpk(ov[8 * j + 6] * rinv * on1[2] * bflo(gq.w), ov[8 * j + 7] * rinv * on1[3] * bfhi(gq.w));
                        *(GAS v4u*)(op + 8 * j) = o4; }
                }
                  HG_GATES(c + 1, gwB); }
                HG_BAR();
                HG_PREP(1, qwB, fwB, vwB); if (c + 3 < SEQ / 64) HG_LOAD(c + 3, qwB, fwB, vwB);
                HG_BAR();
                { const int c = 0; (void)c; }
                { const size_t row0 = (size_t)b * SEQ + 64 * (c + 1); const int c_ = c + 1;
                if (c_ > 0) {
                    const int t = ptid >> 2, vq = ptid & 3; const size_t r = row0 - 64 + t;
                    float ov[32]; float ss = 0.f;
#pragma unroll
                    for (int j = 0; j < 4; ++j) { const v4u w = *(const LAS v4u*)(lds + L_O + t * RS + vq * 64 + j * 16);
                        ov[8 * j + 0] = bflo(w.x); ov[8 * j + 1] = bfhi(w.x); ov[8 * j + 2] = bflo(w.y); ov[8 * j + 3] = bfhi(w.y); ov[8 * j + 4] = bflo(w.z); ov[8 * j + 5] = bfhi(w.z); ov[8 * j + 6] = bflo(w.w); ov[8 * j + 7] = bfhi(w.w); }
#pragma unroll
                    for (int j = 0; j < 32; ++j) ss += ov[j] * ov[j];
                    ss += __shfl_xor(ss, 1); ss += __shfl_xor(ss, 2);
                    const float rinv = 1.f / sqrtf(ss * (1.f / 128.f) + RMS_EPS);
                    bf16* op = Oout + r * DM + h * HD + 32 * vq;
#pragma unroll
                    for (int j = 0; j < 4; ++j) { const v4u gq = gwA[j]; const f32x4v on0 = *(const LAS f32x4v*)(lds + L_ON + (32 * vq + 8 * j) * 4), on1 = *(const LAS f32x4v*)(lds + L_ON + (32 * vq + 8 * j + 4) * 4);
                        v4u o4;
                        o4.x = cvtpk(ov[8 * j + 0] * rinv * on0[0] * bflo(gq.x), ov[8 * j + 1] * rinv * on0[1] * bfhi(gq.x));
                        o4.y = cvtpk(ov[8 * j + 2] * rinv * on0[2] * bflo(gq.y), ov[8 * j + 3] * rinv * on0[3] * bfhi(gq.y));
                        o4.z = cvtpk(ov[8 * j + 4] * rinv * on1[0] * bflo(gq.z), ov[8 * j + 5] * rinv * on1[1] * bfhi(gq.z));
                        o4.w = cvtpk(ov[8 * j + 6] * rinv * on1[2] * bflo(gq.w), ov[8 * j + 7] * rinv * on1[3] * bfhi(gq.w));
                        *(GAS v4u*)(op + 8 * j) = o4; }
                }
                  if (c + 2 < SEQ / 64) HG_GATES(c + 2, gwA); }
                HG_BAR();
                if (c + 2 < SEQ / 64) { HG_PREP(0, qwA, fwA, vwA); if (c + 4 < SEQ / 64) HG_LOAD(c + 4, qwA, fwA, vwA); }
                HG_BAR();
            }
            {
            const int t = ptid >> 2, vq = ptid & 3; const size_t r = (size_t)b * SEQ + SEQ - 64 + t;
            float ov[32]; float ss = 0.f;
#pragma unroll
            for (int j = 0; j < 4; ++j) { const v4u w = *(const LAS v4u*)(lds + L_O + t * RS + vq * 64 + j * 16);
                ov[8 * j + 0] = bflo(w.x); ov[8 * j + 1] = bfhi(w.x); ov[8 * j + 2] = bflo(w.y); ov[8 * j + 3] = bfhi(w.y); ov[8 * j + 4] = bflo(w.z); ov[8 * j + 5] = bfhi(w.z); ov[8 * j + 6] = bflo(w.w); ov[8 * j + 7] = bfhi(w.w); }
#pragma unroll
            for (int j = 0; j < 32; ++j) ss += ov[j] * ov[j];
            ss += __shfl_xor(ss, 1); ss += __shfl_xor(ss, 2);
            const float rinv = 1.f / sqrtf(ss * (1.f / 128.f) + RMS_EPS);
            bf16* op = Oout + r * DM + h * HD + 32 * vq;
#pragma unroll
            for (int j = 0; j < 4; ++j) { const v4u gq = gwB[j]; const f32x4v on0 = *(const LAS f32x4v*)(lds + L_ON + (32 * vq + 8 * j) * 4), on1 = *(const LAS f32x4v*)(lds + L_ON + (32 * vq + 8 * j + 4) * 4);
                v4u o4;
                o4.x = cvtpk(ov[8 * j + 0] * rinv * on0[0] * bflo(gq.x), ov[8 * j + 1] * rinv * on0[1] * bfhi(gq.x));
                o4.y = cvtpk(ov[8 * j + 2] * rinv * on0[2] * bflo(gq.y), ov[8 * j + 3] * rinv * on0[3] * bfhi(gq.y));
                o4.z = cvtpk(ov[8 * j + 4] * rinv * on1[0] * bflo(gq.z), ov[8 * j + 5] * rinv * on1[1] * bfhi(gq.z));
                o4.w = cvtpk(ov[8 * j + 6] * rinv * on1[2] * bflo(gq.w), ov[8 * j + 7] * rinv * on1[3] * bfhi(gq.w));
                *(GAS v4u*)(op + 8 * j) = o4; }
            }
#undef HG_GATES
        } else {
            f32x4v S[8][2];
#pragma unroll
            for (int m = 0; m < 8; ++m) { S[m][0] = (f32x4v){0.f, 0.f, 0.f, 0.f}; S[m][1] = (f32x4v){0.f, 0.f, 0.f, 0.f}; }
            HG_BAR();
            for (int c = 0; c < SEQ / 64; ++c) {
                const int cb = c & 1;
                LAS unsigned char* CB = lds + cb * BUFB;
                {
                const int mt = rw;
                f32x4v acc[4];
#pragma unroll
                for (int nt = 0; nt < 4; ++nt) acc[nt] = (f32x4v){0.f, 0.f, 0.f, 0.f};
#pragma unroll
                for (int ks = 0; ks < 4; ++ks) { const bf16x8 a = *(const LAS bf16x8*)(CB + L_Q + (16 * mt + li) * RS + (32 * ks + 8 * g) * 2);
#pragma unroll
                    for (int nt = 0; nt < 4; ++nt) { const bf16x8 bb = *(const LAS bf16x8*)(CB + L_K + (16 * nt + li) * RS + (32 * ks + 8 * g) * 2);
                        acc[nt] = __builtin_amdgcn_mfma_f32_16x16x32_bf16(a, bb, acc[nt], 0, 0, 0); } }
#pragma unroll
                for (int nt = 0; nt < 4; ++nt) { const int s = 16 * nt + li;
#pragma unroll
                    for (int r = 0; r < 4; ++r) { const int t = 16 * mt + 4 * g + r; const float v = (s <= t) ? acc[nt][r] : 0.f;
                        *(LAS unsigned short*)(lds + L_AM + t * RSA + s * 2) = (unsigned short)f2bf(v); } }
                }
                HG_BAR();
                {
                f32x4v o[4][2];
#pragma unroll
                for (int m = 0; m < 4; ++m) { o[m][0] = (f32x4v){0.f, 0.f, 0.f, 0.f}; o[m][1] = (f32x4v){0.f, 0.f, 0.f, 0.f}; }
#pragma unroll
                for (int ks = 0; ks < 4; ++ks) { bf16x8 bs[2];
#pragma unroll
                    for (int n = 0; n < 2; ++n) { v4u bw; bw.x = cvtpk(S[2 * ks][n][0], S[2 * ks][n][1]); bw.y = cvtpk(S[2 * ks][n][2], S[2 * ks][n][3]); bw.z = cvtpk(S[2 * ks + 1][n][0], S[2 * ks + 1][n][1]); bw.w = cvtpk(S[2 * ks + 1][n][2], S[2 * ks + 1][n][3]);
                        bs[n] = *reinterpret_cast<bf16x8*>(&bw); }
#pragma unroll
                    for (int m = 0; m < 4; ++m) { const LAS unsigned char* qa = CB + L_Q + (16 * m + li) * RS + (32 * ks + 4 * g) * 2;
                        const v2u lo = *(const LAS v2u*)qa, hi2 = *(const LAS v2u*)(qa + 32); v4u aw; aw.x = lo.x; aw.y = lo.y; aw.z = hi2.x; aw.w = hi2.y;
                        const bf16x8 av = *reinterpret_cast<bf16x8*>(&aw);
                        o[m][0] = __builtin_amdgcn_mfma_f32_16x16x32_bf16(av, bs[0], o[m][0], 0, 0, 0);
                        o[m][1] = __builtin_amdgcn_mfma_f32_16x16x32_bf16(av, bs[1], o[m][1], 0, 0, 0); } }
                bf16x8 bv[2][2];
#pragma unroll
                for (int n = 0; n < 2; ++n) {
                    const int va = (int)(unsigned)(uintptr_t)(CB + L_V) + (8 * g + (li >> 2)) * RS + (16 * (2 * rw + n) + 4 * (li & 3)) * 2;
                    s16x4 a0, a1, a2, a3; HG_TR(a0, va, 0); HG_TR(a1, va, 4 * RS); HG_TR(a2, va, 32 * RS); HG_TR(a3, va, 36 * RS);
                    asm volatile("s_waitcnt lgkmcnt(0)" ::: "memory"); __builtin_amdgcn_sched_barrier(0);
                    bv[n][0] = (bf16x8){a0[0], a0[1], a0[2], a0[3], a1[0], a1[1], a1[2], a1[3]}; bv[n][1] = (bf16x8){a2[0], a2[1], a2[2], a2[3], a3[0], a3[1], a3[2], a3[3]}; }
#pragma unroll
                for (int ks = 0; ks < 2; ++ks)
#pragma unroll
                    for (int m = 0; m < 4; ++m) { const bf16x8 a = *(const LAS bf16x8*)(lds + L_AM + (16 * m + li) * RSA + (32 * ks + 8 * g) * 2);
                        o[m][0] = __builtin_amdgcn_mfma_f32_16x16x32_bf16(a, bv[0][ks], o[m][0], 0, 0, 0);
                        o[m][1] = __builtin_amdgcn_mfma_f32_16x16x32_bf16(a, bv[1][ks], o[m][1], 0, 0, 0); }
                { const int ka = (int)(unsigned)(uintptr_t)(CB + L_K) + (8 * g + (li >> 2)) * RS + (4 * (li & 3)) * 2;
                  const LAS float* ebl = (const LAS float*)(lds + L_EBL + cb * 512);
#pragma unroll
                  for (int m = 0; m < 8; ++m) { s16x4 a0, a1, a2, a3;
#define HG_KT(m_) HG_TR(a0, ka, (m_) * 32); HG_TR(a1, ka, (m_) * 32 + 4 * RS); HG_TR(a2, ka, (m_) * 32 + 32 * RS); HG_TR(a3, ka, (m_) * 32 + 36 * RS)
                      switch (m) { case 0: HG_KT(0); break; case 1: HG_KT(1); break; case 2: HG_KT(2); break; case 3: HG_KT(3); break; case 4: HG_KT(4); break; case 5: HG_KT(5); break; case 6: HG_KT(6); break; default: HG_KT(7); break; }
#undef HG_KT
                      asm volatile("s_waitcnt lgkmcnt(0)" ::: "memory"); __builtin_amdgcn_sched_barrier(0);
                      const bf16x8 kt0 = (bf16x8){a0[0], a0[1], a0[2], a0[3], a1[0], a1[1], a1[2], a1[3]}, kt1 = (bf16x8){a2[0], a2[1], a2[2], a2[3], a3[0], a3[1], a3[2], a3[3]};
                      const f32x4v e = *(const LAS f32x4v*)(ebl + 16 * m + 4 * g);
#pragma unroll
                      for (int n = 0; n < 2; ++n) { S[m][n] = __builtin_amdgcn_mfma_f32_16x16x32_bf16(kt0, bv[n][0], S[m][n], 0, 0, 0);
                          S[m][n] = __builtin_amdgcn_mfma_f32_16x16x32_bf16(kt1, bv[n][1], S[m][n], 0, 0, 0);
                          S[m][n] = S[m][n] * e; } } }
#pragma unroll
                for (int m = 0; m < 4; ++m)
#pragma unroll
                    for (int n = 0; n < 2; ++n)
#pragma unroll
                        for (int r = 0; r < 4; ++r) *(LAS unsigned short*)(lds + L_O + (16 * m + 4 * g + r) * RS + (16 * (2 * rw + n) + li) * 2) = (unsigned short)f2bf(o[m][n][r]);
                }
                HG_BAR();
            }
        }
        LDS_WAIT();
        __syncthreads();
#undef HG_LOAD
#undef HG_PREP
    }
}
#undef HG_TR
#undef HG_BAR
}

struct Args { const float* in[14]; float* out; unsigned char* ws; int ph_lo, ph_hi; };
#ifndef CONV_IN_SCAN
#define CONV_IN_SCAN 1
#endif
#ifndef MK_N_LAUNCHES
#define MK_N_LAUNCHES 1
#endif
constexpr int MISC_OFF = LDS_BYTES - 64;
constexpr int N_PHASES = 10;
__global__ void __launch_bounds__(NTHREADS, 2) mk_fwd(Args args) {
    extern __shared__ __attribute__((aligned(16))) unsigned char lds[];
    Frame F;
    F.lds = (LAS unsigned char*)lds;
    F.wave = __builtin_amdgcn_readfirstlane((int)threadIdx.x >> 6); F.lane = lane_id(); F.tid = F.wave * 64 + F.lane;
    F.G = gridDim.x; F.gw = blockIdx.x * NWAVES + F.wave; F.NGW = F.G * NWAVES;
    F.x = args.in[0]; F.norm_g = args.in[1]; F.rel = args.in[2]; F.w_in = args.in[3]; F.pe = args.in[4]; F.cw1 = args.in[5]; F.cw2 = args.in[6]; F.w_out = args.in[7];
    F.h_in = args.in[8]; F.h_lb = args.in[9]; F.h_on = args.in[10]; F.h_out = args.in[11]; F.up = args.in[12]; F.dn = args.in[13];
    F.out = args.out; F.ws = args.ws;
    unsigned char* ws = args.ws;
    bf16* A = (bf16*)(ws + WS_A); bf16* BIG = (bf16*)(ws + WS_BIG); bf16* X16 = (bf16*)(ws + WS_X16);
    const int lo = args.ph_lo, hi = args.ph_hi;
    if (F.tid < 4) ((LAS unsigned*)(F.lds + MISC_OFF))[F.tid] = 0u;
    __syncthreads();
    XcdBarrier bar; bar.wave = F.wave; bar.bar = (unsigned*)(ws + WS_CTL) + 1024; bar.x = 0; bar.st = nullptr;
    if (hi - lo > 1) bar = xcd_barrier_post((unsigned*)(ws + WS_CTL) + 1024, (volatile LAS unsigned*)(F.lds + MISC_OFF), F.wave);
#define IN(k) (lo <= (k) && (k) < hi)
#define PH_FENCE() do { F.lane = lane_id(); F.tid = F.wave * 64 + F.lane; } while (0)
#define SEAM(k) do { if (IN(k) && IN((k) + 1)) xcd_barrier(bar); } while (0)
#define GEMM_PHASE_M(ACT, Ap, Btp, MR_, N_, K_, Op, ldc_, st_, sc_, rs_) do { pg8::Gemm g{(Ap), (Btp), (MR_), (N_), (K_)}; pg8::StaticOrder S; S.init((MR_), (N_), F.G, (int)blockIdx.x); \
        EpiAct<ACT> E{(Op), (ldc_), (st_), (sc_), (const float*)(ws + WS_LB), (rs_), 1.f}; pg8::gemm_phase<EpiAct<ACT>, pg8::StaticOrder, true, true>(F.lds, g, S, E, F.tid); } while (0)
#define GEMM_PHASE(ACT, Ap, Btp, N_, K_, Op, ldc_, st_, sc_, rs_) GEMM_PHASE_M(ACT, Ap, Btp, M, N_, K_, Op, ldc_, st_, sc_, rs_)
#define PANEL_SQL(e_, ro_) PanelSqLast{(float*)(ws + WS_SLOTS) + ((size_t)(e_) * M + (ro_)) * 8, (unsigned*)(ws + WS_CTL) + CW_PANEL + ((e_) * 64 + (ro_) / 256) * 64, (float*)(ws + WS_RINV) + (ro_)}
#define PANEL_SQ(e_, ro_) PanelSq{(float*)(ws + WS_SLOTS) + ((size_t)(e_) * M + (ro_)) * 8, (unsigned*)(ws + WS_CTL) + CW_PANEL + ((e_) * 64 + (ro_) / 256) * 64, (unsigned*)(ws + WS_CTL) + CW_XTMO}
#define GEMM_FUSED(XF32_, FINAL_, W8_, F8_, Ap, Btp, K_, osc_, ro_, xoldp, gp, e1_, e2_) GEMM_FUSED8(XF32_, FINAL_, W8_, F8_, Ap, Btp, K_, osc_, ro_, xoldp, gp, e1_, e2_, WS_X8)
#define GEMM_FUSED8(XF32_, FINAL_, W8_, F8_, Ap, Btp, K_, osc_, ro_, xoldp, gp, e1_, e2_, X8OFF_) do { pg8::Gemm g{(Ap), (Btp), M / 2, DM, (K_)}; pg8::StaticOrder S; S.init(M / 2, DM, F.G, (int)blockIdx.x); \
        EpiRmsRes<XF32_, FINAL_, W8_> E{(const void*)(xoldp), X16 + (size_t)(ro_) * DM, F.out + (size_t)(ro_) * DM, (gp), ws + (X8OFF_) + (size_t)(ro_) * DM, (osc_), PANEL_SQ(e1_, ro_), PANEL_SQL(e2_, ro_)}; \
        pg8::gemm_phase<EpiRmsRes<XF32_, FINAL_, W8_>, pg8::StaticOrder, false, true, F8_>(F.lds, g, S, E, F.tid); } while (0)
#define MLP_FULL_F(FINAL_, WUP, WDN, gp, e1_, e2_) do { { pg8::Gemm g{(const bf16*)(ws + WS_X8), (const bf16*)(ws + (WUP)), M, FF, DM / 2}; pg8::StaticOrder S; S.init(M, FF, F.G, (int)blockIdx.x); \
        EpiUp8 E{ws + WS_BIG, FF, (const float*)(ws + WS_RINV)}; pg8::gemm_phase<EpiUp8, pg8::StaticOrder, true, true, true>(F.lds, g, S, E, F.tid); } xcd_barrier(bar); PH_FENCE(); \
        GEMM_FUSED8(false, FINAL_, !(FINAL_), true, BIG, (const bf16*)(ws + (WDN)), FF / 2, 1.f / (W8SCALE * H8SCALE), 0, X16, gp, e1_, e2_, WS_A); __syncthreads(); PH_FENCE(); \
        GEMM_FUSED8(false, FINAL_, !(FINAL_), true, (const bf16*)(ws + WS_BIG + (size_t)(M / 2) * FF), (const bf16*)(ws + (WDN)), FF / 2, 1.f / (W8SCALE * H8SCALE), M / 2, X16 + (size_t)(M / 2) * DM, gp, e1_, e2_, WS_A); } while (0)

    if (IN(0)) { PH_FENCE(); p0_prologue(F); } SEAM(0);
    if (IN(1)) { PH_FENCE(); GEMM_PHASE(0, A, (const bf16*)(ws + W0_QKV), NQKV, DM, BIG, NQKV, 8, QSCALE, (const float*)(ws + WS_RINV)); } SEAM(1);
    if (IN(2)) { PH_FENCE(); cg::cmp_gate_phase(F.lds, ws, F.G, F.tid); } SEAM(2);
    if (IN(3)) { PH_FENCE(); nsa::nsa_phase(F.lds, ws, F.G, F.tid); } SEAM(3);
    if (IN(4)) { PH_FENCE(); GEMM_FUSED(true, false, true, false, A, (const bf16*)(ws + W0_O), DM, 1.f, 0, F.x, F.norm_g + 1 * DM, 0, 1); __syncthreads();
                 GEMM_FUSED(true, false, true, false, A + (size_t)(M / 2) * DM, (const bf16*)(ws + W0_O), DM, 1.f, M / 2, F.x + (size_t)(M / 2) * DM, F.norm_g + 1 * DM, 0, 1); } SEAM(4);
    if (IN(5)) { PH_FENCE(); MLP_FULL_F(false, W0_UP, W0_DN, F.norm_g + 3 * DM, 2, 3); __syncthreads(); PH_FENCE(); p_convert_l1a(F); } SEAM(5);
    if (IN(6)) { PH_FENCE(); pg8::Gemm g{(const bf16*)(ws + WS_A), (const bf16*)(ws + W1_IN), M, FF, DM / 2}; pg8::StaticOrder S; S.init(M, FF, F.G, (int)blockIdx.x);
                 EpiAct<2> E{BIG, FF, 0, 1.f, (const float*)(ws + WS_LB), (const float*)(ws + WS_RINV), 1.f / W8SCALE}; pg8::gemm_phase<EpiAct<2>, pg8::StaticOrder, false, true, true>(F.lds, g, S, E, F.tid); } SEAM(6);
    if (IN(7)) { PH_FENCE(); const int nstat = (F.G - BATCH * NH) * NWAVES;
                 if ((int)blockIdx.x >= BATCH * NH) p_convert_l1b(F, ((int)blockIdx.x - BATCH * NH) * NWAVES + F.wave, nstat);
                 else { hg::scan_phase(F.lds, ws, F.h_on, F.G, F.tid); PH_FENCE(); p_convert_l1b(F, -1, nstat); } } SEAM(7);
    if (IN(8)) { PH_FENCE(); GEMM_FUSED(false, false, true, false, A, (const bf16*)(ws + W1_O), DM, 1.f, 0, X16, F.norm_g + 5 * DM, 4, 5); __syncthreads();
                 GEMM_FUSED(false, false, true, false, A + (size_t)(M / 2) * DM, (const bf16*)(ws + W1_O), DM, 1.f, M / 2, X16 + (size_t)(M / 2) * DM, F.norm_g + 5 * DM, 4, 5); } SEAM(8);
    if (IN(9)) { PH_FENCE(); MLP_FULL_F(true, W1_UP, W1_DN, F.norm_g + 7 * DM, 6, 7); }
#undef IN
}

extern "C" void kernel_launch(void* const* d_in, const int* in_sizes, int n_in, void* d_out, int out_size, void* d_ws, size_t ws_size, hipStream_t stream) {
    static int grid = 0;
    if (grid == 0) {
        if (n_in != 14 || in_sizes[0] != M * DM || out_size != M * DM || ws_size < WS_END) { fprintf(stderr, "kernel_launch: unexpected shapes (n_in %d, ws %zu)\n", n_in, ws_size); grid = -1; return; }
        int dev = 0, cus = 0;
        if (hipGetDevice(&dev) != hipSuccess || hipDeviceGetAttribute(&cus, hipDeviceAttributeMultiprocessorCount, dev) != hipSuccess) { grid = -1; return; }
        if (hipFuncSetAttribute((const void*)mk_fwd, hipFuncAttributeMaxDynamicSharedMemorySize, LDS_BYTES) != hipSuccess) { fprintf(stderr, "kernel_launch: hipFuncSetAttribute failed\n"); grid = -1; return; }
        (void)hipGetLastError();
        if (cus < 256) { fprintf(stderr, "kernel_launch: this kernel needs 256 co-resident workgroups (one per CU); the device has %d CUs\n", cus); grid = -1; return; }
        grid = 256;
    }
    if (grid < 0) return;
    Args a{};
    for (int i = 0; i < 14; ++i) a.in[i] = (const float*)d_in[i];
    a.out = (float*)d_out; a.ws = (unsigned char*)d_ws;
    if (hipMemsetAsync((char*)d_ws + WS_CTL, 0, CTL_ZERO_BYTES, stream) != hipSuccess) return;
    if (MK_N_LAUNCHES == 1) { a.ph_lo = 0; a.ph_hi = N_PHASES; hipLaunchKernelGGL(mk_fwd, dim3(grid), dim3(NTHREADS), LDS_BYTES, stream, a); }
    else for (int p = 0; p < N_PHASES; ++p) { a.ph_lo = p; a.ph_hi = p + 1; hipLaunchKernelGGL(mk_fwd, dim3(grid), dim3(NTHREADS), LDS_BYTES, stream, a); }
}
```

```cpp
#include <hip/hip_runtime.h>
#include <cstdio>
#include <cstdint>
namespace pg8 {
#define PG8_LAS __attribute__((address_space(3)))
typedef unsigned short bf16_t;
typedef short bf16x8 __attribute__((ext_vector_type(8)));
typedef float f32x4 __attribute__((ext_vector_type(4)));
typedef unsigned u32x4 __attribute__((ext_vector_type(4)));
constexpr int BM = 256, BK = 64, HALF = 128, HTB = HALF * BK * 2  , STAGE_BYTES = 8 * HTB, NXCD = 8, WGM = 4;

__host__ __device__ __forceinline__ int lds_byte(int r, int c) { const int st = (r >> 4) * 2 + (c >> 5), rr = r & 15, cc = c & 31, ob = rr * 64 + cc * 2; return st * 1024 + (ob ^ (((ob >> 9) & 1) << 5)); }
__host__ __device__ __forceinline__ void stage_rc(int b, int& R, int& C) { const int st = b / 1024, sb = b % 1024, swz = sb ^ (((sb >> 9) & 1) << 5); R = (st >> 1) * 16 + swz / 64; C = (st & 1) * 32 + (swz % 64) / 2; }
__host__ __device__ __forceinline__ int perm32(int rho) { const int n = rho >> 4, i = rho & 15; return 8 * (i >> 2) + 4 * n + (i & 3); }

typedef int i32x4 __attribute__((ext_vector_type(4)));
typedef int i32x8 __attribute__((ext_vector_type(8)));
struct Unit { int pm, pn; };
struct Gemm { const bf16_t* A; const bf16_t* Bt; int M, N, K; };

struct StaticOrder {
    int nM, nN, nwg, G, c;
    __host__ __device__ void init(int M, int N, int G_, int c_) { nM = M / BM; nN = N / BM; nwg = nM * nN; G = G_; c = c_; }
    __host__ __device__ bool next(int i, Unit& u) const {
        const long L = (long)i * G + c; if (L >= nwg) return false;
        int wgid = (int)L; { const int q = nwg / NXCD, r = nwg % NXCD, xcd = wgid % NXCD, off = wgid / NXCD; wgid = (xcd < r ? xcd * (q + 1) : r * (q + 1) + (xcd - r) * q) + off; }
        const int nig = WGM * nN, gid = wgid / nig, fm = gid * WGM, gsz = (nM - fm) < WGM ? (nM - fm) : WGM;
        u.pm = fm + ((wgid % nig) % gsz); u.pn = (wgid % nig) / gsz; return true;
    }
    __device__ __forceinline__ void a_ready(const Unit&) const {}
    __device__ __forceinline__ void done(const Unit&) const {}
};

__device__ __forceinline__ unsigned cvt_pk_bf16(float lo, float hi) { unsigned r; asm volatile("v_cvt_pk_bf16_f32 %0, %1, %2" : "=v"(r) : "v"(lo), "v"(hi)); return r; }
typedef float f32x2 __attribute__((ext_vector_type(2)));
__device__ __forceinline__ f32x2 gelu_pk(f32x2 v) {
    const f32x2 av = __builtin_elementwise_abs(v), d = av * 0.2316418882f + 1.0f;
    f32x2 t; t.x = __builtin_amdgcn_rcpf(d.x); t.y = __builtin_amdgcn_rcpf(d.y);
    f32x2 q = t * 0.5307027145f + (-0.7265760135f); q = q * t + 0.7107068705f; q = q * t + (-0.142248368f); q = q * t + 0.127414796f; q = q * t;
    const f32x2 s = (v * v) * (-0.72134752044f);
    f32x2 e; e.x = __builtin_amdgcn_exp2f(s.x); e.y = __builtin_amdgcn_exp2f(s.y);
    const f32x2 m = v * (q * e), r = v - m;
    f32x2 o; o.x = v.x < 0.f ? m.x : r.x; o.y = v.y < 0.f ? m.y : r.y; return o;
}

template <int ACT  > struct EpiBf16 {
    static constexpr bool PERM = true, AFTER_DRAIN = false; static_assert(ACT == 0 || ACT == 1, "EpiBf16: ACT is 0 (none) or 1 (gelu_pk)");
    bf16_t* O; int ldc; const float* bias; int split_cols; size_t split_stride; float scale0;
    __device__ __forceinline__ void operator()(const f32x4 (&acc)[2][2][4][2], const Unit& u, int wr, int wc, int fr, int fq) const {
        const int row0 = u.pm * BM + wr * 64 + fr; int colt = u.pn * BM; bf16_t* base = O;
        float sc = 1.f; if (split_cols) { const int t = colt / split_cols; base += (size_t)t * split_stride; colt -= t * split_cols; if (t == 0) sc = scale0; }
        const int col0 = colt + wc * 32 + 8 * fq, bcol0 = u.pn * BM + wc * 32 + 8 * fq;
        f32x4 bv[2][2];
#pragma unroll
        for (int bj = 0; bj < 2; ++bj)
#pragma unroll
            for (int n = 0; n < 2; ++n) bv[bj][n] = bias ? *(const f32x4*)(bias + bcol0 + bj * HALF + 4 * n) : (f32x4){0.f, 0.f, 0.f, 0.f};
#pragma unroll
        for (int ai = 0; ai < 2; ++ai)
#pragma unroll
            for (int m = 0; m < 4; ++m) { bf16_t* rowp = base + (size_t)(row0 + ai * HALF + m * 16) * ldc + col0;
#pragma unroll
                for (int bj = 0; bj < 2; ++bj) { f32x4 v0 = acc[ai][bj][m][0] + bv[bj][0], v1 = acc[ai][bj][m][1] + bv[bj][1];
                    if (ACT == 1) { f32x2 a = gelu_pk((f32x2){v0[0], v0[1]}), b = gelu_pk((f32x2){v0[2], v0[3]}), c = gelu_pk((f32x2){v1[0], v1[1]}), d = gelu_pk((f32x2){v1[2], v1[3]});
                        v0 = (f32x4){a.x, a.y, b.x, b.y}; v1 = (f32x4){c.x, c.y, d.x, d.y}; }
                    v0 = v0 * sc; v1 = v1 * sc; u32x4 w; w.x = cvt_pk_bf16(v0[0], v0[1]); w.y = cvt_pk_bf16(v0[2], v0[3]); w.z = cvt_pk_bf16(v1[0], v1[1]); w.w = cvt_pk_bf16(v1[2], v1[3]);
                    *(u32x4*)(rowp + bj * HALF) = w; } }
    }
};
__device__ __forceinline__ void mfma_f8(f32x4& c, const i32x8 a, const i32x8 b) { asm volatile("s_nop 1\n\tv_mfma_f32_16x16x128_f8f6f4 %0, %1, %2, %0" : "+v"(c) : "v"(a), "v"(b)); }
template <class Epi, class Sched, bool ALIGN_EPI = false, bool SP2 = false, bool F8 = false>
__device__ __forceinline__ void gemm_phase(PG8_LAS unsigned char* lds, const Gemm g, const Sched& S, const Epi& E, const int tid) {
    const int wid = __builtin_amdgcn_readfirstlane(tid >> 6), lane = tid & 63, wr = wid >> 2, wc = wid & 3, fr = lane & 15, fq = lane >> 4;
    const int K = g.K, nt = K / BK;
    unsigned voffA[2], voffB[2];
#pragma unroll
    for (int i = 0; i < 2; ++i) { int R, C; stage_rc(tid * 16 + i * 8192, R, C); const int Rb = Epi::PERM ? ((R & ~31) + perm32(R & 31)) : R;
        voffA[i] = (unsigned)(R * K + C) * 2u; voffB[i] = (unsigned)(Rb * K + C) * 2u; }
    const size_t kstep = (size_t)(BK * 2);
    const size_t hstep = (size_t)HALF * K * 2;
    const size_t tstep = 2 * hstep;
    const unsigned ldsw = (unsigned)wid * 1024u;
    const int aoff = lds_byte(wr * 64 + fr, fq * 8), boff = lds_byte(wc * 32 + fr, fq * 8);
#define PG8_SA(b, h) (((b) * 2 + (h)) * HTB)
#define PG8_SB(b, h) ((4 + (b) * 2 + (h)) * HTB)
#define PG8_STAGE(bufoff, gbase, voff) do { _Pragma("unroll") for (int _i = 0; _i < 2; ++_i) \
        __builtin_amdgcn_global_load_lds((const unsigned*)((const char*)(gbase) + (voff)[_i]), (PG8_LAS unsigned*)(lds + (bufoff) + ldsw + _i * 8192), 16, 0, 0); } while (0)
#define PG8_LDA(dst, b, h) do { _Pragma("unroll") for (int m = 0; m < 4; ++m) _Pragma("unroll") for (int k = 0; k < 2; ++k) dst[m][k] = *(const PG8_LAS bf16x8*)(lds + PG8_SA(b, h) + aoff + m * 2048 + k * 1024); } while (0)
#define PG8_LDB(dst, b, h) do { _Pragma("unroll") for (int n = 0; n < 2; ++n) _Pragma("unroll") for (int k = 0; k < 2; ++k) dst[n][k] = *(const PG8_LAS bf16x8*)(lds + PG8_SB(b, h) + boff + n * 2048 + k * 1024); } while (0)
#define PG8_CAT8(x) __builtin_shufflevector(__builtin_bit_cast(i32x4, (x)[0]), __builtin_bit_cast(i32x4, (x)[1]), 0, 1, 2, 3, 4, 5, 6, 7)
#define PG8_MMA(ai, bj, At, Bt) do { __builtin_amdgcn_s_setprio(1); _Pragma("unroll") for (int m = 0; m < 4; ++m) _Pragma("unroll") for (int n = 0; n < 2; ++n) { \
        if constexpr (F8) mfma_f8(acc[ai][bj][m][n], PG8_CAT8(Bt[n]), PG8_CAT8(At[m])); \
        else { _Pragma("unroll") for (int k = 0; k < 2; ++k) acc[ai][bj][m][n] = __builtin_amdgcn_mfma_f32_16x16x32_bf16(Bt[n][k], At[m][k], acc[ai][bj][m][n], 0, 0, 0); } } __builtin_amdgcn_s_setprio(0); } while (0)
#define PG8_WAIT_V(n) asm volatile("s_waitcnt vmcnt(" #n ")" ::: "memory")
#define PG8_WAIT_L(n) asm volatile("s_waitcnt lgkmcnt(" #n ")" ::: "memory")
#define PG8_BAR __builtin_amdgcn_s_barrier()
#define PG8_SCHED __builtin_amdgcn_sched_barrier(0)
    Unit cur, nxt; int ui = 0;
    if (!S.next(0, cur)) return;
    float epre[8]; E.prefetch(cur, wr, fr, epre);
    f32x4 acc[2][2][4][2];
#pragma unroll
    for (int a = 0; a < 2; ++a)
#pragma unroll
        for (int b = 0; b < 2; ++b)
#pragma unroll
            for (int m = 0; m < 4; ++m)
#pragma unroll
                for (int n = 0; n < 2; ++n) acc[a][b][m][n] = (f32x4){0.f, 0.f, 0.f, 0.f};
    bf16x8 At[4][2], B0[2][2], B1[2][2];
    const char* cA = (const char*)g.A + (size_t)cur.pm * tstep; const char* cB = (const char*)g.Bt + (size_t)cur.pn * tstep;
    S.a_ready(cur);
    if constexpr (SP2) {
        PG8_STAGE(PG8_SB(0, 0), cB, voffB); PG8_STAGE(PG8_SB(0, 1), cB + hstep, voffB); PG8_STAGE(PG8_SA(0, 0), cA, voffA); PG8_STAGE(PG8_SA(0, 1), cA + hstep, voffA);
        if (wr == 1) PG8_BAR;
        PG8_WAIT_V(2); PG8_BAR;
        PG8_STAGE(PG8_SB(1, 0), cB + kstep, voffB); PG8_STAGE(PG8_SB(1, 1), cB + hstep + kstep, voffB);
        PG8_WAIT_V(4); PG8_BAR;
    } else {
        PG8_STAGE(PG8_SB(0, 0), cB, voffB); PG8_STAGE(PG8_SA(0, 0), cA, voffA); PG8_STAGE(PG8_SB(0, 1), cB + hstep, voffB); PG8_STAGE(PG8_SA(0, 1), cA + hstep, voffA);
        if (wr == 1) PG8_BAR;
        PG8_WAIT_V(4); PG8_BAR;
        PG8_STAGE(PG8_SB(1, 0), cB + kstep, voffB); PG8_STAGE(PG8_SA(1, 0), cA + kstep, voffA); PG8_STAGE(PG8_SB(1, 1), cB + hstep + kstep, voffB);
        PG8_WAIT_V(6); PG8_BAR;
    }
    for (;;) {
        const bool has_next = S.next(ui + 1, nxt);
        const char* nA = has_next ? (const char*)g.A + (size_t)nxt.pm * tstep : cA; const char* nB = has_next ? (const char*)g.Bt + (size_t)nxt.pn * tstep : cB;
        for (int t = 0; t < nt; t += 2) {
            const bool last = (t == nt - 2);
            const char* a1 = cA + (size_t)(t + 1) * kstep;
            const char* a2 = last ? nA : cA + (size_t)(t + 2) * kstep; const char* b2 = last ? nB : cB + (size_t)(t + 2) * kstep;
            const char* a3 = a2 + kstep; const char* b3 = b2 + kstep;
            if (last && has_next) S.a_ready(nxt);
            if constexpr (SP2) {
            PG8_LDB(B0, 0, 0); PG8_LDB(B1, 0, 1); PG8_SCHED; PG8_LDA(At, 0, 0); PG8_STAGE(PG8_SA(1, 0), a1, voffA); PG8_STAGE(PG8_SA(1, 1), a1 + hstep, voffA);
            PG8_WAIT_V(8); PG8_WAIT_L(0); PG8_BAR; PG8_MMA(0, 0, At, B0); PG8_MMA(0, 1, At, B1); PG8_BAR; PG8_SCHED;
            PG8_LDA(At, 0, 1); PG8_STAGE(PG8_SB(0, 0), b2, voffB); PG8_STAGE(PG8_SB(0, 1), b2 + hstep, voffB);
            PG8_WAIT_V(6); PG8_WAIT_L(0); PG8_BAR; PG8_MMA(1, 0, At, B0); PG8_MMA(1, 1, At, B1); PG8_BAR; PG8_SCHED;
            PG8_LDB(B0, 1, 0); PG8_LDB(B1, 1, 1); PG8_SCHED; PG8_LDA(At, 1, 0); PG8_STAGE(PG8_SA(0, 0), a2, voffA); PG8_STAGE(PG8_SA(0, 1), a2 + hstep, voffA);
            PG8_WAIT_V(8); PG8_WAIT_L(0); PG8_BAR; PG8_MMA(0, 0, At, B0); PG8_MMA(0, 1, At, B1); PG8_BAR; PG8_SCHED;
            PG8_LDA(At, 1, 1); PG8_STAGE(PG8_SB(1, 0), b3, voffB); PG8_STAGE(PG8_SB(1, 1), b3 + hstep, voffB);
            PG8_WAIT_V(6); PG8_WAIT_L(0); PG8_BAR; PG8_MMA(1, 0, At, B0); PG8_MMA(1, 1, At, B1); PG8_BAR; PG8_SCHED;
            } else {
            PG8_LDB(B0, 0, 0); PG8_SCHED; PG8_LDA(At, 0, 0); PG8_STAGE(PG8_SA(1, 1), a1 + hstep, voffA);
            PG8_WAIT_L(8); PG8_BAR; PG8_WAIT_L(0); PG8_MMA(0, 0, At, B0); PG8_BAR; PG8_SCHED;
            PG8_LDB(B1, 0, 1); PG8_STAGE(PG8_SB(0, 0), b2, voffB);
            PG8_BAR; PG8_WAIT_L(0); PG8_MMA(0, 1, At, B1); PG8_BAR;
            PG8_LDA(At, 0, 1); PG8_STAGE(PG8_SA(0, 0), a2, voffA);
            PG8_BAR; PG8_WAIT_L(0); PG8_MMA(1, 0, At, B0); PG8_BAR; PG8_SCHED;
            PG8_STAGE(PG8_SB(0, 1), b2 + hstep, voffB);
            PG8_WAIT_V(6); PG8_BAR; PG8_MMA(1, 1, At, B1); PG8_BAR;
            PG8_LDB(B0, 1, 0); PG8_SCHED; PG8_LDA(At, 1, 0); PG8_STAGE(PG8_SA(0, 1), a2 + hstep, voffA);
            PG8_WAIT_L(8); PG8_BAR; PG8_WAIT_L(0); PG8_MMA(0, 0, At, B0); PG8_BAR; PG8_SCHED;
            PG8_LDB(B1, 1, 1); PG8_STAGE(PG8_SB(1, 0), b3, voffB);
            PG8_BAR; PG8_WAIT_L(0); PG8_MMA(0, 1, At, B1); PG8_BAR;
            PG8_LDA(At, 1, 1); PG8_STAGE(PG8_SA(1, 0), a3, voffA);
            PG8_BAR; PG8_WAIT_L(0); PG8_MMA(1, 0, At, B0); PG8_BAR; PG8_SCHED;
            PG8_STAGE(PG8_SB(1, 1), b3 + hstep, voffB);
            PG8_WAIT_V(6); PG8_BAR; PG8_MMA(1, 1, At, B1); PG8_BAR;
            }
        }
        if constexpr (F8) { asm volatile("s_nop 15"); PG8_SCHED; }
        if constexpr (ALIGN_EPI) { if (wr == 0) PG8_BAR; }
        if constexpr (!Epi::AFTER_DRAIN) { E(acc, cur, wr, wc, fr, fq, epre); S.done(cur); }
        if (!has_next) break;
#pragma unroll
        for (int a = 0; a < 2; ++a)
#pragma unroll
            for (int b = 0; b < 2; ++b)
#pragma unroll
                for (int m = 0; m < 4; ++m)
#pragma unroll
                    for (int n = 0; n < 2; ++n) acc[a][b][m][n] = (f32x4){0.f, 0.f, 0.f, 0.f};
        cur = nxt; cA = nA; cB = nB; ++ui;
        E.prefetch(cur, wr, fr, epre);
        if constexpr (ALIGN_EPI) { if (wr == 1) PG8_BAR; }
    }
    PG8_WAIT_V(0);
    if constexpr (!ALIGN_EPI) { if (wr == 0) PG8_BAR; }
    PG8_BAR;
    if constexpr (Epi::AFTER_DRAIN) { E.fused(acc, cur, wr, wc, fr, fq, lds, wid, lane); S.done(cur); }
#undef PG8_SA
#undef PG8_SB
#undef PG8_STAGE
#undef PG8_LDA
#undef PG8_LDB
#undef PG8_MMA
#undef PG8_CAT8
#undef PG8_WAIT_V
#undef PG8_WAIT_L
#undef PG8_BAR
#undef PG8_SCHED
}
}

constexpr int NWAVES = 8, NTHREADS = 512;
constexpr int BATCH = 8, SEQ = 2048, DM = 2048, M = BATCH * SEQ, NH = 16, NG = 4, NR = 4, HD = 128, FF = 8192;
constexpr int NQKV = 5120, NSA_IN = 5168, NC = 127, NCP = 128, NBLK = 32, NGATE = 48;
constexpr float RMS_EPS = 1e-6f;
constexpr int COL_KC = 2048, COL_VC = 2560, COL_KS = 3072, COL_VS = 3584, COL_KW = 4096, COL_VW = 4608;
constexpr float QSCALE = 0.12751743082459868f;

constexpr size_t MiB = 1u << 20;
constexpr size_t WS_CTL = 0, CTL_ZERO_BYTES = 256 * 1024;
constexpr size_t WS_LUT = 1 * MiB, WS_BIAS1 = WS_LUT + 16 * 1024  , WS_LB = WS_BIAS1 + 8192;
constexpr size_t WS_GATES = 2 * MiB;
constexpr size_t WS_KCMP = 5 * MiB, WS_VCMP = 6 * MiB;
constexpr size_t WS_W = 8 * MiB;
constexpr size_t W0_QKV = WS_W, W0_G = WS_W + 20 * MiB, W0_W1 = WS_W + 21 * MiB, W0_W2 = WS_W + 23 * MiB, W0_O = WS_W + 24 * MiB, W0_UP = WS_W + 32 * MiB, W0_DN = WS_W + 64 * MiB;
constexpr size_t W1_IN = WS_W, W1_O = WS_W + 32 * MiB, W1_UP = WS_W + 40 * MiB, W1_DN = WS_W + 72 * MiB;
constexpr size_t WS_A = 120 * MiB;
constexpr size_t WS_BIG = 184 * MiB;
constexpr size_t WS_SCR = 440 * MiB;
constexpr size_t WS_X8 = WS_BIG + 128 * MiB;
constexpr float W8SCALE = 64.f, H8SCALE = 4.f;
constexpr size_t WS_X16 = 440 * MiB;
constexpr size_t WS_RINV = 1 * MiB + 64 * 1024;
constexpr size_t WS_SLOTS = 504 * MiB;
constexpr size_t WS_END = 508 * MiB;
constexpr int CW_XTMO = 64, CW_CONVQ = 128, CW_PANEL = 8192;

constexpr int LDS_BYTES = 147456;

#define GAS __attribute__((address_space(1)))
#define LAS __attribute__((address_space(3)))
typedef unsigned short bf16;
typedef unsigned v4u __attribute__((ext_vector_type(4)));
typedef unsigned v2u __attribute__((ext_vector_type(2)));
typedef float f32x4 __attribute__((ext_vector_type(4)));
#define LDS_WAIT() asm volatile("s_waitcnt lgkmcnt(0)" ::: "memory")
#define VM_WAIT() asm volatile("s_waitcnt vmcnt(0)" ::: "memory")
__device__ __forceinline__ unsigned f2bf(float f) { unsigned u = __builtin_bit_cast(unsigned, f); return (u + 0x7fffu + ((u >> 16) & 1u)) >> 16; }
__device__ __forceinline__ unsigned pk2(float lo, float hi) { return f2bf(lo) | (f2bf(hi) << 16); }
__device__ __forceinline__ float bf2f(unsigned b) { return __builtin_bit_cast(float, b << 16); }
__device__ __forceinline__ float bflo(unsigned w) { return __builtin_bit_cast(float, w << 16); }
__device__ __forceinline__ float bfhi(unsigned w) { return __builtin_bit_cast(float, w & 0xffff0000u); }
__device__ __forceinline__ float wave_sum(float v) {
#pragma unroll
    for (int o = 1; o < 64; o <<= 1) v += __shfl_xor(v, o);
    return v;
}
__device__ __forceinline__ float wave_max(float v) {
#pragma unroll
    for (int o = 1; o < 64; o <<= 1) v = fmaxf(v, __shfl_xor(v, o));
    return v;
}
__device__ __forceinline__ int lane_id() { int l; asm volatile("v_mbcnt_lo_u32_b32 %0, -1, 0\n\tv_mbcnt_hi_u32_b32 %0, -1, %0" : "=v"(l)); return l; }
__device__ __forceinline__ float sigmoidf_(float x) { return 1.f / (1.f + __expf(-x)); }

typedef GAS unsigned gu32;
#define RLX_AGENT __ATOMIC_RELAXED, __HIP_MEMORY_SCOPE_AGENT
#define XB_TMO      128
#define XB_XCNT(j)  (256  + 64 * (j))
#define XB_XSUB(j)  (1280 + 64 * (j))
#define XB_XGEN(j)  (2304 + 64 * (j))
#define XB_TOP      3328
#define XB_TOPGEN   3392
#define XCD_BAR_WORDS 3456
#define XB_SPIN_CAP (1u << 24)

__device__ __forceinline__ unsigned xb_ld(unsigned* p)              { return __hip_atomic_load(p, __ATOMIC_RELAXED, __HIP_MEMORY_SCOPE_AGENT); }
__device__ __forceinline__ unsigned xb_add(unsigned* p, unsigned v) { return __hip_atomic_fetch_add(p, v, __ATOMIC_RELAXED, __HIP_MEMORY_SCOPE_AGENT); }
__device__ __forceinline__ unsigned xb_xcc_id() { return (unsigned)__builtin_amdgcn_s_getreg((3 << 11) | 20) & 0xFu; }
#define XB_SPIN(cond, bar) do { unsigned _sp = 0; while (cond) { __builtin_amdgcn_s_sleep(1); \
    if ((++_sp & 255u) == 0u) { if (xb_ld(&(bar)[XB_TMO])) break; if (_sp > XB_SPIN_CAP) { atomicAdd(&(bar)[XB_TMO], 1u); break; } } } } while (0)

struct XcdBarrier {
    int wave;
    unsigned* bar; unsigned x;
    volatile LAS unsigned* st;
};

__device__ __forceinline__ XcdBarrier xcd_barrier_post(unsigned* bar, volatile LAS unsigned* st, int wave) {
    XcdBarrier b; b.wave = wave; b.bar = bar; b.x = xb_xcc_id(); b.st = st;
    if (wave == 0 && lane_id() == 0) (void)xb_add(&bar[XB_XCNT(b.x)], 1u);
    return b;
}
__device__ __forceinline__ void xcd_barrier_complete(unsigned* bar, unsigned x, unsigned& nloc, unsigned& nx) {
    const unsigned G = gridDim.x * gridDim.y * gridDim.z;
    unsigned sum, cnt, mine, sp = 0u;
    for (;;) {
        sum = 0u; cnt = 0u; mine = 0u;
#pragma unroll
        for (unsigned j = 0; j < 16; ++j) { const unsigned c = xb_ld(&bar[XB_XCNT(j)]); sum += c; cnt += (c > 0u) ? 1u : 0u; mine = (j == x) ? c : mine; }
        if (sum == G) break;
        __builtin_amdgcn_s_sleep(1);
        if ((++sp & 255u) == 0u) { if (xb_ld(&bar[XB_TMO])) break; if (sp > XB_SPIN_CAP) { atomicAdd(&bar[XB_TMO], 1u); break; } }
    }
    nloc = mine > 0u ? mine : 1u; nx = cnt > 0u ? cnt : 1u;
}

__device__ __forceinline__ void xcd_barrier(const XcdBarrier& b) {
    asm volatile("s_waitcnt vmcnt(0)" ::: "memory");
    __syncthreads();
    if (b.wave == 0 && lane_id() == 0) {
        unsigned* bar = b.bar;
        __builtin_amdgcn_s_waitcnt(0);
        unsigned nloc = b.st[0], nx = b.st[1];
        if (nloc == 0u) { xcd_barrier_complete(bar, b.x, nloc, nx); b.st[0] = nloc; b.st[1] = nx; }
        const unsigned old = xb_add(&bar[XB_XSUB(b.x)], 1u);
        const unsigned gen = old / nloc;
        if (old + 1u == (gen + 1u) * nloc) {
            __builtin_amdgcn_fence(__ATOMIC_RELEASE, "agent");
            asm volatile("s_waitcnt vmcnt(0)" ::: "memory");
            const unsigned og = xb_add(&bar[XB_TOP], 1u);
            const unsigned tg = og / nx;
            if (og + 1u == (tg + 1u) * nx) xb_add(&bar[XB_TOPGEN], 1u);
            else XB_SPIN(xb_ld(&bar[XB_TOPGEN]) == tg, bar);
            __builtin_amdgcn_fence(__ATOMIC_ACQUIRE, "agent");
            xb_add(&bar[XB_XGEN(b.x)], 1u);
            asm volatile("s_waitcnt vmcnt(0)" ::: "memory");
        } else {
            XB_SPIN(xb_ld(&bar[XB_XGEN(b.x)]) == gen, bar);
            __builtin_amdgcn_fence(__ATOMIC_ACQUIRE, "agent");
            asm volatile("s_waitcnt vmcnt(0)" ::: "memory");
        }
    }
    __syncthreads();
}

struct Frame {
    LAS unsigned char* lds;
    int tid, lane, wave, G, gw, NGW;
    const float *x, *norm_g, *rel, *w_in, *pe, *cw1, *cw2, *w_out, *h_in, *h_lb, *h_on, *h_out, *up, *dn;
    float* out;
    unsigned char* ws;
};

template <int ACT  > struct EpiAct {
    static constexpr bool PERM = true, AFTER_DRAIN = false;
    bf16* O; int ldc; int scale_tiles; float scale; const float* lb; const float* rs; float rsmul;
    __device__ __forceinline__ void prefetch(const pg8::Unit& u, int wr, int fr, float (&pre)[8]) const {
        const int row0 = u.pm * 256 + wr * 64 + fr;
#pragma unroll
        for (int j = 0; j < 8; ++j) pre[j] = rs ? rs[row0 + (j >> 2) * 128 + (j & 3) * 16] * rsmul : 1.f;
    }
    __device__ __forceinline__ void operator()(const pg8::f32x4 (&acc)[2][2][4][2], const pg8::Unit& u, int wr, int wc, int fr, int fq, const float (&pre)[8]) const {
        const int row0 = u.pm * 256 + wr * 64 + fr, col0 = u.pn * 256 + wc * 32 + 8 * fq;
        const float sc = (u.pn < scale_tiles) ? scale : 1.f;
        const int kind = (ACT == 2) ? ((u.pn < 8 || u.pn >= 24) ? 1 : (u.pn < 16 ? 2 : 0)) : 0;
        pg8::f32x4 lbv[2][2];
        if (ACT == 2) {
#pragma unroll
            for (int bj = 0; bj < 2; ++bj)
#pragma unroll
                for (int n = 0; n < 2; ++n) lbv[bj][n] = (kind == 2) ? *(const pg8::f32x4*)(lb + (col0 - 2048) + bj * 128 + 4 * n) : (pg8::f32x4){0.f, 0.f, 0.f, 0.f};
        }
#pragma unroll
        for (int ai = 0; ai < 2; ++ai)
#pragma unroll
            for (int m = 0; m < 4; ++m) { bf16* rowp = O + (size_t)(row0 + ai * 128 + m * 16) * ldc + col0; const float rsc = pre[ai * 4 + m];
#pragma unroll
                for (int bj = 0; bj < 2; ++bj) { pg8::f32x4 v0 = acc[ai][bj][m][0] * rsc, v1 = acc[ai][bj][m][1] * rsc;
                    if (ACT == 2) {
                        if (kind == 1) {
#pragma unroll
                            for (int j = 0; j < 4; ++j) { v0[j] = v0[j] * __builtin_amdgcn_rcpf(1.f + __expf(-v0[j])); v1[j] = v1[j] * __builtin_amdgcn_rcpf(1.f + __expf(-v1[j])); }
                        } else if (kind == 2) {
#pragma unroll
                            for (int j = 0; j < 4; ++j) { const float l0 = lbv[bj][0][j], l1 = lbv[bj][1][j];
                                v0[j] = __logf(l0 + (1.f - l0) * __builtin_amdgcn_rcpf(1.f + __expf(-v0[j]))); v1[j] = __logf(l1 + (1.f - l1) * __builtin_amdgcn_rcpf(1.f + __expf(-v1[j]))); }
                        }
                    } else { v0 = v0 * sc; v1 = v1 * sc; }
                    pg8::u32x4 w; w.x = pg8::cvt_pk_bf16(v0[0], v0[1]); w.y = pg8::cvt_pk_bf16(v0[2], v0[3]); w.z = pg8::cvt_pk_bf16(v1[0], v1[1]); w.w = pg8::cvt_pk_bf16(v1[2], v1[3]);
                    if (ACT == 2) __builtin_nontemporal_store(w, (pg8::u32x4*)(rowp + bj * 128));
                    else *(pg8::u32x4*)(rowp + bj * 128) = w; } }
    }
};

__device__ __forceinline__ unsigned pk8(float a, float b, float c, float d) { int w = 0; w = __builtin_amdgcn_cvt_pk_fp8_f32(a, b, w, false); w = __builtin_amdgcn_cvt_pk_fp8_f32(c, d, w, true); return (unsigned)w; }
struct EpiUp8 {
    static constexpr bool PERM = true, AFTER_DRAIN = false;
    unsigned char* O; int ldc; const float* rs;
    __device__ __forceinline__ void prefetch(const pg8::Unit& u, int wr, int fr, float (&pre)[8]) const {
        const int row0 = u.pm * 256 + wr * 64 + fr;
#pragma unroll
        for (int j = 0; j < 8; ++j) pre[j] = rs[row0 + (j >> 2) * 128 + (j & 3) * 16] * (2.f / W8SCALE);
    }
    __device__ __forceinline__ void operator()(const pg8::f32x4 (&acc)[2][2][4][2], const pg8::Unit& u, int wr, int wc, int fr, int fq, const float (&pre)[8]) const {
        static_assert(H8SCALE == 4.f, "EpiUp8 folds sqrt(H8SCALE) = 2 into the row scale");
        const int row0 = u.pm * 256 + wr * 64 + fr, col0 = u.pn * 256 + wc * 32 + 8 * fq;
#pragma unroll
        for (int ai = 0; ai < 2; ++ai)
#pragma unroll
            for (int m = 0; m < 4; ++m) { const float rsc = pre[ai * 4 + m]; v2u w[2];
#pragma unroll
                for (int bj = 0; bj < 2; ++bj) { pg8::f32x4 v0 = acc[ai][bj][m][0] * rsc, v1 = acc[ai][bj][m][1] * rsc;
#pragma unroll
                    for (int j = 0; j < 4; ++j) { v0[j] = __builtin_amdgcn_fmed3f(v0[j], 0.f, 21.166010488f); v1[j] = __builtin_amdgcn_fmed3f(v1[j], 0.f, 21.166010488f); }
                    v0 = v0 * v0; v1 = v1 * v1;
                    w[bj].x = pk8(v0[0], v0[1], v0[2], v0[3]); w[bj].y = pk8(v1[0], v1[1], v1[2], v1[3]); }
                const auto sx = __builtin_amdgcn_permlane16_swap(w[0].x, w[1].x, false, false); const auto sy = __builtin_amdgcn_permlane16_swap(w[0].y, w[1].y, false, false);
                *(v4u*)(O + (size_t)(row0 + ai * 128 + m * 16) * ldc + u.pn * 256 + wc * 32 + 8 * (fq & ~1) + (fq & 1) * 128) = (v4u){sx[0], sy[0], sx[1], sy[1]}; }
    }
};

struct PanelSq {
    float* slots;
    unsigned* cnt;
    unsigned* tmo;
    template <class Fn> __device__ __forceinline__ void run(const float (&ssl)[8], const pg8::Unit& u, int wr, int wc, int fr, int fq, LAS unsigned char* lds, int wid, int lane, Fn&& between) const {
        LAS float* P = (LAS float*)lds; LAS float* S = (LAS float*)(lds + 8192);
#pragma unroll
        for (int j = 0; j < 8; ++j) { float t = ssl[j]; t += __shfl_xor(t, 16); t += __shfl_xor(t, 32);
            if (fq == 0) P[((j >> 2) * 128 + wr * 64 + (j & 3) * 16 + fr) * 4 + wc] = t; }
        asm volatile("s_waitcnt lgkmcnt(0)" ::: "memory"); __builtin_amdgcn_s_barrier(); asm volatile("" ::: "memory");
        const int row = wid * 32 + (lane & 31);
        if (lane < 32) { const f32x4 p4 = *(const LAS f32x4*)(P + row * 4); const float t = (p4.x + p4.y) + (p4.z + p4.w);
            __hip_atomic_store((unsigned*)(slots + (size_t)(u.pm * 256 + row) * 8 + u.pn), __builtin_bit_cast(unsigned, t), __ATOMIC_RELAXED, __HIP_MEMORY_SCOPE_AGENT); }
        asm volatile("s_waitcnt vmcnt(0)" ::: "memory");
        if (lane == 0) __hip_atomic_fetch_add(cnt + 64 * u.pm, 1u, __ATOMIC_RELAXED, __HIP_MEMORY_SCOPE_AGENT);
        between();
        if (wid == 0) {
            unsigned sp = 0;
            while ((unsigned)__builtin_amdgcn_readfirstlane(__hip_atomic_load(cnt + 64 * u.pm, __ATOMIC_RELAXED, __HIP_MEMORY_SCOPE_AGENT)) < 64u) {
                __builtin_amdgcn_s_sleep(1);
                if ((++sp & 255u) == 0u) { if (__hip_atomic_load(tmo, __ATOMIC_RELAXED, __HIP_MEMORY_SCOPE_AGENT)) break; if (sp > (1u << 24)) { if (lane == 0) __hip_atomic_store(tmo, 1u, __ATOMIC_RELAXED, __HIP_MEMORY_SCOPE_AGENT); break; } } }
            __builtin_amdgcn_fence(__ATOMIC_ACQUIRE, "agent");
        }
        asm volatile("s_waitcnt vmcnt(0) lgkmcnt(0)" ::: "memory"); __builtin_amdgcn_s_barrier(); asm volatile("" ::: "memory");
        if (lane < 32) { const unsigned* sl = (const unsigned*)(slots + (size_t)(u.pm * 256 + row) * 8); float t = 0.f;
#pragma unroll
            for (int o = 0; o < 8; ++o) t += __builtin_bit_cast(float, __hip_atomic_load(sl + o, __ATOMIC_RELAXED, __HIP_MEMORY_SCOPE_AGENT));
            S[row] = t; }
        asm volatile("s_waitcnt vmcnt(0) lgkmcnt(0)" ::: "memory"); __builtin_amdgcn_s_barrier(); asm volatile("" ::: "memory");
    }
};
struct PanelSqLast {
    float* slots; unsigned* cnt; float* rinv;
    __device__ __forceinline__ void run(const float (&ssl)[8], const pg8::Unit& u, int wr, int wc, int fr, int fq, LAS unsigned char* lds, int wid, int lane) const {
        LAS float* P = (LAS float*)lds;
#pragma unroll
        for (int j = 0; j < 8; ++j) { float t = ssl[j]; t += __shfl_xor(t, 16); t += __shfl_xor(t, 32);
            if (fq == 0) P[((j >> 2) * 128 + wr * 64 + (j & 3) * 16 + fr) * 4 + wc] = t; }
        asm volatile("s_waitcnt lgkmcnt(0)" ::: "memory"); __builtin_amdgcn_s_barrier(); asm volatile("" ::: "memory");
        const int row = wid * 32 + (lane & 31);
        if (lane < 32) { const f32x4 p4 = *(const LAS f32x4*)(P + row * 4); const float t = (p4.x + p4.y) + (p4.z + p4.w);
            __hip_atomic_store((unsigned*)(slots + (size_t)(u.pm * 256 + row) * 8 + u.pn), __builtin_bit_cast(unsigned, t), __ATOMIC_RELAXED, __HIP_MEMORY_SCOPE_AGENT); }
        asm volatile("s_waitcnt vmcnt(0)" ::: "memory");
        unsigned old = 0u;
        if (lane == 0) old = __hip_atomic_fetch_add(cnt + 64 * u.pm, 1u, __ATOMIC_RELAXED, __HIP_MEMORY_SCOPE_AGENT);
        old = (unsigned)__builtin_amdgcn_readfirstlane((int)old);
        if (old == 63u) {
            __builtin_amdgcn_fence(__ATOMIC_ACQUIRE, "agent"); asm volatile("s_waitcnt vmcnt(0)" ::: "memory");
#pragma unroll
            for (int q = 0; q < 4; ++q) { const int r = q * 64 + lane; const unsigned* sl = (const unsigned*)(slots + (size_t)(u.pm * 256 + r) * 8); float t = 0.f;
#pragma unroll
                for (int o = 0; o < 8; ++o) t += __builtin_bit_cast(float, __hip_atomic_load(sl + o, __ATOMIC_RELAXED, __HIP_MEMORY_SCOPE_AGENT));
                rinv[u.pm * 256 + r] = 1.f / sqrtf(t * (1.f / DM) + RMS_EPS); } }
    }
};
template <bool XF32  , bool FINAL  , bool W8  > struct EpiRmsRes {
    static constexpr bool PERM = true, AFTER_DRAIN = true;
    const void* xold; bf16* xnew; float* outf; const float* g; unsigned char* x8; float osc  ; PanelSq st1; PanelSqLast st2;
    __device__ __forceinline__ void prefetch(const pg8::Unit&, int, int, float (&)[8]) const {}
    __device__ __forceinline__ void fused(pg8::f32x4 (&acc)[2][2][4][2], const pg8::Unit& u, int, int, int, int, LAS unsigned char* lds, int wid, int) const {
        const int lane = lane_id(), fr = lane & 15, fq = lane >> 4, wr = wid >> 2, wc = wid & 3;
        const LAS float* S = (const LAS float*)(lds + 8192);
        const int col0 = u.pn * 256 + wc * 32 + 8 * fq;
        float ssl[8];
#pragma unroll
        for (int ai = 0; ai < 2; ++ai)
#pragma unroll
            for (int m = 0; m < 4; ++m) { float t = 0.f;
#pragma unroll
                for (int bj = 0; bj < 2; ++bj)
#pragma unroll
                    for (int n = 0; n < 2; ++n) { const pg8::f32x4 v = acc[ai][bj][m][n]; t += (v[0] * v[0] + v[1] * v[1]) + (v[2] * v[2] + v[3] * v[3]); }
                ssl[ai * 4 + m] = t; }
        constexpr int NPRE = XF32 ? 4 : 8;
        v4u xpre[NPRE][2];
        pg8::f32x4 gv[2][2];
        st1.run(ssl, u, wr, wc, fr, fq, lds, wid, lane, [&]() {
            if (!XF32) { const char* xb = (const char*)xold + (size_t)u.pm * 256 * DM * 2; asm volatile("" : "+s"(xb));
                const unsigned o0 = (unsigned)(((wr * 64 + fr) * DM + col0) * 2);
#pragma unroll
                for (int j = 0; j < 8; ++j)
#pragma unroll
                    for (int bj = 0; bj < 2; ++bj) xpre[j][bj] = *(const GAS v4u*)(xb + (o0 + (unsigned)((((j >> 2) * 128 + (j & 3) * 16) * DM + bj * 128) * 2)));
            }
#pragma unroll
            for (int bj = 0; bj < 2; ++bj)
#pragma unroll
                for (int n = 0; n < 2; ++n) gv[bj][n] = *(const pg8::f32x4*)(g + col0 + bj * 128 + 4 * n);
        });
#pragma unroll
        for (int ai = 0; ai < 2; ++ai)
#pragma unroll
            for (int m = 0; m < 4; ++m) { const int rl = ai * 128 + wr * 64 + m * 16 + fr; const float ry = osc / sqrtf(S[rl] * (osc * osc * (1.f / DM)) + RMS_EPS);
                const size_t off = (size_t)(u.pm * 256 + rl) * DM + col0; float t = 0.f; v2u w8p[2] = {(v2u){0u, 0u}, (v2u){0u, 0u}};
#pragma unroll
                for (int bj = 0; bj < 2; ++bj) { pg8::f32x4 x0, x1;
                    if (XF32) { x0 = *(const pg8::f32x4*)((const float*)xold + off + bj * 128); x1 = *(const pg8::f32x4*)((const float*)xold + off + bj * 128 + 4); }
                    else { const v4u w = xpre[ai * 4 + m][bj]; x0 = (pg8::f32x4){bflo(w.x), bfhi(w.x), bflo(w.y), bfhi(w.y)}; x1 = (pg8::f32x4){bflo(w.z), bfhi(w.z), bflo(w.w), bfhi(w.w)}; }
                    const pg8::f32x4 a0 = x0 + acc[ai][bj][m][0] * ry * gv[bj][0], a1 = x1 + acc[ai][bj][m][1] * ry * gv[bj][1];
                    t += ((a0[0] * a0[0] + a0[1] * a0[1]) + (a0[2] * a0[2] + a0[3] * a0[3])) + ((a1[0] * a1[0] + a1[1] * a1[1]) + (a1[2] * a1[2] + a1[3] * a1[3]));
                    if (FINAL) { *(pg8::f32x4*)(outf + off + bj * 128) = a0; *(pg8::f32x4*)(outf + off + bj * 128 + 4) = a1; }
                    else { pg8::u32x4 w; w.x = pg8::cvt_pk_bf16(a0[0], a0[1]); w.y = pg8::cvt_pk_bf16(a0[2], a0[3]); w.z = pg8::cvt_pk_bf16(a1[0], a1[1]); w.w = pg8::cvt_pk_bf16(a1[2], a1[3]);
                        *(pg8::u32x4*)(xnew + off + bj * 128) = w;
                        if (W8) { w8p[bj].x = pk8(__builtin_amdgcn_fmed3f(a0[0], -448.f, 448.f), __builtin_amdgcn_fmed3f(a0[1], -448.f, 448.f), __builtin_amdgcn_fmed3f(a0[2], -448.f, 448.f), __builtin_amdgcn_fmed3f(a0[3], -448.f, 448.f));
                            w8p[bj].y = pk8(__builtin_amdgcn_fmed3f(a1[0], -448.f, 448.f), __builtin_amdgcn_fmed3f(a1[1], -448.f, 448.f), __builtin_amdgcn_fmed3f(a1[2], -448.f, 448.f), __builtin_amdgcn_fmed3f(a1[3], -448.f, 448.f)); } } }
                if (W8 && !FINAL) {
                    const auto sx = __builtin_amdgcn_permlane16_swap(w8p[0].x, w8p[1].x, false, false); const auto sy = __builtin_amdgcn_permlane16_swap(w8p[0].y, w8p[1].y, false, false);
                    *(v4u*)(x8 + (size_t)(u.pm * 256 + rl) * DM + u.pn * 256 + wc * 32 + 8 * (fq & ~1) + (fq & 1) * 128) = (v4u){sx[0], sy[0], sx[1], sy[1]}; }
                ssl[ai * 4 + m] = t;
                if (XF32 && (m & 1)) asm volatile("" ::: "memory"); }
        if (FINAL) return;
        st2.run(ssl, u, wr, wc, fr, fq, lds, wid, lane);
    }
};

__device__ __forceinline__ void tr_item(const float* W, int ldw, int K, int ncols, bf16* WT, LAS float* scr, int item, int lane, const float* gk = nullptr) {
    const int nblk = (ncols + 31) / 32, kb = item / nblk, nb = item % nblk, k0 = 64 * kb, n0 = 32 * nb;
    const int nn = n0 + (lane & 31);
    float wv[32];
#pragma unroll
    for (int i = 0; i < 32; ++i) { const int kk = 2 * i + (lane >> 5); wv[i] = (nn < ncols) ? W[(size_t)(k0 + kk) * ldw + nn] : 0.f; }
#pragma unroll
    for (int i = 0; i < 32; ++i) { const int kk = 2 * i + (lane >> 5); scr[kk * 33 + (lane & 31)] = wv[i] * (gk ? gk[k0 + kk] : 1.f); }
    LDS_WAIT(); asm volatile("" ::: "memory");
    const int c = lane & 7;
#pragma unroll
    for (int j = 0; j < 4; ++j) { const int n = (lane >> 3) + 8 * j; const LAS float* s = scr + (8 * c) * 33 + n;
        v4u o; o.x = pk2(s[0 * 33], s[1 * 33]); o.y = pk2(s[2 * 33], s[3 * 33]); o.z = pk2(s[4 * 33], s[5 * 33]); o.w = pk2(s[6 * 33], s[7 * 33]);
        *(GAS v4u*)(WT + (size_t)(n0 + n) * K + k0 + 8 * c) = o; }
    LDS_WAIT(); asm volatile("" ::: "memory");
}
__device__ __forceinline__ void tr_item8(const float* W, int ldw, int K, int ncols, unsigned char* WT, LAS float* scr, int item, int lane, const float* gk = nullptr) {
    const int nblk = ncols / 32, kb = item / nblk, nb = item % nblk, k0 = 64 * kb, n0 = 32 * nb;
    const int nn = n0 + (lane & 31);
    float wv[32];
#pragma unroll
    for (int i = 0; i < 32; ++i) { const int kk = 2 * i + (lane >> 5); wv[i] = W[(size_t)(k0 + kk) * ldw + nn]; }
#pragma unroll
    for (int i = 0; i < 32; ++i) { const int kk = 2 * i + (lane >> 5); scr[kk * 33 + (lane & 31)] = wv[i] * (gk ? gk[k0 + kk] * W8SCALE : W8SCALE); }
    LDS_WAIT(); asm volatile("" ::: "memory");
    const int c = lane & 7;
#pragma unroll
    for (int j = 0; j < 4; ++j) { const int n = (lane >> 3) + 8 * j; const LAS float* s = scr + (8 * c) * 33 + n;
        v2u o; o.x = pk8(__builtin_amdgcn_fmed3f(s[0 * 33], -448.f, 448.f), __builtin_amdgcn_fmed3f(s[1 * 33], -448.f, 448.f), __builtin_amdgcn_fmed3f(s[2 * 33], -448.f, 448.f), __builtin_amdgcn_fmed3f(s[3 * 33], -448.f, 448.f));
        o.y = pk8(__builtin_amdgcn_fmed3f(s[4 * 33], -448.f, 448.f), __builtin_amdgcn_fmed3f(s[5 * 33], -448.f, 448.f), __builtin_amdgcn_fmed3f(s[6 * 33], -448.f, 448.f), __builtin_amdgcn_fmed3f(s[7 * 33], -448.f, 448.f));
        *(GAS v2u*)(WT + (size_t)(n0 + n) * K + k0 + 8 * c) = o; }
    LDS_WAIT(); asm volatile("" ::: "memory");
}
#define TR_JOB8G(Wp, ldw, K, ncols, WTp, gk) { const int ni_ = ((K) / 64) * ((ncols) / 32); if (r < ni_) { tr_item8((Wp), (ldw), (K), (ncols), (WTp), scr, r, F.lane, (gk)); continue; } r -= ni_; }
#define TR_JOBG(Wp, ldw, K, ncols, WTp, gk) { const int ni_ = ((K) / 64) * (((ncols) + 31) / 32); if (r < ni_) { tr_item((Wp), (ldw), (K), (ncols), (WTp), scr, r, F.lane, (gk)); continue; } r -= ni_; }
#define TR_JOB(Wp, ldw, K, ncols, WTp) TR_JOBG(Wp, ldw, K, ncols, WTp, nullptr)

__device__ __forceinline__ int rel_bucket(int n) {
    if (n < 16) return n;
    const float v = logf((float)n / 16.f) / 2.0794415416798357f * 16.f;
    const int l = 16 + (int)v; return l < 31 ? l : 31;
}

__device__ __forceinline__ void p0_prologue(Frame& F) {
    LAS float* scr = (LAS float*)(F.lds + F.wave * 16384);
    unsigned char* ws = F.ws;
    constexpr int NITEMS = (DM / 64) * (NQKV / 32) + (DM / 64) * 2 + 2 * (4096 / 64) * 4 + 2 * 2 * 4 + (DM / 64) * (DM / 32) + (DM / 64) * (FF / 32) + (FF / 64) * (DM / 32);
    for (int it = F.gw; it < NITEMS; it += F.NGW) {
        int r = it;
        TR_JOBG(F.w_in, NSA_IN, DM, NQKV, (bf16*)(ws + W0_QKV), F.norm_g)
        TR_JOBG(F.w_in + NQKV, NSA_IN, DM, NGATE, (bf16*)(ws + W0_G), F.norm_g)
        TR_JOB(F.cw1, HD, 4096, HD, (bf16*)(ws + W0_W1))
        TR_JOB(F.cw1 + 4096 * HD, HD, 4096, HD, (bf16*)(ws + W0_W1) + HD * 4096)
        TR_JOB(F.cw2, HD, HD, HD, (bf16*)(ws + W0_W2))
        TR_JOB(F.cw2 + HD * HD, HD, HD, HD, (bf16*)(ws + W0_W2) + HD * HD)
        TR_JOB(F.w_out, DM, DM, DM, (bf16*)(ws + W0_O))
        TR_JOB8G(F.up, FF, DM, FF, ws + W0_UP, F.norm_g + 2 * DM)
        TR_JOB8G(F.dn, DM, FF, DM, ws + W0_DN, nullptr)
    }
    if (blockIdx.x == 0) {
        float* lut = (float*)(ws + WS_LUT);
        for (int i = F.tid; i < NH * 128; i += NTHREADS) { const int h = i >> 7, d = i & 127; lut[i] = F.rel[rel_bucket(d) * NH + h] * 1.4426950408889634f; }
    }
    if (blockIdx.x == 1) {
        float* lb = (float*)(ws + WS_LB);
        for (int i = F.tid; i < DM; i += NTHREADS) lb[i] = 1.f / (1.f + expf(F.h_lb[i] - F.h_lb[DM + i]));
    }
    for (int it = F.gw; it < 2 * HD * 8; it += F.NGW) {
        const int k8 = it & 7, n = (it >> 3) & 127, kv = it >> 10; const float* pe = F.pe + kv * 4096 + 512 * k8; const float* w1 = F.cw1 + ((size_t)kv * 4096 + 512 * k8) * HD + n;
        float wv[8]; float s = 0.f;
#pragma unroll
        for (int j = 0; j < 8; ++j) wv[j] = w1[(size_t)(64 * j + F.lane) * HD];
#pragma unroll
        for (int j = 0; j < 8; ++j) s += pe[64 * j + F.lane] * wv[j];
        s = wave_sum(s);
        if (F.lane == 0) ((float*)(ws + WS_BIAS1))[k8 * 256 + kv * HD + n] = s;
    }
    { const int lane = F.lane; f32x4 xv[8]; int m = F.gw; float* rinv = (float*)(ws + WS_RINV);
      if (m < M) { const GAS f32x4* xr = (const GAS f32x4*)(F.x + (size_t)m * DM) + 2 * lane;
#pragma unroll
          for (int j = 0; j < 8; ++j) xv[j] = xr[128 * (j >> 1) + (j & 1)]; }
      for (; m < M; m += F.NGW) { f32x4 xn[8]; const int m2 = m + F.NGW;
          if (m2 < M) { const GAS f32x4* xr = (const GAS f32x4*)(F.x + (size_t)m2 * DM) + 2 * lane;
#pragma unroll
              for (int j = 0; j < 8; ++j) xn[j] = xr[128 * (j >> 1) + (j & 1)]; }
          float s = 0.f;
#pragma unroll
          for (int j = 0; j < 8; ++j) s += (xv[j].x * xv[j].x + xv[j].y * xv[j].y) + (xv[j].z * xv[j].z + xv[j].w * xv[j].w);
          const float r = 1.f / sqrtf(wave_sum(s) * (1.f / DM) + RMS_EPS);
          if (lane == 0) rinv[m] = r;
          GAS v4u* o16 = (GAS v4u*)((bf16*)(ws + WS_A) + (size_t)m * DM) + lane;
#pragma unroll
          for (int jj = 0; jj < 4; ++jj) { v4u w; w.x = pk2(xv[2 * jj].x, xv[2 * jj].y); w.y = pk2(xv[2 * jj].z, xv[2 * jj].w); w.z = pk2(xv[2 * jj + 1].x, xv[2 * jj + 1].y); w.w = pk2(xv[2 * jj + 1].z, xv[2 * jj + 1].w); o16[64 * jj] = w; }
#pragma unroll
          for (int j = 0; j < 8; ++j) xv[j] = xn[j]; } }
}
__device__ __forceinline__ void p_convert_l1a(Frame& F) {
    LAS float* scr = (LAS float*)(F.lds + F.wave * 16384);
    unsigned char* ws = F.ws;
    constexpr int NITEMS = (DM / 64) * (FF / 32);
    for (int it = F.gw; it < NITEMS; it += F.NGW) {
        int r = it;
        TR_JOB8G(F.h_in, FF, DM, FF, ws + W1_IN, F.norm_g + 4 * DM)
    }
}
__device__ __forceinline__ void p_convert_l1b(Frame& F, int first  , int nstatic  ) {
    LAS float* scr = (LAS float*)(F.lds + F.wave * 16384);
    unsigned char* ws = F.ws; unsigned* q = (unsigned*)(ws + WS_CTL) + CW_CONVQ;
    constexpr int NITEMS = (DM / 64) * (DM / 32) + (DM / 64) * (FF / 32) + (FF / 64) * (DM / 32);
    int chunk = first;
    for (;;) {
        if (chunk < 0) { unsigned t = 0u; if (F.lane == 0) t = __hip_atomic_fetch_add(q, 1u, __ATOMIC_RELAXED, __HIP_MEMORY_SCOPE_AGENT);
            chunk = nstatic + __builtin_amdgcn_readfirstlane((int)t); }
        const int base = 8 * chunk; chunk = -1;
        if (base >= NITEMS) break;
        const int end = base + 8 < NITEMS ? base + 8 : NITEMS;
        for (int it = base; it < end; ++it) {
            int r = it;
            TR_JOB(F.h_out, DM, DM, DM, (bf16*)(ws + W1_O))
            TR_JOB8G(F.up + (size_t)DM * FF, FF, DM, FF, ws + W1_UP, F.norm_g + 6 * DM)
            TR_JOB8G(F.dn + (size_t)FF * DM, DM, FF, DM, ws + W1_DN, nullptr)
        }
    }
}


namespace cg {
typedef short bf16x8 __attribute__((ext_vector_type(8)));
typedef float f32x16 __attribute__((ext_vector_type(16)));
typedef float f32x4c __attribute__((ext_vector_type(4)));
constexpr int L_PART = 0, L_H = 131072, HRS = 272;
static_assert(L_H + 32 * HRS <= LDS_BYTES - 256, "cg LDS map");
__device__ __forceinline__ float gelu_tanh_f(float x) { const float u = 0.7978845608028654f * (x + 0.044715f * x * x * x); const float e = __expf(2.f * u); return x * (1.f - 1.f / (e + 1.f)); }

__device__ __forceinline__ void cmp_gate_phase(LAS unsigned char* lds, unsigned char* wsb, int G, const int tid) {
    const int wid = __builtin_amdgcn_readfirstlane(tid >> 6), lane = tid & 63, r32 = lane & 31, hh = lane >> 5, li = lane & 15, kq = lane >> 4;
    const bf16* proj = (const bf16*)(wsb + WS_BIG); const bf16* w1t = (const bf16*)(wsb + W0_W1); const bf16* w2t = (const bf16*)(wsb + W0_W2); const float* bias1 = (const float*)(wsb + WS_BIAS1);
    const bf16* hn = (const bf16*)(wsb + WS_A); const bf16* wg = (const bf16*)(wsb + W0_G); float* gates = (float*)(wsb + WS_GATES); const float* rinv = (const float*)(wsb + WS_RINV);
    for (int u = blockIdx.x; u < 256; u += G) {
        const int kv = u >> 7, R0 = (u & 127) * 32, b = R0 >> 9, g = (R0 >> 7) & 3, c0 = R0 & 127;
        const int ca = (c0 + li) < NC ? (c0 + li) : NC - 1, cb = (c0 + 16 + li) < NC ? (c0 + 16 + li) : NC - 1;
        const bf16* ar0 = proj + ((size_t)b * SEQ + 16 * ca + 4 * wid) * NQKV + (kv ? COL_VC : COL_KC) + g * HD + 8 * kq;
        const bf16* ar1 = proj + ((size_t)b * SEQ + 16 * cb + 4 * wid) * NQKV + (kv ? COL_VC : COL_KC) + g * HD + 8 * kq;
        const bf16* bcol = w1t + (size_t)kv * HD * 4096 + (size_t)li * 4096 + 512 * wid + 8 * kq;
        f32x4c acc[2][8];
#pragma unroll
        for (int rt = 0; rt < 2; ++rt)
#pragma unroll
            for (int ct = 0; ct < 8; ++ct) acc[rt][ct] = (f32x4c){0.f, 0.f, 0.f, 0.f};
        for (int bt = 0; bt < 8; ++bt) {
            bf16x8 av[2][2], bv[2][8];
#pragma unroll
            for (int st = 0; st < 2; ++st) { const int s = 2 * bt + st, tk = s >> 2, d0 = (s & 3) * 32;
                av[st][0] = *(const GAS bf16x8*)(ar0 + (size_t)tk * NQKV + d0); av[st][1] = *(const GAS bf16x8*)(ar1 + (size_t)tk * NQKV + d0);
#pragma unroll
                for (int ct = 0; ct < 8; ++ct) bv[st][ct] = *(const GAS bf16x8*)(bcol + (size_t)ct * 16 * 4096 + 32 * s); }
            __builtin_amdgcn_sched_barrier(0);
#pragma unroll
            for (int st = 0; st < 2; ++st)
#pragma unroll
                for (int ct = 0; ct < 8; ++ct)
#pragma unroll
                    for (int rt = 0; rt < 2; ++rt) acc[rt][ct] = __builtin_amdgcn_mfma_f32_16x16x32_bf16(av[st][rt], bv[st][ct], acc[rt][ct], 0, 0, 0); }
#pragma unroll
        for (int rt = 0; rt < 2; ++rt)
#pragma unroll
            for (int ct = 0; ct < 8; ++ct) { const int col = 16 * ct + li, ch = (4 * rt + kq) ^ (col & 7);
                *(LAS f32x4c*)(lds + L_PART + wid * 16384 + col * 128 + ch * 16) = acc[rt][ct]; }
        LDS_WAIT();
        __syncthreads();
        { const int col = tid >> 2, rg = tid & 3;
          f32x4c s0 = (f32x4c){0.f, 0.f, 0.f, 0.f}, s1 = s0;
#pragma unroll
          for (int w = 0; w < 8; ++w) { s0 += *(const LAS f32x4c*)(lds + L_PART + w * 16384 + col * 128 + ((2 * rg) ^ (col & 7)) * 16); s1 += *(const LAS f32x4c*)(lds + L_PART + w * 16384 + col * 128 + ((2 * rg + 1) ^ (col & 7)) * 16); }
          float bs = 0.f;
#pragma unroll
          for (int k8 = 0; k8 < 8; ++k8) bs += bias1[k8 * 256 + kv * HD + col];
#pragma unroll
          for (int e = 0; e < 4; ++e) { *(LAS unsigned short*)(lds + L_H + (8 * rg + e) * HRS + col * 2) = (unsigned short)f2bf(gelu_tanh_f(s0[e] + bs));
              *(LAS unsigned short*)(lds + L_H + (8 * rg + 4 + e) * HRS + col * 2) = (unsigned short)f2bf(gelu_tanh_f(s1[e] + bs)); } }
        LDS_WAIT();
        __syncthreads();
        if (wid < 4) { const int ct = wid; f32x16 o2 = f32x16{}; const bf16* b2 = w2t + (size_t)kv * HD * HD + (size_t)(32 * ct + r32) * HD;
#pragma unroll
            for (int ks = 0; ks < 8; ++ks) { const bf16x8 a = *(const LAS bf16x8*)(lds + L_H + r32 * HRS + (16 * ks + 8 * hh) * 2); const bf16x8 bb = *(const GAS bf16x8*)(b2 + 16 * ks + 8 * hh);
                o2 = __builtin_amdgcn_mfma_f32_32x32x16_bf16(a, bb, o2, 0, 0, 0); }
            bf16* outp = (bf16*)(wsb + (kv ? WS_VCMP : WS_KCMP)) + (size_t)R0 * HD + 32 * ct + r32;
#pragma unroll
            for (int r = 0; r < 16; ++r) { const int row = (r & 3) + 8 * (r >> 2) + 4 * hh; const bool pad = ((R0 + row) & 127) == NC;
                outp[(size_t)row * HD] = pad ? (bf16)0 : (bf16)f2bf(o2[r]); } }
        __syncthreads();
    }
    for (int u = blockIdx.x; u < M / 64; u += G) {
        const int m0 = 64 * u;
        const bf16* arow = hn + (size_t)(m0 + li) * DM + 256 * wid + 8 * kq; const bf16* brow = wg + (size_t)li * DM + 256 * wid + 8 * kq;
        f32x4c acc[4][4];
#pragma unroll
        for (int rt = 0; rt < 4; ++rt)
#pragma unroll
            for (int ct = 0; ct < 4; ++ct) acc[rt][ct] = (f32x4c){0.f, 0.f, 0.f, 0.f};
        for (int bt = 0; bt < 4; ++bt) {
            bf16x8 av[2][4], bv[2][4];
#pragma unroll
            for (int st = 0; st < 2; ++st)
#pragma unroll
                for (int t4 = 0; t4 < 4; ++t4) { av[st][t4] = *(const GAS bf16x8*)(arow + (size_t)t4 * 16 * DM + 32 * (2 * bt + st)); bv[st][t4] = *(const GAS bf16x8*)(brow + (size_t)t4 * 16 * DM + 32 * (2 * bt + st)); }
            __builtin_amdgcn_sched_barrier(0);
#pragma unroll
            for (int st = 0; st < 2; ++st)
#pragma unroll
                for (int ct = 0; ct < 4; ++ct)
#pragma unroll
                    for (int rt = 0; rt < 4; ++rt) acc[rt][ct] = __builtin_amdgcn_mfma_f32_16x16x32_bf16(av[st][rt], bv[st][ct], acc[rt][ct], 0, 0, 0); }
#pragma unroll
        for (int rt = 0; rt < 4; ++rt)
#pragma unroll
            for (int ct = 0; ct < 4; ++ct) { const int col = 16 * ct + li, ch = (4 * rt + kq) ^ (col & 15);
                *(LAS f32x4c*)(lds + L_PART + wid * 16384 + col * 256 + ch * 16) = acc[rt][ct]; }
        LDS_WAIT();
        __syncthreads();
        { const int row = tid >> 3, cg8 = tid & 7;
          if (cg8 < NGATE / 8) { float v[8];
#pragma unroll
              for (int e = 0; e < 8; ++e) { const int col = 8 * cg8 + e; float s = 0.f;
#pragma unroll
                  for (int w = 0; w < 8; ++w) s += *(const LAS float*)(lds + L_PART + w * 16384 + col * 256 + (((row >> 2) ^ (col & 15)) * 16) + (row & 3) * 4);
                  v[e] = s; }
              const float rv = rinv[m0 + row];
#pragma unroll
              for (int e = 0; e < 8; ++e) v[e] = 1.f / (1.f + __expf(-v[e] * rv));
              float* gp = gates + (size_t)(m0 + row) * NGATE + 8 * cg8;
              *(f32x4c*)gp = (f32x4c){v[0], v[1], v[2], v[3]}; *(f32x4c*)(gp + 4) = (f32x4c){v[4], v[5], v[6], v[7]}; } }
        __syncthreads();
    }
}
}


namespace nsa {
typedef short bf16x8 __attribute__((ext_vector_type(8)));
typedef short s16x4 __attribute__((ext_vector_type(4)));
typedef float f32x16 __attribute__((ext_vector_type(16)));
typedef unsigned u32x4 __attribute__((ext_vector_type(4)));
constexpr int SHM = 16384;
constexpr int NBUF = 3;
constexpr int L_V = 0, L_K = NBUF * SHM, L_WS = 2 * NBUF * SHM, L_LUT = L_WS + 2048, L_IMP = L_LUT + 8192, L_SEL = L_IMP + 4 * 64 * 33 * 4, L_END = L_SEL + 256;
static_assert(L_END <= LDS_BYTES - 256, "nsa LDS map");
constexpr float THR2 = 11.5f;
#define NSA_KSWZ(row, colB) ((row) * 256 + ((colB) ^ (((row) & 7) << 4)))
#define NSA_SBAR() __builtin_amdgcn_sched_barrier(0)
__device__ __forceinline__ int v_st(int k, int c) { const int kk = (k & ~0xC) | ((k & 4) << 1) | ((k & 8) >> 1); return ((kk >> 3) * 4 + (c >> 5)) * 512 + ((kk & 7) * 32 + (c & 31)) * 2; }
__device__ __forceinline__ int v_rd_base(int lane) { return ((lane & 3) << 3) | (((lane >> 2) & 3) << 6) | (((lane >> 4) & 1) << 5) | (((lane >> 5) & 1) << 8); }
constexpr int v_rd_off(int d0, int ks, int half) { return d0 * 512 + ks * 4096 + half * 2048; }
__device__ __forceinline__ int crow(int r, int hi) { return (r & 3) + 8 * (r >> 2) + 4 * hi; }
__device__ __forceinline__ unsigned cvtpk(float lo, float hi) { unsigned r; asm volatile("v_cvt_pk_bf16_f32 %0, %1, %2" : "=v"(r) : "v"(lo), "v"(hi)); return r; }

__device__ __forceinline__ void qkt(f32x16& p0, f32x16& p1, LAS unsigned char* Kb, int r32, int hi, const bf16x8 (&qr)[8]) {
    p0 = f32x16{}; p1 = f32x16{};
    LAS unsigned char* kb[4];
#pragma unroll
    for (int dd = 0; dd < 4; ++dd) kb[dd] = Kb + NSA_KSWZ(r32, (dd * 16 + hi * 8) * 2);
#pragma unroll
    for (int d0 = 0; d0 < 8; ++d0) { LAS unsigned char* a = kb[d0 & 3] + (d0 >> 2) * 128;
        const bf16x8 b0 = *(const LAS bf16x8*)a; const bf16x8 b1 = *(const LAS bf16x8*)(a + 32 * 256);
        p0 = __builtin_amdgcn_mfma_f32_32x32x16_bf16(b0, qr[d0], p0, 0, 0, 0);
        p1 = __builtin_amdgcn_mfma_f32_32x32x16_bf16(b1, qr[d0], p1, 0, 0, 0); }
}
__device__ __forceinline__ void pv_tile(f32x16 (&o)[4], int vb, bf16x8 pa0, bf16x8 pa1, bf16x8 pa2, bf16x8 pa3) {
#define NSA_TRRD(dst, off) asm volatile("ds_read_b64_tr_b16 %0, %1 offset:%2" : "=&v"(dst) : "v"(vb), "i"(off) : "memory")
#define NSA_PV_KS(ks, pa) do { s16x4 l0, l1, l2, l3, h0, h1, h2, h3; \
        NSA_TRRD(l0, v_rd_off(0, ks, 0)); NSA_TRRD(h0, v_rd_off(0, ks, 1)); NSA_TRRD(l1, v_rd_off(1, ks, 0)); NSA_TRRD(h1, v_rd_off(1, ks, 1)); \
        NSA_TRRD(l2, v_rd_off(2, ks, 0)); NSA_TRRD(h2, v_rd_off(2, ks, 1)); NSA_TRRD(l3, v_rd_off(3, ks, 0)); NSA_TRRD(h3, v_rd_off(3, ks, 1)); \
        asm volatile("s_waitcnt lgkmcnt(0)" ::: "memory"); NSA_SBAR(); \
        o[0] = __builtin_amdgcn_mfma_f32_32x32x16_bf16(pa, (bf16x8){l0[0], l0[1], l0[2], l0[3], h0[0], h0[1], h0[2], h0[3]}, o[0], 0, 0, 0); \
        o[1] = __builtin_amdgcn_mfma_f32_32x32x16_bf16(pa, (bf16x8){l1[0], l1[1], l1[2], l1[3], h1[0], h1[1], h1[2], h1[3]}, o[1], 0, 0, 0); \
        o[2] = __builtin_amdgcn_mfma_f32_32x32x16_bf16(pa, (bf16x8){l2[0], l2[1], l2[2], l2[3], h2[0], h2[1], h2[2], h2[3]}, o[2], 0, 0, 0); \
        o[3] = __builtin_amdgcn_mfma_f32_32x32x16_bf16(pa, (bf16x8){l3[0], l3[1], l3[2], l3[3], h3[0], h3[1], h3[2], h3[3]}, o[3], 0, 0, 0); } while (0)
    NSA_PV_KS(0, pa0); NSA_PV_KS(1, pa1); NSA_PV_KS(2, pa2); NSA_PV_KS(3, pa3);
#undef NSA_PV_KS
#undef NSA_TRRD
}
__device__ __forceinline__ void pack_p(const f32x16& p0, const f32x16& p1, bf16x8& pa0, bf16x8& pa1, bf16x8& pa2, bf16x8& pa3) {
#define NSA_PK4(P, B_, OUT) do { unsigned a0 = cvtpk(P[B_ + 0], P[B_ + 1]), a1 = cvtpk(P[B_ + 2], P[B_ + 3]); \
        unsigned b0 = cvtpk(P[B_ + 4], P[B_ + 5]), b1 = cvtpk(P[B_ + 6], P[B_ + 7]); \
        auto r0 = __builtin_amdgcn_permlane32_swap(a0, b0, false, false); auto r1 = __builtin_amdgcn_permlane32_swap(a1, b1, false, false); \
        u32x4 w = {r0[0], r1[0], r0[1], r1[1]}; OUT = *reinterpret_cast<bf16x8*>(&w); } while (0)
    NSA_PK4(p0, 0, pa0); NSA_PK4(p0, 8, pa1); NSA_PK4(p1, 0, pa2); NSA_PK4(p1, 8, pa3);
#undef NSA_PK4
}
__device__ __forceinline__ float swap_max(float v) { auto rr = __builtin_amdgcn_permlane32_swap(__float_as_uint(v), __float_as_uint(v), false, false); return fmaxf(__uint_as_float(rr[0]), __uint_as_float(rr[1])); }
__device__ __forceinline__ float swap_sum(float v) { auto rr = __builtin_amdgcn_permlane32_swap(__float_as_uint(v), __float_as_uint(v), false, false); return __uint_as_float(rr[0]) + __uint_as_float(rr[1]); }

template <class T> __device__ __forceinline__ const T* opaque_s(const T* p) { asm volatile("" : "+s"(p)); return p; }
__device__ __forceinline__ void tile_dma(LAS unsigned char* lds, int buf, const bf16* Kg, const bf16* Vg, int ld, int pk0, int pk1, int pv0, int pv1, int wid) {
    const char* kb = (const char*)Kg; const char* vb = (const char*)Vg;
    LAS unsigned char* kd = lds + L_K + buf * SHM + wid * 2048; LAS unsigned char* vd = lds + L_V + buf * SHM + wid * 2048;
    __builtin_amdgcn_global_load_lds((const unsigned*)(kb + (unsigned)(((pk0 >> 8) * ld + (pk0 & 255)) * 2)), (LAS unsigned*)kd, 16, 0, 0);
    __builtin_amdgcn_global_load_lds((const unsigned*)(kb + (unsigned)(((pk1 >> 8) * ld + (pk1 & 255)) * 2)), (LAS unsigned*)(kd + 1024), 16, 0, 0);
    __builtin_amdgcn_global_load_lds((const unsigned*)(vb + (unsigned)(((pv0 >> 8) * ld + (pv0 & 255)) * 2)), (LAS unsigned*)vd, 16, 0, 0);
    __builtin_amdgcn_global_load_lds((const unsigned*)(vb + (unsigned)(((pv1 >> 8) * ld + (pv1 & 255)) * 2)), (LAS unsigned*)(vd + 1024), 16, 0, 0);
}
__device__ __forceinline__ int k_piece(int P) { const int row = P >> 8, colB = (P & 255) ^ ((row & 7) << 4); return (row << 8) | (colB >> 1); }
__device__ __forceinline__ int v_piece(int P) { const int st = P >> 9, q = (P & 511) >> 1, kk = (st >> 2) * 8 + (q >> 5), c = (st & 3) * 32 + (q & 31);
    const int k = (kk & ~0xC) | ((kk & 4) << 1) | ((kk & 8) >> 1); return (k << 8) | c; }

__device__ __forceinline__ void nsa_phase(LAS unsigned char* lds, unsigned char* wsb, int G, const int tid) {
    const int wid = __builtin_amdgcn_readfirstlane(tid >> 6), lane = tid & 63, r32 = lane & 31, hi = lane >> 5;
    const int hr = wid >> 1, th = wid & 1;
    const bf16* proj = (const bf16*)(wsb + WS_BIG); const float* gates = (const float*)(wsb + WS_GATES);
    const bf16* kcmp = (const bf16*)(wsb + WS_KCMP); const bf16* vcmp = (const bf16*)(wsb + WS_VCMP); bf16* Oout = (bf16*)(wsb + WS_A);
    float* scrl = (float*)(wsb + WS_SCR) + ((size_t)blockIdx.x * NWAVES + wid) * 4096 + lane * 64;
    LAS float* wsl = (LAS float*)(lds + L_WS) + wid * 64; LAS float* li_l = wsl; LAS float* al_l = wsl + 32;
    LAS float* lutL = (LAS float*)(lds + L_LUT); LAS float* impL = (LAS float*)(lds + L_IMP); LAS unsigned* selL = (LAS unsigned*)(lds + L_SEL);
    const int pk0 = k_piece(wid * 2048 + lane * 16), pk1 = k_piece(wid * 2048 + 1024 + lane * 16), pv0 = v_piece(wid * 2048 + lane * 16), pv1 = v_piece(wid * 2048 + 1024 + lane * 16);
    const int vb0 = (int)(unsigned)(uintptr_t)(lds + L_V) + v_rd_base(lane);
    const float NEG = -__builtin_inff();
    { const float* lut = (const float*)(wsb + WS_LUT); for (int i = tid; i < NH * 128; i += NTHREADS) lutL[i] = lut[i]; }
    __syncthreads();
    for (int ui = 0; ui < 4; ++ui) {
        const int c = blockIdx.x, bg = c & 31, j8 = (c >> 5) & 7;
        if (c >= 256 && G > 256) break;
        const unsigned long long qtab = (ui == 0) ? 0xfeebcf633dull : (ui == 1) ? 0x8ea74b49b7ull : (ui == 2) ? 0x719f062568ull : 0x110a009d43ull;
        const int qb = (int)((qtab >> (5 * j8)) & 31ull);
        const int b = bg >> 2, g = bg & 3, h = g * 4 + hr, t0 = 64 * qb, tq = t0 + 32 * th + r32;
        const size_t rowq = (size_t)b * SEQ + tq;
        const LAS float* lutp = lutL + h * 128; const float c31 = lutp[127];
        bf16x8 qr[8];
        { int hq = hi; asm volatile("" : "+v"(hq));
          const bf16* qp = proj + rowq * NQKV + h * HD + hq * 8;
#pragma unroll
          for (int d0 = 0; d0 < 8; ++d0) qr[d0] = *(const GAS bf16x8*)(qp + d0 * 16); }
        const float g_c = gates[rowq * NGATE + h], g_s = gates[rowq * NGATE + 16 + h], g_w = gates[rowq * NGATE + 32 + h];
        f32x16 o[4]; float cmp_carry = 0.f;
        {
            const bf16* kb = kcmp + (size_t)(b * NG + g) * NCP * HD; const bf16* vbp = vcmp + (size_t)(b * NG + g) * NCP * HD;
            const bool two = (t0 + 63 - 31) >= 16 * 64;
            tile_dma(lds, 0, opaque_s(kb), opaque_s(vbp), HD, pk0, pk1, pv0, pv1, wid);
            if (two) tile_dma(lds, 1, opaque_s(kb + 64 * HD), opaque_s(vbp + 64 * HD), HD, pk0, pk1, pv0, pv1, wid);
            VM_WAIT();
            __syncthreads();
            const int dqc = tq - 31 - 64 * hi;
            f32x16 sA0, sA1, sB0 = f32x16{}, sB1 = f32x16{};
            float tm = -1e30f;
            qkt(sA0, sA1, lds + L_K, r32, hi, qr);
#pragma unroll
            for (int r = 0; r < 16; ++r) { const int cc = (r & 3) + 8 * (r >> 2); const int d0 = dqc - 16 * cc, d1 = d0 - 512;
                sA0[r] = d0 >= 0 ? sA0[r] + lutp[d0 < 0 ? 0 : (d0 < 127 ? d0 : 127)] : NEG; sA1[r] = d1 >= 0 ? sA1[r] + lutp[d1 < 0 ? 0 : (d1 < 127 ? d1 : 127)] : NEG;
                tm = fmaxf(tm, fmaxf(sA0[r], sA1[r]));
                if ((r & 3) == 3) asm volatile("" ::: "memory"); }
            if (two) {
                qkt(sB0, sB1, lds + L_K + SHM, r32, hi, qr);
#pragma unroll
                for (int r = 0; r < 16; ++r) { const int cc = (r & 3) + 8 * (r >> 2); const int d0 = dqc - 1024 - 16 * cc, d1 = d0 - 512;
                    sB0[r] = d0 >= 0 ? sB0[r] + lutp[d0 < 0 ? 0 : (d0 < 127 ? d0 : 127)] : NEG; sB1[r] = d1 >= 0 ? sB1[r] + lutp[d1 < 0 ? 0 : (d1 < 127 ? d1 : 127)] : NEG;
                    tm = fmaxf(tm, fmaxf(sB0[r], sB1[r]));
                    if ((r & 3) == 3) asm volatile("" ::: "memory"); }
            }
            const float mx = swap_max(tm);
            float ps = 0.f;
#pragma unroll
            for (int r = 0; r < 16; ++r) { sA0[r] = __builtin_amdgcn_exp2f(sA0[r] - mx); sA1[r] = __builtin_amdgcn_exp2f(sA1[r] - mx); ps += sA0[r] + sA1[r]; }
            if (two) {
#pragma unroll
                for (int r = 0; r < 16; ++r) { sB0[r] = __builtin_amdgcn_exp2f(sB0[r] - mx); sB1[r] = __builtin_amdgcn_exp2f(sB1[r] - mx); ps += sB0[r] + sB1[r]; }
            }
            const float ls = swap_sum(ps);
            const float inv = ls > 0.f ? 1.f / ls : 0.f;
            LAS float* ip = impL + (hr * 64 + 32 * th + r32) * 33;
#pragma unroll
            for (int d = 0; d < 4; ++d) o[d] = f32x16{};
            if (!two) {
#pragma unroll
                for (int q = 0; q < 16; ++q) ip[16 + q] = 0.f;
            }
            auto imp_pv = [&](f32x16& p0, f32x16& p1, const int T) {
                p0 = p0 * inv; p1 = p1 * inv;
                LAS float* ipt = ip + 16 * T;
#pragma unroll
                for (int q = 0; q < 4; ++q) {
                    ipt[0 + 2 * q + hi] = (p0[4 * q] + p0[4 * q + 1]) + (p0[4 * q + 2] + p0[4 * q + 3]);
                    ipt[8 + 2 * q + hi] = (p1[4 * q] + p1[4 * q + 1]) + (p1[4 * q + 2] + p1[4 * q + 3]); }
                LDS_WAIT(); asm volatile("" ::: "memory");
#pragma unroll
                for (int q = 0; q < 4; ++q) {
                    ipt[0 + 2 * q + hi + 1] += p0[4 * q + 3];
                    if (8 + 2 * q + hi + 1 < 16) ipt[8 + 2 * q + hi + 1] += p1[4 * q + 3]; }
                const float carry = p1[15];
                LDS_WAIT(); asm volatile("" ::: "memory");
                bf16x8 pa0, pa1, pa2, pa3;
                pack_p(p0, p1, pa0, pa1, pa2, pa3); pv_tile(o, vb0 + T * SHM, pa0, pa1, pa2, pa3);
                if (T == 0) cmp_carry = carry;
            };
            imp_pv(sA0, sA1, 0);
            if (two) imp_pv(sB0, sB1, 1);
            if (hi == 1) ip[16] += cmp_carry;
            LDS_WAIT(); asm volatile("" ::: "memory");
            if (hi == 0) li_l[r32] = g_c;
            LDS_WAIT(); asm volatile("" ::: "memory");
            { float gg[16];
#pragma unroll
              for (int r = 0; r < 16; ++r) gg[r] = li_l[crow(r, hi)];
#pragma unroll
              for (int d = 0; d < 4; ++d)
#pragma unroll
                  for (int q = 0; q < 4; ++q) *(GAS f32x4*)(scrl + d * 16 + 4 * q) = (f32x4){o[d][4 * q] * gg[4 * q], o[d][4 * q + 1] * gg[4 * q + 1], o[d][4 * q + 2] * gg[4 * q + 2], o[d][4 * q + 3] * gg[4 * q + 3]}; }
            LDS_WAIT();
            __builtin_amdgcn_s_barrier(); asm volatile("" ::: "memory");
        }
        {
#pragma unroll
            for (int i = 0; i < 4; ++i) { const int tl = 8 * wid + 2 * i + hi, n = r32;
                float v = ((impL[(0 * 64 + tl) * 33 + n] + impL[(1 * 64 + tl) * 33 + n]) + impL[(2 * 64 + tl) * 33 + n]) + impL[(3 * 64 + tl) * 33 + n];
                int key = (int)((__float_as_uint(v) & ~31u) | (unsigned)(31 - n));
                if (n == 0 || n == qb || n == qb - 1) key = (int)(0x461C4000u | (unsigned)(31 - n)); else if (n > qb) key = -64 + (31 - n);
                int cnt = 0;
                for (int mm = 0; mm < 32; ++mm) { const int u = __shfl(key, (lane & 32) | mm); cnt += (u > key) ? 1 : 0; }
                const unsigned long long bal = __ballot(cnt < 8);
                if (lane == 0) { selL[8 * wid + 2 * i] = (unsigned)bal; selL[8 * wid + 2 * i + 1] = (unsigned)(bal >> 32); } }
            LDS_WAIT();
            __builtin_amdgcn_s_barrier(); asm volatile("" ::: "memory");
        }
        const unsigned selw = selL[32 * th + r32];
        const int NS = qb + 1, nlo = qb >= 8 ? qb - 8 : 0, NT = NS + (qb - nlo + 1);
        float m_reg = -1e30f, l_reg = 0.f;
#pragma unroll
        for (int d = 0; d < 4; ++d) o[d] = f32x16{};
        const bf16* kS = proj + (size_t)b * SEQ * NQKV + COL_KS + g * HD; const bf16* vS = proj + (size_t)b * SEQ * NQKV + COL_VS + g * HD;
        const bf16* kW = proj + (size_t)b * SEQ * NQKV + COL_KW + g * HD; const bf16* vW = proj + (size_t)b * SEQ * NQKV + COL_VW + g * HD;
#define NSA_TILE_K(t_) (((t_) >= NS ? kW : kS) + (size_t)(64 * ((t_) >= NS ? nlo + ((t_) - NS) : (t_))) * NQKV)
#define NSA_TILE_V(t_) (((t_) >= NS ? vW : vS) + (size_t)(64 * ((t_) >= NS ? nlo + ((t_) - NS) : (t_))) * NQKV)
        tile_dma(lds, 0, opaque_s(kS), opaque_s(vS), NQKV, pk0, pk1, pv0, pv1, wid);
        if (1 < NT) { tile_dma(lds, 1, opaque_s(NSA_TILE_K(1)), opaque_s(NSA_TILE_V(1)), NQKV, pk0, pk1, pv0, pv1, wid); asm volatile("s_waitcnt vmcnt(4)" ::: "memory"); } else VM_WAIT();
        LDS_WAIT(); __builtin_amdgcn_s_barrier(); asm volatile("" ::: "memory");
        int buf = 0;
        for (int i = 0; i < NT; ++i) {
            const bool win = i >= NS; const int n = win ? nlo + (i - NS) : i;
            if (i == NS) {
                if (hi == 0) li_l[r32] = g_s / l_reg;
                LDS_WAIT(); asm volatile("" ::: "memory");
                { float gg[16];
#pragma unroll
                  for (int r = 0; r < 16; ++r) gg[r] = li_l[crow(r, hi)];
#pragma unroll
                  for (int d = 0; d < 4; ++d)
                  {
                    f32x4 a4[4];
#pragma unroll
                    for (int q = 0; q < 4; ++q) a4[q] = *(const GAS f32x4*)(scrl + d * 16 + 4 * q);
#pragma unroll
                    for (int q = 0; q < 4; ++q) { const f32x4 a = a4[q];
                          *(GAS f32x4*)(scrl + d * 16 + 4 * q) = (f32x4){a.x + o[d][4 * q] * gg[4 * q], a.y + o[d][4 * q + 1] * gg[4 * q + 1], a.z + o[d][4 * q + 2] * gg[4 * q + 2], a.w + o[d][4 * q + 3] * gg[4 * q + 3]}; }
                    asm volatile("" ::: "memory"); }
#pragma unroll
                  for (int d = 0; d < 4; ++d) o[d] = f32x16{}; }
                LDS_WAIT(); m_reg = -1e30f; l_reg = 0.f;
            }
            if (i + 2 < NT) { const int b2 = buf + 2 >= NBUF ? buf + 2 - NBUF : buf + 2;
                tile_dma(lds, b2, opaque_s(NSA_TILE_K(i + 2)), opaque_s(NSA_TILE_V(i + 2)), NQKV, pk0, pk1, pv0, pv1, wid); }
            f32x16 p0, p1;
            qkt(p0, p1, lds + L_K + buf * SHM, r32, hi, qr);
            const bool plain = (n + 2 < qb) && !(win && n + 8 == qb);
            float bofs = 0.f;
            { const int dq = tq - 64 * n - 4 * hi; const unsigned W = win ? 512u : 0x80000000u; const bool ok = win || ((selw >> n) & 1u);
              if (plain) bofs = ok ? c31 : NEG;
              else if (n + 2 >= qb) {
#pragma unroll
                  for (int r = 0; r < 16; ++r) { const int cc = (r & 3) + 8 * (r >> 2); const int d0 = dq - cc, d1 = d0 - 32;
                      const float b0 = lutp[d0 < 0 ? 0 : (d0 < 127 ? d0 : 127)], b1 = lutp[d1 < 0 ? 0 : (d1 < 127 ? d1 : 127)];
                      p0[r] = (ok && (unsigned)d0 < W) ? p0[r] + b0 : NEG; p1[r] = (ok && (unsigned)d1 < W) ? p1[r] + b1 : NEG;
                      if ((r & 3) == 3) asm volatile("" ::: "memory"); }
              } else {
#pragma unroll
                  for (int r = 0; r < 16; ++r) { const int cc = (r & 3) + 8 * (r >> 2); const int d0 = dq - cc, d1 = d0 - 32;
                      p0[r] = (ok && (unsigned)d0 < W) ? p0[r] + c31 : NEG; p1[r] = (ok && (unsigned)d1 < W) ? p1[r] + c31 : NEG; }
              } }
            float pmax = p0[0];
#pragma unroll
            for (int r = 1; r < 16; ++r) pmax = fmaxf(pmax, p0[r]);
#pragma unroll
            for (int r = 0; r < 16; ++r) pmax = fmaxf(pmax, p1[r]);
            pmax = swap_max(pmax) + bofs;
            float mn, alpha;
            if (__all((pmax - m_reg) <= THR2)) { mn = m_reg; alpha = 1.f; }
            else { mn = fmaxf(m_reg, pmax); alpha = __builtin_amdgcn_exp2f(m_reg - mn); m_reg = mn; }
            mn -= bofs;
            float ps = 0.f;
#pragma unroll
            for (int r = 0; r < 16; ++r) { p0[r] = __builtin_amdgcn_exp2f(p0[r] - mn); p1[r] = __builtin_amdgcn_exp2f(p1[r] - mn); ps += p0[r] + p1[r]; }
            ps = swap_sum(ps);
            l_reg = l_reg * alpha + ps;
            if (__any(alpha < 1.f)) { if (hi == 0) al_l[r32] = alpha; LDS_WAIT(); asm volatile("" ::: "memory");
#pragma unroll
                for (int r = 0; r < 16; ++r) { const float aa = al_l[crow(r, hi)];
#pragma unroll
                    for (int d = 0; d < 4; ++d) o[d][r] *= aa; }
                LDS_WAIT(); }
            bf16x8 pa0, pa1, pa2, pa3;
            pack_p(p0, p1, pa0, pa1, pa2, pa3);
            pv_tile(o, vb0 + buf * SHM, pa0, pa1, pa2, pa3);
            if (i + 2 < NT) asm volatile("s_waitcnt vmcnt(4)" ::: "memory"); else VM_WAIT();
            LDS_WAIT();
            __builtin_amdgcn_s_barrier(); asm volatile("" ::: "memory");
            buf = buf + 1 >= NBUF ? 0 : buf + 1;
        }
#undef NSA_TILE_K
#undef NSA_TILE_V
        if (hi == 0) li_l[r32] = g_w / l_reg;
        LDS_WAIT(); asm volatile("" ::: "memory");
        {
            LAS unsigned char* ost = lds + wid * 8192;
            LAS unsigned char* owr = ost + (4 * hi) * 256 + r32 * 2;
            float gg[16];
#pragma unroll
            for (int r = 0; r < 16; ++r) gg[r] = li_l[crow(r, hi)];
#pragma unroll
            for (int d = 0; d < 4; ++d) { f32x4 a4[4];
#pragma unroll
                for (int q = 0; q < 4; ++q) a4[q] = *(const GAS f32x4*)(scrl + d * 16 + 4 * q);
#pragma unroll
                for (int q = 0; q < 4; ++q)
#pragma unroll
                    for (int e = 0; e < 4; ++e) { const int r = 4 * q + e; const float v = a4[q][e] + o[d][r] * gg[r];
                        *(LAS unsigned short*)(owr + ((r & 3) + 8 * (r >> 2)) * 256 + d * 64) = (unsigned short)f2bf(v); }
                asm volatile("" ::: "memory"); }
            LDS_WAIT(); asm volatile("" ::: "memory");
            int ln = lane; asm volatile("" : "+v"(ln));
            bf16* Ow = Oout + ((size_t)b * SEQ + t0 + 32 * th + (ln >> 4)) * DM + h * HD + (ln & 15) * 8;
            const LAS unsigned char* ord = ost + (ln >> 4) * 256 + (ln & 15) * 16;
#pragma unroll
            for (int i = 0; i < 8; ++i) *(GAS v4u*)(Ow + (size_t)(4 * i) * DM) = *(const LAS v4u*)(ord + i * 1024);
        }
        LDS_WAIT();
        __builtin_amdgcn_s_barrier(); asm volatile("" ::: "memory");
    }
}
#undef NSA_KSWZ
#undef NSA_SBAR
}


namespace hg {
typedef short bf16x8 __attribute__((ext_vector_type(8)));
typedef short s16x4 __attribute__((ext_vector_type(4)));
typedef float f32x4v __attribute__((ext_vector_type(4)));
typedef float f32x2v __attribute__((ext_vector_type(2)));
constexpr int RS = 288, RSA = 144;
constexpr int BUFB = 3 * 64 * RS;
constexpr int L_Q = 0, L_K = 64 * RS, L_V = 2 * 64 * RS, L_AM = 2 * BUFB, L_O = L_AM + 64 * RSA, L_EBL = L_O + 64 * RS, L_ON = L_EBL + 1024, L_END = L_ON + 512;
static_assert(L_END <= LDS_BYTES - 256, "hg LDS map");
#define HG_TR(dst, addr, off) asm volatile("ds_read_b64_tr_b16 %0, %1 offset:%2" : "=&v"(dst) : "v"(addr), "i"(off) : "memory")
#define HG_BAR() do { asm volatile("s_waitcnt lgkmcnt(0)" ::: "memory"); __builtin_amdgcn_s_barrier(); asm volatile("" ::: "memory"); } while (0)
__device__ __forceinline__ unsigned cvtpk(float lo, float hi) { unsigned r; asm volatile("v_cvt_pk_bf16_f32 %0, %1, %2" : "=v"(r) : "v"(lo), "v"(hi)); return r; }

__device__ __forceinline__ void scan_phase(LAS unsigned char* lds, unsigned char* wsb, const float* h_on, int G, const int tid) {
    const int wid = __builtin_amdgcn_readfirstlane(tid >> 6), lane = tid & 63, li = lane & 15, g = lane >> 4;
    const bool prod = wid >= 4; const int rw = wid & 3, ptid = rw * 64 + lane;
    const bf16* proj = (const bf16*)(wsb + WS_BIG); bf16* Oout = (bf16*)(wsb + WS_A);
    const float L2E = 1.4426950408889634f;
    const int kp = lane & 7, tg = lane >> 3;
    for (int u = blockIdx.x; u < BATCH * NH; u += G) {
        const int b = u >> 4, h = u & 15;
        if (tid < HD) ((LAS float*)(lds + L_ON))[tid] = h_on[h * HD + tid];
#define HG_LOAD(c_, QW, FW, VW) do { const size_t r0_ = (size_t)b * SEQ + 64 * (c_); \
        _Pragma("unroll") for (int c2 = 0; c2 < 2; ++c2) _Pragma("unroll") for (int i = 0; i < 8; ++i) { const size_t r = r0_ + 8 * tg + i; const int ch_ = h * HD + 32 * rw + 16 * c2 + 2 * kp; \
            QW[c2][i] = *(const GAS unsigned*)(proj + r * FF + ch_); FW[c2][i] = *(const GAS unsigned*)(proj + r * FF + 2048 + ch_); } \
        _Pragma("unroll") for (int j = 0; j < 4; ++j) { const int ci = ptid + 256 * j; VW[j] = *(const GAS v4u*)(proj + (r0_ + (ci >> 4)) * FF + 4096 + h * HD + 8 * (ci & 15)); } } while (0)
#define HG_PREP(pb, QW, FW, VW) do { LAS unsigned char* B_ = lds + (pb) * BUFB; \
        _Pragma("unroll") for (int c2 = 0; c2 < 2; ++c2) { const int chl_ = 32 * rw + 16 * c2 + 2 * kp; float bl0[8], bl1[8]; float c0 = 0.f, c1 = 0.f; \
            _Pragma("unroll") for (int i = 0; i < 8; ++i) { c0 += bflo(FW[c2][i]); c1 += bfhi(FW[c2][i]); bl0[i] = c0; bl1[i] = c1; } \
            float i0 = c0, i1 = c1; \
            _Pragma("unroll") for (int d = 8; d < 64; d <<= 1) { const float x0 = __shfl_up(i0, d), x1 = __shfl_up(i1, d); if (lane >= d) { i0 += x0; i1 += x1; } } \
            const float p0 = i0 - c0, p1 = i1 - c1; \
            if (tg == 7) *(LAS f32x2v*)(lds + L_EBL + (pb) * 512 + chl_ * 4) = (f32x2v){__builtin_amdgcn_exp2f(i0 * L2E), __builtin_amdgcn_exp2f(i1 * L2E)}; \
            _Pragma("unroll") for (int i = 0; i < 8; ++i) { const float b0 = (p0 + bl0[i]) * L2E, b1 = (p1 + bl1[i]) * L2E; \
                const float e0 = __builtin_amdgcn_exp2f(b0), e1 = __builtin_amdgcn_exp2f(b1), n0 = __builtin_amdgcn_exp2f(-b0), n1 = __builtin_amdgcn_exp2f(-b1); \
                const float k0 = 1.f - __builtin_amdgcn_exp2f(bflo(FW[c2][i]) * L2E), k1 = 1.f - __builtin_amdgcn_exp2f(bfhi(FW[c2][i]) * L2E); \
                const int t = 8 * tg + i; \
                *(LAS unsigned*)(B_ + L_Q + t * RS + chl_ * 2) = cvtpk(bflo(QW[c2][i]) * e0, bfhi(QW[c2][i]) * e1); \
                *(LAS unsigned*)(B_ + L_K + t * RS + chl_ * 2) = cvtpk(k0 * n0, k1 * n1); } } \
        _Pragma("unroll") for (int j = 0; j < 4; ++j) { const int ci = ptid + 256 * j; *(LAS v4u*)(B_ + L_V + (ci >> 4) * RS + (ci & 15) * 16) = VW[j]; } } while (0)
        if (prod) {
            unsigned qwA[2][8], fwA[2][8], qwB[2][8], fwB[2][8]; v4u vwA[4], vwB[4], gwA[4], gwB[4];
#pragma unroll
            for (int j = 0; j < 4; ++j) { gwA[j] = (v4u){0u, 0u, 0u, 0u}; gwB[j] = (v4u){0u, 0u, 0u, 0u}; }
#define HG_GATES(c_, GW) do { const int t_ = ptid >> 2, vq_ = ptid & 3; const size_t r_ = (size_t)b * SEQ + 64 * (c_) + t_; \
            _Pragma("unroll") for (int j = 0; j < 4; ++j) GW[j] = *(const GAS v4u*)(proj + r_ * FF + 6144 + h * HD + 32 * vq_ + 8 * j); } while (0)
            HG_LOAD(0, qwA, fwA, vwA); HG_PREP(0, qwA, fwA, vwA); HG_LOAD(1, qwB, fwB, vwB); HG_LOAD(2, qwA, fwA, vwA); HG_GATES(0, gwA);
            HG_BAR();
            for (int c = 0; c < SEQ / 64; c += 2) {
                { const size_t row0 = (size_t)b * SEQ + 64 * c;
                if (c > 0) {
                    const int t = ptid >> 2, vq = ptid & 3; const size_t r = row0 - 64 + t;
                    float ov[32]; float ss = 0.f;
#pragma unroll
                    for (int j = 0; j < 4; ++j) { const v4u w = *(const LAS v4u*)(lds + L_O + t * RS + vq * 64 + j * 16);
                        ov[8 * j + 0] = bflo(w.x); ov[8 * j + 1] = bfhi(w.x); ov[8 * j + 2] = bflo(w.y); ov[8 * j + 3] = bfhi(w.y); ov[8 * j + 4] = bflo(w.z); ov[8 * j + 5] = bfhi(w.z); ov[8 * j + 6] = bflo(w.w); ov[8 * j + 7] = bfhi(w.w); }
#pragma unroll
                    for (int j = 0; j < 32; ++j) ss += ov[j] * ov[j];
                    ss += __shfl_xor(ss, 1); ss += __shfl_xor(ss, 2);
                    const float rinv = 1.f / sqrtf(ss * (1.f / 128.f) + RMS_EPS);
                    bf16* op = Oout + r * DM + h * HD + 32 * vq;
#pragma unroll
                    for (int j = 0; j < 4; ++j) { const v4u gq = gwB[j]; const f32x4v on0 = *(const LAS f32x4v*)(lds + L_ON + (32 * vq + 8 * j) * 4), on1 = *(const LAS f32x4v*)(lds + L_ON + (32 * vq + 8 * j + 4) * 4);
                        v4u o4;
                        o4.x = cvtpk(ov[8 * j + 0] * rinv * on0[0] * bflo(gq.x), ov[8 * j + 1] * rinv * on0[1] * bfhi(gq.x));
                        o4.y = cvtpk(ov[8 * j + 2] * rinv * on0[2] * bflo(gq.y), ov[8 * j + 3] * rinv * on0[3] * bfhi(gq.y));
                        o4.z = cvtpk(ov[8 * j + 4] * rinv * on1[0] * bflo(gq.z), ov[8 * j + 5] * rinv * on1[1] * bfhi(gq.z));
                        o4.w = cvtpk(ov[8 * j + 6] * rinv * on1[2] * bflo(gq.w), ov[8 * j + 7] * rinv * on1[3] * bfhi(gq.w));
                        *(GAS v4u*)(op + 8 * j) = o4; }
                }
                  HG_GATES(c + 1, gwB); }
                HG_BAR();
                HG_PREP(1, qwB, fwB, vwB); if (c + 3 < SEQ / 64) HG_LOAD(c + 3, qwB, fwB, vwB);
                HG_BAR();
                { const int c = 0; (void)c; }
                { const size_t row0 = (size_t)b * SEQ + 64 * (c + 1); const int c_ = c + 1;
                if (c_ > 0) {
                    const int t = ptid >> 2, vq = ptid & 3; const size_t r = row0 - 64 + t;
                    float ov[32]; float ss = 0.f;
#pragma unroll
                    for (int j = 0; j < 4; ++j) { const v4u w = *(const LAS v4u*)(lds + L_O + t * RS + vq * 64 + j * 16);
                        ov[8 * j + 0] = bflo(w.x); ov[8 * j + 1] = bfhi(w.x); ov[8 * j + 2] = bflo(w.y); ov[8 * j + 3] = bfhi(w.y); ov[8 * j + 4] = bflo(w.z); ov[8 * j + 5] = bfhi(w.z); ov[8 * j + 6] = bflo(w.w); ov[8 * j + 7] = bfhi(w.w); }
#pragma unroll
                    for (int j = 0; j < 32; ++j) ss += ov[j] * ov[j];
                    ss += __shfl_xor(ss, 1); ss += __shfl_xor(ss, 2);
                    const float rinv = 1.f / sqrtf(ss * (1.f / 128.f) + RMS_EPS);
                    bf16* op = Oout + r * DM + h * HD + 32 * vq;
#pragma unroll
                    for (int j = 0; j < 4; ++j) { const v4u gq = gwA[j]; const f32x4v on0 = *(const LAS f32x4v*)(lds + L_ON + (32 * vq + 8 * j) * 4), on1 = *(const LAS f32x4v*)(lds + L_ON + (32 * vq + 8 * j + 4) * 4);
                        v4u o4;
                        o4.x = cvtpk(ov[8 * j + 0] * rinv * on0[0] * bflo(gq.x), ov[8 * j + 1] * rinv * on0[1] * bfhi(gq.x));
                        o4.y = cvtpk(ov[8 * j + 2] * rinv * on0[2] * bflo(gq.y), ov[8 * j + 3] * rinv * on0[3] * bfhi(gq.y));
                        o4.z = cvtpk(ov[8 * j + 4] * rinv * on1[0] * bflo(gq.z), ov[8 * j + 5] * rinv * on1[1] * bfhi(gq.z));
                        o4.w = cvtpk(ov[8 * j + 6] * rinv * on1[2] * bflo(gq.w), ov[8 * j + 7] * rinv * on1[3] * bfhi(gq.w));
                        *(GAS v4u*)(op + 8 * j) = o4; }
                }
                  if (c + 2 < SEQ / 64) HG_GATES(c + 2, gwA); }
                HG_BAR();
                if (c + 2 < SEQ / 64) { HG_PREP(0, qwA, fwA, vwA); if (c + 4 < SEQ / 64) HG_LOAD(c + 4, qwA, fwA, vwA); }
                HG_BAR();
            }
            {
            const int t = ptid >> 2, vq = ptid & 3; const size_t r = (size_t)b * SEQ + SEQ - 64 + t;
            float ov[32]; float ss = 0.f;
#pragma unroll
            for (int j = 0; j < 4; ++j) { const v4u w = *(const LAS v4u*)(lds + L_O + t * RS + vq * 64 + j * 16);
                ov[8 * j + 0] = bflo(w.x); ov[8 * j + 1] = bfhi(w.x); ov[8 * j + 2] = bflo(w.y); ov[8 * j + 3] = bfhi(w.y); ov[8 * j + 4] = bflo(w.z); ov[8 * j + 5] = bfhi(w.z); ov[8 * j + 6] = bflo(w.w); ov[8 * j + 7] = bfhi(w.w); }
#pragma unroll
            for (int j = 0; j < 32; ++j) ss += ov[j] * ov[j];
            ss += __shfl_xor(ss, 1); ss += __shfl_xor(ss, 2);
            const float rinv = 1.f / sqrtf(ss * (1.f / 128.f) + RMS_EPS);
            bf16* op = Oout + r * DM + h * HD + 32 * vq;
#pragma unroll
            for (int j = 0; j < 4; ++j) { const v4u gq = gwB[j]; const f32x4v on0 = *(const LAS f32x4v*)(lds + L_ON + (32 * vq + 8 * j) * 4), on1 = *(const LAS f32x4v*)(lds + L_ON + (32 * vq + 8 * j + 4) * 4);
                v4u o4;
                o4.x = cvtpk(ov[8 * j + 0] * rinv * on0[0] * bflo(gq.x), ov[8 * j + 1] * rinv * on0[1] * bfhi(gq.x));
                o4.y = cvtpk(ov[8 * j + 2] * rinv * on0[2] * bflo(gq.y), ov[8 * j + 3] * rinv * on0[3] * bfhi(gq.y));
                o4.z = cvtpk(ov[8 * j + 4] * rinv * on1[0] * bflo(gq.z), ov[8 * j + 5] * rinv * on1[1] * bfhi(gq.z));
                o4.w = cvtpk(ov[8 * j + 6] * rinv * on1[2] * bflo(gq.w), ov[8 * j + 7] * rinv * on1[3] * bfhi(gq.w));
                *(GAS v4u*)(op + 8 * j) = o4; }
            }
#undef HG_GATES
        } else {
            f32x4v S[8][2];
#pragma unroll
            for (int m = 0; m < 8; ++m) { S[m][0] = (f32x4v){0.f, 0.f, 0.f, 0.f}; S[m][1] = (f32x4v){0.f, 0.f, 0.f, 0.f}; }
            HG_BAR();
            for (int c = 0; c < SEQ / 64; ++c) {
                const int cb = c & 1;
                LAS unsigned char* CB = lds + cb * BUFB;
                {
                const int mt = rw;
                f32x4v acc[4];
#pragma unroll
                for (int nt = 0; nt < 4; ++nt) acc[nt] = (f32x4v){0.f, 0.f, 0.f, 0.f};
#pragma unroll
                for (int ks = 0; ks < 4; ++ks) { const bf16x8 a = *(const LAS bf16x8*)(CB + L_Q + (16 * mt + li) * RS + (32 * ks + 8 * g) * 2);
#pragma unroll
                    for (int nt = 0; nt < 4; ++nt) { const bf16x8 bb = *(const LAS bf16x8*)(CB + L_K + (16 * nt + li) * RS + (32 * ks + 8 * g) * 2);
                        acc[nt] = __builtin_amdgcn_mfma_f32_16x16x32_bf16(a, bb, acc[nt], 0, 0, 0); } }
#pragma unroll
                for (int nt = 0; nt < 4; ++nt) { const int s = 16 * nt + li;
#pragma unroll
                    for (int r = 0; r < 4; ++r) { const int t = 16 * mt + 4 * g + r; const float v = (s <= t) ? acc[nt][r] : 0.f;
                        *(LAS unsigned short*)(lds + L_AM + t * RSA + s * 2) = (unsigned short)f2bf(v); } }
                }
                HG_BAR();
                {
                f32x4v o[4][2];
#pragma unroll
                for (int m = 0; m < 4; ++m) { o[m][0] = (f32x4v){0.f, 0.f, 0.f, 0.f}; o[m][1] = (f32x4v){0.f, 0.f, 0.f, 0.f}; }
#pragma unroll
                for (int ks = 0; ks < 4; ++ks) { bf16x8 bs[2];
#pragma unroll
                    for (int n = 0; n < 2; ++n) { v4u bw; bw.x = cvtpk(S[2 * ks][n][0], S[2 * ks][n][1]); bw.y = cvtpk(S[2 * ks][n][2], S[2 * ks][n][3]); bw.z = cvtpk(S[2 * ks + 1][n][0], S[2 * ks + 1][n][1]); bw.w = cvtpk(S[2 * ks + 1][n][2], S[2 * ks + 1][n][3]);
                        bs[n] = *reinterpret_cast<bf16x8*>(&bw); }
#pragma unroll
                    for (int m = 0; m < 4; ++m) { const LAS unsigned char* qa = CB + L_Q + (16 * m + li) * RS + (32 * ks + 4 * g) * 2;
                        const v2u lo = *(const LAS v2u*)qa, hi2 = *(const LAS v2u*)(qa + 32); v4u aw; aw.x = lo.x; aw.y = lo.y; aw.z = hi2.x; aw.w = hi2.y;
                        const bf16x8 av = *reinterpret_cast<bf16x8*>(&aw);
                        o[m][0] = __builtin_amdgcn_mfma_f32_16x16x32_bf16(av, bs[0], o[m][0], 0, 0, 0);
                        o[m][1] = __builtin_amdgcn_mfma_f32_16x16x32_bf16(av, bs[1], o[m][1], 0, 0, 0); } }
                bf16x8 bv[2][2];
#pragma unroll
                for (int n = 0; n < 2; ++n) {
                    const int va = (int)(unsigned)(uintptr_t)(CB + L_V) + (8 * g + (li >> 2)) * RS + (16 * (2 * rw + n) + 4 * (li & 3)) * 2;
                    s16x4 a0, a1, a2, a3; HG_TR(a0, va, 0); HG_TR(a1, va, 4 * RS); HG_TR(a2, va, 32 * RS); HG_TR(a3, va, 36 * RS);
                    asm volatile("s_waitcnt lgkmcnt(0)" ::: "memory"); __builtin_amdgcn_sched_barrier(0);
                    bv[n][0] = (bf16x8){a0[0], a0[1], a0[2], a0[3], a1[0], a1[1], a1[2], a1[3]}; bv[n][1] = (bf16x8){a2[0], a2[1], a2[2], a2[3], a3[0], a3[1], a3[2], a3[3]}; }
#pragma unroll
                for (int ks = 0; ks < 2; ++ks)
#pragma unroll
                    for (int m = 0; m < 4; ++m) { const bf16x8 a = *(const LAS bf16x8*)(lds + L_AM + (16 * m + li) * RSA + (32 * ks + 8 * g) * 2);
                        o[m][0] = __builtin_amdgcn_mfma_f32_16x16x32_bf16(a, bv[0][ks], o[m][0], 0, 0, 0);
                        o[m][1] = __builtin_amdgcn_mfma_f32_16x16x32_bf16(a, bv[1][ks], o[m][1], 0, 0, 0); }
                { const int ka = (int)(unsigned)(uintptr_t)(CB + L_K) + (8 * g + (li >> 2)) * RS + (4 * (li & 3)) * 2;
                  const LAS float* ebl = (const LAS float*)(lds + L_EBL + cb * 512);
#pragma unroll
                  for (int m = 0; m < 8; ++m) { s16x4 a0, a1, a2, a3;
#define HG_KT(m_) HG_TR(a0, ka, (m_) * 32); HG_TR(a1, ka, (m_) * 32 + 4 * RS); HG_TR(a2, ka, (m_) * 32 + 32 * RS); HG_TR(a3, ka, (m_) * 32 + 36 * RS)
                      switch (m) { case 0: HG_KT(0); break; case 1: HG_KT(1); break; case 2: HG_KT(2); break; case 3: HG_KT(3); break; case 4: HG_KT(4); break; case 5: HG_KT(5); break; case 6: HG_KT(6); break; default: HG_KT(7); break; }
#undef HG_KT
                      asm volatile("s_waitcnt lgkmcnt(0)" ::: "memory"); __builtin_amdgcn_sched_barrier(0);
                      const bf16x8 kt0 = (bf16x8){a0[0], a0[1], a0[2], a0[3], a1[0], a1[1], a1[2], a1[3]}, kt1 = (bf16x8){a2[0], a2[1], a2[2], a2[3], a3[0], a3[1], a3[2], a3[3]};
                      const f32x4v e = *(const LAS f32x4v*)(ebl + 16 * m + 4 * g);
#pragma unroll
                      for (int n = 0; n < 2; ++n) { S[m][n] = __builtin_amdgcn_mfma_f32_16x16x32_bf16(kt0, bv[n][0], S[m][n], 0, 0, 0);
                          S[m][n] = __builtin_amdgcn_mfma_f32_16x16x32_bf16(kt1, bv[n][1], S[m][n], 0, 0, 0);
                          S[m][n] = S[m][n] * e; } } }
#pragma unroll
                for (int m = 0; m < 4; ++m)
#pragma unroll
                    for (int n = 0; n < 2; ++n)
#pragma unroll
                        for (int r = 0; r < 4; ++r) *(LAS unsigned short*)(lds + L_O + (16 * m + 4 * g + r) * RS + (16 * (2 * rw + n) + li) * 2) = (unsigned short)f2bf(o[m][n][r]);
                }
                HG_BAR();
            }
        }
        LDS_WAIT();
        __syncthreads();
#undef HG_LOAD
#undef HG_PREP
    }
}
#undef HG_TR
#undef HG_BAR
}

struct Args { const float* in[14]; float* out; unsigned char* ws; int ph_lo, ph_hi; };
#ifndef CONV_IN_SCAN
#define CONV_IN_SCAN 1
#endif
#ifndef MK_N_LAUNCHES
#define MK_N_LAUNCHES 1
#endif
constexpr int MISC_OFF = LDS_BYTES - 64;
constexpr int N_PHASES = 10;
__global__ void __launch_bounds__(NTHREADS, 2) mk_fwd(Args args) {
    extern __shared__ __attribute__((aligned(16))) unsigned char lds[];
    Frame F;
    F.lds = (LAS unsigned char*)lds;
    F.wave = __builtin_amdgcn_readfirstlane((int)threadIdx.x >> 6); F.lane = lane_id(); F.tid = F.wave * 64 + F.lane;
    F.G = gridDim.x; F.gw = blockIdx.x * NWAVES + F.wave; F.NGW = F.G * NWAVES;
    F.x = args.in[0]; F.norm_g = args.in[1]; F.rel = args.in[2]; F.w_in = args.in[3]; F.pe = args.in[4]; F.cw1 = args.in[5]; F.cw2 = args.in[6]; F.w_out = args.in[7];
    F.h_in = args.in[8]; F.h_lb = args.in[9]; F.h_on = args.in[10]; F.h_out = args.in[11]; F.up = args.in[12]; F.dn = args.in[13];
    F.out = args.out; F.ws = args.ws;
    unsigned char* ws = args.ws;
    bf16* A = (bf16*)(ws + WS_A); bf16* BIG = (bf16*)(ws + WS_BIG); bf16* X16 = (bf16*)(ws + WS_X16);
    const int lo = args.ph_lo, hi = args.ph_hi;
    if (F.tid < 4) ((LAS unsigned*)(F.lds + MISC_OFF))[F.tid] = 0u;
    __syncthreads();
    XcdBarrier bar; bar.wave = F.wave; bar.bar = (unsigned*)(ws + WS_CTL) + 1024; bar.x = 0; bar.st = nullptr;
    if (hi - lo > 1) bar = xcd_barrier_post((unsigned*)(ws + WS_CTL) + 1024, (volatile LAS unsigned*)(F.lds + MISC_OFF), F.wave);
#define IN(k) (lo <= (k) && (k) < hi)
#define PH_FENCE() do { F.lane = lane_id(); F.tid = F.wave * 64 + F.lane; } while (0)
#define SEAM(k) do { if (IN(k) && IN((k) + 1)) xcd_barrier(bar); } while (0)
#define GEMM_PHASE_M(ACT, Ap, Btp, MR_, N_, K_, Op, ldc_, st_, sc_, rs_) do { pg8::Gemm g{(Ap), (Btp), (MR_), (N_), (K_)}; pg8::StaticOrder S; S.init((MR_), (N_), F.G, (int)blockIdx.x); \
        EpiAct<ACT> E{(Op), (ldc_), (st_), (sc_), (const float*)(ws + WS_LB), (rs_), 1.f}; pg8::gemm_phase<EpiAct<ACT>, pg8::StaticOrder, true, true>(F.lds, g, S, E, F.tid); } while (0)
#define GEMM_PHASE(ACT, Ap, Btp, N_, K_, Op, ldc_, st_, sc_, rs_) GEMM_PHASE_M(ACT, Ap, Btp, M, N_, K_, Op, ldc_, st_, sc_, rs_)
#define PANEL_SQL(e_, ro_) PanelSqLast{(float*)(ws + WS_SLOTS) + ((size_t)(e_) * M + (ro_)) * 8, (unsigned*)(ws + WS_CTL) + CW_PANEL + ((e_) * 64 + (ro_) / 256) * 64, (float*)(ws + WS_RINV) + (ro_)}
#define PANEL_SQ(e_, ro_) PanelSq{(float*)(ws + WS_SLOTS) + ((size_t)(e_) * M + (ro_)) * 8, (unsigned*)(ws + WS_CTL) + CW_PANEL + ((e_) * 64 + (ro_) / 256) * 64, (unsigned*)(ws + WS_CTL) + CW_XTMO}
#define GEMM_FUSED(XF32_, FINAL_, W8_, F8_, Ap, Btp, K_, osc_, ro_, xoldp, gp, e1_, e2_) GEMM_FUSED8(XF32_, FINAL_, W8_, F8_, Ap, Btp, K_, osc_, ro_, xoldp, gp, e1_, e2_, WS_X8)
#define GEMM_FUSED8(XF32_, FINAL_, W8_, F8_, Ap, Btp, K_, osc_, ro_, xoldp, gp, e1_, e2_, X8OFF_) do { pg8::Gemm g{(Ap), (Btp), M / 2, DM, (K_)}; pg8::StaticOrder S; S.init(M / 2, DM, F.G, (int)blockIdx.x); \
        EpiRmsRes<XF32_, FINAL_, W8_> E{(const void*)(xoldp), X16 + (size_t)(ro_) * DM, F.out + (size_t)(ro_) * DM, (gp), ws + (X8OFF_) + (size_t)(ro_) * DM, (osc_), PANEL_SQ(e1_, ro_), PANEL_SQL(e2_, ro_)}; \
        pg8::gemm_phase<EpiRmsRes<XF32_, FINAL_, W8_>, pg8::StaticOrder, false, true, F8_>(F.lds, g, S, E, F.tid); } while (0)
#define MLP_FULL_F(FINAL_, WUP, WDN, gp, e1_, e2_) do { { pg8::Gemm g{(const bf16*)(ws + WS_X8), (const bf16*)(ws + (WUP)), M, FF, DM / 2}; pg8::StaticOrder S; S.init(M, FF, F.G, (int)blockIdx.x); \
        EpiUp8 E{ws + WS_BIG, FF, (const float*)(ws + WS_RINV)}; pg8::gemm_phase<EpiUp8, pg8::StaticOrder, true, true, true>(F.lds, g, S, E, F.tid); } xcd_barrier(bar); PH_FENCE(); \
        GEMM_FUSED8(false, FINAL_, !(FINAL_), true, BIG, (const bf16*)(ws + (WDN)), FF / 2, 1.f / (W8SCALE * H8SCALE), 0, X16, gp, e1_, e2_, WS_A); __syncthreads(); PH_FENCE(); \
        GEMM_FUSED8(false, FINAL_, !(FINAL_), true, (const bf16*)(ws + WS_BIG + (size_t)(M / 2) * FF), (const bf16*)(ws + (WDN)), FF / 2, 1.f / (W8SCALE * H8SCALE), M / 2, X16 + (size_t)(M / 2) * DM, gp, e1_, e2_, WS_A); } while (0)

    if (IN(0)) { PH_FENCE(); p0_prologue(F); } SEAM(0);
    if (IN(1)) { PH_FENCE(); GEMM_PHASE(0, A, (const bf16*)(ws + W0_QKV), NQKV, DM, BIG, NQKV, 8, QSCALE, (const float*)(ws + WS_RINV)); } SEAM(1);
    if (IN(2)) { PH_FENCE(); cg::cmp_gate_phase(F.lds, ws, F.G, F.tid); } SEAM(2);
    if (IN(3)) { PH_FENCE(); nsa::nsa_phase(F.lds, ws, F.G, F.tid); } SEAM(3);
    if (IN(4)) { PH_FENCE(); GEMM_FUSED(true, false, true, false, A, (const bf16*)(ws + W0_O), DM, 1.f, 0, F.x, F.norm_g + 1 * DM, 0, 1); __syncthreads();
                 GEMM_FUSED(true, false, true, false, A + (size_t)(M / 2) * DM, (const bf16*)(ws + W0_O), DM, 1.f, M / 2, F.x + (size_t)(M / 2) * DM, F.norm_g + 1 * DM, 0, 1); } SEAM(4);
    if (IN(5)) { PH_FENCE(); MLP_FULL_F(false, W0_UP, W0_DN, F.norm_g + 3 * DM, 2, 3); __syncthreads(); PH_FENCE(); p_convert_l1a(F); } SEAM(5);
    if (IN(6)) { PH_FENCE(); pg8::Gemm g{(const bf16*)(ws + WS_A), (const bf16*)(ws + W1_IN), M, FF, DM / 2}; pg8::StaticOrder S; S.init(M, FF, F.G, (int)blockIdx.x);
                 EpiAct<2> E{BIG, FF, 0, 1.f, (const float*)(ws + WS_LB), (const float*)(ws + WS_RINV), 1.f / W8SCALE}; pg8::gemm_phase<EpiAct<2>, pg8::StaticOrder, false, true, true>(F.lds, g, S, E, F.tid); } SEAM(6);
    if (IN(7)) { PH_FENCE(); const int nstat = (F.G - BATCH * NH) * NWAVES;
                 if ((int)blockIdx.x >= BATCH * NH) p_convert_l1b(F, ((int)blockIdx.x - BATCH * NH) * NWAVES + F.wave, nstat);
                 else { hg::scan_phase(F.lds, ws, F.h_on, F.G, F.tid); PH_FENCE(); p_convert_l1b(F, -1, nstat); } } SEAM(7);
    if (IN(8)) { PH_FENCE(); GEMM_FUSED(false, false, true, false, A, (const bf16*)(ws + W1_O), DM, 1.f, 0, X16, F.norm_g + 5 * DM, 4, 5); __syncthreads();
                 GEMM_FUSED(false, false, true, false, A + (size_t)(M / 2) * DM, (const bf16*)(ws + W1_O), DM, 1.f, M / 2, X16 + (size_t)(M / 2) * DM, F.norm_g + 5 * DM, 4, 5); } SEAM(8);
    if (IN(9)) { PH_FENCE(); MLP_FULL_F(true, W1_UP, W1_DN, F.norm_g + 7 * DM, 6, 7); }
#undef IN
}

extern "C" void kernel_launch(void* const* d_in, const int* in_sizes, int n_in, void* d_out, int out_size, void* d_ws, size_t ws_size, hipStream_t stream) {
    static int grid = 0;
    if (grid == 0) {
        if (n_in != 14 || in_sizes[0] != M * DM || out_size != M * DM || ws_size < WS_END) { fprintf(stderr, "kernel_launch: unexpected shapes (n_in %d, ws %zu)\n", n_in, ws_size); grid = -1; return; }
        int dev = 0, cus = 0;
        if (hipGetDevice(&dev) != hipSuccess || hipDeviceGetAttribute(&cus, hipDeviceAttributeMultiprocessorCount, dev) != hipSuccess) { grid = -1; return; }
        if (hipFuncSetAttribute((const void*)mk_fwd, hipFuncAttributeMaxDynamicSharedMemorySize, LDS_BYTES) != hipSuccess) { fprintf(stderr, "kernel_launch: hipFuncSetAttribute failed\n"); grid = -1; return; }
        (void)hipGetLastError();
        if (cus < 256) { fprintf(stderr, "kernel_launch: this kernel needs 256 co-resident workgroups (one per CU); the device has %d CUs\n", cus); grid = -1; return; }
        grid = 256;
    }
    if (grid < 0) return;
    Args a{};
    for (int i = 0; i < 14; ++i) a.in[i] = (const float*)d_in[i];
    a.out = (float*)d_out; a.ws = (unsigned char*)d_ws;
    if (hipMemsetAsync((char*)d_ws + WS_CTL, 0, CTL_ZERO_BYTES, stream) != hipSuccess) return;
    if (MK_N_LAUNCHES == 1) { a.ph_lo = 0; a.ph_hi = N_PHASES; hipLaunchKernelGGL(mk_fwd, dim3(grid), dim3(NTHREADS), LDS_BYTES, stream, a); }
    else for (int p = 0; p < N_PHASES; ++p) { a.ph_lo = p; a.ph_hi = p + 1; hipLaunchKernelGGL(mk_fwd, dim3(grid), dim3(NTHREADS), LDS_BYTES, stream, a); }
}
```

```cpp
#include <hip/hip_runtime.h>
#include <cstdio>
#include <cstdint>
namespace pg8 {
#define PG8_LAS __attribute__((address_space(3)))
typedef unsigned short bf16_t;
typedef short bf16x8 __attribute__((ext_vector_type(8)));
typedef float f32x4 __attribute__((ext_vector_type(4)));
typedef unsigned u32x4 __attribute__((ext_vector_type(4)));
constexpr int BM = 256, BK = 64, HALF = 128, HTB = HALF * BK * 2  , STAGE_BYTES = 8 * HTB, NXCD = 8, WGM = 4;

__host__ __device__ __forceinline__ int lds_byte(int r, int c) { const int st = (r >> 4) * 2 + (c >> 5), rr = r & 15, cc = c & 31, ob = rr * 64 + cc * 2; return st * 1024 + (ob ^ (((ob >> 9) & 1) << 5)); }
__host__ __device__ __forceinline__ void stage_rc(int b, int& R, int& C) { const int st = b / 1024, sb = b % 1024, swz = sb ^ (((sb >> 9) & 1) << 5); R = (st >> 1) * 16 + swz / 64; C = (st & 1) * 32 + (swz % 64) / 2; }
__host__ __device__ __forceinline__ int perm32(int rho) { const int n = rho >> 4, i = rho & 15; return 8 * (i >> 2) + 4 * n + (i & 3); }

typedef int i32x4 __attribute__((ext_vector_type(4)));
typedef int i32x8 __attribute__((ext_vector_type(8)));
struct Unit { int pm, pn; };
struct Gemm { const bf16_t* A; const bf16_t* Bt; int M, N, K; };

struct StaticOrder {
    int nM, nN, nwg, G, c;
    __host__ __device__ void init(int M, int N, int G_, int c_) { nM = M / BM; nN = N / BM; nwg = nM * nN; G = G_; c = c_; }
    __host__ __device__ bool next(int i, Unit& u) const {
        const long L = (long)i * G + c; if (L >= nwg) return false;
        int wgid = (int)L; { const int q = nwg / NXCD, r = nwg % NXCD, xcd = wgid % NXCD, off = wgid / NXCD; wgid = (xcd < r ? xcd * (q + 1) : r * (q + 1) + (xcd - r) * q) + off; }
        const int nig = WGM * nN, gid = wgid / nig, fm = gid * WGM, gsz = (nM - fm) < WGM ? (nM - fm) : WGM;
        u.pm = fm + ((wgid % nig) % gsz); u.pn = (wgid % nig) / gsz; return true;
    }
    __device__ __forceinline__ void a_ready(const Unit&) const {}
    __device__ __forceinline__ void done(const Unit&) const {}
};

__device__ __forceinline__ unsigned cvt_pk_bf16(float lo, float hi) { unsigned r; asm volatile("v_cvt_pk_bf16_f32 %0, %1, %2" : "=v"(r) : "v"(lo), "v"(hi)); return r; }
typedef float f32x2 __attribute__((ext_vector_type(2)));
__device__ __forceinline__ f32x2 gelu_pk(f32x2 v) {
    const f32x2 av = __builtin_elementwise_abs(v), d = av * 0.2316418882f + 1.0f;
    f32x2 t; t.x = __builtin_amdgcn_rcpf(d.x); t.y = __builtin_amdgcn_rcpf(d.y);
    f32x2 q = t * 0.5307027145f + (-0.7265760135f); q = q * t + 0.7107068705f; q = q * t + (-0.142248368f); q = q * t + 0.127414796f; q = q * t;
    const f32x2 s = (v * v) * (-0.72134752044f);
    f32x2 e; e.x = __builtin_amdgcn_exp2f(s.x); e.y = __builtin_amdgcn_exp2f(s.y);
    const f32x2 m = v * (q * e), r = v - m;
    f32x2 o; o.x = v.x < 0.f ? m.x : r.x; o.y = v.y < 0.f ? m.y : r.y; return o;
}

template <int ACT  > struct EpiBf16 {
    static constexpr bool PERM = true, AFTER_DRAIN = false; static_assert(ACT == 0 || ACT == 1, "EpiBf16: ACT is 0 (none) or 1 (gelu_pk)");
    bf16_t* O; int ldc; const float* bias; int split_cols; size_t split_stride; float scale0;
    __device__ __forceinline__ void operator()(const f32x4 (&acc)[2][2][4][2], const Unit& u, int wr, int wc, int fr, int fq) const {
        const int row0 = u.pm * BM + wr * 64 + fr; int colt = u.pn * BM; bf16_t* base = O;
        float sc = 1.f; if (split_cols) { const int t = colt / split_cols; base += (size_t)t * split_stride; colt -= t * split_cols; if (t == 0) sc = scale0; }
        const int col0 = colt + wc * 32 + 8 * fq, bcol0 = u.pn * BM + wc * 32 + 8 * fq;
        f32x4 bv[2][2];
#pragma unroll
        for (int bj = 0; bj < 2; ++bj)
#pragma unroll
            for (int n = 0; n < 2; ++n) bv[bj][n] = bias ? *(const f32x4*)(bias + bcol0 + bj * HALF + 4 * n) : (f32x4){0.f, 0.f, 0.f, 0.f};
#pragma unroll
        for (int ai = 0; ai < 2; ++ai)
#pragma unroll
            for (int m = 0; m < 4; ++m) { bf16_t* rowp = base + (size_t)(row0 + ai * HALF + m * 16) * ldc + col0;
#pragma unroll
                for (int bj = 0; bj < 2; ++bj) { f32x4 v0 = acc[ai][bj][m][0] + bv[bj][0], v1 = acc[ai][bj][m][1] + bv[bj][1];
                    if (ACT == 1) { f32x2 a = gelu_pk((f32x2){v0[0], v0[1]}), b = gelu_pk((f32x2){v0[2], v0[3]}), c = gelu_pk((f32x2){v1[0], v1[1]}), d = gelu_pk((f32x2){v1[2], v1[3]});
                        v0 = (f32x4){a.x, a.y, b.x, b.y}; v1 = (f32x4){c.x, c.y, d.x, d.y}; }
                    v0 = v0 * sc; v1 = v1 * sc; u32x4 w; w.x = cvt_pk_bf16(v0[0], v0[1]); w.y = cvt_pk_bf16(v0[2], v0[3]); w.z = cvt_pk_bf16(v1[0], v1[1]); w.w = cvt_pk_bf16(v1[2], v1[3]);
                    *(u32x4*)(rowp + bj * HALF) = w; } }
    }
};
__device__ __forceinline__ void mfma_f8(f32x4& c, const i32x8 a, const i32x8 b) { asm volatile("s_nop 1\n\tv_mfma_f32_16x16x128_f8f6f4 %0, %1, %2, %0" : "+v"(c) : "v"(a), "v"(b)); }
template <class Epi, class Sched, bool ALIGN_EPI = false, bool SP2 = false, bool F8 = false>
__device__ __forceinline__ void gemm_phase(PG8_LAS unsigned char* lds, const Gemm g, const Sched& S, const Epi& E, const int tid) {
    const int wid = __builtin_amdgcn_readfirstlane(tid >> 6), lane = tid & 63, wr = wid >> 2, wc = wid & 3, fr = lane & 15, fq = lane >> 4;
    const int K = g.K, nt = K / BK;
    unsigned voffA[2], voffB[2];
#pragma unroll
    for (int i = 0; i < 2; ++i) { int R, C; stage_rc(tid * 16 + i * 8192, R, C); const int Rb = Epi::PERM ? ((R & ~31) + perm32(R & 31)) : R;
        voffA[i] = (unsigned)(R * K + C) * 2u; voffB[i] = (unsigned)(Rb * K + C) * 2u; }
    const size_t kstep = (size_t)(BK * 2);
    const size_t hstep = (size_t)HALF * K * 2;
    const size_t tstep = 2 * hstep;
    const unsigned ldsw = (unsigned)wid * 1024u;
    const int aoff = lds_byte(wr * 64 + fr, fq * 8), boff = lds_byte(wc * 32 + fr, fq * 8);
#define PG8_SA(b, h) (((b) * 2 + (h)) * HTB)
#define PG8_SB(b, h) ((4 + (b) * 2 + (h)) * HTB)
#define PG8_STAGE(bufoff, gbase, voff) do { _Pragma("unroll") for (int _i = 0; _i < 2; ++_i) \
        __builtin_amdgcn_global_load_lds((const unsigned*)((const char*)(gbase) + (voff)[_i]), (PG8_LAS unsigned*)(lds + (bufoff) + ldsw + _i * 8192), 16, 0, 0); } while (0)
#define PG8_LDA(dst, b, h) do { _Pragma("unroll") for (int m = 0; m < 4; ++m) _Pragma("unroll") for (int k = 0; k < 2; ++k) dst[m][k] = *(const PG8_LAS bf16x8*)(lds + PG8_SA(b, h) + aoff + m * 2048 + k * 1024); } while (0)
#define PG8_LDB(dst, b, h) do { _Pragma("unroll") for (int n = 0; n < 2; ++n) _Pragma("unroll") for (int k = 0; k < 2; ++k) dst[n][k] = *(const PG8_LAS bf16x8*)(lds + PG8_SB(b, h) + boff + n * 2048 + k * 1024); } while (0)
#define PG8_CAT8(x) __builtin_shufflevector(__builtin_bit_cast(i32x4, (x)[0]), __builtin_bit_cast(i32x4, (x)[1]), 0, 1, 2, 3, 4, 5, 6, 7)
#define PG8_MMA(ai, bj, At, Bt) do { __builtin_amdgcn_s_setprio(1); _Pragma("unroll") for (int m = 0; m < 4; ++m) _Pragma("unroll") for (int n = 0; n < 2; ++n) { \
        if constexpr (F8) mfma_f8(acc[ai][bj][m][n], PG8_CAT8(Bt[n]), PG8_CAT8(At[m])); \
        else { _Pragma("unroll") for (int k = 0; k < 2; ++k) acc[ai][bj][m][n] = __builtin_amdgcn_mfma_f32_16x16x32_bf16(Bt[n][k], At[m][k], acc[ai][bj][m][n], 0, 0, 0); } } __builtin_amdgcn_s_setprio(0); } while (0)
#define PG8_WAIT_V(n) asm volatile("s_waitcnt vmcnt(" #n ")" ::: "memory")
#define PG8_WAIT_L(n) asm volatile("s_waitcnt lgkmcnt(" #n ")" ::: "memory")
#define PG8_BAR __builtin_amdgcn_s_barrier()
#define PG8_SCHED __builtin_amdgcn_sched_barrier(0)
    Unit cur, nxt; int ui = 0;
    if (!S.next(0, cur)) return;
    float epre[8]; E.prefetch(cur, wr, fr, epre);
    f32x4 acc[2][2][4][2];
#pragma unroll
    for (int a = 0; a < 2; ++a)
#pragma unroll
        for (int b = 0; b < 2; ++b)
#pragma unroll
            for (int m = 0; m < 4; ++m)
#pragma unroll
                for (int n = 0; n < 2; ++n) acc[a][b][m][n] = (f32x4){0.f, 0.f, 0.f, 0.f};
    bf16x8 At[4][2], B0[2][2], B1[2][2];
    const char* cA = (const char*)g.A + (size_t)cur.pm * tstep; const char* cB = (const char*)g.Bt + (size_t)cur.pn * tstep;
    S.a_ready(cur);
    if constexpr (SP2) {
        PG8_STAGE(PG8_SB(0, 0), cB, voffB); PG8_STAGE(PG8_SB(0, 1), cB + hstep, voffB); PG8_STAGE(PG8_SA(0, 0), cA, voffA); PG8_STAGE(PG8_SA(0, 1), cA + hstep, voffA);
        if (wr == 1) PG8_BAR;
        PG8_WAIT_V(2); PG8_BAR;
        PG8_STAGE(PG8_SB(1, 0), cB + kstep, voffB); PG8_STAGE(PG8_SB(1, 1), cB + hstep + kstep, voffB);
        PG8_WAIT_V(4); PG8_BAR;
    } else {
        PG8_STAGE(PG8_SB(0, 0), cB, voffB); PG8_STAGE(PG8_SA(0, 0), cA, voffA); PG8_STAGE(PG8_SB(0, 1), cB + hstep, voffB); PG8_STAGE(PG8_SA(0, 1), cA + hstep, voffA);
        if (wr == 1) PG8_BAR;
        PG8_WAIT_V(4); PG8_BAR;
        PG8_STAGE(PG8_SB(1, 0), cB + kstep, voffB); PG8_STAGE(PG8_SA(1, 0), cA + kstep, voffA); PG8_STAGE(PG8_SB(1, 1), cB + hstep + kstep, voffB);
        PG8_WAIT_V(6); PG8_BAR;
    }
    for (;;) {
        const bool has_next = S.next(ui + 1, nxt);
        const char* nA = has_next ? (const char*)g.A + (size_t)nxt.pm * tstep : cA; const char* nB = has_next ? (const char*)g.Bt + (size_t)nxt.pn * tstep : cB;
        for (int t = 0; t < nt; t += 2) {
            const bool last = (t == nt - 2);
            const char* a1 = cA + (size_t)(t + 1) * kstep;
            const char* a2 = last ? nA : cA + (size_t)(t + 2) * kstep; const char* b2 = last ? nB : cB + (size_t)(t + 2) * kstep;
            const char* a3 = a2 + kstep; const char* b3 = b2 + kstep;
            if (last && has_next) S.a_ready(nxt);
            if constexpr (SP2) {
            PG8_LDB(B0, 0, 0); PG8_LDB(B1, 0, 1); PG8_SCHED; PG8_LDA(At, 0, 0); PG8_STAGE(PG8_SA(1, 0), a1, voffA); PG8_STAGE(PG8_SA(1, 1), a1 + hstep, voffA);
            PG8_WAIT_V(8); PG8_WAIT_L(0); PG8_BAR; PG8_MMA(0, 0, At, B0); PG8_MMA(0, 1, At, B1); PG8_BAR; PG8_SCHED;
            PG8_LDA(At, 0, 1); PG8_STAGE(PG8_SB(0, 0), b2, voffB); PG8_STAGE(PG8_SB(0, 1), b2 + hstep, voffB);
            PG8_WAIT_V(6); PG8_WAIT_L(0); PG8_BAR; PG8_MMA(1, 0, At, B0); PG8_MMA(1, 1, At, B1); PG8_BAR; PG8_SCHED;
            PG8_LDB(B0, 1, 0); PG8_LDB(B1, 1, 1); PG8_SCHED; PG8_LDA(At, 1, 0); PG8_STAGE(PG8_SA(0, 0), a2, voffA); PG8_STAGE(PG8_SA(0, 1), a2 + hstep, voffA);
            PG8_WAIT_V(8); PG8_WAIT_L(0); PG8_BAR; PG8_MMA(0, 0, At, B0); PG8_MMA(0, 1, At, B1); PG8_BAR; PG8_SCHED;
            PG8_LDA(At, 1, 1); PG8_STAGE(PG8_SB(1, 0), b3, voffB); PG8_STAGE(PG8_SB(1, 1), b3 + hstep, voffB);
            PG8_WAIT_V(6); PG8_WAIT_L(0); PG8_BAR; PG8_MMA(1, 0, At, B0); PG8_MMA(1, 1, At, B1); PG8_BAR; PG8_SCHED;
            } else {
            PG8_LDB(B0, 0, 0); PG8_SCHED; PG8_LDA(At, 0, 0); PG8_STAGE(PG8_SA(1, 1), a1 + hstep, voffA);
            PG8_WAIT_L(8); PG8_BAR; PG8_WAIT_L(0); PG8_MMA(0, 0, At, B0); PG8_BAR; PG8_SCHED;
            PG8_LDB(B1, 0, 1); PG8_STAGE(PG8_SB(0, 0), b2, voffB);
            PG8_BAR; PG8_WAIT_L(0); PG8_MMA(0, 1, At, B1); PG8_BAR;
            PG8_LDA(At, 0, 1); PG8_STAGE(PG8_SA(0, 0), a2, voffA);
            PG8_BAR; PG8_WAIT_L(0); PG8_MMA(1, 0, At, B0); PG8_BAR; PG8_SCHED;
            PG8_STAGE(PG8_SB(0, 1), b2 + hstep, voffB);
            PG8_WAIT_V(6); PG8_BAR; PG8_MMA(1, 1, At, B1); PG8_BAR;
            PG8_LDB(B0, 1, 0); PG8_SCHED; PG8_LDA(At, 1, 0); PG8_STAGE(PG8_SA(0, 1), a2 + hstep, voffA);
            PG8_WAIT_L(8); PG8_BAR; PG8_WAIT_L(0); PG8_MMA(0, 0, At, B0); PG8_BAR; PG8_SCHED;
            PG8_LDB(B1, 1, 1); PG8_STAGE(PG8_SB(1, 0), b3, voffB);
            PG8_BAR; PG8_WAIT_L(0); PG8_MMA(0, 1, At, B1); PG8_BAR;
            PG8_LDA(At, 1, 1); PG8_STAGE(PG8_SA(1, 0), a3, voffA);
            PG8_BAR; PG8_WAIT_L(0); PG8_MMA(1, 0, At, B0); PG8_BAR; PG8_SCHED;
            PG8_STAGE(PG8_SB(1, 1), b3 + hstep, voffB);
            PG8_WAIT_V(6); PG8_BAR; PG8_MMA(1, 1, At, B1); PG8_BAR;
            }
        }
        if constexpr (F8) { asm volatile("s_nop 15"); PG8_SCHED; }
        if constexpr (ALIGN_EPI) { if (wr == 0) PG8_BAR; }
        if constexpr (!Epi::AFTER_DRAIN) { E(acc, cur, wr, wc, fr, fq, epre); S.done(cur); }
        if (!has_next) break;
#pragma unroll
        for (int a = 0; a < 2; ++a)
#pragma unroll
            for (int b = 0; b < 2; ++b)
#pragma unroll
                for (int m = 0; m < 4; ++m)
#pragma unroll
                    for (int n = 0; n < 2; ++n) acc[a][b][m][n] = (f32x4){0.f, 0.f, 0.f, 0.f};
        cur = nxt; cA = nA; cB = nB; ++ui;
        E.prefetch(cur, wr, fr, epre);
        if constexpr (ALIGN_EPI) { if (wr == 1) PG8_BAR; }
    }
    PG8_WAIT_V(0);
    if constexpr (!ALIGN_EPI) { if (wr == 0) PG8_BAR; }
    PG8_BAR;
    if constexpr (Epi::AFTER_DRAIN) { E.fused(acc, cur, wr, wc, fr, fq, lds, wid, lane); S.done(cur); }
#undef PG8_SA
#undef PG8_SB
#undef PG8_STAGE
#undef PG8_LDA
#undef PG8_LDB
#undef PG8_MMA
#undef PG8_CAT8
#undef PG8_WAIT_V
#undef PG8_WAIT_L
#undef PG8_BAR
#undef PG8_SCHED
}
}

constexpr int NWAVES = 8, NTHREADS = 512;
constexpr int BATCH = 8, SEQ = 2048, DM = 2048, M = BATCH * SEQ, NH = 16, NG = 4, NR = 4, HD = 128, FF = 8192;
constexpr int NQKV = 5120, NSA_IN = 5168, NC = 127, NCP = 128, NBLK = 32, NGATE = 48;
constexpr float RMS_EPS = 1e-6f;
constexpr int COL_KC = 2048, COL_VC = 2560, COL_KS = 3072, COL_VS = 3584, COL_KW = 4096, COL_VW = 4608;
constexpr float QSCALE = 0.12751743082459868f;

constexpr size_t MiB = 1u << 20;
constexpr size_t WS_CTL = 0, CTL_ZERO_BYTES = 256 * 1024;
constexpr size_t WS_LUT = 1 * MiB, WS_BIAS1 = WS_LUT + 16 * 1024  , WS_LB = WS_BIAS1 + 8192;
constexpr size_t WS_GATES = 2 * MiB;
constexpr size_t WS_KCMP = 5 * MiB, WS_VCMP = 6 * MiB;
constexpr size_t WS_W = 8 * MiB;
constexpr size_t W0_QKV = WS_W, W0_G = WS_W + 20 * MiB, W0_W1 = WS_W + 21 * MiB, W0_W2 = WS_W + 23 * MiB, W0_O = WS_W + 24 * MiB, W0_UP = WS_W + 32 * MiB, W0_DN = WS_W + 64 * MiB;
constexpr size_t W1_IN = WS_W, W1_O = WS_W + 32 * MiB, W1_UP = WS_W + 40 * MiB, W1_DN = WS_W + 72 * MiB;
constexpr size_t WS_A = 120 * MiB;
constexpr size_t WS_BIG = 184 * MiB;
constexpr size_t WS_SCR = WS_W + 80 * MiB;
constexpr size_t WS_X8 = WS_BIG + 128 * MiB;
constexpr float W8SCALE = 64.f, H8SCALE = 4.f;
constexpr size_t WS_X16 = 440 * MiB;
constexpr size_t WS_RINV = 1 * MiB + 64 * 1024;
constexpr size_t WS_SLOTS = 504 * MiB;
constexpr size_t WS_END = 508 * MiB;
constexpr int CW_XTMO = 64, CW_CONVQ = 128, CW_PANEL = 8192;

constexpr int LDS_BYTES = 147456;

#define GAS __attribute__((address_space(1)))
#define LAS __attribute__((address_space(3)))
typedef unsigned short bf16;
typedef unsigned v4u __attribute__((ext_vector_type(4)));
typedef unsigned v2u __attribute__((ext_vector_type(2)));
typedef float f32x4 __attribute__((ext_vector_type(4)));
#define LDS_WAIT() asm volatile("s_waitcnt lgkmcnt(0)" ::: "memory")
#define VM_WAIT() asm volatile("s_waitcnt vmcnt(0)" ::: "memory")
__device__ __forceinline__ unsigned f2bf(float f) { unsigned u = __builtin_bit_cast(unsigned, f); return (u + 0x7fffu + ((u >> 16) & 1u)) >> 16; }
__device__ __forceinline__ unsigned pk2(float lo, float hi) { return f2bf(lo) | (f2bf(hi) << 16); }
__device__ __forceinline__ float bf2f(unsigned b) { return __builtin_bit_cast(float, b << 16); }
__device__ __forceinline__ float bflo(unsigned w) { return __builtin_bit_cast(float, w << 16); }
__device__ __forceinline__ float bfhi(unsigned w) { return __builtin_bit_cast(float, w & 0xffff0000u); }
__device__ __forceinline__ float wave_sum(float v) {
#pragma unroll
    for (int o = 1; o < 64; o <<= 1) v += __shfl_xor(v, o);
    return v;
}
__device__ __forceinline__ float wave_max(float v) {
#pragma unroll
    for (int o = 1; o < 64; o <<= 1) v = fmaxf(v, __shfl_xor(v, o));
    return v;
}
__device__ __forceinline__ int lane_id() { int l; asm volatile("v_mbcnt_lo_u32_b32 %0, -1, 0\n\tv_mbcnt_hi_u32_b32 %0, -1, %0" : "=v"(l)); return l; }
__device__ __forceinline__ float sigmoidf_(float x) { return 1.f / (1.f + __expf(-x)); }

typedef GAS unsigned gu32;
#define RLX_AGENT __ATOMIC_RELAXED, __HIP_MEMORY_SCOPE_AGENT
#define XB_TMO      128
#define XB_XCNT(j)  (256  + 64 * (j))
#define XB_XSUB(j)  (1280 + 64 * (j))
#define XB_XGEN(j)  (2304 + 64 * (j))
#define XB_TOP      3328
#define XB_TOPGEN   3392
#define XCD_BAR_WORDS 3456
#define XB_SPIN_CAP (1u << 24)

__device__ __forceinline__ unsigned xb_ld(unsigned* p)              { return __hip_atomic_load(p, __ATOMIC_RELAXED, __HIP_MEMORY_SCOPE_AGENT); }
__device__ __forceinline__ unsigned xb_add(unsigned* p, unsigned v) { return __hip_atomic_fetch_add(p, v, __ATOMIC_RELAXED, __HIP_MEMORY_SCOPE_AGENT); }
__device__ __forceinline__ unsigned xb_xcc_id() { return (unsigned)__builtin_amdgcn_s_getreg((3 << 11) | 20) & 0xFu; }
#define XB_SPIN(cond, bar) do { unsigned _sp = 0; while (cond) { __builtin_amdgcn_s_sleep(1); \
    if ((++_sp & 255u) == 0u) { if (xb_ld(&(bar)[XB_TMO])) break; if (_sp > XB_SPIN_CAP) { atomicAdd(&(bar)[XB_TMO], 1u); break; } } } } while (0)

struct XcdBarrier {
    int wave;
    unsigned* bar; unsigned x;
    volatile LAS unsigned* st;
};

__device__ __forceinline__ XcdBarrier xcd_barrier_post(unsigned* bar, volatile LAS unsigned* st, int wave) {
    XcdBarrier b; b.wave = wave; b.bar = bar; b.x = xb_xcc_id(); b.st = st;
    if (wave == 0 && lane_id() == 0) (void)xb_add(&bar[XB_XCNT(b.x)], 1u);
    return b;
}
__device__ __forceinline__ void xcd_barrier_complete(unsigned* bar, unsigned x, unsigned& nloc, unsigned& nx) {
    const unsigned G = gridDim.x * gridDim.y * gridDim.z;
    unsigned sum, cnt, mine, sp = 0u;
    for (;;) {
        sum = 0u; cnt = 0u; mine = 0u;
#pragma unroll
        for (unsigned j = 0; j < 16; ++j) { const unsigned c = xb_ld(&bar[XB_XCNT(j)]); sum += c; cnt += (c > 0u) ? 1u : 0u; mine = (j == x) ? c : mine; }
        if (sum == G) break;
        __builtin_amdgcn_s_sleep(1);
        if ((++sp & 255u) == 0u) { if (xb_ld(&bar[XB_TMO])) break; if (sp > XB_SPIN_CAP) { atomicAdd(&bar[XB_TMO], 1u); break; } }
    }
    nloc = mine > 0u ? mine : 1u; nx = cnt > 0u ? cnt : 1u;
}

__device__ __forceinline__ void xcd_barrier(const XcdBarrier& b) {
    asm volatile("s_waitcnt vmcnt(0)" ::: "memory");
    __syncthreads();
    if (b.wave == 0 && lane_id() == 0) {
        unsigned* bar = b.bar;
        __builtin_amdgcn_s_waitcnt(0);
        unsigned nloc = b.st[0], nx = b.st[1];
        if (nloc == 0u) { xcd_barrier_complete(bar, b.x, nloc, nx); b.st[0] = nloc; b.st[1] = nx; }
        const unsigned old = xb_add(&bar[XB_XSUB(b.x)], 1u);
        const unsigned gen = old / nloc;
        if (old + 1u == (gen + 1u) * nloc) {
            __builtin_amdgcn_fence(__ATOMIC_RELEASE, "agent");
            asm volatile("s_waitcnt vmcnt(0)" ::: "memory");
            const unsigned og = xb_add(&bar[XB_TOP], 1u);
            const unsigned tg = og / nx;
            if (og + 1u == (tg + 1u) * nx) xb_add(&bar[XB_TOPGEN], 1u);
            else XB_SPIN(xb_ld(&bar[XB_TOPGEN]) == tg, bar);
            __builtin_amdgcn_fence(__ATOMIC_ACQUIRE, "agent");
            xb_add(&bar[XB_XGEN(b.x)], 1u);
            asm volatile("s_waitcnt vmcnt(0)" ::: "memory");
        } else {
            XB_SPIN(xb_ld(&bar[XB_XGEN(b.x)]) == gen, bar);
            __builtin_amdgcn_fence(__ATOMIC_ACQUIRE, "agent");
            asm volatile("s_waitcnt vmcnt(0)" ::: "memory");
        }
    }
    __syncthreads();
}

struct Frame {
    LAS unsigned char* lds;
    int tid, lane, wave, G, gw, NGW;
    const float *x, *norm_g, *rel, *w_in, *pe, *cw1, *cw2, *w_out, *h_in, *h_lb, *h_on, *h_out, *up, *dn;
    float* out;
    unsigned char* ws;
};

template <int ACT  > struct EpiAct {
    static constexpr bool PERM = true, AFTER_DRAIN = false;
    bf16* O; int ldc; int scale_tiles; float scale; const float* lb; const float* rs; float rsmul;
    __device__ __forceinline__ void prefetch(const pg8::Unit& u, int wr, int fr, float (&pre)[8]) const {
        const int row0 = u.pm * 256 + wr * 64 + fr;
#pragma unroll
        for (int j = 0; j < 8; ++j) pre[j] = rs ? rs[row0 + (j >> 2) * 128 + (j & 3) * 16] * rsmul : 1.f;
    }
    __device__ __forceinline__ void operator()(const pg8::f32x4 (&acc)[2][2][4][2], const pg8::Unit& u, int wr, int wc, int fr, int fq, const float (&pre)[8]) const {
        const int row0 = u.pm * 256 + wr * 64 + fr, col0 = u.pn * 256 + wc * 32 + 8 * fq;
        const float sc = (u.pn < scale_tiles) ? scale : 1.f;
        const int kind = (ACT == 2) ? ((u.pn < 8 || u.pn >= 24) ? 1 : (u.pn < 16 ? 2 : 0)) : 0;
        pg8::f32x4 lbv[2][2];
        if (ACT == 2) {
#pragma unroll
            for (int bj = 0; bj < 2; ++bj)
#pragma unroll
                for (int n = 0; n < 2; ++n) lbv[bj][n] = (kind == 2) ? *(const pg8::f32x4*)(lb + (col0 - 2048) + bj * 128 + 4 * n) : (pg8::f32x4){0.f, 0.f, 0.f, 0.f};
        }
#pragma unroll
        for (int ai = 0; ai < 2; ++ai)
#pragma unroll
            for (int m = 0; m < 4; ++m) { bf16* rowp = O + (size_t)(row0 + ai * 128 + m * 16) * ldc + col0; const float rsc = pre[ai * 4 + m];
#pragma unroll
                for (int bj = 0; bj < 2; ++bj) { pg8::f32x4 v0 = acc[ai][bj][m][0] * rsc, v1 = acc[ai][bj][m][1] * rsc;
                    if (ACT == 2) {
                        if (kind == 1) {
#pragma unroll
                            for (int j = 0; j < 4; ++j) { v0[j] = v0[j] * __builtin_amdgcn_rcpf(1.f + __expf(-v0[j])); v1[j] = v1[j] * __builtin_amdgcn_rcpf(1.f + __expf(-v1[j])); }
                        } else if (kind == 2) {
#pragma unroll
                            for (int j = 0; j < 4; ++j) { const float l0 = lbv[bj][0][j], l1 = lbv[bj][1][j];
                                v0[j] = __logf(l0 + (1.f - l0) * __builtin_amdgcn_rcpf(1.f + __expf(-v0[j]))); v1[j] = __logf(l1 + (1.f - l1) * __builtin_amdgcn_rcpf(1.f + __expf(-v1[j]))); }
                        }
                    } else { v0 = v0 * sc; v1 = v1 * sc; }
                    pg8::u32x4 w; w.x = pg8::cvt_pk_bf16(v0[0], v0[1]); w.y = pg8::cvt_pk_bf16(v0[2], v0[3]); w.z = pg8::cvt_pk_bf16(v1[0], v1[1]); w.w = pg8::cvt_pk_bf16(v1[2], v1[3]);
                    if (ACT == 2) __builtin_nontemporal_store(w, (pg8::u32x4*)(rowp + bj * 128));
                    else *(pg8::u32x4*)(rowp + bj * 128) = w; } }
    }
};

__device__ __forceinline__ unsigned pk8(float a, float b, float c, float d) { int w = 0; w = __builtin_amdgcn_cvt_pk_fp8_f32(a, b, w, false); w = __builtin_amdgcn_cvt_pk_fp8_f32(c, d, w, true); return (unsigned)w; }
struct EpiUp8 {
    static constexpr bool PERM = true, AFTER_DRAIN = false;
    unsigned char* O; int ldc; const float* rs;
    __device__ __forceinline__ void prefetch(const pg8::Unit& u, int wr, int fr, float (&pre)[8]) const {
        const int row0 = u.pm * 256 + wr * 64 + fr;
#pragma unroll
        for (int j = 0; j < 8; ++j) pre[j] = rs[row0 + (j >> 2) * 128 + (j & 3) * 16] * (2.f / W8SCALE);
    }
    __device__ __forceinline__ void operator()(const pg8::f32x4 (&acc)[2][2][4][2], const pg8::Unit& u, int wr, int wc, int fr, int fq, const float (&pre)[8]) const {
        static_assert(H8SCALE == 4.f, "EpiUp8 folds sqrt(H8SCALE) = 2 into the row scale");
        const int row0 = u.pm * 256 + wr * 64 + fr, col0 = u.pn * 256 + wc * 32 + 8 * fq;
#pragma unroll
        for (int ai = 0; ai < 2; ++ai)
#pragma unroll
            for (int m = 0; m < 4; ++m) { const float rsc = pre[ai * 4 + m]; v2u w[2];
#pragma unroll
                for (int bj = 0; bj < 2; ++bj) { pg8::f32x4 v0 = acc[ai][bj][m][0] * rsc, v1 = acc[ai][bj][m][1] * rsc;
#pragma unroll
                    for (int j = 0; j < 4; ++j) { v0[j] = __builtin_amdgcn_fmed3f(v0[j], 0.f, 21.166010488f); v1[j] = __builtin_amdgcn_fmed3f(v1[j], 0.f, 21.166010488f); }
                    v0 = v0 * v0; v1 = v1 * v1;
                    w[bj].x = pk8(v0[0], v0[1], v0[2], v0[3]); w[bj].y = pk8(v1[0], v1[1], v1[2], v1[3]); }
                const auto sx = __builtin_amdgcn_permlane16_swap(w[0].x, w[1].x, false, false); const auto sy = __builtin_amdgcn_permlane16_swap(w[0].y, w[1].y, false, false);
                *(v4u*)(O + (size_t)(row0 + ai * 128 + m * 16) * ldc + u.pn * 256 + wc * 32 + 8 * (fq & ~1) + (fq & 1) * 128) = (v4u){sx[0], sy[0], sx[1], sy[1]}; }
    }
};

struct PanelSq {
    float* slots;
    unsigned* cnt;
    unsigned* tmo;
    template <class Fn> __device__ __forceinline__ void run(const float (&ssl)[8], const pg8::Unit& u, int wr, int wc, int fr, int fq, LAS unsigned char* lds, int wid, int lane, Fn&& between) const {
        LAS float* P = (LAS float*)lds; LAS float* S = (LAS float*)(lds + 8192);
#pragma unroll
        for (int j = 0; j < 8; ++j) { float t = ssl[j]; t += __shfl_xor(t, 16); t += __shfl_xor(t, 32);
            if (fq == 0) P[((j >> 2) * 128 + wr * 64 + (j & 3) * 16 + fr) * 4 + wc] = t; }
        asm volatile("s_waitcnt lgkmcnt(0)" ::: "memory"); __builtin_amdgcn_s_barrier(); asm volatile("" ::: "memory");
        const int row = wid * 32 + (lane & 31);
        if (lane < 32) { const f32x4 p4 = *(const LAS f32x4*)(P + row * 4); const float t = (p4.x + p4.y) + (p4.z + p4.w);
            __hip_atomic_store((unsigned*)(slots + (size_t)(u.pm * 256 + row) * 8 + u.pn), __builtin_bit_cast(unsigned, t), __ATOMIC_RELAXED, __HIP_MEMORY_SCOPE_AGENT); }
        asm volatile("s_waitcnt vmcnt(0)" ::: "memory");
        if (lane == 0) __hip_atomic_fetch_add(cnt + 64 * u.pm, 1u, __ATOMIC_RELAXED, __HIP_MEMORY_SCOPE_AGENT);
        between();
        if (wid == 0) {
            unsigned sp = 0;
            while ((unsigned)__builtin_amdgcn_readfirstlane(__hip_atomic_load(cnt + 64 * u.pm, __ATOMIC_RELAXED, __HIP_MEMORY_SCOPE_AGENT)) < 64u) {
                __builtin_amdgcn_s_sleep(1);
                if ((++sp & 255u) == 0u) { if (__hip_atomic_load(tmo, __ATOMIC_RELAXED, __HIP_MEMORY_SCOPE_AGENT)) break; if (sp > (1u << 24)) { if (lane == 0) __hip_atomic_store(tmo, 1u, __ATOMIC_RELAXED, __HIP_MEMORY_SCOPE_AGENT); break; } } }
            __builtin_amdgcn_fence(__ATOMIC_ACQUIRE, "agent");
        }
        asm volatile("s_waitcnt vmcnt(0) lgkmcnt(0)" ::: "memory"); __builtin_amdgcn_s_barrier(); asm volatile("" ::: "memory");
        if (lane < 32) { const unsigned* sl = (const unsigned*)(slots + (size_t)(u.pm * 256 + row) * 8); float t = 0.f;
#pragma unroll
            for (int o = 0; o < 8; ++o) t += __builtin_bit_cast(float, __hip_atomic_load(sl + o, __ATOMIC_RELAXED, __HIP_MEMORY_SCOPE_AGENT));
            S[row] = t; }
        asm volatile("s_waitcnt vmcnt(0) lgkmcnt(0)" ::: "memory"); __builtin_amdgcn_s_barrier(); asm volatile("" ::: "memory");
    }
};
struct PanelSqLast {
    float* slots; unsigned* cnt; float* rinv;
    __device__ __forceinline__ void run(const float (&ssl)[8], const pg8::Unit& u, int wr, int wc, int fr, int fq, LAS unsigned char* lds, int wid, int lane) const {
        LAS float* P = (LAS float*)lds;
#pragma unroll
        for (int j = 0; j < 8; ++j) { float t = ssl[j]; t += __shfl_xor(t, 16); t += __shfl_xor(t, 32);
            if (fq == 0) P[((j >> 2) * 128 + wr * 64 + (j & 3) * 16 + fr) * 4 + wc] = t; }
        asm volatile("s_waitcnt lgkmcnt(0)" ::: "memory"); __builtin_amdgcn_s_barrier(); asm volatile("" ::: "memory");
        const int row = wid * 32 + (lane & 31);
        if (lane < 32) { const f32x4 p4 = *(const LAS f32x4*)(P + row * 4); const float t = (p4.x + p4.y) + (p4.z + p4.w);
            __hip_atomic_store((unsigned*)(slots + (size_t)(u.pm * 256 + row) * 8 + u.pn), __builtin_bit_cast(unsigned, t), __ATOMIC_RELAXED, __HIP_MEMORY_SCOPE_AGENT); }
        asm volatile("s_waitcnt vmcnt(0)" ::: "memory");
        unsigned old = 0u;
        if (lane == 0) old = __hip_atomic_fetch_add(cnt + 64 * u.pm, 1u, __ATOMIC_RELAXED, __HIP_MEMORY_SCOPE_AGENT);
        old = (unsigned)__builtin_amdgcn_readfirstlane((int)old);
        if (old == 63u) {
            __builtin_amdgcn_fence(__ATOMIC_ACQUIRE, "agent"); asm volatile("s_waitcnt vmcnt(0)" ::: "memory");
#pragma unroll
            for (int q = 0; q < 4; ++q) { const int r = q * 64 + lane; const unsigned* sl = (const unsigned*)(slots + (size_t)(u.pm * 256 + r) * 8); float t = 0.f;
#pragma unroll
                for (int o = 0; o < 8; ++o) t += __builtin_bit_cast(float, __hip_atomic_load(sl + o, __ATOMIC_RELAXED, __HIP_MEMORY_SCOPE_AGENT));
                rinv[u.pm * 256 + r] = 1.f / sqrtf(t * (1.f / DM) + RMS_EPS); } }
    }
};
template <bool XF32  , bool FINAL  , bool W8  > struct EpiRmsRes {
    static constexpr bool PERM = true, AFTER_DRAIN = true;
    const void* xold; bf16* xnew; float* outf; const float* g; unsigned char* x8; float osc  ; PanelSq st1; PanelSqLast st2;
    __device__ __forceinline__ void prefetch(const pg8::Unit&, int, int, float (&)[8]) const {}
    __device__ __forceinline__ void fused(pg8::f32x4 (&acc)[2][2][4][2], const pg8::Unit& u, int, int, int, int, LAS unsigned char* lds, int wid, int) const {
        const int lane = lane_id(), fr = lane & 15, fq = lane >> 4, wr = wid >> 2, wc = wid & 3;
        const LAS float* S = (const LAS float*)(lds + 8192);
        const int col0 = u.pn * 256 + wc * 32 + 8 * fq;
        float ssl[8];
#pragma unroll
        for (int ai = 0; ai < 2; ++ai)
#pragma unroll
            for (int m = 0; m < 4; ++m) { float t = 0.f;
#pragma unroll
                for (int bj = 0; bj < 2; ++bj)
#pragma unroll
                    for (int n = 0; n < 2; ++n) { const pg8::f32x4 v = acc[ai][bj][m][n]; t += (v[0] * v[0] + v[1] * v[1]) + (v[2] * v[2] + v[3] * v[3]); }
                ssl[ai * 4 + m] = t; }
        constexpr int NPRE = XF32 ? 4 : 8;
        v4u xpre[NPRE][2];
        pg8::f32x4 gv[2][2];
        st1.run(ssl, u, wr, wc, fr, fq, lds, wid, lane, [&]() {
            if (!XF32) { const char* xb = (const char*)xold + (size_t)u.pm * 256 * DM * 2; asm volatile("" : "+s"(xb));
                const unsigned o0 = (unsigned)(((wr * 64 + fr) * DM + col0) * 2);
#pragma unroll
                for (int j = 0; j < 8; ++j)
#pragma unroll
                    for (int bj = 0; bj < 2; ++bj) xpre[j][bj] = *(const GAS v4u*)(xb + (o0 + (unsigned)((((j >> 2) * 128 + (j & 3) * 16) * DM + bj * 128) * 2)));
            }
#pragma unroll
            for (int bj = 0; bj < 2; ++bj)
#pragma unroll
                for (int n = 0; n < 2; ++n) gv[bj][n] = *(const pg8::f32x4*)(g + col0 + bj * 128 + 4 * n);
        });
#pragma unroll
        for (int ai = 0; ai < 2; ++ai)
#pragma unroll
            for (int m = 0; m < 4; ++m) { const int rl = ai * 128 + wr * 64 + m * 16 + fr; const float ry = osc / sqrtf(S[rl] * (osc * osc * (1.f / DM)) + RMS_EPS);
                const size_t off = (size_t)(u.pm * 256 + rl) * DM + col0; float t = 0.f; v2u w8p[2] = {(v2u){0u, 0u}, (v2u){0u, 0u}};
#pragma unroll
                for (int bj = 0; bj < 2; ++bj) { pg8::f32x4 x0, x1;
                    if (XF32) { x0 = *(const pg8::f32x4*)((const float*)xold + off + bj * 128); x1 = *(const pg8::f32x4*)((const float*)xold + off + bj * 128 + 4); }
                    else { const v4u w = xpre[ai * 4 + m][bj]; x0 = (pg8::f32x4){bflo(w.x), bfhi(w.x), bflo(w.y), bfhi(w.y)}; x1 = (pg8::f32x4){bflo(w.z), bfhi(w.z), bflo(w.w), bfhi(w.w)}; }
                    const pg8::f32x4 a0 = x0 + acc[ai][bj][m][0] * ry * gv[bj][0], a1 = x1 + acc[ai][bj][m][1] * ry * gv[bj][1];
                    t += ((a0[0] * a0[0] + a0[1] * a0[1]) + (a0[2] * a0[2] + a0[3] * a0[3])) + ((a1[0] * a1[0] + a1[1] * a1[1]) + (a1[2] * a1[2] + a1[3] * a1[3]));
                    if (FINAL) { *(pg8::f32x4*)(outf + off + bj * 128) = a0; *(pg8::f32x4*)(outf + off + bj * 128 + 4) = a1; }
                    else { pg8::u32x4 w; w.x = pg8::cvt_pk_bf16(a0[0], a0[1]); w.y = pg8::cvt_pk_bf16(a0[2], a0[3]); w.z = pg8::cvt_pk_bf16(a1[0], a1[1]); w.w = pg8::cvt_pk_bf16(a1[2], a1[3]);
                        *(pg8::u32x4*)(xnew + off + bj * 128) = w;
                        if (W8) { w8p[bj].x = pk8(__builtin_amdgcn_fmed3f(a0[0], -448.f, 448.f), __builtin_amdgcn_fmed3f(a0[1], -448.f, 448.f), __builtin_amdgcn_fmed3f(a0[2], -448.f, 448.f), __builtin_amdgcn_fmed3f(a0[3], -448.f, 448.f));
                            w8p[bj].y = pk8(__builtin_amdgcn_fmed3f(a1[0], -448.f, 448.f), __builtin_amdgcn_fmed3f(a1[1], -448.f, 448.f), __builtin_amdgcn_fmed3f(a1[2], -448.f, 448.f), __builtin_amdgcn_fmed3f(a1[3], -448.f, 448.f)); } } }
                if (W8 && !FINAL) {
                    const auto sx = __builtin_amdgcn_permlane16_swap(w8p[0].x, w8p[1].x, false, false); const auto sy = __builtin_amdgcn_permlane16_swap(w8p[0].y, w8p[1].y, false, false);
                    *(v4u*)(x8 + (size_t)(u.pm * 256 + rl) * DM + u.pn * 256 + wc * 32 + 8 * (fq & ~1) + (fq & 1) * 128) = (v4u){sx[0], sy[0], sx[1], sy[1]}; }
                ssl[ai * 4 + m] = t;
                if (XF32 && (m & 1)) asm volatile("" ::: "memory"); }
        if (FINAL) return;
        st2.run(ssl, u, wr, wc, fr, fq, lds, wid, lane);
    }
};

__device__ __forceinline__ void tr_item(const float* W, int ldw, int K, int ncols, bf16* WT, LAS float* scr, int item, int lane, const float* gk = nullptr) {
    const int nblk = (ncols + 31) / 32, kb = item / nblk, nb = item % nblk, k0 = 64 * kb, n0 = 32 * nb;
    const int nn = n0 + (lane & 31);
    float wv[32];
#pragma unroll
    for (int i = 0; i < 32; ++i) { const int kk = 2 * i + (lane >> 5); wv[i] = (nn < ncols) ? W[(size_t)(k0 + kk) * ldw + nn] : 0.f; }
#pragma unroll
    for (int i = 0; i < 32; ++i) { const int kk = 2 * i + (lane >> 5); scr[kk * 33 + (lane & 31)] = wv[i] * (gk ? gk[k0 + kk] : 1.f); }
    LDS_WAIT(); asm volatile("" ::: "memory");
    const int c = lane & 7;
#pragma unroll
    for (int j = 0; j < 4; ++j) { const int n = (lane >> 3) + 8 * j; const LAS float* s = scr + (8 * c) * 33 + n;
        v4u o; o.x = pk2(s[0 * 33], s[1 * 33]); o.y = pk2(s[2 * 33], s[3 * 33]); o.z = pk2(s[4 * 33], s[5 * 33]); o.w = pk2(s[6 * 33], s[7 * 33]);
        *(GAS v4u*)(WT + (size_t)(n0 + n) * K + k0 + 8 * c) = o; }
    LDS_WAIT(); asm volatile("" ::: "memory");
}
__device__ __forceinline__ void tr_item8(const float* W, int ldw, int K, int ncols, unsigned char* WT, LAS float* scr, int item, int lane, const float* gk = nullptr) {
    const int nblk = ncols / 32, kb = item / nblk, nb = item % nblk, k0 = 64 * kb, n0 = 32 * nb;
    const int nn = n0 + (lane & 31);
    float wv[32];
#pragma unroll
    for (int i = 0; i < 32; ++i) { const int kk = 2 * i + (lane >> 5); wv[i] = W[(size_t)(k0 + kk) * ldw + nn]; }
#pragma unroll
    for (int i = 0; i < 32; ++i) { const int kk = 2 * i + (lane >> 5); scr[kk * 33 + (lane & 31)] = wv[i] * (gk ? gk[k0 + kk] * W8SCALE : W8SCALE); }
    LDS_WAIT(); asm volatile("" ::: "memory");
    const int c = lane & 7;
#pragma unroll
    for (int j = 0; j < 4; ++j) { const int n = (lane >> 3) + 8 * j; const LAS float* s = scr + (8 * c) * 33 + n;
        v2u o; o.x = pk8(__builtin_amdgcn_fmed3f(s[0 * 33], -448.f, 448.f), __builtin_amdgcn_fmed3f(s[1 * 33], -448.f, 448.f), __builtin_amdgcn_fmed3f(s[2 * 33], -448.f, 448.f), __builtin_amdgcn_fmed3f(s[3 * 33], -448.f, 448.f));
        o.y = pk8(__builtin_amdgcn_fmed3f(s[4 * 33], -448.f, 448.f), __builtin_amdgcn_fmed3f(s[5 * 33], -448.f, 448.f), __builtin_amdgcn_fmed3f(s[6 * 33], -448.f, 448.f), __builtin_amdgcn_fmed3f(s[7 * 33], -448.f, 448.f));
        *(GAS v2u*)(WT + (size_t)(n0 + n) * K + k0 + 8 * c) = o; }
    LDS_WAIT(); asm volatile("" ::: "memory");
}
#define TR_JOB8G(Wp, ldw, K, ncols, WTp, gk) { const int ni_ = ((K) / 64) * ((ncols) / 32); if (r < ni_) { tr_item8((Wp), (ldw), (K), (ncols), (WTp), scr, r, F.lane, (gk)); continue; } r -= ni_; }
#define TR_JOBG(Wp, ldw, K, ncols, WTp, gk) { const int ni_ = ((K) / 64) * (((ncols) + 31) / 32); if (r < ni_) { tr_item((Wp), (ldw), (K), (ncols), (WTp), scr, r, F.lane, (gk)); continue; } r -= ni_; }
#define TR_JOB(Wp, ldw, K, ncols, WTp) TR_JOBG(Wp, ldw, K, ncols, WTp, nullptr)

__device__ __forceinline__ int rel_bucket(int n) {
    if (n < 16) return n;
    const float v = logf((float)n / 16.f) / 2.0794415416798357f * 16.f;
    const int l = 16 + (int)v; return l < 31 ? l : 31;
}

__device__ __forceinline__ void p0_prologue(Frame& F) {
    LAS float* scr = (LAS float*)(F.lds + F.wave * 16384);
    unsigned char* ws = F.ws;
    constexpr int NITEMS = (DM / 64) * (NQKV / 32) + (DM / 64) * 2 + 2 * (4096 / 64) * 4 + 2 * 2 * 4 + (DM / 64) * (DM / 32) + (DM / 64) * (FF / 32) + (FF / 64) * (DM / 32);
    for (int it = F.gw; it < NITEMS; it += F.NGW) {
        int r = it;
        TR_JOBG(F.w_in, NSA_IN, DM, NQKV, (bf16*)(ws + W0_QKV), F.norm_g)
        TR_JOBG(F.w_in + NQKV, NSA_IN, DM, NGATE, (bf16*)(ws + W0_G), F.norm_g)
        TR_JOB(F.cw1, HD, 4096, HD, (bf16*)(ws + W0_W1))
        TR_JOB(F.cw1 + 4096 * HD, HD, 4096, HD, (bf16*)(ws + W0_W1) + HD * 4096)
        TR_JOB(F.cw2, HD, HD, HD, (bf16*)(ws + W0_W2))
        TR_JOB(F.cw2 + HD * HD, HD, HD, HD, (bf16*)(ws + W0_W2) + HD * HD)
        TR_JOB(F.w_out, DM, DM, DM, (bf16*)(ws + W0_O))
        TR_JOB8G(F.up, FF, DM, FF, ws + W0_UP, F.norm_g + 2 * DM)
        TR_JOB8G(F.dn, DM, FF, DM, ws + W0_DN, nullptr)
    }
    if (blockIdx.x == 0) {
        float* lut = (float*)(ws + WS_LUT);
        for (int i = F.tid; i < NH * 128; i += NTHREADS) { const int h = i >> 7, d = i & 127; lut[i] = F.rel[rel_bucket(d) * NH + h] * 1.4426950408889634f; }
    }
    if (blockIdx.x == 1) {
        float* lb = (float*)(ws + WS_LB);
        for (int i = F.tid; i < DM; i += NTHREADS) lb[i] = 1.f / (1.f + expf(F.h_lb[i] - F.h_lb[DM + i]));
    }
    for (int it = F.gw; it < 2 * HD * 8; it += F.NGW) {
        const int k8 = it & 7, n = (it >> 3) & 127, kv = it >> 10; const float* pe = F.pe + kv * 4096 + 512 * k8; const float* w1 = F.cw1 + ((size_t)kv * 4096 + 512 * k8) * HD + n;
        float wv[8]; float s = 0.f;
#pragma unroll
        for (int j = 0; j < 8; ++j) wv[j] = w1[(size_t)(64 * j + F.lane) * HD];
#pragma unroll
        for (int j = 0; j < 8; ++j) s += pe[64 * j + F.lane] * wv[j];
        s = wave_sum(s);
        if (F.lane == 0) ((float*)(ws + WS_BIAS1))[k8 * 256 + kv * HD + n] = s;
    }
    { const int lane = F.lane; f32x4 xv[8]; int m = F.gw; float* rinv = (float*)(ws + WS_RINV);
      if (m < M) { const GAS f32x4* xr = (const GAS f32x4*)(F.x + (size_t)m * DM) + 2 * lane;
#pragma unroll
          for (int j = 0; j < 8; ++j) xv[j] = xr[128 * (j >> 1) + (j & 1)]; }
      for (; m < M; m += F.NGW) { f32x4 xn[8]; const int m2 = m + F.NGW;
          if (m2 < M) { const GAS f32x4* xr = (const GAS f32x4*)(F.x + (size_t)m2 * DM) + 2 * lane;
#pragma unroll
              for (int j = 0; j < 8; ++j) xn[j] = xr[128 * (j >> 1) + (j & 1)]; }
          float s = 0.f;
#pragma unroll
          for (int j = 0; j < 8; ++j) s += (xv[j].x * xv[j].x + xv[j].y * xv[j].y) + (xv[j].z * xv[j].z + xv[j].w * xv[j].w);
          const float r = 1.f / sqrtf(wave_sum(s) * (1.f / DM) + RMS_EPS);
          if (lane == 0) rinv[m] = r;
          GAS v4u* o16 = (GAS v4u*)((bf16*)(ws + WS_X16) + (size_t)m * DM) + lane;
#pragma unroll
          for (int jj = 0; jj < 4; ++jj) { v4u w; w.x = pk2(xv[2 * jj].x, xv[2 * jj].y); w.y = pk2(xv[2 * jj].z, xv[2 * jj].w); w.z = pk2(xv[2 * jj + 1].x, xv[2 * jj + 1].y); w.w = pk2(xv[2 * jj + 1].z, xv[2 * jj + 1].w); o16[64 * jj] = w; }
#pragma unroll
          for (int j = 0; j < 8; ++j) xv[j] = xn[j]; } }
}
__device__ __forceinline__ void p_convert_l1a(Frame& F) {
    LAS float* scr = (LAS float*)(F.lds + F.wave * 16384);
    unsigned char* ws = F.ws;
    constexpr int NITEMS = (DM / 64) * (FF / 32);
    for (int it = F.gw; it < NITEMS; it += F.NGW) {
        int r = it;
        TR_JOB8G(F.h_in, FF, DM, FF, ws + W1_IN, F.norm_g + 4 * DM)
    }
}
__device__ __forceinline__ void p_convert_l1b(Frame& F, int first  , int nstatic  ) {
    LAS float* scr = (LAS float*)(F.lds + F.wave * 16384);
    unsigned char* ws = F.ws; unsigned* q = (unsigned*)(ws + WS_CTL) + CW_CONVQ;
    constexpr int NITEMS = (DM / 64) * (DM / 32) + (DM / 64) * (FF / 32) + (FF / 64) * (DM / 32);
    int chunk = first;
    for (;;) {
        if (chunk < 0) { unsigned t = 0u; if (F.lane == 0) t = __hip_atomic_fetch_add(q, 1u, __ATOMIC_RELAXED, __HIP_MEMORY_SCOPE_AGENT);
            chunk = nstatic + __builtin_amdgcn_readfirstlane((int)t); }
        const int base = 8 * chunk; chunk = -1;
        if (base >= NITEMS) break;
        const int end = base + 8 < NITEMS ? base + 8 : NITEMS;
        for (int it = base; it < end; ++it) {
            int r = it;
            TR_JOB(F.h_out, DM, DM, DM, (bf16*)(ws + W1_O))
            TR_JOB8G(F.up + (size_t)DM * FF, FF, DM, FF, ws + W1_UP, F.norm_g + 6 * DM)
            TR_JOB8G(F.dn + (size_t)FF * DM, DM, FF, DM, ws + W1_DN, nullptr)
        }
    }
}


namespace cg {
typedef short bf16x8 __attribute__((ext_vector_type(8)));
typedef float f32x16 __attribute__((ext_vector_type(16)));
typedef float f32x4c __attribute__((ext_vector_type(4)));
constexpr int L_PART = 0, L_H = 131072, HRS = 272;
static_assert(L_H + 32 * HRS <= LDS_BYTES - 256, "cg LDS map");
__device__ __forceinline__ float gelu_tanh_f(float x) { const float u = 0.7978845608028654f * (x + 0.044715f * x * x * x); const float e = __expf(2.f * u); return x * (1.f - 1.f / (e + 1.f)); }

__device__ __forceinline__ void cmp_gate_phase(LAS unsigned char* lds, unsigned char* wsb, int G, const int tid) {
    const int wid = __builtin_amdgcn_readfirstlane(tid >> 6), lane = tid & 63, r32 = lane & 31, hh = lane >> 5, li = lane & 15, kq = lane >> 4;
    const bf16* proj = (const bf16*)(wsb + WS_BIG); const bf16* w1t = (const bf16*)(wsb + W0_W1); const bf16* w2t = (const bf16*)(wsb + W0_W2); const float* bias1 = (const float*)(wsb + WS_BIAS1);
    const bf16* hn = (const bf16*)(wsb + WS_X16); const bf16* wg = (const bf16*)(wsb + W0_G); float* gates = (float*)(wsb + WS_GATES); const float* rinv = (const float*)(wsb + WS_RINV);
    for (int u = blockIdx.x; u < 256; u += G) {
        const int kv = u >> 7, R0 = (u & 127) * 32, b = R0 >> 9, g = (R0 >> 7) & 3, c0 = R0 & 127;
        const int ca = (c0 + li) < NC ? (c0 + li) : NC - 1, cb = (c0 + 16 + li) < NC ? (c0 + 16 + li) : NC - 1;
        const bf16* ar0 = proj + ((size_t)b * SEQ + 16 * ca + 4 * wid) * NQKV + (kv ? COL_VC : COL_KC) + g * HD + 8 * kq;
        const bf16* ar1 = proj + ((size_t)b * SEQ + 16 * cb + 4 * wid) * NQKV + (kv ? COL_VC : COL_KC) + g * HD + 8 * kq;
        const bf16* bcol = w1t + (size_t)kv * HD * 4096 + (size_t)li * 4096 + 512 * wid + 8 * kq;
        f32x4c acc[2][8];
#pragma unroll
        for (int rt = 0; rt < 2; ++rt)
#pragma unroll
            for (int ct = 0; ct < 8; ++ct) acc[rt][ct] = (f32x4c){0.f, 0.f, 0.f, 0.f};
        for (int bt = 0; bt < 8; ++bt) {
            bf16x8 av[2][2], bv[2][8];
#pragma unroll
            for (int st = 0; st < 2; ++st) { const int s = 2 * bt + st, tk = s >> 2, d0 = (s & 3) * 32;
                av[st][0] = *(const GAS bf16x8*)(ar0 + (size_t)tk * NQKV + d0); av[st][1] = *(const GAS bf16x8*)(ar1 + (size_t)tk * NQKV + d0);
#pragma unroll
                for (int ct = 0; ct < 8; ++ct) bv[st][ct] = *(const GAS bf16x8*)(bcol + (size_t)ct * 16 * 4096 + 32 * s); }
            __builtin_amdgcn_sched_barrier(0);
#pragma unroll
            for (int st = 0; st < 2; ++st)
#pragma unroll
                for (int ct = 0; ct < 8; ++ct)
#pragma unroll
                    for (int rt = 0; rt < 2; ++rt) acc[rt][ct] = __builtin_amdgcn_mfma_f32_16x16x32_bf16(av[st][rt], bv[st][ct], acc[rt][ct], 0, 0, 0); }
#pragma unroll
        for (int rt = 0; rt < 2; ++rt)
#pragma unroll
            for (int ct = 0; ct < 8; ++ct) { const int col = 16 * ct + li, ch = (4 * rt + kq) ^ (col & 7);
                *(LAS f32x4c*)(lds + L_PART + wid * 16384 + col * 128 + ch * 16) = acc[rt][ct]; }
        LDS_WAIT();
        __syncthreads();
        { const int col = tid >> 2, rg = tid & 3;
          f32x4c s0 = (f32x4c){0.f, 0.f, 0.f, 0.f}, s1 = s0;
#pragma unroll
          for (int w = 0; w < 8; ++w) { s0 += *(const LAS f32x4c*)(lds + L_PART + w * 16384 + col * 128 + ((2 * rg) ^ (col & 7)) * 16); s1 += *(const LAS f32x4c*)(lds + L_PART + w * 16384 + col * 128 + ((2 * rg + 1) ^ (col & 7)) * 16); }
          float bs = 0.f;
#pragma unroll
          for (int k8 = 0; k8 < 8; ++k8) bs += bias1[k8 * 256 + kv * HD + col];
#pragma unroll
          for (int e = 0; e < 4; ++e) { *(LAS unsigned short*)(lds + L_H + (8 * rg + e) * HRS + col * 2) = (unsigned short)f2bf(gelu_tanh_f(s0[e] + bs));
              *(LAS unsigned short*)(lds + L_H + (8 * rg + 4 + e) * HRS + col * 2) = (unsigned short)f2bf(gelu_tanh_f(s1[e] + bs)); } }
        LDS_WAIT();
        __syncthreads();
        if (wid < 4) { const int ct = wid; f32x16 o2 = f32x16{}; const bf16* b2 = w2t + (size_t)kv * HD * HD + (size_t)(32 * ct + r32) * HD;
#pragma unroll
            for (int ks = 0; ks < 8; ++ks) { const bf16x8 a = *(const LAS bf16x8*)(lds + L_H + r32 * HRS + (16 * ks + 8 * hh) * 2); const bf16x8 bb = *(const GAS bf16x8*)(b2 + 16 * ks + 8 * hh);
                o2 = __builtin_amdgcn_mfma_f32_32x32x16_bf16(a, bb, o2, 0, 0, 0); }
            bf16* outp = (bf16*)(wsb + (kv ? WS_VCMP : WS_KCMP)) + (size_t)R0 * HD + 32 * ct + r32;
#pragma unroll
            for (int r = 0; r < 16; ++r) { const int row = (r & 3) + 8 * (r >> 2) + 4 * hh; const bool pad = ((R0 + row) & 127) == NC;
                outp[(size_t)row * HD] = pad ? (bf16)0 : (bf16)f2bf(o2[r]); } }
        __syncthreads();
    }
    for (int u = blockIdx.x; u < M / 64; u += G) {
        const int m0 = 64 * u;
        const bf16* arow = hn + (size_t)(m0 + li) * DM + 256 * wid + 8 * kq; const bf16* brow = wg + (size_t)li * DM + 256 * wid + 8 * kq;
        f32x4c acc[4][4];
#pragma unroll
        for (int rt = 0; rt < 4; ++rt)
#pragma unroll
            for (int ct = 0; ct < 4; ++ct) acc[rt][ct] = (f32x4c){0.f, 0.f, 0.f, 0.f};
        for (int bt = 0; bt < 4; ++bt) {
            bf16x8 av[2][4], bv[2][4];
#pragma unroll
            for (int st = 0; st < 2; ++st)
#pragma unroll
                for (int t4 = 0; t4 < 4; ++t4) { av[st][t4] = *(const GAS bf16x8*)(arow + (size_t)t4 * 16 * DM + 32 * (2 * bt + st)); bv[st][t4] = *(const GAS bf16x8*)(brow + (size_t)t4 * 16 * DM + 32 * (2 * bt + st)); }
            __builtin_amdgcn_sched_barrier(0);
#pragma unroll
            for (int st = 0; st < 2; ++st)
#pragma unroll
                for (int ct = 0; ct < 4; ++ct)
#pragma unroll
                    for (int rt = 0; rt < 4; ++rt) acc[rt][ct] = __builtin_amdgcn_mfma_f32_16x16x32_bf16(av[st][rt], bv[st][ct], acc[rt][ct], 0, 0, 0); }
#pragma unroll
        for (int rt = 0; rt < 4; ++rt)
#pragma unroll
            for (int ct = 0; ct < 4; ++ct) { const int col = 16 * ct + li, ch = (4 * rt + kq) ^ (col & 15);
                *(LAS f32x4c*)(lds + L_PART + wid * 16384 + col * 256 + ch * 16) = acc[rt][ct]; }
        LDS_WAIT();
        __syncthreads();
        { const int row = tid >> 3, cg8 = tid & 7;
          if (cg8 < NGATE / 8) { float v[8];
#pragma unroll
              for (int e = 0; e < 8; ++e) { const int col = 8 * cg8 + e; float s = 0.f;
#pragma unroll
                  for (int w = 0; w < 8; ++w) s += *(const LAS float*)(lds + L_PART + w * 16384 + col * 256 + (((row >> 2) ^ (col & 15)) * 16) + (row & 3) * 4);
                  v[e] = s; }
              const float rv = rinv[m0 + row];
#pragma unroll
              for (int e = 0; e < 8; ++e) v[e] = 1.f / (1.f + __expf(-v[e] * rv));
              float* gp = gates + (size_t)(m0 + row) * NGATE + 8 * cg8;
              *(f32x4c*)gp = (f32x4c){v[0], v[1], v[2], v[3]}; *(f32x4c*)(gp + 4) = (f32x4c){v[4], v[5], v[6], v[7]}; } }
        __syncthreads();
    }
}
}


namespace nsa {
typedef short bf16x8 __attribute__((ext_vector_type(8)));
typedef short s16x4 __attribute__((ext_vector_type(4)));
typedef float f32x16 __attribute__((ext_vector_type(16)));
typedef unsigned u32x4 __attribute__((ext_vector_type(4)));
constexpr int SHM = 16384;
constexpr int NBUF = 3;
constexpr int L_V = 0, L_K = NBUF * SHM, L_WS = 2 * NBUF * SHM, L_LUT = L_WS + 2048, L_IMP = L_LUT + 8192, L_SEL = L_IMP + 4 * 64 * 33 * 4, L_END = L_SEL + 256;
static_assert(L_END <= LDS_BYTES - 256, "nsa LDS map");
constexpr float THR2 = 11.5f;
#define NSA_KSWZ(row, colB) ((row) * 256 + ((colB) ^ (((row) & 7) << 4)))
#define NSA_SBAR() __builtin_amdgcn_sched_barrier(0)
__device__ __forceinline__ int v_st(int k, int c) { const int kk = (k & ~0xC) | ((k & 4) << 1) | ((k & 8) >> 1); return ((kk >> 3) * 4 + (c >> 5)) * 512 + ((kk & 7) * 32 + (c & 31)) * 2; }
__device__ __forceinline__ int v_rd_base(int lane) { return ((lane & 3) << 3) | (((lane >> 2) & 3) << 6) | (((lane >> 4) & 1) << 5) | (((lane >> 5) & 1) << 8); }
constexpr int v_rd_off(int d0, int ks, int half) { return d0 * 512 + ks * 4096 + half * 2048; }
__device__ __forceinline__ int crow(int r, int hi) { return (r & 3) + 8 * (r >> 2) + 4 * hi; }
__device__ __forceinline__ unsigned cvtpk(float lo, float hi) { unsigned r; asm volatile("v_cvt_pk_bf16_f32 %0, %1, %2" : "=v"(r) : "v"(lo), "v"(hi)); return r; }

__device__ __forceinline__ void qkt(f32x16& p0, f32x16& p1, LAS unsigned char* Kb, int r32, int hi, const bf16x8 (&qr)[8]) {
    p0 = f32x16{}; p1 = f32x16{};
    LAS unsigned char* kb[4];
#pragma unroll
    for (int dd = 0; dd < 4; ++dd) kb[dd] = Kb + NSA_KSWZ(r32, (dd * 16 + hi * 8) * 2);
#pragma unroll
    for (int d0 = 0; d0 < 8; ++d0) { LAS unsigned char* a = kb[d0 & 3] + (d0 >> 2) * 128;
        const bf16x8 b0 = *(const LAS bf16x8*)a; const bf16x8 b1 = *(const LAS bf16x8*)(a + 32 * 256);
        p0 = __builtin_amdgcn_mfma_f32_32x32x16_bf16(b0, qr[d0], p0, 0, 0, 0);
        p1 = __builtin_amdgcn_mfma_f32_32x32x16_bf16(b1, qr[d0], p1, 0, 0, 0); }
}
__device__ __forceinline__ void pv_tile(f32x16 (&o)[4], int vb, bf16x8 pa0, bf16x8 pa1, bf16x8 pa2, bf16x8 pa3) {
#define NSA_TRRD(dst, off) asm volatile("ds_read_b64_tr_b16 %0, %1 offset:%2" : "=&v"(dst) : "v"(vb), "i"(off) : "memory")
#define NSA_PV_KS(ks, pa) do { s16x4 l0, l1, l2, l3, h0, h1, h2, h3; \
        NSA_TRRD(l0, v_rd_off(0, ks, 0)); NSA_TRRD(h0, v_rd_off(0, ks, 1)); NSA_TRRD(l1, v_rd_off(1, ks, 0)); NSA_TRRD(h1, v_rd_off(1, ks, 1)); \
        NSA_TRRD(l2, v_rd_off(2, ks, 0)); NSA_TRRD(h2, v_rd_off(2, ks, 1)); NSA_TRRD(l3, v_rd_off(3, ks, 0)); NSA_TRRD(h3, v_rd_off(3, ks, 1)); \
        asm volatile("s_waitcnt lgkmcnt(0)" ::: "memory"); NSA_SBAR(); \
        o[0] = __builtin_amdgcn_mfma_f32_32x32x16_bf16(pa, (bf16x8){l0[0], l0[1], l0[2], l0[3], h0[0], h0[1], h0[2], h0[3]}, o[0], 0, 0, 0); \
        o[1] = __builtin_amdgcn_mfma_f32_32x32x16_bf16(pa, (bf16x8){l1[0], l1[1], l1[2], l1[3], h1[0], h1[1], h1[2], h1[3]}, o[1], 0, 0, 0); \
        o[2] = __builtin_amdgcn_mfma_f32_32x32x16_bf16(pa, (bf16x8){l2[0], l2[1], l2[2], l2[3], h2[0], h2[1], h2[2], h2[3]}, o[2], 0, 0, 0); \
        o[3] = __builtin_amdgcn_mfma_f32_32x32x16_bf16(pa, (bf16x8){l3[0], l3[1], l3[2], l3[3], h3[0], h3[1], h3[2], h3[3]}, o[3], 0, 0, 0); } while (0)
    NSA_PV_KS(0, pa0); NSA_PV_KS(1, pa1); NSA_PV_KS(2, pa2); NSA_PV_KS(3, pa3);
#undef NSA_PV_KS
#undef NSA_TRRD
}
__device__ __forceinline__ void pack_p(const f32x16& p0, const f32x16& p1, bf16x8& pa0, bf16x8& pa1, bf16x8& pa2, bf16x8& pa3) {
#define NSA_PK4(P, B_, OUT) do { unsigned a0 = cvtpk(P[B_ + 0], P[B_ + 1]), a1 = cvtpk(P[B_ + 2], P[B_ + 3]); \
        unsigned b0 = cvtpk(P[B_ + 4], P[B_ + 5]), b1 = cvtpk(P[B_ + 6], P[B_ + 7]); \
        auto r0 = __builtin_amdgcn_permlane32_swap(a0, b0, false, false); auto r1 = __builtin_amdgcn_permlane32_swap(a1, b1, false, false); \
        u32x4 w = {r0[0], r1[0], r0[1], r1[1]}; OUT = *reinterpret_cast<bf16x8*>(&w); } while (0)
    NSA_PK4(p0, 0, pa0); NSA_PK4(p0, 8, pa1); NSA_PK4(p1, 0, pa2); NSA_PK4(p1, 8, pa3);
#undef NSA_PK4
}
__device__ __forceinline__ float swap_max(float v) { auto rr = __builtin_amdgcn_permlane32_swap(__float_as_uint(v), __float_as_uint(v), false, false); return fmaxf(__uint_as_float(rr[0]), __uint_as_float(rr[1])); }
__device__ __forceinline__ float swap_sum(float v) { auto rr = __builtin_amdgcn_permlane32_swap(__float_as_uint(v), __float_as_uint(v), false, false); return __uint_as_float(rr[0]) + __uint_as_float(rr[1]); }

template <class T> __device__ __forceinline__ const T* opaque_s(const T* p) { asm volatile("" : "+s"(p)); return p; }
__device__ __forceinline__ void tile_dma(LAS unsigned char* lds, int buf, const bf16* Kg, const bf16* Vg, int ld, int pk0, int pk1, int pv0, int pv1, int wid) {
    const char* kb = (const char*)Kg; const char* vb = (const char*)Vg;
    LAS unsigned char* kd = lds + L_K + buf * SHM + wid * 2048; LAS unsigned char* vd = lds + L_V + buf * SHM + wid * 2048;
    __builtin_amdgcn_global_load_lds((const unsigned*)(kb + (unsigned)(((pk0 >> 8) * ld + (pk0 & 255)) * 2)), (LAS unsigned*)kd, 16, 0, 0);
    __builtin_amdgcn_global_load_lds((const unsigned*)(kb + (unsigned)(((pk1 >> 8) * ld + (pk1 & 255)) * 2)), (LAS unsigned*)(kd + 1024), 16, 0, 0);
    __builtin_amdgcn_global_load_lds((const unsigned*)(vb + (unsigned)(((pv0 >> 8) * ld + (pv0 & 255)) * 2)), (LAS unsigned*)vd, 16, 0, 0);
    __builtin_amdgcn_global_load_lds((const unsigned*)(vb + (unsigned)(((pv1 >> 8) * ld + (pv1 & 255)) * 2)), (LAS unsigned*)(vd + 1024), 16, 0, 0);
}
__device__ __forceinline__ int k_piece(int P) { const int row = P >> 8, colB = (P & 255) ^ ((row & 7) << 4); return (row << 8) | (colB >> 1); }
__device__ __forceinline__ int v_piece(int P) { const int st = P >> 9, q = (P & 511) >> 1, kk = (st >> 2) * 8 + (q >> 5), c = (st & 3) * 32 + (q & 31);
    const int k = (kk & ~0xC) | ((kk & 4) << 1) | ((kk & 8) >> 1); return (k << 8) | c; }

__device__ __forceinline__ void nsa_phase(LAS unsigned char* lds, unsigned char* wsb, int G, const int tid) {
    const int wid = __builtin_amdgcn_readfirstlane(tid >> 6), lane = tid & 63, r32 = lane & 31, hi = lane >> 5;
    const int hr = wid >> 1, th = wid & 1;
    const bf16* proj = (const bf16*)(wsb + WS_BIG); const float* gates = (const float*)(wsb + WS_GATES);
    const bf16* kcmp = (const bf16*)(wsb + WS_KCMP); const bf16* vcmp = (const bf16*)(wsb + WS_VCMP); bf16* Oout = (bf16*)(wsb + WS_A);
    float* scrl = (float*)(wsb + WS_SCR) + ((size_t)blockIdx.x * NWAVES + wid) * 4096 + lane * 64;
    LAS float* wsl = (LAS float*)(lds + L_WS) + wid * 64; LAS float* li_l = wsl; LAS float* al_l = wsl + 32;
    LAS float* lutL = (LAS float*)(lds + L_LUT); LAS float* impL = (LAS float*)(lds + L_IMP); LAS unsigned* selL = (LAS unsigned*)(lds + L_SEL);
    const int pk0 = k_piece(wid * 2048 + lane * 16), pk1 = k_piece(wid * 2048 + 1024 + lane * 16), pv0 = v_piece(wid * 2048 + lane * 16), pv1 = v_piece(wid * 2048 + 1024 + lane * 16);
    const int vb0 = (int)(unsigned)(uintptr_t)(lds + L_V) + v_rd_base(lane);
    const float NEG = -__builtin_inff();
    { const float* lut = (const float*)(wsb + WS_LUT); for (int i = tid; i < NH * 128; i += NTHREADS) lutL[i] = lut[i]; }
    __syncthreads();
    for (int ui = 0; ui < 4; ++ui) {
        const int c = blockIdx.x, bg = c & 31, j8 = (c >> 5) & 7;
        if (c >= 256 && G > 256) break;
        const unsigned long long qtab = (ui == 0) ? 0xfeebcf633dull : (ui == 1) ? 0x8ea74b49b7ull : (ui == 2) ? 0x719f062568ull : 0x110a009d43ull;
        const int qb = (int)((qtab >> (5 * j8)) & 31ull);
        const int b = bg >> 2, g = bg & 3, h = g * 4 + hr, t0 = 64 * qb, tq = t0 + 32 * th + r32;
        const size_t rowq = (size_t)b * SEQ + tq;
        const LAS float* lutp = lutL + h * 128; const float c31 = lutp[127];
        bf16x8 qr[8];
        { int hq = hi; asm volatile("" : "+v"(hq));
          const bf16* qp = proj + rowq * NQKV + h * HD + hq * 8;
#pragma unroll
          for (int d0 = 0; d0 < 8; ++d0) qr[d0] = *(const GAS bf16x8*)(qp + d0 * 16); }
        const float g_c = gates[rowq * NGATE + h], g_s = gates[rowq * NGATE + 16 + h], g_w = gates[rowq * NGATE + 32 + h];
        f32x16 o[4]; float cmp_carry = 0.f;
        {
            const bf16* kb = kcmp + (size_t)(b * NG + g) * NCP * HD; const bf16* vbp = vcmp + (size_t)(b * NG + g) * NCP * HD;
            const bool two = (t0 + 63 - 31) >= 16 * 64;
            tile_dma(lds, 0, opaque_s(kb), opaque_s(vbp), HD, pk0, pk1, pv0, pv1, wid);
            if (two) tile_dma(lds, 1, opaque_s(kb + 64 * HD), opaque_s(vbp + 64 * HD), HD, pk0, pk1, pv0, pv1, wid);
            VM_WAIT();
            __syncthreads();
            const int dqc = tq - 31 - 64 * hi;
            f32x16 sA0, sA1, sB0 = f32x16{}, sB1 = f32x16{};
            float tm = -1e30f;
            qkt(sA0, sA1, lds + L_K, r32, hi, qr);
#pragma unroll
            for (int r = 0; r < 16; ++r) { const int cc = (r & 3) + 8 * (r >> 2); const int d0 = dqc - 16 * cc, d1 = d0 - 512;
                sA0[r] = d0 >= 0 ? sA0[r] + lutp[d0 < 0 ? 0 : (d0 < 127 ? d0 : 127)] : NEG; sA1[r] = d1 >= 0 ? sA1[r] + lutp[d1 < 0 ? 0 : (d1 < 127 ? d1 : 127)] : NEG;
                tm = fmaxf(tm, fmaxf(sA0[r], sA1[r]));
                if ((r & 3) == 3) asm volatile("" ::: "memory"); }
            if (two) {
                qkt(sB0, sB1, lds + L_K + SHM, r32, hi, qr);
#pragma unroll
                for (int r = 0; r < 16; ++r) { const int cc = (r & 3) + 8 * (r >> 2); const int d0 = dqc - 1024 - 16 * cc, d1 = d0 - 512;
                    sB0[r] = d0 >= 0 ? sB0[r] + lutp[d0 < 0 ? 0 : (d0 < 127 ? d0 : 127)] : NEG; sB1[r] = d1 >= 0 ? sB1[r] + lutp[d1 < 0 ? 0 : (d1 < 127 ? d1 : 127)] : NEG;
                    tm = fmaxf(tm, fmaxf(sB0[r], sB1[r]));
                    if ((r & 3) == 3) asm volatile("" ::: "memory"); }
            }
            const float mx = swap_max(tm);
            float ps = 0.f;
#pragma unroll
            for (int r = 0; r < 16; ++r) { sA0[r] = __builtin_amdgcn_exp2f(sA0[r] - mx); sA1[r] = __builtin_amdgcn_exp2f(sA1[r] - mx); ps += sA0[r] + sA1[r]; }
            if (two) {
#pragma unroll
                for (int r = 0; r < 16; ++r) { sB0[r] = __builtin_amdgcn_exp2f(sB0[r] - mx); sB1[r] = __builtin_amdgcn_exp2f(sB1[r] - mx); ps += sB0[r] + sB1[r]; }
            }
            const float ls = swap_sum(ps);
            const float inv = ls > 0.f ? 1.f / ls : 0.f;
            LAS float* ip = impL + (hr * 64 + 32 * th + r32) * 33;
#pragma unroll
            for (int d = 0; d < 4; ++d) o[d] = f32x16{};
            if (!two) {
#pragma unroll
                for (int q = 0; q < 16; ++q) ip[16 + q] = 0.f;
            }
            auto imp_pv = [&](f32x16& p0, f32x16& p1, const int T) {
                p0 = p0 * inv; p1 = p1 * inv;
                LAS float* ipt = ip + 16 * T;
#pragma unroll
                for (int q = 0; q < 4; ++q) {
                    ipt[0 + 2 * q + hi] = (p0[4 * q] + p0[4 * q + 1]) + (p0[4 * q + 2] + p0[4 * q + 3]);
                    ipt[8 + 2 * q + hi] = (p1[4 * q] + p1[4 * q + 1]) + (p1[4 * q + 2] + p1[4 * q + 3]); }
                LDS_WAIT(); asm volatile("" ::: "memory");
#pragma unroll
                for (int q = 0; q < 4; ++q) {
                    ipt[0 + 2 * q + hi + 1] += p0[4 * q + 3];
                    if (8 + 2 * q + hi + 1 < 16) ipt[8 + 2 * q + hi + 1] += p1[4 * q + 3]; }
                const float carry = p1[15];
                LDS_WAIT(); asm volatile("" ::: "memory");
                bf16x8 pa0, pa1, pa2, pa3;
                pack_p(p0, p1, pa0, pa1, pa2, pa3); pv_tile(o, vb0 + T * SHM, pa0, pa1, pa2, pa3);
                if (T == 0) cmp_carry = carry;
            };
            imp_pv(sA0, sA1, 0);
            if (two) imp_pv(sB0, sB1, 1);
            if (hi == 1) ip[16] += cmp_carry;
            LDS_WAIT(); asm volatile("" ::: "memory");
            if (hi == 0) li_l[r32] = g_c;
            LDS_WAIT(); asm volatile("" ::: "memory");
            { float gg[16];
#pragma unroll
              for (int r = 0; r < 16; ++r) gg[r] = li_l[crow(r, hi)];
#pragma unroll
              for (int d = 0; d < 4; ++d)
#pragma unroll
                  for (int q = 0; q < 4; ++q) *(GAS f32x4*)(scrl + d * 16 + 4 * q) = (f32x4){o[d][4 * q] * gg[4 * q], o[d][4 * q + 1] * gg[4 * q + 1], o[d][4 * q + 2] * gg[4 * q + 2], o[d][4 * q + 3] * gg[4 * q + 3]}; }
            LDS_WAIT();
            __builtin_amdgcn_s_barrier(); asm volatile("" ::: "memory");
        }
        {
#pragma unroll
            for (int i = 0; i < 4; ++i) { const int tl = 8 * wid + 2 * i + hi, n = r32;
                float v = ((impL[(0 * 64 + tl) * 33 + n] + impL[(1 * 64 + tl) * 33 + n]) + impL[(2 * 64 + tl) * 33 + n]) + impL[(3 * 64 + tl) * 33 + n];
                int key = (int)((__float_as_uint(v) & ~31u) | (unsigned)(31 - n));
                if (n == 0 || n == qb || n == qb - 1) key = (int)(0x461C4000u | (unsigned)(31 - n)); else if (n > qb) key = -64 + (31 - n);
                int cnt = 0;
                for (int mm = 0; mm < 32; ++mm) { const int u = __shfl(key, (lane & 32) | mm); cnt += (u > key) ? 1 : 0; }
                const unsigned long long bal = __ballot(cnt < 8);
                if (lane == 0) { selL[8 * wid + 2 * i] = (unsigned)bal; selL[8 * wid + 2 * i + 1] = (unsigned)(bal >> 32); } }
            LDS_WAIT();
            __builtin_amdgcn_s_barrier(); asm volatile("" ::: "memory");
        }
        const unsigned selw = selL[32 * th + r32];
        const int NS = qb + 1, nlo = qb >= 8 ? qb - 8 : 0, NT = NS + (qb - nlo + 1);
        float m_reg = -1e30f, l_reg = 0.f;
#pragma unroll
        for (int d = 0; d < 4; ++d) o[d] = f32x16{};
        const bf16* kS = proj + (size_t)b * SEQ * NQKV + COL_KS + g * HD; const bf16* vS = proj + (size_t)b * SEQ * NQKV + COL_VS + g * HD;
        const bf16* kW = proj + (size_t)b * SEQ * NQKV + COL_KW + g * HD; const bf16* vW = proj + (size_t)b * SEQ * NQKV + COL_VW + g * HD;
#define NSA_TILE_K(t_) (((t_) >= NS ? kW : kS) + (size_t)(64 * ((t_) >= NS ? nlo + ((t_) - NS) : (t_))) * NQKV)
#define NSA_TILE_V(t_) (((t_) >= NS ? vW : vS) + (size_t)(64 * ((t_) >= NS ? nlo + ((t_) - NS) : (t_))) * NQKV)
        tile_dma(lds, 0, opaque_s(kS), opaque_s(vS), NQKV, pk0, pk1, pv0, pv1, wid);
        if (1 < NT) { tile_dma(lds, 1, opaque_s(NSA_TILE_K(1)), opaque_s(NSA_TILE_V(1)), NQKV, pk0, pk1, pv0, pv1, wid); asm volatile("s_waitcnt vmcnt(4)" ::: "memory"); } else VM_WAIT();
        LDS_WAIT(); __builtin_amdgcn_s_barrier(); asm volatile("" ::: "memory");
        int buf = 0;
        for (int i = 0; i < NT; ++i) {
            const bool win = i >= NS; const int n = win ? nlo + (i - NS) : i;
            if (i == NS) {
                if (hi == 0) li_l[r32] = g_s / l_reg;
                LDS_WAIT(); asm volatile("" ::: "memory");
                { float gg[16];
#pragma unroll
                  for (int r = 0; r < 16; ++r) gg[r] = li_l[crow(r, hi)];
#pragma unroll
                  for (int d = 0; d < 4; ++d)
                  {
                    f32x4 a4[4];
#pragma unroll
                    for (int q = 0; q < 4; ++q) a4[q] = *(const GAS f32x4*)(scrl + d * 16 + 4 * q);
#pragma unroll
                    for (int q = 0; q < 4; ++q) { const f32x4 a = a4[q];
                          *(GAS f32x4*)(scrl + d * 16 + 4 * q) = (f32x4){a.x + o[d][4 * q] * gg[4 * q], a.y + o[d][4 * q + 1] * gg[4 * q + 1], a.z + o[d][4 * q + 2] * gg[4 * q + 2], a.w + o[d][4 * q + 3] * gg[4 * q + 3]}; }
                    asm volatile("" ::: "memory"); }
#pragma unroll
                  for (int d = 0; d < 4; ++d) o[d] = f32x16{}; }
                LDS_WAIT(); m_reg = -1e30f; l_reg = 0.f;
            }
            if (i + 2 < NT) { const int b2 = buf + 2 >= NBUF ? buf + 2 - NBUF : buf + 2;
                tile_dma(lds, b2, opaque_s(NSA_TILE_K(i + 2)), opaque_s(NSA_TILE_V(i + 2)), NQKV, pk0, pk1, pv0, pv1, wid); }
            f32x16 p0, p1;
            qkt(p0, p1, lds + L_K + buf * SHM, r32, hi, qr);
            const bool plain = (n + 2 < qb) && !(win && n + 8 == qb);
            float bofs = 0.f;
            { const int dq = tq - 64 * n - 4 * hi; const unsigned W = win ? 512u : 0x80000000u; const bool ok = win || ((selw >> n) & 1u);
              if (plain) bofs = ok ? c31 : NEG;
              else if (n + 2 >= qb) {
#pragma unroll
                  for (int r = 0; r < 16; ++r) { const int cc = (r & 3) + 8 * (r >> 2); const int d0 = dq - cc, d1 = d0 - 32;
                      const float b0 = lutp[d0 < 0 ? 0 : (d0 < 127 ? d0 : 127)], b1 = lutp[d1 < 0 ? 0 : (d1 < 127 ? d1 : 127)];
                      p0[r] = (ok && (unsigned)d0 < W) ? p0[r] + b0 : NEG; p1[r] = (ok && (unsigned)d1 < W) ? p1[r] + b1 : NEG;
                      if ((r & 3) == 3) asm volatile("" ::: "memory"); }
              } else {
#pragma unroll
                  for (int r = 0; r < 16; ++r) { const int cc = (r & 3) + 8 * (r >> 2); const int d0 = dq - cc, d1 = d0 - 32;
                      p0[r] = (ok && (unsigned)d0 < W) ? p0[r] + c31 : NEG; p1[r] = (ok && (unsigned)d1 < W) ? p1[r] + c31 : NEG; }
              } }
            float pmax = p0[0];
#pragma unroll
            for (int r = 1; r < 16; ++r) pmax = fmaxf(pmax, p0[r]);
#pragma unroll
            for (int r = 0; r < 16; ++r) pmax = fmaxf(pmax, p1[r]);
            pmax = swap_max(pmax) + bofs;
            float mn, alpha;
            if (__all((pmax - m_reg) <= THR2)) { mn = m_reg; alpha = 1.f; }
            else { mn = fmaxf(m_reg, pmax); alpha = __builtin_amdgcn_exp2f(m_reg - mn); m_reg = mn; }
            mn -= bofs;
            float ps = 0.f;
#pragma unroll
            for (int r = 0; r < 16; ++r) { p0[r] = __builtin_amdgcn_exp2f(p0[r] - mn); p1[r] = __builtin_amdgcn_exp2f(p1[r] - mn); ps += p0[r] + p1[r]; }
            ps = swap_sum(ps);
            l_reg = l_reg * alpha + ps;
            if (__any(alpha < 1.f)) { if (hi == 0) al_l[r32] = alpha; LDS_WAIT(); asm volatile("" ::: "memory");
#pragma unroll
                for (int r = 0; r < 16; ++r) { const float aa = al_l[crow(r, hi)];
#pragma unroll
                    for (int d = 0; d < 4; ++d) o[d][r] *= aa; }
                LDS_WAIT(); }
            bf16x8 pa0, pa1, pa2, pa3;
            pack_p(p0, p1, pa0, pa1, pa2, pa3);
            pv_tile(o, vb0 + buf * SHM, pa0, pa1, pa2, pa3);
            if (i + 2 < NT) asm volatile("s_waitcnt vmcnt(4)" ::: "memory"); else VM_WAIT();
            LDS_WAIT();
            __builtin_amdgcn_s_barrier(); asm volatile("" ::: "memory");
            buf = buf + 1 >= NBUF ? 0 : buf + 1;
        }
#undef NSA_TILE_K
#undef NSA_TILE_V
        if (hi == 0) li_l[r32] = g_w / l_reg;
        LDS_WAIT(); asm volatile("" ::: "memory");
        {
            LAS unsigned char* ost = lds + wid * 8192;
            LAS unsigned char* owr = ost + (4 * hi) * 256 + r32 * 2;
            float gg[16];
#pragma unroll
            for (int r = 0; r < 16; ++r) gg[r] = li_l[crow(r, hi)];
#pragma unroll
            for (int d = 0; d < 4; ++d) { f32x4 a4[4];
#pragma unroll
                for (int q = 0; q < 4; ++q) a4[q] = *(const GAS f32x4*)(scrl + d * 16 + 4 * q);
#pragma unroll
                for (int q = 0; q < 4; ++q)
#pragma unroll
                    for (int e = 0; e < 4; ++e) { const int r = 4 * q + e; const float v = a4[q][e] + o[d][r] * gg[r];
                        *(LAS unsigned short*)(owr + ((r & 3) + 8 * (r >> 2)) * 256 + d * 64) = (unsigned short)f2bf(v); }
                asm volatile("" ::: "memory"); }
            LDS_WAIT(); asm volatile("" ::: "memory");
            int ln = lane; asm volatile("" : "+v"(ln));
            bf16* Ow = Oout + ((size_t)b * SEQ + t0 + 32 * th + (ln >> 4)) * DM + h * HD + (ln & 15) * 8;
            const LAS unsigned char* ord = ost + (ln >> 4) * 256 + (ln & 15) * 16;
#pragma unroll
            for (int i = 0; i < 8; ++i) *(GAS v4u*)(Ow + (size_t)(4 * i) * DM) = *(const LAS v4u*)(ord + i * 1024);
        }
        LDS_WAIT();
        __builtin_amdgcn_s_barrier(); asm volatile("" ::: "memory");
    }
}
#undef NSA_KSWZ
#undef NSA_SBAR
}


namespace hg {
typedef short bf16x8 __attribute__((ext_vector_type(8)));
typedef short s16x4 __attribute__((ext_vector_type(4)));
typedef float f32x4v __attribute__((ext_vector_type(4)));
typedef float f32x2v __attribute__((ext_vector_type(2)));
constexpr int RS = 288, RSA = 144;
constexpr int BUFB = 3 * 64 * RS;
constexpr int L_Q = 0, L_K = 64 * RS, L_V = 2 * 64 * RS, L_AM = 2 * BUFB, L_O = L_AM + 64 * RSA, L_EBL = L_O + 64 * RS, L_ON = L_EBL + 1024, L_END = L_ON + 512;
static_assert(L_END <= LDS_BYTES - 256, "hg LDS map");
#define HG_TR(dst, addr, off) asm volatile("ds_read_b64_tr_b16 %0, %1 offset:%2" : "=&v"(dst) : "v"(addr), "i"(off) : "memory")
#define HG_BAR() do { asm volatile("s_waitcnt lgkmcnt(0)" ::: "memory"); __builtin_amdgcn_s_barrier(); asm volatile("" ::: "memory"); } while (0)
__device__ __forceinline__ unsigned cvtpk(float lo, float hi) { unsigned r; asm volatile("v_cvt_pk_bf16_f32 %0, %1, %2" : "=v"(r) : "v"(lo), "v"(hi)); return r; }

__device__ __forceinline__ void scan_phase(LAS unsigned char* lds, unsigned char* wsb, const float* h_on, int G, const int tid) {
    const int wid = __builtin_amdgcn_readfirstlane(tid >> 6), lane = tid & 63, li = lane & 15, g = lane >> 4;
    const bool prod = wid >= 4; const int rw = wid & 3, ptid = rw * 64 + lane;
    const bf16* proj = (const bf16*)(wsb + WS_BIG); bf16* Oout = (bf16*)(wsb + WS_A);
    const float L2E = 1.4426950408889634f;
    const int kp = lane & 7, tg = lane >> 3;
    for (int u = blockIdx.x; u < BATCH * NH; u += G) {
        const int b = u >> 4, h = u & 15;
        if (tid < HD) ((LAS float*)(lds + L_ON))[tid] = h_on[h * HD + tid];
#define HG_LOAD(c_, QW, FW, VW) do { const size_t r0_ = (size_t)b * SEQ + 64 * (c_); \
        _Pragma("unroll") for (int c2 = 0; c2 < 2; ++c2) _Pragma("unroll") for (int i = 0; i < 8; ++i) { const size_t r = r0_ + 8 * tg + i; const int ch_ = h * HD + 32 * rw + 16 * c2 + 2 * kp; \
            QW[c2][i] = *(const GAS unsigned*)(proj + r * FF + ch_); FW[c2][i] = *(const GAS unsigned*)(proj + r * FF + 2048 + ch_); } \
        _Pragma("unroll") for (int j = 0; j < 4; ++j) { const int ci = ptid + 256 * j; VW[j] = *(const GAS v4u*)(proj + (r0_ + (ci >> 4)) * FF + 4096 + h * HD + 8 * (ci & 15)); } } while (0)
#define HG_PREP(pb, QW, FW, VW) do { LAS unsigned char* B_ = lds + (pb) * BUFB; \
        _Pragma("unroll") for (int c2 = 0; c2 < 2; ++c2) { const int chl_ = 32 * rw + 16 * c2 + 2 * kp; float bl0[8], bl1[8]; float c0 = 0.f, c1 = 0.f; \
            _Pragma("unroll") for (int i = 0; i < 8; ++i) { c0 += bflo(FW[c2][i]); c1 += bfhi(FW[c2][i]); bl0[i] = c0; bl1[i] = c1; } \
            float i0 = c0, i1 = c1; \
            _Pragma("unroll") for (int d = 8; d < 64; d <<= 1) { const float x0 = __shfl_up(i0, d), x1 = __shfl_up(i1, d); if (lane >= d) { i0 += x0; i1 += x1; } } \
            const float p0 = i0 - c0, p1 = i1 - c1; \
            if (tg == 7) *(LAS f32x2v*)(lds + L_EBL + (pb) * 512 + chl_ * 4) = (f32x2v){__builtin_amdgcn_exp2f(i0 * L2E), __builtin_amdgcn_exp2f(i1 * L2E)}; \
            _Pragma("unroll") for (int i = 0; i < 8; ++i) { const float b0 = (p0 + bl0[i]) * L2E, b1 = (p1 + bl1[i]) * L2E; \
                const float e0 = __builtin_amdgcn_exp2f(b0), e1 = __builtin_amdgcn_exp2f(b1), n0 = __builtin_amdgcn_exp2f(-b0), n1 = __builtin_amdgcn_exp2f(-b1); \
                const float k0 = 1.f - __builtin_amdgcn_exp2f(bflo(FW[c2][i]) * L2E), k1 = 1.f - __builtin_amdgcn_exp2f(bfhi(FW[c2][i]) * L2E); \
                const int t = 8 * tg + i; \
                *(LAS unsigned*)(B_ + L_Q + t * RS + chl_ * 2) = cvtpk(bflo(QW[c2][i]) * e0, bfhi(QW[c2][i]) * e1); \
                *(LAS unsigned*)(B_ + L_K + t * RS + chl_ * 2) = cvtpk(k0 * n0, k1 * n1); } } \
        _Pragma("unroll") for (int j = 0; j < 4; ++j) { const int ci = ptid + 256 * j; *(LAS v4u*)(B_ + L_V + (ci >> 4) * RS + (ci & 15) * 16) = VW[j]; } } while (0)
        if (prod) {
            unsigned qwA[2][8], fwA[2][8], qwB[2][8], fwB[2][8]; v4u vwA[4], vwB[4], gwA[4], gwB[4];
#pragma unroll
            for (int j = 0; j < 4; ++j) { gwA[j] = (v4u){0u, 0u, 0u, 0u}; gwB[j] = (v4u){0u, 0u, 0u, 0u}; }
#define HG_GATES(c_, GW) do { const int t_ = ptid >> 2, vq_ = ptid & 3; const size_t r_ = (size_t)b * SEQ + 64 * (c_) + t_; \
            _Pragma("unroll") for (int j = 0; j < 4; ++j) GW[j] = *(const GAS v4u*)(proj + r_ * FF + 6144 + h * HD + 32 * vq_ + 8 * j); } while (0)
            HG_LOAD(0, qwA, fwA, vwA); HG_PREP(0, qwA, fwA, vwA); HG_LOAD(1, qwB, fwB, vwB); HG_LOAD(2, qwA, fwA, vwA); HG_GATES(0, gwA);
            HG_BAR();
            for (int c = 0; c < SEQ / 64; c += 2) {
                { const size_t row0 = (size_t)b * SEQ + 64 * c;
                if (c > 0) {
                    const int t = ptid >> 2, vq = ptid & 3; const size_t r = row0 - 64 + t;
                    float ov[32]; float ss = 0.f;
#pragma unroll
                    for (int j = 0; j < 4; ++j) { const v4u w = *(const LAS v4u*)(lds + L_O + t * RS + vq * 64 + j * 16);
                        ov[8 * j + 0] = bflo(w.x); ov[8 * j + 1] = bfhi(w.x); ov[8 * j + 2] = bflo(w.y); ov[8 * j + 3] = bfhi(w.y); ov[8 * j + 4] = bflo(w.z); ov[8 * j + 5] = bfhi(w.z); ov[8 * j + 6] = bflo(w.w); ov[8 * j + 7] = bfhi(w.w); }
#pragma unroll
                    for (int j = 0; j < 32; ++j) ss += ov[j] * ov[j];
                    ss += __shfl_xor(ss, 1); ss += __shfl_xor(ss, 2);
                    const float rinv = 1.f / sqrtf(ss * (1.f / 128.f) + RMS_EPS);
                    bf16* op = Oout + r * DM + h * HD + 32 * vq;
#pragma unroll
                    for (int j = 0; j < 4; ++j) { const v4u gq = gwB[j]; const f32x4v on0 = *(const LAS f32x4v*)(lds + L_ON + (32 * vq + 8 * j) * 4), on1 = *(const LAS f32x4v*)(lds + L_ON + (32 * vq + 8 * j + 4) * 4);
                        v4u o4;
                        o4.x = cvtpk(ov[8 * j + 0] * rinv * on0[0] * bflo(gq.x), ov[8 * j + 1] * rinv * on0[1] * bfhi(gq.x));
                        o4.y = cvtpk(ov[8 * j + 2] * rinv * on0[2] * bflo(gq.y), ov[8 * j + 3] * rinv * on0[3] * bfhi(gq.y));
                        o4.z = cvtpk(ov[8 * j + 4] * rinv * on1[0] * bflo(gq.z), ov[8 * j + 5] * rinv * on1[1] * bfhi(gq.z));
                        o4.w = cvtpk(ov[8 * j + 6] * rinv * on1[2] * bflo(gq.w), ov[8 * j + 7] * rinv * on1[3] * bfhi(gq.w));
                        *(GAS v4u*)(op + 8 * j) = o4; }
                }
                  HG_GATES(c + 1, gwB); }
                HG_BAR();
                HG_PREP(1, qwB, fwB, vwB); if (c + 3 < SEQ / 64) HG_LOAD(c + 3, qwB, fwB, vwB);
                HG_BAR();
                { const int c = 0; (void)c; }
                { const size_t row0 = (size_t)b * SEQ + 64 * (c + 1); const int c_ = c + 1;
                if (c_ > 0) {
                    const int t = ptid >> 2, vq = ptid & 3; const size_t r = row0 - 64 + t;
                    float ov[32]; float ss = 0.f;
#pragma unroll
                    for (int j = 0; j < 4; ++j) { const v4u w = *(const LAS v4u*)(lds + L_O + t * RS + vq * 64 + j * 16);
                        ov[8 * j + 0] = bflo(w.x); ov[8 * j + 1] = bfhi(w.x); ov[8 * j + 2] = bflo(w.y); ov[8 * j + 3] = bfhi(w.y); ov[8 * j + 4] = bflo(w.z); ov[8 * j + 5] = bfhi(w.z); ov[8 * j + 6] = bflo(w.w); ov[8 * j + 7] = bfhi(w.w); }
#pragma unroll
                    for (int j = 0; j < 32; ++j) ss += ov[j] * ov[j];
                    ss += __shfl_xor(ss, 1); ss += __shfl_xor(ss, 2);
                    const float rinv = 1.f / sqrtf(ss * (1.f / 128.f) + RMS_EPS);
                    bf16* op = Oout + r * DM + h * HD + 32 * vq;
#pragma unroll
                    for (int j = 0; j < 4; ++j) { const v4u gq = gwA[j]; const f32x4v on0 = *(const LAS f32x4v*)(lds + L_ON + (32 * vq + 8 * j) * 4), on1 = *(const LAS f32x4v*)(lds + L_ON + (32 * vq + 8 * j + 4) * 4);
                        v4u o4;
                        o4.x = cvtpk(ov[8 * j + 0] * rinv * on0[0] * bflo(gq.x), ov[8 * j + 1] * rinv * on0[1] * bfhi(gq.x));
                        o4.y = cvtpk(ov[8 * j + 2] * rinv * on0[2] * bflo(gq.y), ov[8 * j + 3] * rinv * on0[3] * bfhi(gq.y));
                        o4.z = cvtpk(ov[8 * j + 4] * rinv * on1[0] * bflo(gq.z), ov[8 * j + 5] * rinv * on1[1] * bfhi(gq.z));
                        o4.w = cvtpk(ov[8 * j + 6] * rinv * on1[2] * bflo(gq.w), ov[8 * j + 7] * rinv * on1[3] * bfhi(gq.w));
                        *(GAS v4u*)(op + 8 * j) = o4; }
                }
                  if (c + 2 < SEQ / 64) HG_GATES(c + 2, gwA); }
                HG_BAR();
                if (c + 2 < SEQ / 64) { HG_PREP(0, qwA, fwA, vwA); if (c + 4 < SEQ / 64) HG_LOAD(c + 4, qwA, fwA, vwA); }
                HG_BAR();
            }
            {
            const int t = ptid >> 2, vq = ptid & 3; const size_t r = (size_t)b * SEQ + SEQ - 64 + t;
            float ov[32]; float ss = 0.f;
#pragma unroll
            for (int j = 0; j < 4; ++j) { const v4u w = *(const LAS v4u*)(lds + L_O + t * RS + vq * 64 + j * 16);
                ov[8 * j + 0] = bflo(w.x); ov[8 * j + 1] = bfhi(w.x); ov[8 * j + 2] = bflo(w.y); ov[8 * j + 3] = bfhi(w.y); ov[8 * j + 4] = bflo(w.z); ov[8 * j + 5] = bfhi(w.z); ov[8 * j + 6] = bflo(w.w); ov[8 * j + 7] = bfhi(w.w); }
#pragma unroll
            for (int j = 0; j < 32; ++j) ss += ov[j] * ov[j];
            ss += __shfl_xor(ss, 1); ss += __shfl_xor(ss, 2);
            const float rinv = 1.f / sqrtf(ss * (1.f / 128.f) + RMS_EPS);
            bf16* op = Oout + r * DM + h * HD + 32 * vq;
#pragma unroll
            for (int j = 0; j < 4; ++j) { const v4u gq = gwB[j]; const f32x4v on0 = *(const LAS f32x4v*)(lds + L_ON + (32 * vq + 8 * j) * 4), on1 = *(const LAS f32x4v*)(lds + L_ON + (32 * vq + 8 * j + 4) * 4);
                v4u o4;
                o4.x = cvtpk(ov[8 * j + 0] * rinv * on0[0] * bflo(gq.x), ov[8 * j + 1] * rinv * on0[1] * bfhi(gq.x));
                o4.y = cvtpk(ov[8 * j + 2] * rinv * on0[2] * bflo(gq.y), ov[8 * j + 3] * rinv * on0[3] * bfhi(gq.y));
                o4.z = cvtpk(ov[8 * j + 4] * rinv * on1[0] * bflo(gq.z), ov[8 * j + 5] * rinv * on1[1] * bfhi(gq.z));
                o4.w = cvtpk(ov[8 * j + 6] * rinv * on1[2] * bflo(gq.w), ov[8 * j + 7] * rinv * on1[3] * bfhi(gq.w));
                *(GAS v4u*)(op + 8 * j) = o4; }
            }
#undef HG_GATES
        } else {
            f32x4v S[8][2];
#pragma unroll
            for (int m = 0; m < 8; ++m) { S[m][0] = (f32x4v){0.f, 0.f, 0.f, 0.f}; S[m][1] = (f32x4v){0.f, 0.f, 0.f, 0.f}; }
            HG_BAR();
            for (int c = 0; c < SEQ / 64; ++c) {
                const int cb = c & 1;
                LAS unsigned char* CB = lds + cb * BUFB;
                {
                const int mt = rw;
                f32x4v acc[4];
#pragma unroll
                for (int nt = 0; nt < 4; ++nt) acc[nt] = (f32x4v){0.f, 0.f, 0.f, 0.f};
#pragma unroll
                for (int ks = 0; ks < 4; ++ks) { const bf16x8 a = *(const LAS bf16x8*)(CB + L_Q + (16 * mt + li) * RS + (32 * ks + 8 * g) * 2);
#pragma unroll
                    for (int nt = 0; nt < 4; ++nt) { const bf16x8 bb = *(const LAS bf16x8*)(CB + L_K + (16 * nt + li) * RS + (32 * ks + 8 * g) * 2);
                        acc[nt] = __builtin_amdgcn_mfma_f32_16x16x32_bf16(a, bb, acc[nt], 0, 0, 0); } }
#pragma unroll
                for (int nt = 0; nt < 4; ++nt) { const int s = 16 * nt + li;
#pragma unroll
                    for (int r = 0; r < 4; ++r) { const int t = 16 * mt + 4 * g + r; const float v = (s <= t) ? acc[nt][r] : 0.f;
                        *(LAS unsigned short*)(lds + L_AM + t * RSA + s * 2) = (unsigned short)f2bf(v); } }
                }
                HG_BAR();
                {
                f32x4v o[4][2];
#pragma unroll
                for (int m = 0; m < 4; ++m) { o[m][0] = (f32x4v){0.f, 0.f, 0.f, 0.f}; o[m][1] = (f32x4v){0.f, 0.f, 0.f, 0.f}; }
#pragma unroll
                for (int ks = 0; ks < 4; ++ks) { bf16x8 bs[2];
#pragma unroll
                    for (int n = 0; n < 2; ++n) { v4u bw; bw.x = cvtpk(S[2 * ks][n][0], S[2 * ks][n][1]); bw.y = cvtpk(S[2 * ks][n][2], S[2 * ks][n][3]); bw.z = cvtpk(S[2 * ks + 1][n][0], S[2 * ks + 1][n][1]); bw.w = cvtpk(S[2 * ks + 1][n][2], S[2 * ks + 1][n][3]);
                        bs[n] = *reinterpret_cast<bf16x8*>(&bw); }
#pragma unroll
                    for (int m = 0; m < 4; ++m) { const LAS unsigned char* qa = CB + L_Q + (16 * m + li) * RS + (32 * ks + 4 * g) * 2;
                        const v2u lo = *(const LAS v2u*)qa, hi2 = *(const LAS v2u*)(qa + 32); v4u aw; aw.x = lo.x; aw.y = lo.y; aw.z = hi2.x; aw.w = hi2.y;
                        const bf16x8 av = *reinterpret_cast<bf16x8*>(&aw);
                        o[m][0] = __builtin_amdgcn_mfma_f32_16x16x32_bf16(av, bs[0], o[m][0], 0, 0, 0);
                        o[m][1] = __builtin_amdgcn_mfma_f32_16x16x32_bf16(av, bs[1], o[m][1], 0, 0, 0); } }
                bf16x8 bv[2][2];
#pragma unroll
                for (int n = 0; n < 2; ++n) {
                    const int va = (int)(unsigned)(uintptr_t)(CB + L_V) + (8 * g + (li >> 2)) * RS + (16 * (2 * rw + n) + 4 * (li & 3)) * 2;
                    s16x4 a0, a1, a2, a3; HG_TR(a0, va, 0); HG_TR(a1, va, 4 * RS); HG_TR(a2, va, 32 * RS); HG_TR(a3, va, 36 * RS);
                    asm volatile("s_waitcnt lgkmcnt(0)" ::: "memory"); __builtin_amdgcn_sched_barrier(0);
                    bv[n][0] = (bf16x8){a0[0], a0[1], a0[2], a0[3], a1[0], a1[1], a1[2], a1[3]}; bv[n][1] = (bf16x8){a2[0], a2[1], a2[2], a2[3], a3[0], a3[1], a3[2], a3[3]}; }
#pragma unroll
                for (int ks = 0; ks < 2; ++ks)
#pragma unroll
                    for (int m = 0; m < 4; ++m) { const bf16x8 a = *(const LAS bf16x8*)(lds + L_AM + (16 * m + li) * RSA + (32 * ks + 8 * g) * 2);
                        o[m][0] = __builtin_amdgcn_mfma_f32_16x16x32_bf16(a, bv[0][ks], o[m][0], 0, 0, 0);
                        o[m][1] = __builtin_amdgcn_mfma_f32_16x16x32_bf16(a, bv[1][ks], o[m][1], 0, 0, 0); }
                { const int ka = (int)(unsigned)(uintptr_t)(CB + L_K) + (8 * g + (li >> 2)) * RS + (4 * (li & 3)) * 2;
                  const LAS float* ebl = (const LAS float*)(lds + L_EBL + cb * 512);
#pragma unroll
                  for (int m = 0; m < 8; ++m) { s16x4 a0, a1, a2, a3;
#define HG_KT(m_) HG_TR(a0, ka, (m_) * 32); HG_TR(a1, ka, (m_) * 32 + 4 * RS); HG_TR(a2, ka, (m_) * 32 + 32 * RS); HG_TR(a3, ka, (m_) * 32 + 36 * RS)
                      switch (m) { case 0: HG_KT(0); break; case 1: HG_KT(1); break; case 2: HG_KT(2); break; case 3: HG_KT(3); break; case 4: HG_KT(4); break; case 5: HG_KT(5); break; case 6: HG_KT(6); break; default: HG_KT(7); break; }
#undef HG_KT
                      asm volatile("s_waitcnt lgkmcnt(0)" ::: "memory"); __builtin_amdgcn_sched_barrier(0);
                      const bf16x8 kt0 = (bf16x8){a0[0], a0[1], a0[2], a0[3], a1[0], a1[1], a1[2], a1[3]}, kt1 = (bf16x8){a2[0], a2[1], a2[2], a2[3], a3[0], a3[1], a3[2], a3[3]};
                      const f32x4v e = *(const LAS f32x4v*)(ebl + 16 * m + 4 * g);
#pragma unroll
                      for (int n = 0; n < 2; ++n) { S[m][n] = __builtin_amdgcn_mfma_f32_16x16x32_bf16(kt0, bv[n][0], S[m][n], 0, 0, 0);
                          S[m][n] = __builtin_amdgcn_mfma_f32_16x16x32_bf16(kt1, bv[n][1], S[m][n], 0, 0, 0);
                          S[m][n] = S[m][n] * e; } } }
#pragma unroll
                for (int m = 0; m < 4; ++m)
#pragma unroll
                    for (int n = 0; n < 2; ++n)
#pragma unroll
                        for (int r = 0; r < 4; ++r) *(LAS unsigned short*)(lds + L_O + (16 * m + 4 * g + r) * RS + (16 * (2 * rw + n) + li) * 2) = (unsigned short)f2bf(o[m][n][r]);
                }
                HG_BAR();
            }
        }
        LDS_WAIT();
        __syncthreads();
#undef HG_LOAD
#undef HG_PREP
    }
}
#undef HG_TR
#undef HG_BAR
}

struct Args { const float* in[14]; float* out; unsigned char* ws; int ph_lo, ph_hi; };
#ifndef CONV_IN_SCAN
#define CONV_IN_SCAN 1
#endif
#ifndef MK_N_LAUNCHES
#define MK_N_LAUNCHES 1
#endif
constexpr int MISC_OFF = LDS_BYTES - 64;
constexpr int N_PHASES = 10;
__global__ void __launch_bounds__(NTHREADS, 2) mk_fwd(Args args) {
    extern __shared__ __attribute__((aligned(16))) unsigned char lds[];
    Frame F;
    F.lds = (LAS unsigned char*)lds;
    F.wave = __builtin_amdgcn_readfirstlane((int)threadIdx.x >> 6); F.lane = lane_id(); F.tid = F.wave * 64 + F.lane;
    F.G = gridDim.x; F.gw = blockIdx.x * NWAVES + F.wave; F.NGW = F.G * NWAVES;
    F.x = args.in[0]; F.norm_g = args.in[1]; F.rel = args.in[2]; F.w_in = args.in[3]; F.pe = args.in[4]; F.cw1 = args.in[5]; F.cw2 = args.in[6]; F.w_out = args.in[7];
    F.h_in = args.in[8]; F.h_lb = args.in[9]; F.h_on = args.in[10]; F.h_out = args.in[11]; F.up = args.in[12]; F.dn = args.in[13];
    F.out = args.out; F.ws = args.ws;
    unsigned char* ws = args.ws;
    bf16* A = (bf16*)(ws + WS_A); bf16* BIG = (bf16*)(ws + WS_BIG); bf16* X16 = (bf16*)(ws + WS_X16);
    const int lo = args.ph_lo, hi = args.ph_hi;
    if (F.tid < 4) ((LAS unsigned*)(F.lds + MISC_OFF))[F.tid] = 0u;
    __syncthreads();
    XcdBarrier bar; bar.wave = F.wave; bar.bar = (unsigned*)(ws + WS_CTL) + 1024; bar.x = 0; bar.st = nullptr;
    if (hi - lo > 1) bar = xcd_barrier_post((unsigned*)(ws + WS_CTL) + 1024, (volatile LAS unsigned*)(F.lds + MISC_OFF), F.wave);
#define IN(k) (lo <= (k) && (k) < hi)
#define PH_FENCE() do { F.lane = lane_id(); F.tid = F.wave * 64 + F.lane; } while (0)
#define SEAM(k) do { if (IN(k) && IN((k) + 1)) xcd_barrier(bar); } while (0)
#define GEMM_PHASE_M(ACT, Ap, Btp, MR_, N_, K_, Op, ldc_, st_, sc_, rs_) do { pg8::Gemm g{(Ap), (Btp), (MR_), (N_), (K_)}; pg8::StaticOrder S; S.init((MR_), (N_), F.G, (int)blockIdx.x); \
        EpiAct<ACT> E{(Op), (ldc_), (st_), (sc_), (const float*)(ws + WS_LB), (rs_), 1.f}; pg8::gemm_phase<EpiAct<ACT>, pg8::StaticOrder, true, true>(F.lds, g, S, E, F.tid); } while (0)
#define GEMM_PHASE(ACT, Ap, Btp, N_, K_, Op, ldc_, st_, sc_, rs_) GEMM_PHASE_M(ACT, Ap, Btp, M, N_, K_, Op, ldc_, st_, sc_, rs_)
#define PANEL_SQL(e_, ro_) PanelSqLast{(float*)(ws + WS_SLOTS) + ((size_t)(e_) * M + (ro_)) * 8, (unsigned*)(ws + WS_CTL) + CW_PANEL + ((e_) * 64 + (ro_) / 256) * 64, (float*)(ws + WS_RINV) + (ro_)}
#define PANEL_SQ(e_, ro_) PanelSq{(float*)(ws + WS_SLOTS) + ((size_t)(e_) * M + (ro_)) * 8, (unsigned*)(ws + WS_CTL) + CW_PANEL + ((e_) * 64 + (ro_) / 256) * 64, (unsigned*)(ws + WS_CTL) + CW_XTMO}
#define GEMM_FUSED(XF32_, FINAL_, W8_, F8_, Ap, Btp, K_, osc_, ro_, xoldp, gp, e1_, e2_) GEMM_FUSED8(XF32_, FINAL_, W8_, F8_, Ap, Btp, K_, osc_, ro_, xoldp, gp, e1_, e2_, WS_X8)
#define GEMM_FUSED8(XF32_, FINAL_, W8_, F8_, Ap, Btp, K_, osc_, ro_, xoldp, gp, e1_, e2_, X8OFF_) do { pg8::Gemm g{(Ap), (Btp), M / 2, DM, (K_)}; pg8::StaticOrder S; S.init(M / 2, DM, F.G, (int)blockIdx.x); \
        EpiRmsRes<XF32_, FINAL_, W8_> E{(const void*)(xoldp), X16 + (size_t)(ro_) * DM, F.out + (size_t)(ro_) * DM, (gp), ws + (X8OFF_) + (size_t)(ro_) * DM, (osc_), PANEL_SQ(e1_, ro_), PANEL_SQL(e2_, ro_)}; \
        pg8::gemm_phase<EpiRmsRes<XF32_, FINAL_, W8_>, pg8::StaticOrder, false, true, F8_>(F.lds, g, S, E, F.tid); } while (0)
#define MLP_FULL_F(FINAL_, WUP, WDN, gp, e1_, e2_) do { { pg8::Gemm g{(const bf16*)(ws + WS_X8), (const bf16*)(ws + (WUP)), M, FF, DM / 2}; pg8::StaticOrder S; S.init(M, FF, F.G, (int)blockIdx.x); \
        EpiUp8 E{ws + WS_BIG, FF, (const float*)(ws + WS_RINV)}; pg8::gemm_phase<EpiUp8, pg8::StaticOrder, true, true, true>(F.lds, g, S, E, F.tid); } xcd_barrier(bar); PH_FENCE(); \
        GEMM_FUSED8(false, FINAL_, !(FINAL_), true, BIG, (const bf16*)(ws + (WDN)), FF / 2, 1.f / (W8SCALE * H8SCALE), 0, X16, gp, e1_, e2_, WS_A); __syncthreads(); PH_FENCE(); \
        GEMM_FUSED8(false, FINAL_, !(FINAL_), true, (const bf16*)(ws + WS_BIG + (size_t)(M / 2) * FF), (const bf16*)(ws + (WDN)), FF / 2, 1.f / (W8SCALE * H8SCALE), M / 2, X16 + (size_t)(M / 2) * DM, gp, e1_, e2_, WS_A); } while (0)

    if (IN(0)) { PH_FENCE(); p0_prologue(F); } SEAM(0);
    if (IN(1)) { PH_FENCE(); GEMM_PHASE(0, X16, (const bf16*)(ws + W0_QKV), NQKV, DM, BIG, NQKV, 8, QSCALE, (const float*)(ws + WS_RINV)); } SEAM(1);
    if (IN(2)) { PH_FENCE(); cg::cmp_gate_phase(F.lds, ws, F.G, F.tid); } SEAM(2);
    if (IN(3)) { PH_FENCE(); nsa::nsa_phase(F.lds, ws, F.G, F.tid); } SEAM(3);
    if (IN(4)) { PH_FENCE(); GEMM_FUSED(false, false, true, false, A, (const bf16*)(ws + W0_O), DM, 1.f, 0, X16, F.norm_g + 1 * DM, 0, 1); __syncthreads();
                 GEMM_FUSED(false, false, true, false, A + (size_t)(M / 2) * DM, (const bf16*)(ws + W0_O), DM, 1.f, M / 2, X16 + (size_t)(M / 2) * DM, F.norm_g + 1 * DM, 0, 1); } SEAM(4);
    if (IN(5)) { PH_FENCE(); MLP_FULL_F(false, W0_UP, W0_DN, F.norm_g + 3 * DM, 2, 3); __syncthreads(); PH_FENCE(); p_convert_l1a(F); } SEAM(5);
    if (IN(6)) { PH_FENCE(); pg8::Gemm g{(const bf16*)(ws + WS_A), (const bf16*)(ws + W1_IN), M, FF, DM / 2}; pg8::StaticOrder S; S.init(M, FF, F.G, (int)blockIdx.x);
                 EpiAct<2> E{BIG, FF, 0, 1.f, (const float*)(ws + WS_LB), (const float*)(ws + WS_RINV), 1.f / W8SCALE}; pg8::gemm_phase<EpiAct<2>, pg8::StaticOrder, false, true, true>(F.lds, g, S, E, F.tid); } SEAM(6);
    if (IN(7)) { PH_FENCE(); const int nstat = (F.G - BATCH * NH) * NWAVES;
                 if ((int)blockIdx.x >= BATCH * NH) p_convert_l1b(F, ((int)blockIdx.x - BATCH * NH) * NWAVES + F.wave, nstat);
                 else { hg::scan_phase(F.lds, ws, F.h_on, F.G, F.tid); PH_FENCE(); p_convert_l1b(F, -1, nstat); } } SEAM(7);
    if (IN(8)) { PH_FENCE(); GEMM_FUSED(false, false, true, false, A, (const bf16*)(ws + W1_O), DM, 1.f, 0, X16, F.norm_g + 5 * DM, 4, 5); __syncthreads();
                 GEMM_FUSED(false, false, true, false, A + (size_t)(M / 2) * DM, (const bf16*)(ws + W1_O), DM, 1.f, M / 2, X16 + (size_t)(M / 2) * DM, F.norm_g + 5 * DM, 4, 5); } SEAM(8);
    if (IN(9)) { PH_FENCE(); MLP_FULL_F(true, W1_UP, W1_DN, F.norm_g + 7 * DM, 6, 7); }
#undef IN
}

extern "C" void kernel_launch(void* const* d_in, const int* in_sizes, int n_in, void* d_out, int out_size, void* d_ws, size_t ws_size, hipStream_t stream) {
    static int grid = 0;
    if (grid == 0) {
        if (n_in != 14 || in_sizes[0] != M * DM || out_size != M * DM || ws_size < WS_END) { fprintf(stderr, "kernel_launch: unexpected shapes (n_in %d, ws %zu)\n", n_in, ws_size); grid = -1; return; }
        int dev = 0, cus = 0;
        if (hipGetDevice(&dev) != hipSuccess || hipDeviceGetAttribute(&cus, hipDeviceAttributeMultiprocessorCount, dev) != hipSuccess) { grid = -1; return; }
        if (hipFuncSetAttribute((const void*)mk_fwd, hipFuncAttributeMaxDynamicSharedMemorySize, LDS_BYTES) != hipSuccess) { fprintf(stderr, "kernel_launch: hipFuncSetAttribute failed\n"); grid = -1; return; }
        (void)hipGetLastError();
        if (cus < 256) { fprintf(stderr, "kernel_launch: this kernel needs 256 co-resident workgroups (one per CU); the device has %d CUs\n", cus); grid = -1; return; }
        grid = 256;
    }
    if (grid < 0) return;
    Args a{};
    for (int i = 0; i < 14; ++i) a.in[i] = (const float*)d_in[i];
    a.out = (float*)d_out; a.ws = (unsigned char*)d_ws;
    if (hipMemsetAsync((char*)d_ws + WS_CTL, 0, CTL_ZERO_BYTES, stream) != hipSuccess) return;
    if (MK_N_LAUNCHES == 1) { a.ph_lo = 0; a.ph_hi = N_PHASES; hipLaunchKernelGGL(mk_fwd, dim3(grid), dim3(NTHREADS), LDS_BYTES, stream, a); }
    else for (int p = 0; p < N_PHASES; ++p) { a.ph_lo = p; a.ph_hi = p + 1; hipLaunchKernelGGL(mk_fwd, dim3(grid), dim3(NTHREADS), LDS_BYTES, stream, a); }
}
```

```cpp
#include <hip/hip_runtime.h>
#include <cstdio>
#include <cstdint>
namespace pg8 {
#define PG8_LAS __attribute__((address_space(3)))
typedef unsigned short bf16_t;
typedef short bf16x8 __attribute__((ext_vector_type(8)));
typedef float f32x4 __attribute__((ext_vector_type(4)));
typedef unsigned u32x4 __attribute__((ext_vector_type(4)));
constexpr int BM = 256, BK = 64, HALF = 128, HTB = HALF * BK * 2  , STAGE_BYTES = 8 * HTB, NXCD = 8, WGM = 4;

__host__ __device__ __forceinline__ int lds_byte(int r, int c) { const int st = (r >> 4) * 2 + (c >> 5), rr = r & 15, cc = c & 31, ob = rr * 64 + cc * 2; return st * 1024 + (ob ^ (((ob >> 9) & 1) << 5)); }
__host__ __device__ __forceinline__ void stage_rc(int b, int& R, int& C) { const int st = b / 1024, sb = b % 1024, swz = sb ^ (((sb >> 9) & 1) << 5); R = (st >> 1) * 16 + swz / 64; C = (st & 1) * 32 + (swz % 64) / 2; }
__host__ __device__ __forceinline__ int perm32(int rho) { const int n = rho >> 4, i = rho & 15; return 8 * (i >> 2) + 4 * n + (i & 3); }

typedef int i32x4 __attribute__((ext_vector_type(4)));
typedef int i32x8 __attribute__((ext_vector_type(8)));
struct Unit { int pm, pn; };
struct Gemm { const bf16_t* A; const bf16_t* Bt; int M, N, K; };

struct StaticOrder {
    int nM, nN, nwg, G, c;
    __host__ __device__ void init(int M, int N, int G_, int c_) { nM = M / BM; nN = N / BM; nwg = nM * nN; G = G_; c = c_; }
    __host__ __device__ bool next(int i, Unit& u) const {
        const long L = (long)i * G + c; if (L >= nwg) return false;
        int wgid = (int)L; { const int q = nwg / NXCD, r = nwg % NXCD, xcd = wgid % NXCD, off = wgid / NXCD; wgid = (xcd < r ? xcd * (q + 1) : r * (q + 1) + (xcd - r) * q) + off; }
        const int nig = WGM * nN, gid = wgid / nig, fm = gid * WGM, gsz = (nM - fm) < WGM ? (nM - fm) : WGM;
        u.pm = fm + ((wgid % nig) % gsz); u.pn = (wgid % nig) / gsz; return true;
    }
    __device__ __forceinline__ void a_ready(const Unit&) const {}
    __device__ __forceinline__ void done(const Unit&) const {}
};

struct RotOrder : StaticOrder {
    __host__ __device__ bool next(int i, Unit& u) const {
        const long L = (long)i * G + c; if (L >= nwg) return false;
        int wgid = (int)L; { const int q = nwg / NXCD, r = nwg % NXCD, xcd = wgid % NXCD, off = wgid / NXCD; wgid = (xcd < r ? xcd * (q + 1) : r * (q + 1) + (xcd - r) * q) + off; }
        const int nig = WGM * nN, gid = wgid / nig, fm = gid * WGM, w = wgid % nig, r4 = w >> 5, j = w & 31, k = j >> 2;
        u.pm = fm + (j & 3); u.pn = 8 * ((r4 + k) & 3) + k; return true;
    }
};

__device__ __forceinline__ unsigned cvt_pk_bf16(float lo, float hi) { unsigned r; asm volatile("v_cvt_pk_bf16_f32 %0, %1, %2" : "=v"(r) : "v"(lo), "v"(hi)); return r; }
typedef float f32x2 __attribute__((ext_vector_type(2)));
__device__ __forceinline__ f32x2 gelu_pk(f32x2 v) {
    const f32x2 av = __builtin_elementwise_abs(v), d = av * 0.2316418882f + 1.0f;
    f32x2 t; t.x = __builtin_amdgcn_rcpf(d.x); t.y = __builtin_amdgcn_rcpf(d.y);
    f32x2 q = t * 0.5307027145f + (-0.7265760135f); q = q * t + 0.7107068705f; q = q * t + (-0.142248368f); q = q * t + 0.127414796f; q = q * t;
    const f32x2 s = (v * v) * (-0.72134752044f);
    f32x2 e; e.x = __builtin_amdgcn_exp2f(s.x); e.y = __builtin_amdgcn_exp2f(s.y);
    const f32x2 m = v * (q * e), r = v - m;
    f32x2 o; o.x = v.x < 0.f ? m.x : r.x; o.y = v.y < 0.f ? m.y : r.y; return o;
}

template <int ACT  > struct EpiBf16 {
    static constexpr bool PERM = true, AFTER_DRAIN = false; static_assert(ACT == 0 || ACT == 1, "EpiBf16: ACT is 0 (none) or 1 (gelu_pk)");
    bf16_t* O; int ldc; const float* bias; int split_cols; size_t split_stride; float scale0;
    __device__ __forceinline__ void operator()(const f32x4 (&acc)[2][2][4][2], const Unit& u, int wr, int wc, int fr, int fq) const {
        const int row0 = u.pm * BM + wr * 64 + fr; int colt = u.pn * BM; bf16_t* base = O;
        float sc = 1.f; if (split_cols) { const int t = colt / split_cols; base += (size_t)t * split_stride; colt -= t * split_cols; if (t == 0) sc = scale0; }
        const int col0 = colt + wc * 32 + 8 * fq, bcol0 = u.pn * BM + wc * 32 + 8 * fq;
        f32x4 bv[2][2];
#pragma unroll
        for (int bj = 0; bj < 2; ++bj)
#pragma unroll
            for (int n = 0; n < 2; ++n) bv[bj][n] = bias ? *(const f32x4*)(bias + bcol0 + bj * HALF + 4 * n) : (f32x4){0.f, 0.f, 0.f, 0.f};
#pragma unroll
        for (int ai = 0; ai < 2; ++ai)
#pragma unroll
            for (int m = 0; m < 4; ++m) { bf16_t* rowp = base + (size_t)(row0 + ai * HALF + m * 16) * ldc + col0;
#pragma unroll
                for (int bj = 0; bj < 2; ++bj) { f32x4 v0 = acc[ai][bj][m][0] + bv[bj][0], v1 = acc[ai][bj][m][1] + bv[bj][1];
                    if (ACT == 1) { f32x2 a = gelu_pk((f32x2){v0[0], v0[1]}), b = gelu_pk((f32x2){v0[2], v0[3]}), c = gelu_pk((f32x2){v1[0], v1[1]}), d = gelu_pk((f32x2){v1[2], v1[3]});
                        v0 = (f32x4){a.x, a.y, b.x, b.y}; v1 = (f32x4){c.x, c.y, d.x, d.y}; }
                    v0 = v0 * sc; v1 = v1 * sc; u32x4 w; w.x = cvt_pk_bf16(v0[0], v0[1]); w.y = cvt_pk_bf16(v0[2], v0[3]); w.z = cvt_pk_bf16(v1[0], v1[1]); w.w = cvt_pk_bf16(v1[2], v1[3]);
                    *(u32x4*)(rowp + bj * HALF) = w; } }
    }
};
__device__ __forceinline__ void mfma_f8(f32x4& c, const i32x8 a, const i32x8 b) { asm volatile("s_nop 1\n\tv_mfma_f32_16x16x128_f8f6f4 %0, %1, %2, %0" : "+v"(c) : "v"(a), "v"(b)); }
template <class Epi, class Sched, bool ALIGN_EPI = false, bool SP2 = false, bool F8 = false>
__device__ __forceinline__ void gemm_phase(PG8_LAS unsigned char* lds, const Gemm g, const Sched& S, const Epi& E, const int tid) {
    const int wid = __builtin_amdgcn_readfirstlane(tid >> 6), lane = tid & 63, wr = wid >> 2, wc = wid & 3, fr = lane & 15, fq = lane >> 4;
    const int K = g.K, nt = K / BK;
    unsigned voffA[2], voffB[2];
#pragma unroll
    for (int i = 0; i < 2; ++i) { int R, C; stage_rc(tid * 16 + i * 8192, R, C); const int Rb = Epi::PERM ? ((R & ~31) + perm32(R & 31)) : R;
        voffA[i] = (unsigned)(R * K + C) * 2u; voffB[i] = (unsigned)(Rb * K + C) * 2u; }
    const size_t kstep = (size_t)(BK * 2);
    const size_t hstep = (size_t)HALF * K * 2;
    const size_t tstep = 2 * hstep;
    const unsigned ldsw = (unsigned)wid * 1024u;
    const int aoff = lds_byte(wr * 64 + fr, fq * 8), boff = lds_byte(wc * 32 + fr, fq * 8);
#define PG8_SA(b, h) (((b) * 2 + (h)) * HTB)
#define PG8_SB(b, h) ((4 + (b) * 2 + (h)) * HTB)
#define PG8_STAGE(bufoff, gbase, voff) do { _Pragma("unroll") for (int _i = 0; _i < 2; ++_i) \
        __builtin_amdgcn_global_load_lds((const unsigned*)((const char*)(gbase) + (voff)[_i]), (PG8_LAS unsigned*)(lds + (bufoff) + ldsw + _i * 8192), 16, 0, 0); } while (0)
#define PG8_LDA(dst, b, h) do { _Pragma("unroll") for (int m = 0; m < 4; ++m) _Pragma("unroll") for (int k = 0; k < 2; ++k) dst[m][k] = *(const PG8_LAS bf16x8*)(lds + PG8_SA(b, h) + aoff + m * 2048 + k * 1024); } while (0)
#define PG8_LDB(dst, b, h) do { _Pragma("unroll") for (int n = 0; n < 2; ++n) _Pragma("unroll") for (int k = 0; k < 2; ++k) dst[n][k] = *(const PG8_LAS bf16x8*)(lds + PG8_SB(b, h) + boff + n * 2048 + k * 1024); } while (0)
#define PG8_CAT8(x) __builtin_shufflevector(__builtin_bit_cast(i32x4, (x)[0]), __builtin_bit_cast(i32x4, (x)[1]), 0, 1, 2, 3, 4, 5, 6, 7)
#define PG8_MMA(ai, bj, At, Bt) do { __builtin_amdgcn_s_setprio(1); _Pragma("unroll") for (int m = 0; m < 4; ++m) _Pragma("unroll") for (int n = 0; n < 2; ++n) { \
        if constexpr (F8) mfma_f8(acc[ai][bj][m][n], PG8_CAT8(Bt[n]), PG8_CAT8(At[m])); \
        else { _Pragma("unroll") for (int k = 0; k < 2; ++k) acc[ai][bj][m][n] = __builtin_amdgcn_mfma_f32_16x16x32_bf16(Bt[n][k], At[m][k], acc[ai][bj][m][n], 0, 0, 0); } } __builtin_amdgcn_s_setprio(0); } while (0)
#define PG8_WAIT_V(n) asm volatile("s_waitcnt vmcnt(" #n ")" ::: "memory")
#define PG8_WAIT_L(n) asm volatile("s_waitcnt lgkmcnt(" #n ")" ::: "memory")
#define PG8_BAR __builtin_amdgcn_s_barrier()
#define PG8_SCHED __builtin_amdgcn_sched_barrier(0)
    Unit cur, nxt; int ui = 0;
    if (!S.next(0, cur)) return;
    float epre[8]; E.prefetch(cur, wr, fr, epre);
    f32x4 acc[2][2][4][2];
#pragma unroll
    for (int a = 0; a < 2; ++a)
#pragma unroll
        for (int b = 0; b < 2; ++b)
#pragma unroll
            for (int m = 0; m < 4; ++m)
#pragma unroll
                for (int n = 0; n < 2; ++n) acc[a][b][m][n] = (f32x4){0.f, 0.f, 0.f, 0.f};
    bf16x8 At[4][2], B0[2][2], B1[2][2];
    const char* cA = (const char*)g.A + (size_t)cur.pm * tstep; const char* cB = (const char*)g.Bt + (size_t)cur.pn * tstep;
    S.a_ready(cur);
    if constexpr (SP2) {
        PG8_STAGE(PG8_SB(0, 0), cB, voffB); PG8_STAGE(PG8_SB(0, 1), cB + hstep, voffB); PG8_STAGE(PG8_SA(0, 0), cA, voffA); PG8_STAGE(PG8_SA(0, 1), cA + hstep, voffA);
        if (wr == 1) PG8_BAR;
        PG8_WAIT_V(2); PG8_BAR;
        PG8_STAGE(PG8_SB(1, 0), cB + kstep, voffB); PG8_STAGE(PG8_SB(1, 1), cB + hstep + kstep, voffB);
        PG8_WAIT_V(4); PG8_BAR;
    } else {
        PG8_STAGE(PG8_SB(0, 0), cB, voffB); PG8_STAGE(PG8_SA(0, 0), cA, voffA); PG8_STAGE(PG8_SB(0, 1), cB + hstep, voffB); PG8_STAGE(PG8_SA(0, 1), cA + hstep, voffA);
        if (wr == 1) PG8_BAR;
        PG8_WAIT_V(4); PG8_BAR;
        PG8_STAGE(PG8_SB(1, 0), cB + kstep, voffB); PG8_STAGE(PG8_SA(1, 0), cA + kstep, voffA); PG8_STAGE(PG8_SB(1, 1), cB + hstep + kstep, voffB);
        PG8_WAIT_V(6); PG8_BAR;
    }
    for (;;) {
        const bool has_next = S.next(ui + 1, nxt);
        const char* nA = has_next ? (const char*)g.A + (size_t)nxt.pm * tstep : cA; const char* nB = has_next ? (const char*)g.Bt + (size_t)nxt.pn * tstep : cB;
        for (int t = 0; t < nt; t += 2) {
            const bool last = (t == nt - 2);
            const char* a1 = cA + (size_t)(t + 1) * kstep;
            const char* a2 = last ? nA : cA + (size_t)(t + 2) * kstep; const char* b2 = last ? nB : cB + (size_t)(t + 2) * kstep;
            const char* a3 = a2 + kstep; const char* b3 = b2 + kstep;
            if (last && has_next) S.a_ready(nxt);
            if constexpr (SP2) {
            PG8_LDB(B0, 0, 0); PG8_LDB(B1, 0, 1); PG8_SCHED; PG8_LDA(At, 0, 0); PG8_STAGE(PG8_SA(1, 0), a1, voffA); PG8_STAGE(PG8_SA(1, 1), a1 + hstep, voffA);
            PG8_WAIT_V(8); PG8_WAIT_L(0); PG8_BAR; PG8_MMA(0, 0, At, B0); PG8_MMA(0, 1, At, B1); PG8_BAR; PG8_SCHED;
            PG8_LDA(At, 0, 1); PG8_STAGE(PG8_SB(0, 0), b2, voffB); PG8_STAGE(PG8_SB(0, 1), b2 + hstep, voffB);
            PG8_WAIT_V(6); PG8_WAIT_L(0); PG8_BAR; PG8_MMA(1, 0, At, B0); PG8_MMA(1, 1, At, B1); PG8_BAR; PG8_SCHED;
            PG8_LDB(B0, 1, 0); PG8_LDB(B1, 1, 1); PG8_SCHED; PG8_LDA(At, 1, 0); PG8_STAGE(PG8_SA(0, 0), a2, voffA); PG8_STAGE(PG8_SA(0, 1), a2 + hstep, voffA);
            PG8_WAIT_V(8); PG8_WAIT_L(0); PG8_BAR; PG8_MMA(0, 0, At, B0); PG8_MMA(0, 1, At, B1); PG8_BAR; PG8_SCHED;
            PG8_LDA(At, 1, 1); PG8_STAGE(PG8_SB(1, 0), b3, voffB); PG8_STAGE(PG8_SB(1, 1), b3 + hstep, voffB);
            PG8_WAIT_V(6); PG8_WAIT_L(0); PG8_BAR; PG8_MMA(1, 0, At, B0); PG8_MMA(1, 1, At, B1); PG8_BAR; PG8_SCHED;
            } else {
            PG8_LDB(B0, 0, 0); PG8_SCHED; PG8_LDA(At, 0, 0); PG8_STAGE(PG8_SA(1, 1), a1 + hstep, voffA);
            PG8_WAIT_L(8); PG8_BAR; PG8_WAIT_L(0); PG8_MMA(0, 0, At, B0); PG8_BAR; PG8_SCHED;
            PG8_LDB(B1, 0, 1); PG8_STAGE(PG8_SB(0, 0), b2, voffB);
            PG8_BAR; PG8_WAIT_L(0); PG8_MMA(0, 1, At, B1); PG8_BAR;
            PG8_LDA(At, 0, 1); PG8_STAGE(PG8_SA(0, 0), a2, voffA);
            PG8_BAR; PG8_WAIT_L(0); PG8_MMA(1, 0, At, B0); PG8_BAR; PG8_SCHED;
            PG8_STAGE(PG8_SB(0, 1), b2 + hstep, voffB);
            PG8_WAIT_V(6); PG8_BAR; PG8_MMA(1, 1, At, B1); PG8_BAR;
            PG8_LDB(B0, 1, 0); PG8_SCHED; PG8_LDA(At, 1, 0); PG8_STAGE(PG8_SA(0, 1), a2 + hstep, voffA);
            PG8_WAIT_L(8); PG8_BAR; PG8_WAIT_L(0); PG8_MMA(0, 0, At, B0); PG8_BAR; PG8_SCHED;
            PG8_LDB(B1, 1, 1); PG8_STAGE(PG8_SB(1, 0), b3, voffB);
            PG8_BAR; PG8_WAIT_L(0); PG8_MMA(0, 1, At, B1); PG8_BAR;
            PG8_LDA(At, 1, 1); PG8_STAGE(PG8_SA(1, 0), a3, voffA);
            PG8_BAR; PG8_WAIT_L(0); PG8_MMA(1, 0, At, B0); PG8_BAR; PG8_SCHED;
            PG8_STAGE(PG8_SB(1, 1), b3 + hstep, voffB);
            PG8_WAIT_V(6); PG8_BAR; PG8_MMA(1, 1, At, B1); PG8_BAR;
            }
        }
        if constexpr (F8) { asm volatile("s_nop 15"); PG8_SCHED; }
        if constexpr (ALIGN_EPI) { if (wr == 0) PG8_BAR; }
        if constexpr (!Epi::AFTER_DRAIN) { E(acc, cur, wr, wc, fr, fq, epre); S.done(cur); }
        if (!has_next) break;
#pragma unroll
        for (int a = 0; a < 2; ++a)
#pragma unroll
            for (int b = 0; b < 2; ++b)
#pragma unroll
                for (int m = 0; m < 4; ++m)
#pragma unroll
                    for (int n = 0; n < 2; ++n) acc[a][b][m][n] = (f32x4){0.f, 0.f, 0.f, 0.f};
        cur = nxt; cA = nA; cB = nB; ++ui;
        E.prefetch(cur, wr, fr, epre);
        if constexpr (ALIGN_EPI) { if (wr == 1) PG8_BAR; }
    }
    PG8_WAIT_V(0);
    if constexpr (!ALIGN_EPI) { if (wr == 0) PG8_BAR; }
    PG8_BAR;
    if constexpr (Epi::AFTER_DRAIN) { E.fused(acc, cur, wr, wc, fr, fq, lds, wid, lane); S.done(cur); }
#undef PG8_SA
#undef PG8_SB
#undef PG8_STAGE
#undef PG8_LDA
#undef PG8_LDB
#undef PG8_MMA
#undef PG8_CAT8
#undef PG8_WAIT_V
#undef PG8_WAIT_L
#undef PG8_BAR
#undef PG8_SCHED
}
}

constexpr int NWAVES = 8, NTHREADS = 512;
constexpr int BATCH = 8, SEQ = 2048, DM = 2048, M = BATCH * SEQ, NH = 16, NG = 4, NR = 4, HD = 128, FF = 8192;
constexpr int NQKV = 5120, NSA_IN = 5168, NC = 127, NCP = 128, NBLK = 32, NGATE = 48;
constexpr float RMS_EPS = 1e-6f;
constexpr int COL_KC = 2048, COL_VC = 2560, COL_KS = 3072, COL_VS = 3584, COL_KW = 4096, COL_VW = 4608;
constexpr float QSCALE = 0.12751743082459868f;

constexpr size_t MiB = 1u << 20;
constexpr size_t WS_CTL = 0, CTL_ZERO_BYTES = 256 * 1024;
constexpr size_t WS_LUT = 1 * MiB, WS_BIAS1 = WS_LUT + 16 * 1024  , WS_LB = WS_BIAS1 + 8192;
constexpr size_t WS_GATES = 2 * MiB;
constexpr size_t WS_KCMP = 5 * MiB, WS_VCMP = 6 * MiB;
constexpr size_t WS_W = 8 * MiB;
constexpr size_t W0_QKV = WS_W, W0_G = WS_W + 20 * MiB, W0_W1 = WS_W + 21 * MiB, W0_W2 = WS_W + 23 * MiB, W0_O = WS_W + 24 * MiB, W0_UP = WS_W + 32 * MiB, W0_DN = WS_W + 64 * MiB;
constexpr size_t W1_IN = WS_W, W1_O = WS_W + 32 * MiB, W1_UP = WS_W + 40 * MiB, W1_DN = WS_W + 72 * MiB;
constexpr size_t WS_A = 120 * MiB;
constexpr size_t WS_BIG = 184 * MiB;
constexpr size_t WS_SCR = WS_W + 80 * MiB;
constexpr size_t WS_X8 = WS_BIG + 128 * MiB;
constexpr float N8SCALE = 16.f;
constexpr float A8SCALE = 4.f;
constexpr float W8SCALE = 64.f, H8SCALE = 4.f;
constexpr size_t WS_X16 = 440 * MiB;
constexpr size_t WS_RINV = 1 * MiB + 64 * 1024;
constexpr size_t WS_SLOTS = 504 * MiB;
constexpr size_t WS_END = 508 * MiB;
constexpr int CW_XTMO = 64, CW_CONVQ = 128, CW_PANEL = 8192;

constexpr int LDS_BYTES = 147456;

#define GAS __attribute__((address_space(1)))
#define LAS __attribute__((address_space(3)))
typedef unsigned short bf16;
typedef unsigned v4u __attribute__((ext_vector_type(4)));
typedef unsigned v2u __attribute__((ext_vector_type(2)));
typedef float f32x4 __attribute__((ext_vector_type(4)));
#define LDS_WAIT() asm volatile("s_waitcnt lgkmcnt(0)" ::: "memory")
#define VM_WAIT() asm volatile("s_waitcnt vmcnt(0)" ::: "memory")
__device__ __forceinline__ unsigned f2bf(float f) { unsigned u = __builtin_bit_cast(unsigned, f); return (u + 0x7fffu + ((u >> 16) & 1u)) >> 16; }
__device__ __forceinline__ unsigned pk2(float lo, float hi) { return f2bf(lo) | (f2bf(hi) << 16); }
__device__ __forceinline__ float bf2f(unsigned b) { return __builtin_bit_cast(float, b << 16); }
__device__ __forceinline__ float bflo(unsigned w) { return __builtin_bit_cast(float, w << 16); }
__device__ __forceinline__ float bfhi(unsigned w) { return __builtin_bit_cast(float, w & 0xffff0000u); }
__device__ __forceinline__ float wave_sum(float v) {
#pragma unroll
    for (int o = 1; o < 64; o <<= 1) v += __shfl_xor(v, o);
    return v;
}
__device__ __forceinline__ float wave_max(float v) {
#pragma unroll
    for (int o = 1; o < 64; o <<= 1) v = fmaxf(v, __shfl_xor(v, o));
    return v;
}
__device__ __forceinline__ int lane_id() { int l; asm volatile("v_mbcnt_lo_u32_b32 %0, -1, 0\n\tv_mbcnt_hi_u32_b32 %0, -1, %0" : "=v"(l)); return l; }
__device__ __forceinline__ float sigmoidf_(float x) { return 1.f / (1.f + __expf(-x)); }

typedef GAS unsigned gu32;
#define RLX_AGENT __ATOMIC_RELAXED, __HIP_MEMORY_SCOPE_AGENT
#define XB_TMO      128
#define XB_XCNT(j)  (256  + 64 * (j))
#define XB_XSUB(j)  (1280 + 64 * (j))
#define XB_XGEN(j)  (2304 + 64 * (j))
#define XB_TOP      3328
#define XB_TOPGEN   3392
#define XCD_BAR_WORDS 3456
#define XB_SPIN_CAP (1u << 24)

__device__ __forceinline__ unsigned xb_ld(unsigned* p)              { return __hip_atomic_load(p, __ATOMIC_RELAXED, __HIP_MEMORY_SCOPE_AGENT); }
__device__ __forceinline__ unsigned xb_add(unsigned* p, unsigned v) { return __hip_atomic_fetch_add(p, v, __ATOMIC_RELAXED, __HIP_MEMORY_SCOPE_AGENT); }
__device__ __forceinline__ unsigned xb_xcc_id() { return (unsigned)__builtin_amdgcn_s_getreg((3 << 11) | 20) & 0xFu; }
#define XB_SPIN(cond, bar) do { unsigned _sp = 0; while (cond) { __builtin_amdgcn_s_sleep(1); \
    if ((++_sp & 255u) == 0u) { if (xb_ld(&(bar)[XB_TMO])) break; if (_sp > XB_SPIN_CAP) { atomicAdd(&(bar)[XB_TMO], 1u); break; } } } } while (0)

struct XcdBarrier {
    int wave;
    unsigned* bar; unsigned x;
    volatile LAS unsigned* st;
};

__device__ __forceinline__ XcdBarrier xcd_barrier_post(unsigned* bar, volatile LAS unsigned* st, int wave) {
    XcdBarrier b; b.wave = wave; b.bar = bar; b.x = xb_xcc_id(); b.st = st;
    if (wave == 0 && lane_id() == 0) (void)xb_add(&bar[XB_XCNT(b.x)], 1u);
    return b;
}
__device__ __forceinline__ void xcd_barrier_complete(unsigned* bar, unsigned x, unsigned& nloc, unsigned& nx) {
    const unsigned G = gridDim.x * gridDim.y * gridDim.z;
    unsigned sum, cnt, mine, sp = 0u;
    for (;;) {
        sum = 0u; cnt = 0u; mine = 0u;
#pragma unroll
        for (unsigned j = 0; j < 16; ++j) { const unsigned c = xb_ld(&bar[XB_XCNT(j)]); sum += c; cnt += (c > 0u) ? 1u : 0u; mine = (j == x) ? c : mine; }
        if (sum == G) break;
        __builtin_amdgcn_s_sleep(1);
        if ((++sp & 255u) == 0u) { if (xb_ld(&bar[XB_TMO])) break; if (sp > XB_SPIN_CAP) { atomicAdd(&bar[XB_TMO], 1u); break; } }
    }
    nloc = mine > 0u ? mine : 1u; nx = cnt > 0u ? cnt : 1u;
}

__device__ __forceinline__ void xcd_barrier(const XcdBarrier& b) {
    asm volatile("s_waitcnt vmcnt(0)" ::: "memory");
    __syncthreads();
    if (b.wave == 0 && lane_id() == 0) {
        unsigned* bar = b.bar;
        __builtin_amdgcn_s_waitcnt(0);
        unsigned nloc = b.st[0], nx = b.st[1];
        if (nloc == 0u) { xcd_barrier_complete(bar, b.x, nloc, nx); b.st[0] = nloc; b.st[1] = nx; }
        const unsigned old = xb_add(&bar[XB_XSUB(b.x)], 1u);
        const unsigned gen = old / nloc;
        if (old + 1u == (gen + 1u) * nloc) {
            __builtin_amdgcn_fence(__ATOMIC_RELEASE, "agent");
            asm volatile("s_waitcnt vmcnt(0)" ::: "memory");
            const unsigned og = xb_add(&bar[XB_TOP], 1u);
            const unsigned tg = og / nx;
            if (og + 1u == (tg + 1u) * nx) xb_add(&bar[XB_TOPGEN], 1u);
            else XB_SPIN(xb_ld(&bar[XB_TOPGEN]) == tg, bar);
            __builtin_amdgcn_fence(__ATOMIC_ACQUIRE, "agent");
            xb_add(&bar[XB_XGEN(b.x)], 1u);
            asm volatile("s_waitcnt vmcnt(0)" ::: "memory");
        } else {
            XB_SPIN(xb_ld(&bar[XB_XGEN(b.x)]) == gen, bar);
            __builtin_amdgcn_fence(__ATOMIC_ACQUIRE, "agent");
            asm volatile("s_waitcnt vmcnt(0)" ::: "memory");
        }
    }
    __syncthreads();
}

struct Frame {
    LAS unsigned char* lds;
    int tid, lane, wave, G, gw, NGW;
    const float *x, *norm_g, *rel, *w_in, *pe, *cw1, *cw2, *w_out, *h_in, *h_lb, *h_on, *h_out, *up, *dn;
    float* out;
    unsigned char* ws;
};

template <int ACT  > struct EpiAct {
    static constexpr bool PERM = true, AFTER_DRAIN = false;
    bf16* O; int ldc; int scale_tiles; float scale; const float* lb; const float* rs; float rsmul;
    __device__ __forceinline__ void prefetch(const pg8::Unit& u, int wr, int fr, float (&pre)[8]) const {
        const int row0 = u.pm * 256 + wr * 64 + fr;
#pragma unroll
        for (int j = 0; j < 8; ++j) pre[j] = rs ? rs[row0 + (j >> 2) * 128 + (j & 3) * 16] * rsmul : 1.f;
    }
    __device__ __forceinline__ void operator()(const pg8::f32x4 (&acc)[2][2][4][2], const pg8::Unit& u, int wr, int wc, int fr, int fq, const float (&pre)[8]) const {
        const int row0 = u.pm * 256 + wr * 64 + fr, col0 = u.pn * 256 + wc * 32 + 8 * fq;
        const float sc = (u.pn < scale_tiles) ? scale : 1.f;
        const int kind = (ACT == 2) ? ((u.pn < 8 || u.pn >= 24) ? 1 : (u.pn < 16 ? 2 : 0)) : 0;
        pg8::f32x4 lbv[2][2];
        if (ACT == 2) {
#pragma unroll
            for (int bj = 0; bj < 2; ++bj)
#pragma unroll
                for (int n = 0; n < 2; ++n) lbv[bj][n] = (kind == 2) ? *(const pg8::f32x4*)(lb + (col0 - 2048) + bj * 128 + 4 * n) : (pg8::f32x4){0.f, 0.f, 0.f, 0.f};
        }
#pragma unroll
        for (int ai = 0; ai < 2; ++ai)
#pragma unroll
            for (int m = 0; m < 4; ++m) { bf16* rowp = O + (size_t)(row0 + ai * 128 + m * 16) * ldc + col0; const float rsc = (ACT == 2) ? pre[ai * 4 + m] : pre[ai * 4 + m] * sc;
#pragma unroll
                for (int bj = 0; bj < 2; ++bj) { pg8::f32x4 v0 = acc[ai][bj][m][0] * rsc, v1 = acc[ai][bj][m][1] * rsc;
                    if (ACT == 2) {
                        if (kind == 1) {
#pragma unroll
                            for (int j = 0; j < 4; ++j) { v0[j] = v0[j] * __builtin_amdgcn_rcpf(1.f + __builtin_amdgcn_exp2f(v0[j] * -1.4426950408889634f)); v1[j] = v1[j] * __builtin_amdgcn_rcpf(1.f + __builtin_amdgcn_exp2f(v1[j] * -1.4426950408889634f)); }
                        } else if (kind == 2) {
#pragma unroll
                            for (int j = 0; j < 4; ++j) { const float l0 = lbv[bj][0][j], l1 = lbv[bj][1][j];
                                v0[j] = 0.6931471805599453f * __builtin_amdgcn_logf(l0 + (1.f - l0) * __builtin_amdgcn_rcpf(1.f + __builtin_amdgcn_exp2f(v0[j] * -1.4426950408889634f)));
                                v1[j] = 0.6931471805599453f * __builtin_amdgcn_logf(l1 + (1.f - l1) * __builtin_amdgcn_rcpf(1.f + __builtin_amdgcn_exp2f(v1[j] * -1.4426950408889634f))); }
                        }
                    }
                    pg8::u32x4 w; w.x = pg8::cvt_pk_bf16(v0[0], v0[1]); w.y = pg8::cvt_pk_bf16(v0[2], v0[3]); w.z = pg8::cvt_pk_bf16(v1[0], v1[1]); w.w = pg8::cvt_pk_bf16(v1[2], v1[3]);
                    *(pg8::u32x4*)(rowp + bj * 128) = w; } }
    }
};

__device__ __forceinline__ unsigned pk8(float a, float b, float c, float d) { int w = 0; w = __builtin_amdgcn_cvt_pk_fp8_f32(a, b, w, false); w = __builtin_amdgcn_cvt_pk_fp8_f32(c, d, w, true); return (unsigned)w; }
struct EpiUp8 {
    static constexpr bool PERM = true, AFTER_DRAIN = false;
    unsigned char* O; int ldc; const float* rs;
    __device__ __forceinline__ void prefetch(const pg8::Unit& u, int wr, int fr, float (&pre)[8]) const {
        const int row0 = u.pm * 256 + wr * 64 + fr;
#pragma unroll
        for (int j = 0; j < 8; ++j) pre[j] = rs[row0 + (j >> 2) * 128 + (j & 3) * 16] * (2.f / W8SCALE);
    }
    __device__ __forceinline__ void operator()(const pg8::f32x4 (&acc)[2][2][4][2], const pg8::Unit& u, int wr, int wc, int fr, int fq, const float (&pre)[8]) const {
        static_assert(H8SCALE == 4.f, "EpiUp8 folds sqrt(H8SCALE) = 2 into the row scale");
        const int row0 = u.pm * 256 + wr * 64 + fr, col0 = u.pn * 256 + wc * 32 + 8 * fq;
#pragma unroll
        for (int ai = 0; ai < 2; ++ai)
#pragma unroll
            for (int m = 0; m < 4; ++m) { const float rsc = pre[ai * 4 + m]; v2u w[2];
#pragma unroll
                for (int bj = 0; bj < 2; ++bj) { pg8::f32x4 v0 = acc[ai][bj][m][0] * rsc, v1 = acc[ai][bj][m][1] * rsc;
#pragma unroll
                    for (int j = 0; j < 4; ++j) { v0[j] = __builtin_amdgcn_fmed3f(v0[j], 0.f, 21.166010488f); v1[j] = __builtin_amdgcn_fmed3f(v1[j], 0.f, 21.166010488f); }
                    v0 = v0 * v0; v1 = v1 * v1;
                    w[bj].x = pk8(v0[0], v0[1], v0[2], v0[3]); w[bj].y = pk8(v1[0], v1[1], v1[2], v1[3]); }
                const auto sx = __builtin_amdgcn_permlane16_swap(w[0].x, w[1].x, false, false); const auto sy = __builtin_amdgcn_permlane16_swap(w[0].y, w[1].y, false, false);
                *(v4u*)(O + (size_t)(row0 + ai * 128 + m * 16) * ldc + u.pn * 256 + wc * 32 + 8 * (fq & ~1) + (fq & 1) * 128) = (v4u){sx[0], sy[0], sx[1], sy[1]}; }
    }
};

struct PanelSq {
    float* slots;
    unsigned* cnt;
    unsigned* tmo;
    template <class Fn> __device__ __forceinline__ void run(const float (&ssl)[8], const pg8::Unit& u, int wr, int wc, int fr, int fq, LAS unsigned char* lds, int wid, int lane, Fn&& between) const {
        LAS float* P = (LAS float*)lds; LAS float* S = (LAS float*)(lds + 8192);
#pragma unroll
        for (int j = 0; j < 8; ++j) { float t = ssl[j]; t += __shfl_xor(t, 16); t += __shfl_xor(t, 32);
            if (fq == 0) P[((j >> 2) * 128 + wr * 64 + (j & 3) * 16 + fr) * 4 + wc] = t; }
        asm volatile("s_waitcnt lgkmcnt(0)" ::: "memory"); __builtin_amdgcn_s_barrier(); asm volatile("" ::: "memory");
        const int row = wid * 32 + (lane & 31);
        if (lane < 32) { const f32x4 p4 = *(const LAS f32x4*)(P + row * 4); const float t = (p4.x + p4.y) + (p4.z + p4.w);
            __hip_atomic_store((unsigned*)(slots + (size_t)(u.pm * 256 + row) * 8 + u.pn), __builtin_bit_cast(unsigned, t), __ATOMIC_RELAXED, __HIP_MEMORY_SCOPE_AGENT); }
        asm volatile("s_waitcnt vmcnt(0)" ::: "memory");
        if (lane == 0) __hip_atomic_fetch_add(cnt + 64 * u.pm, 1u, __ATOMIC_RELAXED, __HIP_MEMORY_SCOPE_AGENT);
        between();
        if (wid == 0) {
            unsigned sp = 0;
            while ((unsigned)__builtin_amdgcn_readfirstlane(__hip_atomic_load(cnt + 64 * u.pm, __ATOMIC_RELAXED, __HIP_MEMORY_SCOPE_AGENT)) < 64u) {
                __builtin_amdgcn_s_sleep(1);
                if ((++sp & 255u) == 0u) { if (__hip_atomic_load(tmo, __ATOMIC_RELAXED, __HIP_MEMORY_SCOPE_AGENT)) break; if (sp > (1u << 24)) { if (lane == 0) __hip_atomic_store(tmo, 1u, __ATOMIC_RELAXED, __HIP_MEMORY_SCOPE_AGENT); break; } } }
            __builtin_amdgcn_fence(__ATOMIC_ACQUIRE, "agent");
        }
        asm volatile("s_waitcnt vmcnt(0) lgkmcnt(0)" ::: "memory"); __builtin_amdgcn_s_barrier(); asm volatile("" ::: "memory");
        if (lane < 32) { const unsigned* sl = (const unsigned*)(slots + (size_t)(u.pm * 256 + row) * 8); float t = 0.f;
#pragma unroll
            for (int o = 0; o < 8; ++o) t += __builtin_bit_cast(float, __hip_atomic_load(sl + o, __ATOMIC_RELAXED, __HIP_MEMORY_SCOPE_AGENT));
            S[row] = t; }
        asm volatile("s_waitcnt vmcnt(0) lgkmcnt(0)" ::: "memory"); __builtin_amdgcn_s_barrier(); asm volatile("" ::: "memory");
    }
};
struct PanelSqLast {
    float* slots; unsigned* cnt; float* rinv;
    __device__ __forceinline__ void run(const float (&ssl)[8], const pg8::Unit& u, int wr, int wc, int fr, int fq, LAS unsigned char* lds, int wid, int lane) const {
        LAS float* P = (LAS float*)lds;
#pragma unroll
        for (int j = 0; j < 8; ++j) { float t = ssl[j]; t += __shfl_xor(t, 16); t += __shfl_xor(t, 32);
            if (fq == 0) P[((j >> 2) * 128 + wr * 64 + (j & 3) * 16 + fr) * 4 + wc] = t; }
        asm volatile("s_waitcnt lgkmcnt(0)" ::: "memory"); __builtin_amdgcn_s_barrier(); asm volatile("" ::: "memory");
        const int row = wid * 32 + (lane & 31);
        if (lane < 32) { const f32x4 p4 = *(const LAS f32x4*)(P + row * 4); const float t = (p4.x + p4.y) + (p4.z + p4.w);
            __hip_atomic_store((unsigned*)(slots + (size_t)(u.pm * 256 + row) * 8 + u.pn), __builtin_bit_cast(unsigned, t), __ATOMIC_RELAXED, __HIP_MEMORY_SCOPE_AGENT); }
        asm volatile("s_waitcnt vmcnt(0)" ::: "memory");
        unsigned old = 0u;
        if (lane == 0) old = __hip_atomic_fetch_add(cnt + 64 * u.pm, 1u, __ATOMIC_RELAXED, __HIP_MEMORY_SCOPE_AGENT);
        old = (unsigned)__builtin_amdgcn_readfirstlane((int)old);
        if (old == 63u) {
            __builtin_amdgcn_fence(__ATOMIC_ACQUIRE, "agent"); asm volatile("s_waitcnt vmcnt(0)" ::: "memory");
#pragma unroll
            for (int q = 0; q < 4; ++q) { const int r = q * 64 + lane; const unsigned* sl = (const unsigned*)(slots + (size_t)(u.pm * 256 + r) * 8); float t = 0.f;
#pragma unroll
                for (int o = 0; o < 8; ++o) t += __builtin_bit_cast(float, __hip_atomic_load(sl + o, __ATOMIC_RELAXED, __HIP_MEMORY_SCOPE_AGENT));
                rinv[u.pm * 256 + r] = __builtin_amdgcn_rsqf(t * (1.f / DM) + RMS_EPS); } }
    }
};
template <bool XF32  , bool FINAL  , bool W8  > struct EpiRmsRes {
    static constexpr bool PERM = true, AFTER_DRAIN = true;
    const void* xold; bf16* xnew; float* outf; const float* g; unsigned char* x8; float osc  ; PanelSq st1; PanelSqLast st2;
    __device__ __forceinline__ void prefetch(const pg8::Unit&, int, int, float (&)[8]) const {}
    __device__ __forceinline__ void fused(pg8::f32x4 (&acc)[2][2][4][2], const pg8::Unit& u, int, int, int, int, LAS unsigned char* lds, int wid, int) const {
        const int lane = lane_id(), fr = lane & 15, fq = lane >> 4, wr = wid >> 2, wc = wid & 3;
        const LAS float* S = (const LAS float*)(lds + 8192);
        const int col0 = u.pn * 256 + wc * 32 + 8 * fq;
        float ssl[8];
#pragma unroll
        for (int ai = 0; ai < 2; ++ai)
#pragma unroll
            for (int m = 0; m < 4; ++m) { float t = 0.f;
#pragma unroll
                for (int bj = 0; bj < 2; ++bj)
#pragma unroll
                    for (int n = 0; n < 2; ++n) { const pg8::f32x4 v = acc[ai][bj][m][n]; t += (v[0] * v[0] + v[1] * v[1]) + (v[2] * v[2] + v[3] * v[3]); }
                ssl[ai * 4 + m] = t; }
        constexpr int NPRE = XF32 ? 4 : 8;
        v4u xpre[NPRE][2];
        pg8::f32x4 gv[2][2];
        st1.run(ssl, u, wr, wc, fr, fq, lds, wid, lane, [&]() {
            if (!XF32) { const char* xb = (const char*)xold + (size_t)u.pm * 256 * DM * 2; asm volatile("" : "+s"(xb));
                const unsigned o0 = (unsigned)(((wr * 64 + fr) * DM + col0) * 2);
#pragma unroll
                for (int j = 0; j < 8; ++j)
#pragma unroll
                    for (int bj = 0; bj < 2; ++bj) xpre[j][bj] = *(const GAS v4u*)(xb + (o0 + (unsigned)((((j >> 2) * 128 + (j & 3) * 16) * DM + bj * 128) * 2)));
            }
#pragma unroll
            for (int bj = 0; bj < 2; ++bj)
#pragma unroll
                for (int n = 0; n < 2; ++n) gv[bj][n] = *(const pg8::f32x4*)(g + col0 + bj * 128 + 4 * n);
        });
#pragma unroll
        for (int ai = 0; ai < 2; ++ai)
#pragma unroll
            for (int m = 0; m < 4; ++m) { const int rl = ai * 128 + wr * 64 + m * 16 + fr; const float ry = osc * __builtin_amdgcn_rsqf(S[rl] * (osc * osc * (1.f / DM)) + RMS_EPS);
                const size_t off = (size_t)(u.pm * 256 + rl) * DM + col0; float t = 0.f; v2u w8p[2] = {(v2u){0u, 0u}, (v2u){0u, 0u}};
#pragma unroll
                for (int bj = 0; bj < 2; ++bj) { pg8::f32x4 x0, x1;
                    if (XF32) { x0 = *(const pg8::f32x4*)((const float*)xold + off + bj * 128); x1 = *(const pg8::f32x4*)((const float*)xold + off + bj * 128 + 4); }
                    else { const v4u w = xpre[ai * 4 + m][bj]; x0 = (pg8::f32x4){bflo(w.x), bfhi(w.x), bflo(w.y), bfhi(w.y)}; x1 = (pg8::f32x4){bflo(w.z), bfhi(w.z), bflo(w.w), bfhi(w.w)}; }
                    const pg8::f32x4 a0 = x0 + acc[ai][bj][m][0] * ry * gv[bj][0], a1 = x1 + acc[ai][bj][m][1] * ry * gv[bj][1];
                    t += ((a0[0] * a0[0] + a0[1] * a0[1]) + (a0[2] * a0[2] + a0[3] * a0[3])) + ((a1[0] * a1[0] + a1[1] * a1[1]) + (a1[2] * a1[2] + a1[3] * a1[3]));
                    if (FINAL) { *(pg8::f32x4*)(outf + off + bj * 128) = a0; *(pg8::f32x4*)(outf + off + bj * 128 + 4) = a1; }
                    else { pg8::u32x4 w; w.x = pg8::cvt_pk_bf16(a0[0], a0[1]); w.y = pg8::cvt_pk_bf16(a0[2], a0[3]); w.z = pg8::cvt_pk_bf16(a1[0], a1[1]); w.w = pg8::cvt_pk_bf16(a1[2], a1[3]);
                        *(pg8::u32x4*)(xnew + off + bj * 128) = w;
                        if (W8) { w8p[bj].x = pk8(__builtin_amdgcn_fmed3f(a0[0], -448.f, 448.f), __builtin_amdgcn_fmed3f(a0[1], -448.f, 448.f), __builtin_amdgcn_fmed3f(a0[2], -448.f, 448.f), __builtin_amdgcn_fmed3f(a0[3], -448.f, 448.f));
                            w8p[bj].y = pk8(__builtin_amdgcn_fmed3f(a1[0], -448.f, 448.f), __builtin_amdgcn_fmed3f(a1[1], -448.f, 448.f), __builtin_amdgcn_fmed3f(a1[2], -448.f, 448.f), __builtin_amdgcn_fmed3f(a1[3], -448.f, 448.f)); } } }
                if (W8 && !FINAL) {
                    const auto sx = __builtin_amdgcn_permlane16_swap(w8p[0].x, w8p[1].x, false, false); const auto sy = __builtin_amdgcn_permlane16_swap(w8p[0].y, w8p[1].y, false, false);
                    *(v4u*)(x8 + (size_t)(u.pm * 256 + rl) * DM + u.pn * 256 + wc * 32 + 8 * (fq & ~1) + (fq & 1) * 128) = (v4u){sx[0], sy[0], sx[1], sy[1]}; }
                ssl[ai * 4 + m] = t;
                if (XF32 && (m & 1)) asm volatile("" ::: "memory"); }
        if (FINAL) return;
        st2.run(ssl, u, wr, wc, fr, fq, lds, wid, lane);
    }
};

__device__ __forceinline__ void tr_item(const float* W, int ldw, int K, int ncols, bf16* WT, LAS float* scr, int item, int lane, const float* gk = nullptr) {
    const int nblk = (ncols + 31) / 32, kb = item / nblk, nb = item % nblk, k0 = 64 * kb, n0 = 32 * nb;
    const int nn = n0 + (lane & 31);
    float wv[32];
#pragma unroll
    for (int i = 0; i < 32; ++i) { const int kk = 2 * i + (lane >> 5); wv[i] = (nn < ncols) ? W[(size_t)(k0 + kk) * ldw + nn] : 0.f; }
#pragma unroll
    for (int i = 0; i < 32; ++i) { const int kk = 2 * i + (lane >> 5); scr[kk * 33 + (lane & 31)] = wv[i] * (gk ? gk[k0 + kk] : 1.f); }
    LDS_WAIT(); asm volatile("" ::: "memory");
    const int c = lane & 7;
#pragma unroll
    for (int j = 0; j < 4; ++j) { const int n = (lane >> 3) + 8 * j; const LAS float* s = scr + (8 * c) * 33 + n;
        v4u o; o.x = pk2(s[0 * 33], s[1 * 33]); o.y = pk2(s[2 * 33], s[3 * 33]); o.z = pk2(s[4 * 33], s[5 * 33]); o.w = pk2(s[6 * 33], s[7 * 33]);
        *(GAS v4u*)(WT + (size_t)(n0 + n) * K + k0 + 8 * c) = o; }
    LDS_WAIT(); asm volatile("" ::: "memory");
}
__device__ __forceinline__ void tr_item8(const float* W, int ldw, int K, int ncols, unsigned char* WT, LAS float* scr, int item, int lane, const float* gk = nullptr) {
    const int nblk = ncols / 32, kb = item / nblk, nb = item % nblk, k0 = 64 * kb, n0 = 32 * nb;
    const int nn = n0 + (lane & 31);
    float wv[32];
#pragma unroll
    for (int i = 0; i < 32; ++i) { const int kk = 2 * i + (lane >> 5); wv[i] = W[(size_t)(k0 + kk) * ldw + nn]; }
#pragma unroll
    for (int i = 0; i < 32; ++i) { const int kk = 2 * i + (lane >> 5); scr[kk * 33 + (lane & 31)] = wv[i] * (gk ? gk[k0 + kk] * W8SCALE : W8SCALE); }
    LDS_WAIT(); asm volatile("" ::: "memory");
    const int c = lane & 7;
#pragma unroll
    for (int j = 0; j < 4; ++j) { const int n = (lane >> 3) + 8 * j; const LAS float* s = scr + (8 * c) * 33 + n;
        v2u o; o.x = pk8(__builtin_amdgcn_fmed3f(s[0 * 33], -448.f, 448.f), __builtin_amdgcn_fmed3f(s[1 * 33], -448.f, 448.f), __builtin_amdgcn_fmed3f(s[2 * 33], -448.f, 448.f), __builtin_amdgcn_fmed3f(s[3 * 33], -448.f, 448.f));
        o.y = pk8(__builtin_amdgcn_fmed3f(s[4 * 33], -448.f, 448.f), __builtin_amdgcn_fmed3f(s[5 * 33], -448.f, 448.f), __builtin_amdgcn_fmed3f(s[6 * 33], -448.f, 448.f), __builtin_amdgcn_fmed3f(s[7 * 33], -448.f, 448.f));
        *(GAS v2u*)(WT + (size_t)(n0 + n) * K + k0 + 8 * c) = o; }
    LDS_WAIT(); asm volatile("" ::: "memory");
}
#define TR_JOB8G(Wp, ldw, K, ncols, WTp, gk) { const int ni_ = ((K) / 64) * ((ncols) / 32); if (r < ni_) { tr_item8((Wp), (ldw), (K), (ncols), (WTp), scr, r, F.lane, (gk)); continue; } r -= ni_; }
#define TR_JOBG(Wp, ldw, K, ncols, WTp, gk) { const int ni_ = ((K) / 64) * (((ncols) + 31) / 32); if (r < ni_) { tr_item((Wp), (ldw), (K), (ncols), (WTp), scr, r, F.lane, (gk)); continue; } r -= ni_; }
#define TR_JOB(Wp, ldw, K, ncols, WTp) TR_JOBG(Wp, ldw, K, ncols, WTp, nullptr)

struct TrDesc { const float* W; void* WT; const float* gk; int ldw, K, ncols, f8, item; };
__device__ __forceinline__ void tr_load(const TrDesc& d, float (&wv)[32], f32x4 (&g8)[2], int lane) {
    const int nblk = (d.ncols + 31) / 32, kb = d.item / nblk, nb = d.item % nblk, k0 = 64 * kb, n0 = 32 * nb;
    const int nn = n0 + (lane & 31); const bool inr = nn < d.ncols;
    const float* wp = d.W + (size_t)(k0 + (lane >> 5)) * d.ldw + (inr ? nn : d.ncols - 1);
#pragma unroll
    for (int i = 0; i < 32; ++i) { const float* p_ = wp + (size_t)(2 * i) * d.ldw; asm volatile("global_load_dword %0, %1, off nt" : "=v"(wv[i]) : "v"(p_) : "memory"); }
    const float* gp = d.gk ? d.gk + k0 + 8 * (lane & 7) : d.W; const float* gp4 = gp + 4;
    asm volatile("global_load_dwordx4 %0, %1, off" : "=v"(g8[0]) : "v"(gp) : "memory"); asm volatile("global_load_dwordx4 %0, %1, off" : "=v"(g8[1]) : "v"(gp4) : "memory");
}
__device__ __forceinline__ void tr_finish(const TrDesc& d, float (&wv)[32], f32x4 (&g8in)[2], LAS float* scr, int lane, int nwait) {
    if (nwait == 38) asm volatile("s_waitcnt vmcnt(38)" ::: "memory"); else if (nwait == 34) asm volatile("s_waitcnt vmcnt(34)" ::: "memory"); else asm volatile("s_waitcnt vmcnt(0)" ::: "memory");
#pragma unroll
    for (int i = 0; i < 32; ++i) asm volatile("" : "+v"(wv[i]));
    asm volatile("" : "+v"(g8in[0])); asm volatile("" : "+v"(g8in[1]));
    const int nblk = (d.ncols + 31) / 32, kb = d.item / nblk, nb = d.item % nblk, k0 = 64 * kb, n0 = 32 * nb;
    const bool inr = n0 + (lane & 31) < d.ncols;
    f32x4 g8[2]; g8[0] = d.gk ? g8in[0] : (f32x4){1.f, 1.f, 1.f, 1.f}; g8[1] = d.gk ? g8in[1] : (f32x4){1.f, 1.f, 1.f, 1.f};
#pragma unroll
    for (int i = 0; i < 32; ++i) { const int kk = 2 * i + (lane >> 5); scr[kk * 33 + (lane & 31)] = inr ? wv[i] : 0.f; }
    LDS_WAIT(); asm volatile("" ::: "memory");
    const int c = lane & 7;
    if (d.f8) {
        unsigned char* WT = (unsigned char*)d.WT;
#pragma unroll
        for (int j = 0; j < 4; ++j) { const int n = (lane >> 3) + 8 * j; const LAS float* sp = scr + (8 * c) * 33 + n; float v[8];
#pragma unroll
            for (int e = 0; e < 8; ++e) v[e] = __builtin_amdgcn_fmed3f(sp[e * 33] * (g8[e >> 2][e & 3] * W8SCALE), -448.f, 448.f);
            v2u o; o.x = pk8(v[0], v[1], v[2], v[3]); o.y = pk8(v[4], v[5], v[6], v[7]);
            *(GAS v2u*)(WT + (size_t)(n0 + n) * d.K + k0 + 8 * c) = o; }
    } else {
        bf16* WT = (bf16*)d.WT;
#pragma unroll
        for (int j = 0; j < 4; ++j) { const int n = (lane >> 3) + 8 * j; const LAS float* sp = scr + (8 * c) * 33 + n; float v[8];
#pragma unroll
            for (int e = 0; e < 8; ++e) v[e] = sp[e * 33] * g8[e >> 2][e & 3];
            v4u o; o.x = pk2(v[0], v[1]); o.y = pk2(v[2], v[3]); o.z = pk2(v[4], v[5]); o.w = pk2(v[6], v[7]);
            *(GAS v4u*)(WT + (size_t)(n0 + n) * d.K + k0 + 8 * c) = o; }
    }
    LDS_WAIT(); asm volatile("" ::: "memory");
}
template <class Next, class Decode> __device__ __forceinline__ void tr_stream(LAS float* scr, int lane, Next&& next, Decode&& decode) {
    TrDesc dA, dB; float wA[32], wB[32]; f32x4 gA[2], gB[2];
    int itA = next(); if (itA < 0) return;
    dA = decode(itA); tr_load(dA, wA, gA, lane);
    int steady = 34;
    for (;;) {
        const int itB = next(); if (itB >= 0) { dB = decode(itB); tr_load(dB, wB, gB, lane); }
        tr_finish(dA, wA, gA, scr, lane, itB >= 0 ? steady : 0);
        if (itB < 0) break;
        steady = 38;
        itA = next(); if (itA >= 0) { dA = decode(itA); tr_load(dA, wA, gA, lane); }
        tr_finish(dB, wB, gB, scr, lane, itA >= 0 ? 38 : 0);
        if (itA < 0) break;
    }
}
#define TD_JOB(Wp, ldw_, K_, ncols_, WTp, gk_, f8_) { const int ni_ = ((K_) / 64) * (((ncols_) + 31) / 32); if (r < ni_) return TrDesc{(Wp), (void*)(WTp), (gk_), (ldw_), (K_), (ncols_), (f8_), r}; r -= ni_; }

__device__ __forceinline__ int rel_bucket(int n) {
    if (n < 16) return n;
    const float v = logf((float)n / 16.f) / 2.0794415416798357f * 16.f;
    const int l = 16 + (int)v; return l < 31 ? l : 31;
}

__device__ __forceinline__ void p0_prologue(Frame& F) {
    LAS float* scr = (LAS float*)(F.lds + F.wave * 16384);
    unsigned char* ws = F.ws;
    constexpr int NITEMS = (DM / 64) * (NQKV / 32) + (DM / 64) * 2 + 2 * (4096 / 64) * 4 + 2 * 2 * 4 + (DM / 64) * (DM / 32) + (DM / 64) * (FF / 32) + (FF / 64) * (DM / 32);
    { int cur = F.gw;
      tr_stream(scr, F.lane, [&]() -> int { const int r = cur < NITEMS ? cur : -1; cur += F.NGW; return r; },
        [&](int it) -> TrDesc { int r = it;
          TD_JOB(F.dn, DM, FF, DM, ws + W0_DN, nullptr, 1)
          TD_JOB(F.up, FF, DM, FF, ws + W0_UP, F.norm_g + 2 * DM, 1)
          TD_JOB(F.w_out, DM, DM, DM, ws + W0_O, nullptr, 1)
          TD_JOB(F.cw1, HD, 4096, HD, ws + W0_W1, nullptr, 0)
          TD_JOB(F.cw1 + 4096 * HD, HD, 4096, HD, (bf16*)(ws + W0_W1) + HD * 4096, nullptr, 0)
          TD_JOB(F.cw2, HD, HD, HD, ws + W0_W2, nullptr, 0)
          TD_JOB(F.cw2 + HD * HD, HD, HD, HD, (bf16*)(ws + W0_W2) + HD * HD, nullptr, 0)
          TD_JOB(F.w_in + NQKV, NSA_IN, DM, NGATE, ws + W0_G, F.norm_g, 0)
          TD_JOB(F.w_in, NSA_IN, DM, NQKV, ws + W0_QKV, F.norm_g, 0)
          return TrDesc{F.dn, (void*)(ws + W0_DN), nullptr, DM, FF, DM, 1, 0}; }); }
    if (blockIdx.x == 0) {
        float* lut = (float*)(ws + WS_LUT);
        for (int i = F.tid; i < NH * 128; i += NTHREADS) { const int h = i >> 7, d = i & 127; lut[i] = F.rel[rel_bucket(d) * NH + h] * 1.4426950408889634f; }
    }
    if (blockIdx.x == 1) {
        float* lb = (float*)(ws + WS_LB);
        for (int i = F.tid; i < DM; i += NTHREADS) lb[i] = 1.f / (1.f + expf(F.h_lb[i] - F.h_lb[DM + i]));
    }
    for (int it = F.gw; it < 2 * HD * 8; it += F.NGW) {
        const int k8 = it & 7, n = (it >> 3) & 127, kv = it >> 10; const float* pe = F.pe + kv * 4096 + 512 * k8; const float* w1 = F.cw1 + ((size_t)kv * 4096 + 512 * k8) * HD + n;
        float wv[8]; float s = 0.f;
#pragma unroll
        for (int j = 0; j < 8; ++j) wv[j] = w1[(size_t)(64 * j + F.lane) * HD];
#pragma unroll
        for (int j = 0; j < 8; ++j) s += pe[64 * j + F.lane] * wv[j];
        s = wave_sum(s);
        if (F.lane == 0) ((float*)(ws + WS_BIAS1))[k8 * 256 + kv * HD + n] = s;
    }
    { const int lane = F.lane; f32x4 xv[8]; int m = F.gw; float* rinv = (float*)(ws + WS_RINV);
      if (m < M) { const GAS f32x4* xr = (const GAS f32x4*)(F.x + (size_t)m * DM) + 2 * lane;
#pragma unroll
          for (int j = 0; j < 8; ++j) xv[j] = __builtin_nontemporal_load(xr + 128 * (j >> 1) + (j & 1)); }
      for (; m < M; m += F.NGW) { f32x4 xn[8]; const int m2 = m + F.NGW;
          if (m2 < M) { const GAS f32x4* xr = (const GAS f32x4*)(F.x + (size_t)m2 * DM) + 2 * lane;
#pragma unroll
              for (int j = 0; j < 8; ++j) xn[j] = __builtin_nontemporal_load(xr + 128 * (j >> 1) + (j & 1)); }
          float s = 0.f;
#pragma unroll
          for (int j = 0; j < 8; ++j) s += (xv[j].x * xv[j].x + xv[j].y * xv[j].y) + (xv[j].z * xv[j].z + xv[j].w * xv[j].w);
          const float r = __builtin_amdgcn_rsqf(wave_sum(s) * (1.f / DM) + RMS_EPS);
          if (lane == 0) rinv[m] = r;
          GAS v4u* o16 = (GAS v4u*)((bf16*)(ws + WS_X16) + (size_t)m * DM) + lane;
#pragma unroll
          for (int jj = 0; jj < 4; ++jj) { v4u w; w.x = pk2(xv[2 * jj].x, xv[2 * jj].y); w.y = pk2(xv[2 * jj].z, xv[2 * jj].w); w.z = pk2(xv[2 * jj + 1].x, xv[2 * jj + 1].y); w.w = pk2(xv[2 * jj + 1].z, xv[2 * jj + 1].w); o16[64 * jj] = w; }
#pragma unroll
          for (int j = 0; j < 8; ++j) xv[j] = xn[j]; } }
}
__device__ __forceinline__ void p_convert_l1a(Frame& F) {
    LAS float* scr = (LAS float*)(F.lds + F.wave * 16384);
    unsigned char* ws = F.ws;
    constexpr int NITEMS = (DM / 64) * (FF / 32);
    int cur = F.gw;
    tr_stream(scr, F.lane, [&]() -> int { const int r = cur < NITEMS ? cur : -1; cur += F.NGW; return r; },
      [&](int it) -> TrDesc { return TrDesc{F.h_in, (void*)(ws + W1_IN), F.norm_g + 4 * DM, FF, DM, FF, 1, it}; });
}
__device__ __forceinline__ void p_convert_l1b(Frame& F, int first  , int nstatic  ) {
    F.lane = lane_id();
    LAS float* scr = (LAS float*)(F.lds + F.wave * 16384);
    unsigned char* ws = F.ws; unsigned* q = (unsigned*)(ws + WS_CTL) + CW_CONVQ;
    constexpr int NITEMS = (DM / 64) * (DM / 32) + (DM / 64) * (FF / 32) + (FF / 64) * (DM / 32);
    int chunk = first, pos = 0, end = 0;
    tr_stream(scr, F.lane, [&]() -> int {
        if (pos >= end) {
            if (chunk < 0) { unsigned t = 0u; if (F.lane == 0) t = __hip_atomic_fetch_add(q, 1u, __ATOMIC_RELAXED, __HIP_MEMORY_SCOPE_AGENT);
                chunk = nstatic + __builtin_amdgcn_readfirstlane((int)t); }
            const int base = 8 * chunk; chunk = -1;
            if (base >= NITEMS) return -1;
            pos = base; end = base + 8 < NITEMS ? base + 8 : NITEMS; }
        return pos++; },
      [&](int it) -> TrDesc { int r = it;
        TD_JOB(F.h_out, DM, DM, DM, ws + W1_O, F.h_on, 1)
        TD_JOB(F.up + (size_t)DM * FF, FF, DM, FF, ws + W1_UP, F.norm_g + 6 * DM, 1)
        TD_JOB(F.dn + (size_t)FF * DM, DM, FF, DM, ws + W1_DN, nullptr, 1)
        return TrDesc{F.dn + (size_t)FF * DM, (void*)(ws + W1_DN), nullptr, DM, FF, DM, 1, 0}; });
}


namespace cg {
typedef short bf16x8 __attribute__((ext_vector_type(8)));
typedef float f32x16 __attribute__((ext_vector_type(16)));
typedef float f32x4c __attribute__((ext_vector_type(4)));
constexpr int L_PART = 0, L_H = 131072, HRS = 272;
static_assert(L_H + 32 * HRS <= LDS_BYTES - 256, "cg LDS map");
__device__ __forceinline__ float gelu_tanh_f(float x) { const float u = 0.7978845608028654f * (x + 0.044715f * x * x * x); const float e = __builtin_amdgcn_exp2f(2.8853900817779268f * u); return x * (1.f - __builtin_amdgcn_rcpf(e + 1.f)); }

__device__ __forceinline__ void cmp_gate_phase(LAS unsigned char* lds, unsigned char* wsb, int G, const int tid) {
    const int wid = __builtin_amdgcn_readfirstlane(tid >> 6), lane = tid & 63, r32 = lane & 31, hh = lane >> 5, li = lane & 15, kq = lane >> 4;
    const bf16* proj = (const bf16*)(wsb + WS_BIG); const bf16* w1t = (const bf16*)(wsb + W0_W1); const bf16* w2t = (const bf16*)(wsb + W0_W2); const float* bias1 = (const float*)(wsb + WS_BIAS1);
    const bf16* hn = (const bf16*)(wsb + WS_X16); const bf16* wg = (const bf16*)(wsb + W0_G); float* gates = (float*)(wsb + WS_GATES); const float* rinv = (const float*)(wsb + WS_RINV);
    for (int u = blockIdx.x; u < 256; u += G) {
        const int kv = u >> 7, R0 = (u & 127) * 32, b = R0 >> 9, g = (R0 >> 7) & 3, c0 = R0 & 127;
        const int ca = (c0 + li) < NC ? (c0 + li) : NC - 1, cb = (c0 + 16 + li) < NC ? (c0 + 16 + li) : NC - 1;
        const bf16* ar0 = proj + ((size_t)b * SEQ + 16 * ca + 4 * wid) * NQKV + (kv ? COL_VC : COL_KC) + g * HD + 8 * kq;
        const bf16* ar1 = proj + ((size_t)b * SEQ + 16 * cb + 4 * wid) * NQKV + (kv ? COL_VC : COL_KC) + g * HD + 8 * kq;
        const bf16* bcol = w1t + (size_t)kv * HD * 4096 + (size_t)li * 4096 + 512 * wid + 8 * kq;
        f32x4c acc[2][8];
#pragma unroll
        for (int rt = 0; rt < 2; ++rt)
#pragma unroll
            for (int ct = 0; ct < 8; ++ct) acc[rt][ct] = (f32x4c){0.f, 0.f, 0.f, 0.f};
        for (int bt = 0; bt < 8; ++bt) {
            bf16x8 av[2][2], bv[2][8];
#pragma unroll
            for (int st = 0; st < 2; ++st) { const int s = 2 * bt + st, tk = s >> 2, d0 = (s & 3) * 32;
                av[st][0] = *(const GAS bf16x8*)(ar0 + (size_t)tk * NQKV + d0); av[st][1] = *(const GAS bf16x8*)(ar1 + (size_t)tk * NQKV + d0);
#pragma unroll
                for (int ct = 0; ct < 8; ++ct) bv[st][ct] = *(const GAS bf16x8*)(bcol + (size_t)ct * 16 * 4096 + 32 * s); }
            __builtin_amdgcn_sched_barrier(0);
#pragma unroll
            for (int st = 0; st < 2; ++st)
#pragma unroll
                for (int ct = 0; ct < 8; ++ct)
#pragma unroll
                    for (int rt = 0; rt < 2; ++rt) acc[rt][ct] = __builtin_amdgcn_mfma_f32_16x16x32_bf16(av[st][rt], bv[st][ct], acc[rt][ct], 0, 0, 0); }
#pragma unroll
        for (int rt = 0; rt < 2; ++rt)
#pragma unroll
            for (int ct = 0; ct < 8; ++ct) { const int col = 16 * ct + li, ch = (4 * rt + kq) ^ (col & 7);
                *(LAS f32x4c*)(lds + L_PART + wid * 16384 + col * 128 + ch * 16) = acc[rt][ct]; }
        LDS_WAIT();
        __syncthreads();
        { const int col = tid >> 2, rg = tid & 3;
          f32x4c s0 = (f32x4c){0.f, 0.f, 0.f, 0.f}, s1 = s0;
#pragma unroll
          for (int w = 0; w < 8; ++w) { s0 += *(const LAS f32x4c*)(lds + L_PART + w * 16384 + col * 128 + ((2 * rg) ^ (col & 7)) * 16); s1 += *(const LAS f32x4c*)(lds + L_PART + w * 16384 + col * 128 + ((2 * rg + 1) ^ (col & 7)) * 16); }
          float bs = 0.f;
#pragma unroll
          for (int k8 = 0; k8 < 8; ++k8) bs += bias1[k8 * 256 + kv * HD + col];
#pragma unroll
          for (int e = 0; e < 4; ++e) { *(LAS unsigned short*)(lds + L_H + (8 * rg + e) * HRS + col * 2) = (unsigned short)f2bf(gelu_tanh_f(s0[e] + bs));
              *(LAS unsigned short*)(lds + L_H + (8 * rg + 4 + e) * HRS + col * 2) = (unsigned short)f2bf(gelu_tanh_f(s1[e] + bs)); } }
        LDS_WAIT();
        __syncthreads();
        if (wid < 4) { const int ct = wid; f32x16 o2 = f32x16{}; const bf16* b2 = w2t + (size_t)kv * HD * HD + (size_t)(32 * ct + r32) * HD;
#pragma unroll
            for (int ks = 0; ks < 8; ++ks) { const bf16x8 a = *(const LAS bf16x8*)(lds + L_H + r32 * HRS + (16 * ks + 8 * hh) * 2); const bf16x8 bb = *(const GAS bf16x8*)(b2 + 16 * ks + 8 * hh);
                o2 = __builtin_amdgcn_mfma_f32_32x32x16_bf16(a, bb, o2, 0, 0, 0); }
            bf16* outp = (bf16*)(wsb + (kv ? WS_VCMP : WS_KCMP)) + (size_t)R0 * HD + 32 * ct + r32;
#pragma unroll
            for (int r = 0; r < 16; ++r) { const int row = (r & 3) + 8 * (r >> 2) + 4 * hh; const bool pad = ((R0 + row) & 127) == NC;
                outp[(size_t)row * HD] = pad ? (bf16)0 : (bf16)f2bf(o2[r]); } }
        __syncthreads();
    }
    for (int u = blockIdx.x; u < M / 64; u += G) {
        const int m0 = 64 * u;
        const bf16* arow = hn + (size_t)(m0 + li) * DM + 256 * wid + 8 * kq; const bf16* brow = wg + (size_t)li * DM + 256 * wid + 8 * kq;
        f32x4c acc[4][4];
#pragma unroll
        for (int rt = 0; rt < 4; ++rt)
#pragma unroll
            for (int ct = 0; ct < 4; ++ct) acc[rt][ct] = (f32x4c){0.f, 0.f, 0.f, 0.f};
        for (int bt = 0; bt < 4; ++bt) {
            bf16x8 av[2][4], bv[2][4];
#pragma unroll
            for (int st = 0; st < 2; ++st)
#pragma unroll
                for (int t4 = 0; t4 < 4; ++t4) { av[st][t4] = *(const GAS bf16x8*)(arow + (size_t)t4 * 16 * DM + 32 * (2 * bt + st)); bv[st][t4] = *(const GAS bf16x8*)(brow + (size_t)t4 * 16 * DM + 32 * (2 * bt + st)); }
            __builtin_amdgcn_sched_barrier(0);
#pragma unroll
            for (int st = 0; st < 2; ++st)
#pragma unroll
                for (int ct = 0; ct < 4; ++ct)
#pragma unroll
                    for (int rt = 0; rt < 4; ++rt) acc[rt][ct] = __builtin_amdgcn_mfma_f32_16x16x32_bf16(av[st][rt], bv[st][ct], acc[rt][ct], 0, 0, 0); }
#pragma unroll
        for (int rt = 0; rt < 4; ++rt)
#pragma unroll
            for (int ct = 0; ct < 4; ++ct) { const int col = 16 * ct + li, ch = (4 * rt + kq) ^ (col & 15);
                *(LAS f32x4c*)(lds + L_PART + wid * 16384 + col * 256 + ch * 16) = acc[rt][ct]; }
        LDS_WAIT();
        __syncthreads();
        { const int row = tid >> 3, cg8 = tid & 7;
          if (cg8 < NGATE / 8) { float v[8];
#pragma unroll
              for (int e = 0; e < 8; ++e) { const int col = 8 * cg8 + e; float s = 0.f;
#pragma unroll
                  for (int w = 0; w < 8; ++w) s += *(const LAS float*)(lds + L_PART + w * 16384 + col * 256 + (((row >> 2) ^ (col & 15)) * 16) + (row & 3) * 4);
                  v[e] = s; }
              const float rv = rinv[m0 + row];
#pragma unroll
              for (int e = 0; e < 8; ++e) v[e] = __builtin_amdgcn_rcpf(1.f + __builtin_amdgcn_exp2f(v[e] * (rv * -1.4426950408889634f)));
              float* gp = gates + (size_t)(m0 + row) * NGATE + 8 * cg8;
              *(f32x4c*)gp = (f32x4c){v[0], v[1], v[2], v[3]}; *(f32x4c*)(gp + 4) = (f32x4c){v[4], v[5], v[6], v[7]}; } }
        __syncthreads();
    }
}
}


namespace nsa {
typedef short bf16x8 __attribute__((ext_vector_type(8)));
typedef short s16x4 __attribute__((ext_vector_type(4)));
typedef float f32x16 __attribute__((ext_vector_type(16)));
typedef unsigned u32x4 __attribute__((ext_vector_type(4)));
constexpr int SHM = 16384;
constexpr int NBUF = 3;
constexpr int L_V = 0, L_K = NBUF * SHM, L_WS = 2 * NBUF * SHM, L_LUT = L_WS + 2048, L_IMP = L_LUT + 8192, L_SEL = L_IMP + 4 * 64 * 33 * 4, L_END = L_SEL + 256;
static_assert(L_END <= LDS_BYTES - 256, "nsa LDS map");
constexpr float THR2 = 11.5f;
#define NSA_KSWZ(row, colB) ((row) * 256 + ((colB) ^ (((row) & 7) << 4)))
#define NSA_SBAR() __builtin_amdgcn_sched_barrier(0)
__device__ __forceinline__ int v_st(int k, int c) { const int kk = (k & ~0xC) | ((k & 4) << 1) | ((k & 8) >> 1); return ((kk >> 3) * 4 + (c >> 5)) * 512 + ((kk & 7) * 32 + (c & 31)) * 2; }
__device__ __forceinline__ int v_rd_base(int lane) { return ((lane & 3) << 3) | (((lane >> 2) & 3) << 6) | (((lane >> 4) & 1) << 5) | (((lane >> 5) & 1) << 8); }
constexpr int v_rd_off(int d0, int ks, int half) { return d0 * 512 + ks * 4096 + half * 2048; }
__device__ __forceinline__ int crow(int r, int hi) { return (r & 3) + 8 * (r >> 2) + 4 * hi; }
__device__ __forceinline__ unsigned cvtpk(float lo, float hi) { unsigned r; asm volatile("v_cvt_pk_bf16_f32 %0, %1, %2" : "=v"(r) : "v"(lo), "v"(hi)); return r; }

__device__ __forceinline__ void qkt(f32x16& p0, f32x16& p1, LAS unsigned char* Kb, int r32, int hi, const bf16x8 (&qr)[8]) {
    p0 = f32x16{}; p1 = f32x16{};
    LAS unsigned char* kb[4];
#pragma unroll
    for (int dd = 0; dd < 4; ++dd) kb[dd] = Kb + NSA_KSWZ(r32, (dd * 16 + hi * 8) * 2);
#pragma unroll
    for (int d0 = 0; d0 < 8; ++d0) { LAS unsigned char* a = kb[d0 & 3] + (d0 >> 2) * 128;
        const bf16x8 b0 = *(const LAS bf16x8*)a; const bf16x8 b1 = *(const LAS bf16x8*)(a + 32 * 256);
        p0 = __builtin_amdgcn_mfma_f32_32x32x16_bf16(b0, qr[d0], p0, 0, 0, 0);
        p1 = __builtin_amdgcn_mfma_f32_32x32x16_bf16(b1, qr[d0], p1, 0, 0, 0); }
}
__device__ __forceinline__ void pv_tile(f32x16 (&o)[4], int vb, bf16x8 pa0, bf16x8 pa1, bf16x8 pa2, bf16x8 pa3) {
#define NSA_TRRD(dst, off) asm volatile("ds_read_b64_tr_b16 %0, %1 offset:%2" : "=&v"(dst) : "v"(vb), "i"(off) : "memory")
#define NSA_PV_KS(ks, pa) do { s16x4 l0, l1, l2, l3, h0, h1, h2, h3; \
        NSA_TRRD(l0, v_rd_off(0, ks, 0)); NSA_TRRD(h0, v_rd_off(0, ks, 1)); NSA_TRRD(l1, v_rd_off(1, ks, 0)); NSA_TRRD(h1, v_rd_off(1, ks, 1)); \
        NSA_TRRD(l2, v_rd_off(2, ks, 0)); NSA_TRRD(h2, v_rd_off(2, ks, 1)); NSA_TRRD(l3, v_rd_off(3, ks, 0)); NSA_TRRD(h3, v_rd_off(3, ks, 1)); \
        asm volatile("s_waitcnt lgkmcnt(0)" ::: "memory"); NSA_SBAR(); \
        o[0] = __builtin_amdgcn_mfma_f32_32x32x16_bf16(pa, (bf16x8){l0[0], l0[1], l0[2], l0[3], h0[0], h0[1], h0[2], h0[3]}, o[0], 0, 0, 0); \
        o[1] = __builtin_amdgcn_mfma_f32_32x32x16_bf16(pa, (bf16x8){l1[0], l1[1], l1[2], l1[3], h1[0], h1[1], h1[2], h1[3]}, o[1], 0, 0, 0); \
        o[2] = __builtin_amdgcn_mfma_f32_32x32x16_bf16(pa, (bf16x8){l2[0], l2[1], l2[2], l2[3], h2[0], h2[1], h2[2], h2[3]}, o[2], 0, 0, 0); \
        o[3] = __builtin_amdgcn_mfma_f32_32x32x16_bf16(pa, (bf16x8){l3[0], l3[1], l3[2], l3[3], h3[0], h3[1], h3[2], h3[3]}, o[3], 0, 0, 0); } while (0)
    NSA_PV_KS(0, pa0); NSA_PV_KS(1, pa1); NSA_PV_KS(2, pa2); NSA_PV_KS(3, pa3);
#undef NSA_PV_KS
#undef NSA_TRRD
}
__device__ __forceinline__ void pack_p(const f32x16& p0, const f32x16& p1, bf16x8& pa0, bf16x8& pa1, bf16x8& pa2, bf16x8& pa3) {
#define NSA_PK4(P, B_, OUT) do { unsigned a0 = cvtpk(P[B_ + 0], P[B_ + 1]), a1 = cvtpk(P[B_ + 2], P[B_ + 3]); \
        unsigned b0 = cvtpk(P[B_ + 4], P[B_ + 5]), b1 = cvtpk(P[B_ + 6], P[B_ + 7]); \
        auto r0 = __builtin_amdgcn_permlane32_swap(a0, b0, false, false); auto r1 = __builtin_amdgcn_permlane32_swap(a1, b1, false, false); \
        u32x4 w = {r0[0], r1[0], r0[1], r1[1]}; OUT = *reinterpret_cast<bf16x8*>(&w); } while (0)
    NSA_PK4(p0, 0, pa0); NSA_PK4(p0, 8, pa1); NSA_PK4(p1, 0, pa2); NSA_PK4(p1, 8, pa3);
#undef NSA_PK4
}
__device__ __forceinline__ float swap_max(float v) { auto rr = __builtin_amdgcn_permlane32_swap(__float_as_uint(v), __float_as_uint(v), false, false); return fmaxf(__uint_as_float(rr[0]), __uint_as_float(rr[1])); }
__device__ __forceinline__ float swap_sum(float v) { auto rr = __builtin_amdgcn_permlane32_swap(__float_as_uint(v), __float_as_uint(v), false, false); return __uint_as_float(rr[0]) + __uint_as_float(rr[1]); }

template <class T> __device__ __forceinline__ const T* opaque_s(const T* p) { asm volatile("" : "+s"(p)); return p; }
__device__ __forceinline__ void tile_dma(LAS unsigned char* lds, int buf, const bf16* Kg, const bf16* Vg, int ld, int pk0, int pk1, int pv0, int pv1, int wid) {
    const char* kb = (const char*)Kg; const char* vb = (const char*)Vg;
    LAS unsigned char* kd = lds + L_K + buf * SHM + wid * 2048; LAS unsigned char* vd = lds + L_V + buf * SHM + wid * 2048;
    __builtin_amdgcn_global_load_lds((const unsigned*)(kb + (unsigned)(((pk0 >> 8) * ld + (pk0 & 255)) * 2)), (LAS unsigned*)kd, 16, 0, 0);
    __builtin_amdgcn_global_load_lds((const unsigned*)(kb + (unsigned)(((pk1 >> 8) * ld + (pk1 & 255)) * 2)), (LAS unsigned*)(kd + 1024), 16, 0, 0);
    __builtin_amdgcn_global_load_lds((const unsigned*)(vb + (unsigned)(((pv0 >> 8) * ld + (pv0 & 255)) * 2)), (LAS unsigned*)vd, 16, 0, 0);
    __builtin_amdgcn_global_load_lds((const unsigned*)(vb + (unsigned)(((pv1 >> 8) * ld + (pv1 & 255)) * 2)), (LAS unsigned*)(vd + 1024), 16, 0, 0);
}
__device__ __forceinline__ int k_piece(int P) { const int row = P >> 8, colB = (P & 255) ^ ((row & 7) << 4); return (row << 8) | (colB >> 1); }
__device__ __forceinline__ int v_piece(int P) { const int st = P >> 9, q = (P & 511) >> 1, kk = (st >> 2) * 8 + (q >> 5), c = (st & 3) * 32 + (q & 31);
    const int k = (kk & ~0xC) | ((kk & 4) << 1) | ((kk & 8) >> 1); return (k << 8) | c; }

__device__ __forceinline__ void nsa_phase(LAS unsigned char* lds, unsigned char* wsb, int G, const int tid) {
    const int wid = __builtin_amdgcn_readfirstlane(tid >> 6), lane = tid & 63, r32 = lane & 31, hi = lane >> 5;
    const int hr = wid >> 1, th = wid & 1;
    const bf16* proj = (const bf16*)(wsb + WS_BIG); const float* gates = (const float*)(wsb + WS_GATES);
    const bf16* kcmp = (const bf16*)(wsb + WS_KCMP); const bf16* vcmp = (const bf16*)(wsb + WS_VCMP); unsigned char* Oout = wsb + WS_A;
    float* scrl = (float*)(wsb + WS_SCR) + ((size_t)blockIdx.x * NWAVES + wid) * 4096 + lane * 64;
    LAS float* wsl = (LAS float*)(lds + L_WS) + wid * 64; LAS float* li_l = wsl; LAS float* al_l = wsl + 32;
    LAS float* lutL = (LAS float*)(lds + L_LUT); LAS float* impL = (LAS float*)(lds + L_IMP); LAS unsigned* selL = (LAS unsigned*)(lds + L_SEL);
    const int pk0 = k_piece(wid * 2048 + lane * 16), pk1 = k_piece(wid * 2048 + 1024 + lane * 16), pv0 = v_piece(wid * 2048 + lane * 16), pv1 = v_piece(wid * 2048 + 1024 + lane * 16);
    const int vb0 = (int)(unsigned)(uintptr_t)(lds + L_V) + v_rd_base(lane);
    const float NEG = -__builtin_inff();
    { const float* lut = (const float*)(wsb + WS_LUT); for (int i = tid; i < NH * 128; i += NTHREADS) lutL[i] = lut[i]; }
    __syncthreads();
    for (int ui = 0; ui < 4; ++ui) {
        const int c = blockIdx.x, bg = c & 31, j8 = (c >> 5) & 7;
        if (c >= 256 && G > 256) break;
        const unsigned long long qtab = (ui == 0) ? 0xfeebcf633dull : (ui == 1) ? 0x8ea74b49b7ull : (ui == 2) ? 0x719f062568ull : 0x110a009d43ull;
        const int qb = (int)((qtab >> (5 * j8)) & 31ull);
        const int b = bg >> 2, g = bg & 3, h = g * 4 + hr, t0 = 64 * qb, tq = t0 + 32 * th + r32;
        const size_t rowq = (size_t)b * SEQ + tq;
        const LAS float* lutp = lutL + h * 128; const float c31 = lutp[127];
        bf16x8 qr[8];
        { int hq = hi; asm volatile("" : "+v"(hq));
          const bf16* qp = proj + rowq * NQKV + h * HD + hq * 8;
#pragma unroll
          for (int d0 = 0; d0 < 8; ++d0) qr[d0] = *(const GAS bf16x8*)(qp + d0 * 16); }
        const float g_c = gates[rowq * NGATE + h], g_s = gates[rowq * NGATE + 16 + h], g_w = gates[rowq * NGATE + 32 + h];
        f32x16 o[4]; float cmp_carry = 0.f;
        {
            const bf16* kb = kcmp + (size_t)(b * NG + g) * NCP * HD; const bf16* vbp = vcmp + (size_t)(b * NG + g) * NCP * HD;
            const bool two = (t0 + 63 - 31) >= 16 * 64;
            tile_dma(lds, 0, opaque_s(kb), opaque_s(vbp), HD, pk0, pk1, pv0, pv1, wid);
            if (two) tile_dma(lds, 1, opaque_s(kb + 64 * HD), opaque_s(vbp + 64 * HD), HD, pk0, pk1, pv0, pv1, wid);
            VM_WAIT();
            __syncthreads();
            const int dqc = tq - 31 - 64 * hi;
            f32x16 sA0, sA1, sB0 = f32x16{}, sB1 = f32x16{};
            float tm = -1e30f;
            qkt(sA0, sA1, lds + L_K, r32, hi, qr);
#pragma unroll
            for (int r = 0; r < 16; ++r) { const int cc = (r & 3) + 8 * (r >> 2); const int d0 = dqc - 16 * cc, d1 = d0 - 512;
                sA0[r] = d0 >= 0 ? sA0[r] + lutp[d0 < 0 ? 0 : (d0 < 127 ? d0 : 127)] : NEG; sA1[r] = d1 >= 0 ? sA1[r] + lutp[d1 < 0 ? 0 : (d1 < 127 ? d1 : 127)] : NEG;
                tm = fmaxf(tm, fmaxf(sA0[r], sA1[r]));
                if ((r & 3) == 3) asm volatile("" ::: "memory"); }
            if (two) {
                qkt(sB0, sB1, lds + L_K + SHM, r32, hi, qr);
#pragma unroll
                for (int r = 0; r < 16; ++r) { const int cc = (r & 3) + 8 * (r >> 2); const int d0 = dqc - 1024 - 16 * cc, d1 = d0 - 512;
                    sB0[r] = d0 >= 0 ? sB0[r] + lutp[d0 < 0 ? 0 : (d0 < 127 ? d0 : 127)] : NEG; sB1[r] = d1 >= 0 ? sB1[r] + lutp[d1 < 0 ? 0 : (d1 < 127 ? d1 : 127)] : NEG;
                    tm = fmaxf(tm, fmaxf(sB0[r], sB1[r]));
                    if ((r & 3) == 3) asm volatile("" ::: "memory"); }
            }
            const float mx = swap_max(tm);
            float ps = 0.f;
#pragma unroll
            for (int r = 0; r < 16; ++r) { sA0[r] = __builtin_amdgcn_exp2f(sA0[r] - mx); sA1[r] = __builtin_amdgcn_exp2f(sA1[r] - mx); ps += sA0[r] + sA1[r]; }
            if (two) {
#pragma unroll
                for (int r = 0; r < 16; ++r) { sB0[r] = __builtin_amdgcn_exp2f(sB0[r] - mx); sB1[r] = __builtin_amdgcn_exp2f(sB1[r] - mx); ps += sB0[r] + sB1[r]; }
            }
            const float ls = swap_sum(ps);
            const float inv = ls > 0.f ? 1.f / ls : 0.f;
            LAS float* ip = impL + (hr * 64 + 32 * th + r32) * 33;
#pragma unroll
            for (int d = 0; d < 4; ++d) o[d] = f32x16{};
            if (!two) {
#pragma unroll
                for (int q = 0; q < 16; ++q) ip[16 + q] = 0.f;
            }
            auto imp_pv = [&](f32x16& p0, f32x16& p1, const int T) {
                p0 = p0 * inv; p1 = p1 * inv;
                LAS float* ipt = ip + 16 * T;
#pragma unroll
                for (int q = 0; q < 4; ++q) {
                    ipt[0 + 2 * q + hi] = (p0[4 * q] + p0[4 * q + 1]) + (p0[4 * q + 2] + p0[4 * q + 3]);
                    ipt[8 + 2 * q + hi] = (p1[4 * q] + p1[4 * q + 1]) + (p1[4 * q + 2] + p1[4 * q + 3]); }
                LDS_WAIT(); asm volatile("" ::: "memory");
#pragma unroll
                for (int q = 0; q < 4; ++q) {
                    ipt[0 + 2 * q + hi + 1] += p0[4 * q + 3];
                    if (8 + 2 * q + hi + 1 < 16) ipt[8 + 2 * q + hi + 1] += p1[4 * q + 3]; }
                const float carry = p1[15];
                LDS_WAIT(); asm volatile("" ::: "memory");
                bf16x8 pa0, pa1, pa2, pa3;
                pack_p(p0, p1, pa0, pa1, pa2, pa3); pv_tile(o, vb0 + T * SHM, pa0, pa1, pa2, pa3);
                if (T == 0) cmp_carry = carry;
            };
            imp_pv(sA0, sA1, 0);
            if (two) imp_pv(sB0, sB1, 1);
            if (hi == 1) ip[16] += cmp_carry;
            LDS_WAIT(); asm volatile("" ::: "memory");
            if (hi == 0) li_l[r32] = g_c;
            LDS_WAIT(); asm volatile("" ::: "memory");
            { float gg[16];
#pragma unroll
              for (int r = 0; r < 16; ++r) gg[r] = li_l[crow(r, hi)];
#pragma unroll
              for (int d = 0; d < 4; ++d)
#pragma unroll
                  for (int q = 0; q < 4; ++q) *(GAS f32x4*)(scrl + d * 16 + 4 * q) = (f32x4){o[d][4 * q] * gg[4 * q], o[d][4 * q + 1] * gg[4 * q + 1], o[d][4 * q + 2] * gg[4 * q + 2], o[d][4 * q + 3] * gg[4 * q + 3]}; }
            LDS_WAIT();
            __builtin_amdgcn_s_barrier(); asm volatile("" ::: "memory");
        }
        {
#pragma unroll
            for (int i = 0; i < 4; ++i) { const int tl = 8 * wid + 2 * i + hi, n = r32;
                float v = ((impL[(0 * 64 + tl) * 33 + n] + impL[(1 * 64 + tl) * 33 + n]) + impL[(2 * 64 + tl) * 33 + n]) + impL[(3 * 64 + tl) * 33 + n];
                int key = (int)((__float_as_uint(v) & ~31u) | (unsigned)(31 - n));
                if (n == 0 || n == qb || n == qb - 1) key = (int)(0x461C4000u | (unsigned)(31 - n)); else if (n > qb) key = -64 + (31 - n);
                int cnt = 0;
                for (int mm = 0; mm < 32; ++mm) { const int u = __shfl(key, (lane & 32) | mm); cnt += (u > key) ? 1 : 0; }
                const unsigned long long bal = __ballot(cnt < 8);
                if (lane == 0) { selL[8 * wid + 2 * i] = (unsigned)bal; selL[8 * wid + 2 * i + 1] = (unsigned)(bal >> 32); } }
            LDS_WAIT();
            __builtin_amdgcn_s_barrier(); asm volatile("" ::: "memory");
        }
        const unsigned selw = selL[32 * th + r32];
        const int NS = qb + 1, nlo = qb >= 8 ? qb - 8 : 0, NT = NS + (qb - nlo + 1);
        float m_reg = -1e30f, l_reg = 0.f;
#pragma unroll
        for (int d = 0; d < 4; ++d) o[d] = f32x16{};
        const bf16* kS = proj + (size_t)b * SEQ * NQKV + COL_KS + g * HD; const bf16* vS = proj + (size_t)b * SEQ * NQKV + COL_VS + g * HD;
        const bf16* kW = proj + (size_t)b * SEQ * NQKV + COL_KW + g * HD; const bf16* vW = proj + (size_t)b * SEQ * NQKV + COL_VW + g * HD;
#define NSA_TILE_K(t_) (((t_) >= NS ? kW : kS) + (size_t)(64 * ((t_) >= NS ? nlo + ((t_) - NS) : (t_))) * NQKV)
#define NSA_TILE_V(t_) (((t_) >= NS ? vW : vS) + (size_t)(64 * ((t_) >= NS ? nlo + ((t_) - NS) : (t_))) * NQKV)
        tile_dma(lds, 0, opaque_s(kS), opaque_s(vS), NQKV, pk0, pk1, pv0, pv1, wid);
        if (1 < NT) { tile_dma(lds, 1, opaque_s(NSA_TILE_K(1)), opaque_s(NSA_TILE_V(1)), NQKV, pk0, pk1, pv0, pv1, wid); asm volatile("s_waitcnt vmcnt(4)" ::: "memory"); } else VM_WAIT();
        LDS_WAIT(); __builtin_amdgcn_s_barrier(); asm volatile("" ::: "memory");
        int buf = 0;
        for (int i = 0; i < NT; ++i) {
            const bool win = i >= NS; const int n = win ? nlo + (i - NS) : i;
            if (i == NS) {
                if (hi == 0) li_l[r32] = g_s / l_reg;
                LDS_WAIT(); asm volatile("" ::: "memory");
                { float gg[16];
#pragma unroll
                  for (int r = 0; r < 16; ++r) gg[r] = li_l[crow(r, hi)];
#pragma unroll
                  for (int d = 0; d < 4; ++d)
                  {
                    f32x4 a4[4];
#pragma unroll
                    for (int q = 0; q < 4; ++q) a4[q] = *(const GAS f32x4*)(scrl + d * 16 + 4 * q);
#pragma unroll
                    for (int q = 0; q < 4; ++q) { const f32x4 a = a4[q];
                          *(GAS f32x4*)(scrl + d * 16 + 4 * q) = (f32x4){a.x + o[d][4 * q] * gg[4 * q], a.y + o[d][4 * q + 1] * gg[4 * q + 1], a.z + o[d][4 * q + 2] * gg[4 * q + 2], a.w + o[d][4 * q + 3] * gg[4 * q + 3]}; }
                    asm volatile("" ::: "memory"); }
#pragma unroll
                  for (int d = 0; d < 4; ++d) o[d] = f32x16{}; }
                LDS_WAIT(); m_reg = -1e30f; l_reg = 0.f;
            }
            if (i + 2 < NT) { const int b2 = buf + 2 >= NBUF ? buf + 2 - NBUF : buf + 2;
                tile_dma(lds, b2, opaque_s(NSA_TILE_K(i + 2)), opaque_s(NSA_TILE_V(i + 2)), NQKV, pk0, pk1, pv0, pv1, wid); }
            f32x16 p0, p1;
            qkt(p0, p1, lds + L_K + buf * SHM, r32, hi, qr);
            const bool plain = (n + 2 < qb) && !(win && n + 8 == qb);
            float bofs = 0.f;
            { const int dq = tq - 64 * n - 4 * hi; const unsigned W = win ? 512u : 0x80000000u; const bool ok = win || ((selw >> n) & 1u);
              if (plain) bofs = ok ? c31 : NEG;
              else if (n + 2 >= qb) {
#pragma unroll
                  for (int r = 0; r < 16; ++r) { const int cc = (r & 3) + 8 * (r >> 2); const int d0 = dq - cc, d1 = d0 - 32;
                      const float b0 = lutp[d0 < 0 ? 0 : (d0 < 127 ? d0 : 127)], b1 = lutp[d1 < 0 ? 0 : (d1 < 127 ? d1 : 127)];
                      p0[r] = (ok && (unsigned)d0 < W) ? p0[r] + b0 : NEG; p1[r] = (ok && (unsigned)d1 < W) ? p1[r] + b1 : NEG;
                      if ((r & 3) == 3) asm volatile("" ::: "memory"); }
              } else {
#pragma unroll
                  for (int r = 0; r < 16; ++r) { const int cc = (r & 3) + 8 * (r >> 2); const int d0 = dq - cc, d1 = d0 - 32;
                      p0[r] = (ok && (unsigned)d0 < W) ? p0[r] + c31 : NEG; p1[r] = (ok && (unsigned)d1 < W) ? p1[r] + c31 : NEG; }
              } }
            float pmax = p0[0];
#pragma unroll
            for (int r = 1; r < 16; ++r) pmax = fmaxf(pmax, p0[r]);
#pragma unroll
            for (int r = 0; r < 16; ++r) pmax = fmaxf(pmax, p1[r]);
            pmax = swap_max(pmax) + bofs;
            float mn, alpha;
            if (__all((pmax - m_reg) <= THR2)) { mn = m_reg; alpha = 1.f; }
            else { mn = fmaxf(m_reg, pmax); alpha = __builtin_amdgcn_exp2f(m_reg - mn); m_reg = mn; }
            mn -= bofs;
            float ps = 0.f;
#pragma unroll
            for (int r = 0; r < 16; ++r) { p0[r] = __builtin_amdgcn_exp2f(p0[r] - mn); p1[r] = __builtin_amdgcn_exp2f(p1[r] - mn); ps += p0[r] + p1[r]; }
            ps = swap_sum(ps);
            l_reg = l_reg * alpha + ps;
            if (__any(alpha < 1.f)) { if (hi == 0) al_l[r32] = alpha; LDS_WAIT(); asm volatile("" ::: "memory");
#pragma unroll
                for (int r = 0; r < 16; ++r) { const float aa = al_l[crow(r, hi)];
#pragma unroll
                    for (int d = 0; d < 4; ++d) o[d][r] *= aa; }
                LDS_WAIT(); }
            bf16x8 pa0, pa1, pa2, pa3;
            pack_p(p0, p1, pa0, pa1, pa2, pa3);
            pv_tile(o, vb0 + buf * SHM, pa0, pa1, pa2, pa3);
            if (i + 2 < NT) asm volatile("s_waitcnt vmcnt(4)" ::: "memory"); else VM_WAIT();
            LDS_WAIT();
            __builtin_amdgcn_s_barrier(); asm volatile("" ::: "memory");
            buf = buf + 1 >= NBUF ? 0 : buf + 1;
        }
#undef NSA_TILE_K
#undef NSA_TILE_V
        if (hi == 0) li_l[r32] = g_w / l_reg;
        LDS_WAIT(); asm volatile("" ::: "memory");
        {
            LAS unsigned char* ost = lds + wid * 8192;
            LAS unsigned char* owr = ost + (4 * hi) * 256 + r32;
            float gg[16];
#pragma unroll
            for (int r = 0; r < 16; ++r) gg[r] = li_l[crow(r, hi)];
#pragma unroll
            for (int d = 0; d < 4; ++d) { f32x4 a4[4];
#pragma unroll
                for (int q = 0; q < 4; ++q) a4[q] = *(const GAS f32x4*)(scrl + d * 16 + 4 * q);
#pragma unroll
                for (int q = 0; q < 4; ++q)
#pragma unroll
                    for (int e = 0; e < 4; ++e) { const int r = 4 * q + e; const float v = a4[q][e] + o[d][r] * gg[r];
                        *(LAS unsigned char*)(owr + ((r & 3) + 8 * (r >> 2)) * 256 + d * 32) = (unsigned char)__builtin_amdgcn_cvt_pk_fp8_f32(__builtin_amdgcn_fmed3f(v * N8SCALE, -448.f, 448.f), 0.f, 0, false); }
                asm volatile("" ::: "memory"); }
            LDS_WAIT(); asm volatile("" ::: "memory");
            int ln = lane; asm volatile("" : "+v"(ln));
            unsigned char* Ow = Oout + ((size_t)b * SEQ + t0 + 32 * th + (ln >> 3)) * DM + h * HD + (ln & 7) * 16;
            const LAS unsigned char* ord = ost + (ln >> 3) * 256 + (ln & 7) * 16;
#pragma unroll
            for (int i = 0; i < 4; ++i) *(GAS v4u*)(Ow + (size_t)(8 * i) * DM) = *(const LAS v4u*)(ord + i * 2048);
        }
        LDS_WAIT();
        __builtin_amdgcn_s_barrier(); asm volatile("" ::: "memory");
    }
}
#undef NSA_KSWZ
#undef NSA_SBAR
}


namespace hg {
typedef short bf16x8 __attribute__((ext_vector_type(8)));
typedef short s16x4 __attribute__((ext_vector_type(4)));
typedef float f32x4v __attribute__((ext_vector_type(4)));
typedef float f32x2v __attribute__((ext_vector_type(2)));
constexpr int RS = 288, RSA = 144;
constexpr int BUFB = 3 * 64 * RS;
constexpr int L_Q = 0, L_K = 64 * RS, L_V = 2 * 64 * RS, L_AM = 2 * BUFB, L_O = L_AM + 64 * RSA, L_EBL = L_O + 64 * RS, L_ON = L_EBL + 1024, L_END = L_ON + 512;
static_assert(L_END <= LDS_BYTES - 256, "hg LDS map");
#define HG_C8(x) __builtin_amdgcn_fmed3f((x), -448.f, 448.f)
#define HG_TR(dst, addr, off) asm volatile("ds_read_b64_tr_b16 %0, %1 offset:%2" : "=&v"(dst) : "v"(addr), "i"(off) : "memory")
#define HG_BAR() do { asm volatile("s_waitcnt lgkmcnt(0)" ::: "memory"); __builtin_amdgcn_s_barrier(); asm volatile("" ::: "memory"); } while (0)
__device__ __forceinline__ unsigned cvtpk(float lo, float hi) { unsigned r; asm volatile("v_cvt_pk_bf16_f32 %0, %1, %2" : "=v"(r) : "v"(lo), "v"(hi)); return r; }

__device__ __forceinline__ void scan_phase(LAS unsigned char* lds, unsigned char* wsb, const float* h_on, int G, const int tid) {
    const int wid = __builtin_amdgcn_readfirstlane(tid >> 6), lane = tid & 63, li = lane & 15, g = lane >> 4;
    const bool prod = wid >= 4; const int rw = wid & 3, ptid = rw * 64 + lane;
    const bf16* proj = (const bf16*)(wsb + WS_BIG); unsigned char* Oout = wsb + WS_A;
    const float L2E = 1.4426950408889634f;
    const int kp = lane & 7, tg = lane >> 3;
    for (int u = blockIdx.x; u < BATCH * NH; u += G) {
        const int b = u >> 4, h = u & 15;
        (void)h_on;
#define HG_LOAD(c_, QW, FW, VW) do { const size_t r0_ = (size_t)b * SEQ + 64 * (c_); \
        _Pragma("unroll") for (int c2 = 0; c2 < 2; ++c2) _Pragma("unroll") for (int i = 0; i < 8; ++i) { const size_t r = r0_ + 8 * tg + i; const int ch_ = h * HD + 32 * rw + 16 * c2 + 2 * kp; \
            QW[c2][i] = *(const GAS unsigned*)(proj + r * FF + ch_); FW[c2][i] = *(const GAS unsigned*)(proj + r * FF + 2048 + ch_); } \
        _Pragma("unroll") for (int j = 0; j < 4; ++j) { const int ci = ptid + 256 * j; VW[j] = *(const GAS v4u*)(proj + (r0_ + (ci >> 4)) * FF + 4096 + h * HD + 8 * (ci & 15)); } } while (0)
#define HG_PREP(pb, QW, FW, VW) do { LAS unsigned char* B_ = lds + (pb) * BUFB; \
        _Pragma("unroll") for (int c2 = 0; c2 < 2; ++c2) { const int chl_ = 32 * rw + 16 * c2 + 2 * kp; float bl0[8], bl1[8]; float c0 = 0.f, c1 = 0.f; \
            _Pragma("unroll") for (int i = 0; i < 8; ++i) { c0 += bflo(FW[c2][i]); c1 += bfhi(FW[c2][i]); bl0[i] = c0; bl1[i] = c1; } \
            float i0 = c0, i1 = c1; \
            _Pragma("unroll") for (int d = 8; d < 64; d <<= 1) { const float x0 = __shfl_up(i0, d), x1 = __shfl_up(i1, d); if (lane >= d) { i0 += x0; i1 += x1; } } \
            const float p0 = i0 - c0, p1 = i1 - c1; \
            if (tg == 7) *(LAS f32x2v*)(lds + L_EBL + (pb) * 512 + chl_ * 4) = (f32x2v){__builtin_amdgcn_exp2f(i0 * L2E), __builtin_amdgcn_exp2f(i1 * L2E)}; \
            float ep0 = 0.f, ep1 = 0.f;        \
            _Pragma("unroll") for (int i = 0; i < 8; ++i) { const float b0 = (p0 + bl0[i]) * L2E, b1 = (p1 + bl1[i]) * L2E; \
                const float f0 = __builtin_amdgcn_exp2f(bflo(FW[c2][i]) * L2E), f1 = __builtin_amdgcn_exp2f(bfhi(FW[c2][i]) * L2E); \
                const float e0 = (i == 0) ? __builtin_amdgcn_exp2f(b0) : ep0 * f0, e1 = (i == 0) ? __builtin_amdgcn_exp2f(b1) : ep1 * f1, n0 = __builtin_amdgcn_exp2f(-b0), n1 = __builtin_amdgcn_exp2f(-b1); \
                ep0 = e0; ep1 = e1; \
                const float k0 = 1.f - f0, k1 = 1.f - f1; \
                const int t = 8 * tg + i; \
                *(LAS unsigned*)(B_ + L_Q + t * RS + ((chl_ * 2) ^ (64 * (tg >> 1)))) = cvtpk(bflo(QW[c2][i]) * e0, bfhi(QW[c2][i]) * e1);     \
                *(LAS unsigned*)(B_ + L_K + t * RS + chl_ * 2) = cvtpk(k0 * n0, k1 * n1); } } \
        _Pragma("unroll") for (int j = 0; j < 4; ++j) { const int ci = ptid + 256 * j; *(LAS v4u*)(B_ + L_V + (ci >> 4) * RS + (ci & 15) * 16) = VW[j]; } } while (0)
        if (prod) {
            int lane_o = lane; asm volatile("" : "+v"(lane_o));
            const int lane = lane_o, kp = lane & 7, tg = lane >> 3, ptid = rw * 64 + lane;
            unsigned qwA[2][8], fwA[2][8], qwB[2][8], fwB[2][8]; v4u vwA[4], vwB[4], gwA[4], gwB[4];
#pragma unroll
            for (int j = 0; j < 4; ++j) { gwA[j] = (v4u){0u, 0u, 0u, 0u}; gwB[j] = (v4u){0u, 0u, 0u, 0u}; }
#define HG_GATES(c_, GW) do { const int t_ = ptid >> 2, vq_ = ptid & 3; const size_t r_ = (size_t)b * SEQ + 64 * (c_) + t_; \
            _Pragma("unroll") for (int j = 0; j < 4; ++j) GW[j] = *(const GAS v4u*)(proj + r_ * FF + 6144 + h * HD + 32 * vq_ + 8 * j); } while (0)
            HG_LOAD(0, qwA, fwA, vwA); HG_PREP(0, qwA, fwA, vwA); HG_LOAD(1, qwB, fwB, vwB); HG_LOAD(2, qwA, fwA, vwA); HG_GATES(0, gwA);
            HG_BAR();
            for (int c = 0; c < SEQ / 64; c += 2) {
                { const size_t row0 = (size_t)b * SEQ + 64 * c;
                if (c > 0) {
                    const int t = ptid >> 2, vq = ptid & 3; const size_t r = row0 - 64 + t;
                    float ov[32]; float ss = 0.f;
#pragma unroll
                    for (int j = 0; j < 4; ++j) { const v4u w = *(const LAS v4u*)(lds + L_O + t * RS + vq * 64 + j * 16);
                        ov[8 * j + 0] = bflo(w.x); ov[8 * j + 1] = bfhi(w.x); ov[8 * j + 2] = bflo(w.y); ov[8 * j + 3] = bfhi(w.y); ov[8 * j + 4] = bflo(w.z); ov[8 * j + 5] = bfhi(w.z); ov[8 * j + 6] = bflo(w.w); ov[8 * j + 7] = bfhi(w.w); }
#pragma unroll
                    for (int j = 0; j < 32; ++j) ss += ov[j] * ov[j];
                    ss += __shfl_xor(ss, 1); ss += __shfl_xor(ss, 2);
                    const float rinv = A8SCALE * __builtin_amdgcn_rsqf(ss * (1.f / 128.f) + RMS_EPS);
                    unsigned char* op = Oout + r * DM + h * HD + 32 * vq; unsigned w8[4];
#pragma unroll
                    for (int j = 0; j < 4; ++j) { const v4u gq = gwB[j];
                        w8[2 * (j & 1)] = pk8(HG_C8(ov[8 * j + 0] * rinv * bflo(gq.x)), HG_C8(ov[8 * j + 1] * rinv * bfhi(gq.x)), HG_C8(ov[8 * j + 2] * rinv * bflo(gq.y)), HG_C8(ov[8 * j + 3] * rinv * bfhi(gq.y)));
                        w8[2 * (j & 1) + 1] = pk8(HG_C8(ov[8 * j + 4] * rinv * bflo(gq.z)), HG_C8(ov[8 * j + 5] * rinv * bfhi(gq.z)), HG_C8(ov[8 * j + 6] * rinv * bflo(gq.w)), HG_C8(ov[8 * j + 7] * rinv * bfhi(gq.w)));
                        if (j & 1) *(GAS v4u*)(op + 16 * (j >> 1)) = (v4u){w8[0], w8[1], w8[2], w8[3]}; }
                }
                  HG_GATES(c + 1, gwB); }
                HG_BAR();
                HG_PREP(1, qwB, fwB, vwB); if (c + 3 < SEQ / 64) HG_LOAD(c + 3, qwB, fwB, vwB);
                HG_BAR();
                { const int c = 0; (void)c; }
                { const size_t row0 = (size_t)b * SEQ + 64 * (c + 1); const int c_ = c + 1;
                if (c_ > 0) {
                    const int t = ptid >> 2, vq = ptid & 3; const size_t r = row0 - 64 + t;
                    float ov[32]; float ss = 0.f;
#pragma unroll
                    for (int j = 0; j < 4; ++j) { const v4u w = *(const LAS v4u*)(lds + L_O + t * RS + vq * 64 + j * 16);
                        ov[8 * j + 0] = bflo(w.x); ov[8 * j + 1] = bfhi(w.x); ov[8 * j + 2] = bflo(w.y); ov[8 * j + 3] = bfhi(w.y); ov[8 * j + 4] = bflo(w.z); ov[8 * j + 5] = bfhi(w.z); ov[8 * j + 6] = bflo(w.w); ov[8 * j + 7] = bfhi(w.w); }
#pragma unroll
                    for (int j = 0; j < 32; ++j) ss += ov[j] * ov[j];
                    ss += __shfl_xor(ss, 1); ss += __shfl_xor(ss, 2);
                    const float rinv = A8SCALE * __builtin_amdgcn_rsqf(ss * (1.f / 128.f) + RMS_EPS);
                    unsigned char* op = Oout + r * DM + h * HD + 32 * vq; unsigned w8[4];
#pragma unroll
                    for (int j = 0; j < 4; ++j) { const v4u gq = gwA[j];
                        w8[2 * (j & 1)] = pk8(HG_C8(ov[8 * j + 0] * rinv * bflo(gq.x)), HG_C8(ov[8 * j + 1] * rinv * bfhi(gq.x)), HG_C8(ov[8 * j + 2] * rinv * bflo(gq.y)), HG_C8(ov[8 * j + 3] * rinv * bfhi(gq.y)));
                        w8[2 * (j & 1) + 1] = pk8(HG_C8(ov[8 * j + 4] * rinv * bflo(gq.z)), HG_C8(ov[8 * j + 5] * rinv * bfhi(gq.z)), HG_C8(ov[8 * j + 6] * rinv * bflo(gq.w)), HG_C8(ov[8 * j + 7] * rinv * bfhi(gq.w)));
                        if (j & 1) *(GAS v4u*)(op + 16 * (j >> 1)) = (v4u){w8[0], w8[1], w8[2], w8[3]}; }
                }
                  if (c + 2 < SEQ / 64) HG_GATES(c + 2, gwA); }
                HG_BAR();
                if (c + 2 < SEQ / 64) { HG_PREP(0, qwA, fwA, vwA); if (c + 4 < SEQ / 64) HG_LOAD(c + 4, qwA, fwA, vwA); }
                HG_BAR();
            }
            {
            const int t = ptid >> 2, vq = ptid & 3; const size_t r = (size_t)b * SEQ + SEQ - 64 + t;
            float ov[32]; float ss = 0.f;
#pragma unroll
            for (int j = 0; j < 4; ++j) { const v4u w = *(const LAS v4u*)(lds + L_O + t * RS + vq * 64 + j * 16);
                ov[8 * j + 0] = bflo(w.x); ov[8 * j + 1] = bfhi(w.x); ov[8 * j + 2] = bflo(w.y); ov[8 * j + 3] = bfhi(w.y); ov[8 * j + 4] = bflo(w.z); ov[8 * j + 5] = bfhi(w.z); ov[8 * j + 6] = bflo(w.w); ov[8 * j + 7] = bfhi(w.w); }
#pragma unroll
            for (int j = 0; j < 32; ++j) ss += ov[j] * ov[j];
            ss += __shfl_xor(ss, 1); ss += __shfl_xor(ss, 2);
            const float rinv = A8SCALE * __builtin_amdgcn_rsqf(ss * (1.f / 128.f) + RMS_EPS);
            unsigned char* op = Oout + r * DM + h * HD + 32 * vq; unsigned w8[4];
#pragma unroll
            for (int j = 0; j < 4; ++j) { const v4u gq = gwB[j];
                w8[2 * (j & 1)] = pk8(HG_C8(ov[8 * j + 0] * rinv * bflo(gq.x)), HG_C8(ov[8 * j + 1] * rinv * bfhi(gq.x)), HG_C8(ov[8 * j + 2] * rinv * bflo(gq.y)), HG_C8(ov[8 * j + 3] * rinv * bfhi(gq.y)));
                w8[2 * (j & 1) + 1] = pk8(HG_C8(ov[8 * j + 4] * rinv * bflo(gq.z)), HG_C8(ov[8 * j + 5] * rinv * bfhi(gq.z)), HG_C8(ov[8 * j + 6] * rinv * bflo(gq.w)), HG_C8(ov[8 * j + 7] * rinv * bfhi(gq.w)));
                if (j & 1) *(GAS v4u*)(op + 16 * (j >> 1)) = (v4u){w8[0], w8[1], w8[2], w8[3]}; }
            }
#undef HG_GATES
        } else {
            int lane_o = lane; asm volatile("" : "+v"(lane_o));
            const int li = lane_o & 15, g = lane_o >> 4;
            f32x4v S[8][2];
#pragma unroll
            for (int m = 0; m < 8; ++m) { S[m][0] = (f32x4v){0.f, 0.f, 0.f, 0.f}; S[m][1] = (f32x4v){0.f, 0.f, 0.f, 0.f}; }
            HG_BAR();
            for (int c = 0; c < SEQ / 64; ++c) {
                const int cb = c & 1;
                LAS unsigned char* CB = lds + cb * BUFB;
                {
                const int mt = rw;
                f32x4v acc[4];
#pragma unroll
                for (int nt = 0; nt < 4; ++nt) acc[nt] = (f32x4v){0.f, 0.f, 0.f, 0.f};
#pragma unroll
                for (int ks = 0; ks < 4; ++ks) { const bf16x8 a = *(const LAS bf16x8*)(CB + L_Q + (16 * mt + li) * RS + 64 * (ks ^ mt) + 16 * g);
#pragma unroll
                    for (int nt = 0; nt < 4; ++nt) { const bf16x8 bb = *(const LAS bf16x8*)(CB + L_K + (16 * nt + li) * RS + (32 * ks + 8 * g) * 2);
                        acc[nt] = __builtin_amdgcn_mfma_f32_16x16x32_bf16(bb, a, acc[nt], 0, 0, 0); } }
#pragma unroll
                for (int nt = 0; nt < 4; ++nt) { const int t = 16 * mt + li, s0 = 16 * nt + 4 * g;
                    const float v0 = (s0 + 0 <= t) ? acc[nt][0] : 0.f, v1 = (s0 + 1 <= t) ? acc[nt][1] : 0.f, v2 = (s0 + 2 <= t) ? acc[nt][2] : 0.f, v3 = (s0 + 3 <= t) ? acc[nt][3] : 0.f;
                    *(LAS v2u*)(lds + L_AM + t * RSA + s0 * 2) = (v2u){cvtpk(v0, v1), cvtpk(v2, v3)}; }
                }
                HG_BAR();
                {
                f32x4v o[4][2];
#pragma unroll
                for (int m = 0; m < 4; ++m) { o[m][0] = (f32x4v){0.f, 0.f, 0.f, 0.f}; o[m][1] = (f32x4v){0.f, 0.f, 0.f, 0.f}; }
#pragma unroll
                for (int ks = 0; ks < 4; ++ks) { bf16x8 bs[2];
#pragma unroll
                    for (int n = 0; n < 2; ++n) { v4u bw; bw.x = cvtpk(S[2 * ks][n][0], S[2 * ks][n][1]); bw.y = cvtpk(S[2 * ks][n][2], S[2 * ks][n][3]); bw.z = cvtpk(S[2 * ks + 1][n][0], S[2 * ks + 1][n][1]); bw.w = cvtpk(S[2 * ks + 1][n][2], S[2 * ks + 1][n][3]);
                        bs[n] = *reinterpret_cast<bf16x8*>(&bw); }
#pragma unroll
                    for (int m = 0; m < 4; ++m) { const LAS unsigned char* qa = CB + L_Q + (16 * m + li) * RS + 64 * (ks ^ m) + 8 * g;
                        const v2u lo = *(const LAS v2u*)qa, hi2 = *(const LAS v2u*)(qa + 32); v4u aw; aw.x = lo.x; aw.y = lo.y; aw.z = hi2.x; aw.w = hi2.y;
                        const bf16x8 av = *reinterpret_cast<bf16x8*>(&aw);
                        o[m][0] = __builtin_amdgcn_mfma_f32_16x16x32_bf16(bs[0], av, o[m][0], 0, 0, 0);
                        o[m][1] = __builtin_amdgcn_mfma_f32_16x16x32_bf16(bs[1], av, o[m][1], 0, 0, 0); } }
                bf16x8 bv[2][2];
#pragma unroll
                for (int n = 0; n < 2; ++n) {
                    const int va = (int)(unsigned)(uintptr_t)(CB + L_V) + (8 * g + (li >> 2)) * RS + (16 * (2 * rw + n) + 4 * (li & 3)) * 2;
                    s16x4 a0, a1, a2, a3; HG_TR(a0, va, 0); HG_TR(a1, va, 4 * RS); HG_TR(a2, va, 32 * RS); HG_TR(a3, va, 36 * RS);
                    asm volatile("s_waitcnt lgkmcnt(0)" ::: "memory"); __builtin_amdgcn_sched_barrier(0);
                    bv[n][0] = (bf16x8){a0[0], a0[1], a0[2], a0[3], a1[0], a1[1], a1[2], a1[3]}; bv[n][1] = (bf16x8){a2[0], a2[1], a2[2], a2[3], a3[0], a3[1], a3[2], a3[3]}; }
#pragma unroll
                for (int ks = 0; ks < 2; ++ks)
#pragma unroll
                    for (int m = 0; m < 4; ++m) { const bf16x8 a = *(const LAS bf16x8*)(lds + L_AM + (16 * m + li) * RSA + (32 * ks + 8 * g) * 2);
                        o[m][0] = __builtin_amdgcn_mfma_f32_16x16x32_bf16(bv[0][ks], a, o[m][0], 0, 0, 0);
                        o[m][1] = __builtin_amdgcn_mfma_f32_16x16x32_bf16(bv[1][ks], a, o[m][1], 0, 0, 0); }
                { const int ka = (int)(unsigned)(uintptr_t)(CB + L_K) + (8 * g + (li >> 2)) * RS + (4 * (li & 3)) * 2;
                  const LAS float* ebl = (const LAS float*)(lds + L_EBL + cb * 512);
#pragma unroll
                  for (int m = 0; m < 8; ++m) { s16x4 a0, a1, a2, a3;
#define HG_KT(m_) HG_TR(a0, ka, (m_) * 32); HG_TR(a1, ka, (m_) * 32 + 4 * RS); HG_TR(a2, ka, (m_) * 32 + 32 * RS); HG_TR(a3, ka, (m_) * 32 + 36 * RS)
                      switch (m) { case 0: HG_KT(0); break; case 1: HG_KT(1); break; case 2: HG_KT(2); break; case 3: HG_KT(3); break; case 4: HG_KT(4); break; case 5: HG_KT(5); break; case 6: HG_KT(6); break; default: HG_KT(7); break; }
#undef HG_KT
                      asm volatile("s_waitcnt lgkmcnt(0)" ::: "memory"); __builtin_amdgcn_sched_barrier(0);
                      const bf16x8 kt0 = (bf16x8){a0[0], a0[1], a0[2], a0[3], a1[0], a1[1], a1[2], a1[3]}, kt1 = (bf16x8){a2[0], a2[1], a2[2], a2[3], a3[0], a3[1], a3[2], a3[3]};
                      const f32x4v e = *(const LAS f32x4v*)(ebl + 16 * m + 4 * g);
#pragma unroll
                      for (int n = 0; n < 2; ++n) { S[m][n] = __builtin_amdgcn_mfma_f32_16x16x32_bf16(kt0, bv[n][0], S[m][n], 0, 0, 0);
                          S[m][n] = __builtin_amdgcn_mfma_f32_16x16x32_bf16(kt1, bv[n][1], S[m][n], 0, 0, 0);
                          S[m][n] = S[m][n] * e; } } }
#pragma unroll
                for (int m = 0; m < 4; ++m)
#pragma unroll
                    for (int n = 0; n < 2; ++n)
                        *(LAS v2u*)(lds + L_O + (16 * m + li) * RS + (16 * (2 * rw + n) + 4 * g) * 2) = (v2u){cvtpk(o[m][n][0], o[m][n][1]), cvtpk(o[m][n][2], o[m][n][3])};
                }
                HG_BAR();
            }
        }
        LDS_WAIT();
        __syncthreads();
#undef HG_LOAD
#undef HG_PREP
    }
}
#undef HG_TR
#undef HG_C8
#undef HG_BAR
}

struct Args { const float* in[14]; float* out; unsigned char* ws; int ph_lo, ph_hi; };
#ifndef CONV_IN_SCAN
#define CONV_IN_SCAN 1
#endif
#ifndef MK_N_LAUNCHES
#define MK_N_LAUNCHES 1
#endif
constexpr int MISC_OFF = LDS_BYTES - 64;
constexpr int N_PHASES = 10;
__global__ void __launch_bounds__(NTHREADS, 2) mk_fwd(Args args) {
    extern __shared__ __attribute__((aligned(16))) unsigned char lds[];
    Frame F;
    F.lds = (LAS unsigned char*)lds;
    F.wave = __builtin_amdgcn_readfirstlane((int)threadIdx.x >> 6); F.lane = lane_id(); F.tid = F.wave * 64 + F.lane;
    F.G = gridDim.x; F.gw = blockIdx.x * NWAVES + F.wave; F.NGW = F.G * NWAVES;
    F.x = args.in[0]; F.norm_g = args.in[1]; F.rel = args.in[2]; F.w_in = args.in[3]; F.pe = args.in[4]; F.cw1 = args.in[5]; F.cw2 = args.in[6]; F.w_out = args.in[7];
    F.h_in = args.in[8]; F.h_lb = args.in[9]; F.h_on = args.in[10]; F.h_out = args.in[11]; F.up = args.in[12]; F.dn = args.in[13];
    F.out = args.out; F.ws = args.ws;
    unsigned char* ws = args.ws;
    bf16* A = (bf16*)(ws + WS_A); bf16* BIG = (bf16*)(ws + WS_BIG); bf16* X16 = (bf16*)(ws + WS_X16);
    const int lo = args.ph_lo, hi = args.ph_hi;
    if (F.tid < 4) ((LAS unsigned*)(F.lds + MISC_OFF))[F.tid] = 0u;
    __syncthreads();
    XcdBarrier bar; bar.wave = F.wave; bar.bar = (unsigned*)(ws + WS_CTL) + 1024; bar.x = 0; bar.st = nullptr;
    if (hi - lo > 1) bar = xcd_barrier_post((unsigned*)(ws + WS_CTL) + 1024, (volatile LAS unsigned*)(F.lds + MISC_OFF), F.wave);
#define IN(k) (lo <= (k) && (k) < hi)
#define PH_FENCE() do { F.lane = lane_id(); F.tid = F.wave * 64 + F.lane; } while (0)
#define SEAM(k) do { if (IN(k) && IN((k) + 1)) xcd_barrier(bar); } while (0)
#define GEMM_PHASE_M(ACT, Ap, Btp, MR_, N_, K_, Op, ldc_, st_, sc_, rs_) do { pg8::Gemm g{(Ap), (Btp), (MR_), (N_), (K_)}; pg8::StaticOrder S; S.init((MR_), (N_), F.G, (int)blockIdx.x); \
        EpiAct<ACT> E{(Op), (ldc_), (st_), (sc_), (const float*)(ws + WS_LB), (rs_), 1.f}; pg8::gemm_phase<EpiAct<ACT>, pg8::StaticOrder, true, true>(F.lds, g, S, E, F.tid); } while (0)
#define GEMM_PHASE(ACT, Ap, Btp, N_, K_, Op, ldc_, st_, sc_, rs_) GEMM_PHASE_M(ACT, Ap, Btp, M, N_, K_, Op, ldc_, st_, sc_, rs_)
#define PANEL_SQL(e_, ro_) PanelSqLast{(float*)(ws + WS_SLOTS) + ((size_t)(e_) * M + (ro_)) * 8, (unsigned*)(ws + WS_CTL) + CW_PANEL + ((e_) * 64 + (ro_) / 256) * 64, (float*)(ws + WS_RINV) + (ro_)}
#define PANEL_SQ(e_, ro_) PanelSq{(float*)(ws + WS_SLOTS) + ((size_t)(e_) * M + (ro_)) * 8, (unsigned*)(ws + WS_CTL) + CW_PANEL + ((e_) * 64 + (ro_) / 256) * 64, (unsigned*)(ws + WS_CTL) + CW_XTMO}
#define GEMM_FUSED(XF32_, FINAL_, W8_, F8_, Ap, Btp, K_, osc_, ro_, xoldp, gp, e1_, e2_) GEMM_FUSED8(XF32_, FINAL_, W8_, F8_, Ap, Btp, K_, osc_, ro_, xoldp, gp, e1_, e2_, WS_X8)
#define GEMM_FUSED8(XF32_, FINAL_, W8_, F8_, Ap, Btp, K_, osc_, ro_, xoldp, gp, e1_, e2_, X8OFF_) do { pg8::Gemm g{(Ap), (Btp), M / 2, DM, (K_)}; pg8::StaticOrder S; S.init(M / 2, DM, F.G, (int)blockIdx.x); \
        EpiRmsRes<XF32_, FINAL_, W8_> E{(const void*)(xoldp), X16 + (size_t)(ro_) * DM, F.out + (size_t)(ro_) * DM, (gp), ws + (X8OFF_) + (size_t)(ro_) * DM, (osc_), PANEL_SQ(e1_, ro_), PANEL_SQL(e2_, ro_)}; \
        pg8::gemm_phase<EpiRmsRes<XF32_, FINAL_, W8_>, pg8::StaticOrder, false, true, F8_>(F.lds, g, S, E, F.tid); } while (0)
#define MLP_FULL_F(FINAL_, WUP, WDN, gp, e1_, e2_) do { { pg8::Gemm g{(const bf16*)(ws + WS_X8), (const bf16*)(ws + (WUP)), M, FF, DM / 2}; pg8::StaticOrder S; S.init(M, FF, F.G, (int)blockIdx.x); \
        EpiUp8 E{ws + WS_BIG, FF, (const float*)(ws + WS_RINV)}; pg8::gemm_phase<EpiUp8, pg8::StaticOrder, true, true, true>(F.lds, g, S, E, F.tid); } xcd_barrier(bar); PH_FENCE(); \
        GEMM_FUSED8(false, FINAL_, !(FINAL_), true, BIG, (const bf16*)(ws + (WDN)), FF / 2, 1.f / (W8SCALE * H8SCALE), 0, X16, gp, e1_, e2_, WS_A); __syncthreads(); PH_FENCE(); \
        GEMM_FUSED8(false, FINAL_, !(FINAL_), true, (const bf16*)(ws + WS_BIG + (size_t)(M / 2) * FF), (const bf16*)(ws + (WDN)), FF / 2, 1.f / (W8SCALE * H8SCALE), M / 2, X16 + (size_t)(M / 2) * DM, gp, e1_, e2_, WS_A); } while (0)

    if (IN(0)) { PH_FENCE(); p0_prologue(F); } SEAM(0);
    if (IN(1)) { PH_FENCE(); GEMM_PHASE(0, X16, (const bf16*)(ws + W0_QKV), NQKV, DM, BIG, NQKV, 8, QSCALE, (const float*)(ws + WS_RINV)); } SEAM(1);
    if (IN(2)) { PH_FENCE(); cg::cmp_gate_phase(F.lds, ws, F.G, F.tid); } SEAM(2);
    if (IN(3)) { PH_FENCE(); nsa::nsa_phase(F.lds, ws, F.G, F.tid); } SEAM(3);
    if (IN(4)) { PH_FENCE(); GEMM_FUSED(false, false, true, true, (const bf16*)(ws + WS_A), (const bf16*)(ws + W0_O), DM / 2, 1.f / (W8SCALE * N8SCALE), 0, X16, F.norm_g + 1 * DM, 0, 1); __syncthreads(); PH_FENCE();
                 GEMM_FUSED(false, false, true, true, (const bf16*)(ws + WS_A + (size_t)(M / 2) * DM), (const bf16*)(ws + W0_O), DM / 2, 1.f / (W8SCALE * N8SCALE), M / 2, X16 + (size_t)(M / 2) * DM, F.norm_g + 1 * DM, 0, 1); } SEAM(4);
    if (IN(5)) { PH_FENCE(); MLP_FULL_F(false, W0_UP, W0_DN, F.norm_g + 3 * DM, 2, 3); __syncthreads(); PH_FENCE(); p_convert_l1a(F); } SEAM(5);
    if (IN(6)) { PH_FENCE(); pg8::Gemm g{(const bf16*)(ws + WS_A), (const bf16*)(ws + W1_IN), M, FF, DM / 2}; pg8::RotOrder S; S.init(M, FF, F.G, (int)blockIdx.x);
                 EpiAct<2> E{BIG, FF, 0, 1.f, (const float*)(ws + WS_LB), (const float*)(ws + WS_RINV), 1.f / W8SCALE}; pg8::gemm_phase<EpiAct<2>, pg8::RotOrder, true, true, true>(F.lds, g, S, E, F.tid); } SEAM(6);
    if (IN(7)) { PH_FENCE(); const int nstat = (F.G - BATCH * NH) * NWAVES;
                 if ((int)blockIdx.x >= BATCH * NH) p_convert_l1b(F, ((int)blockIdx.x - BATCH * NH) * NWAVES + F.wave, nstat);
                 else { hg::scan_phase(F.lds, ws, F.h_on, F.G, F.tid); PH_FENCE(); p_convert_l1b(F, -1, nstat); } } SEAM(7);
    if (IN(8)) { PH_FENCE(); GEMM_FUSED(false, false, true, true, (const bf16*)(ws + WS_A), (const bf16*)(ws + W1_O), DM / 2, 1.f / (W8SCALE * A8SCALE), 0, X16, F.norm_g + 5 * DM, 4, 5); __syncthreads(); PH_FENCE();
                 GEMM_FUSED(false, false, true, true, (const bf16*)(ws + WS_A + (size_t)(M / 2) * DM), (const bf16*)(ws + W1_O), DM / 2, 1.f / (W8SCALE * A8SCALE), M / 2, X16 + (size_t)(M / 2) * DM, F.norm_g + 5 * DM, 4, 5); } SEAM(8);
    if (IN(9)) { PH_FENCE(); MLP_FULL_F(true, W1_UP, W1_DN, F.norm_g + 7 * DM, 6, 7); }
#undef IN
}

extern "C" void kernel_launch(void* const* d_in, const int* in_sizes, int n_in, void* d_out, int out_size, void* d_ws, size_t ws_size, hipStream_t stream) {
    static int grid = 0;
    if (grid == 0) {
        if (n_in != 14 || in_sizes[0] != M * DM || out_size != M * DM || ws_size < WS_END) { fprintf(stderr, "kernel_launch: unexpected shapes (n_in %d, ws %zu)\n", n_in, ws_size); grid = -1; return; }
        int dev = 0, cus = 0;
        if (hipGetDevice(&dev) != hipSuccess || hipDeviceGetAttribute(&cus, hipDeviceAttributeMultiprocessorCount, dev) != hipSuccess) { grid = -1; return; }
        if (hipFuncSetAttribute((const void*)mk_fwd, hipFuncAttributeMaxDynamicSharedMemorySize, LDS_BYTES) != hipSuccess) { fprintf(stderr, "kernel_launch: hipFuncSetAttribute failed\n"); grid = -1; return; }
        (void)hipGetLastError();
        if (cus < 256) { fprintf(stderr, "kernel_launch: this kernel needs 256 co-resident workgroups (one per CU); the device has %d CUs\n", cus); grid = -1; return; }
        grid = 256;
    }
    if (grid < 0) return;
    Args a{};
    for (int i = 0; i < 14; ++i) a.in[i] = (const float*)d_in[i];
    a.out = (float*)d_out; a.ws = (unsigned char*)d_ws;
    if (hipMemsetAsync((char*)d_ws + WS_CTL, 0, CTL_ZERO_BYTES, stream) != hipSuccess) return;
    if (MK_N_LAUNCHES == 1) { a.ph_lo = 0; a.ph_hi = N_PHASES; hipLaunchKernelGGL(mk_fwd, dim3(grid), dim3(NTHREADS), LDS_BYTES, stream, a); }
    else for (int p = 0; p < N_PHASES; ++p) { a.ph_lo = p; a.ph_hi = p + 1; hipLaunchKernelGGL(mk_fwd, dim3(grid), dim3(NTHREADS), LDS_BYTES, stream, a); }
}
```
